# Optimizing an MI355X kernel written in HIP

```python
import math
import jax, jax.numpy as jnp
from jax import lax
import numpy as np

D_MODEL = 1024
BATCH = 8
SEQ = 2048
DEPTH = 1
DEC_BATCH = 128
DEC_SEQ = 1
PAST_LEN = 16384
PAGE_SIZE = 128

D_CONV_A = D_MODEL
K_A = 3
EXPAND = 2
D_INNER = EXPAND * D_MODEL
HEAD_DIM = 64
N_HEADS = D_INNER // HEAD_DIM
N_GROUPS = 4
HEADS_PER_GROUP = N_HEADS // N_GROUPS
D_STATE = 128
K_B = 4
CHUNK = 128
D_XBC = D_INNER + 2 * N_GROUPS * D_STATE
D_FF = 4 * D_MODEL
EPS = 1e-6

_SECTION_WIDTHS = [D_CONV_A, D_CONV_A, D_CONV_A, D_INNER, D_XBC, N_HEADS, D_MODEL, D_MODEL]
SPLIT_POINTS = [int(v) for v in np.cumsum(_SECTION_WIDTHS)[:-1]]
D_IN_PROJ = int(sum(_SECTION_WIDTHS))

kernel_name = 'hybrid_shortconv_ssd_decoder_step'


def rmsnorm(x, g):
    xf = x.astype(jnp.float32)
    ms = jnp.mean(xf * xf, axis=-1, keepdims=True)
    return (xf * lax.rsqrt(ms + EPS) * g.astype(jnp.float32)).astype(x.dtype)


def group_rmsnorm(y, g):
    b, L, d = y.shape
    yf = y.astype(jnp.float32).reshape(b, L, N_GROUPS, d // N_GROUPS)
    ms = jnp.mean(yf * yf, axis=-1, keepdims=True)
    yn = (yf * lax.rsqrt(ms + EPS)).reshape(b, L, d)
    return (yn * g.astype(jnp.float32)).astype(y.dtype)


def causal_conv(u, prev, w, bias=None):
    K = w.shape[0]
    L = u.shape[1]
    full = jnp.concatenate([prev.astype(u.dtype), u], axis=1)
    out = full[:, 0:L] * w[0]
    for k in range(1, K):
        out = out + full[:, k:k + L] * w[k]
    if bias is not None:
        out = out + bias
    return out, full[:, L:]


def ssd(xh, dt, a, bm, cm, h0):
    b, L = xh.shape[0], xh.shape[1]
    q = min(CHUNK, L)
    nc = -(-L // q)
    pad = nc * q - L
    f32 = jnp.float32
    if pad:
        padt = lambda t: jnp.pad(t, [(0, 0), (0, pad)] + [(0, 0)] * (t.ndim - 2))
        xh, dt, bm, cm = padt(xh), padt(dt), padt(bm), padt(cm)
    G, R, P, N = N_GROUPS, HEADS_PER_GROUP, HEAD_DIM, D_STATE
    x = xh.reshape(b, nc, q, G, R, P).astype(f32)
    dtc = dt.reshape(b, nc, q, G, R)
    B = bm.reshape(b, nc, q, G, N).astype(f32)
    C = cm.reshape(b, nc, q, G, N).astype(f32)
    acs = jnp.cumsum(dtc * a.reshape(G, R), axis=2)
    acs_t = jnp.moveaxis(acs, 2, -1)
    seg = acs_t[..., :, None] - acs_t[..., None, :]
    causal = jnp.tril(jnp.ones((q, q), dtype=bool))
    lmat = jnp.exp(jnp.where(causal, seg, -jnp.inf))
    cb = jnp.einsum('bcqgn,bcsgn->bcgqs', C, B)
    wts = cb[:, :, :, None] * lmat * jnp.moveaxis(dtc, 2, -1)[..., None, :]
    y_diag = jnp.einsum('bcgrqs,bcsgrp->bcqgrp', wts, x)
    decay_end = jnp.exp(acs[:, :, -1:] - acs) * dtc
    states = jnp.einsum('bcsgn,bcsgr,bcsgrp->bcgrpn', B, decay_end, x)
    chunk_decay = jnp.exp(acs[:, :, -1])

    def step(h, inp):
        dec, st = inp
        return dec[..., None, None] * h + st, h

    h_last, h_in = lax.scan(step, h0.reshape(b, G, R, P, N).astype(f32),
                            (jnp.moveaxis(chunk_decay, 1, 0), jnp.moveaxis(states, 1, 0)))
    y_off = jnp.einsum('bcqgn,bcqgr,cbgrpn->bcqgrp', C, jnp.exp(acs), h_in)
    y = (y_diag + y_off).reshape(b, nc * q, N_HEADS, P)[:, :L]
    return y, h_last.reshape(b, N_HEADS, P, N)


def layer(x, c, st_a, st_bconv, st_ssm, w_ada, b_ada, norm1_g, w_in, conv_a_w, w_a_out,
          conv_b_w, conv_b_b, dt_bias, a_log, d_skip, ssm_norm_g, w_b_out, w_o,
          norm2_g, w_mlp1, w_mlp2):
    b_, L = x.shape[0], x.shape[1]
    mod = jax.nn.silu(c) @ w_ada + b_ada
    sh1, sc1, g1, sh2, sc2, g2 = jnp.split(mod[:, None, :], 6, axis=-1)
    u = rmsnorm(x, norm1_g) * (1 + sc1) + sh1
    proj = u @ w_in
    bgate, cgate, hval, z, xbc, dt_raw, ga, gb = jnp.split(proj, SPLIT_POINTS, axis=-1)
    conv_out, new_a = causal_conv(cgate * hval, st_a, conv_a_w)
    y_a = (bgate * conv_out) @ w_a_out
    xbc_c, new_bconv = causal_conv(xbc, st_bconv, conv_b_w, conv_b_b)
    xbc_c = jax.nn.silu(xbc_c)
    xs, bm, cm = jnp.split(xbc_c, [D_INNER, D_INNER + N_GROUPS * D_STATE], axis=-1)
    dt = jax.nn.softplus(dt_raw.astype(jnp.float32) + dt_bias.astype(jnp.float32))
    a = -jnp.exp(a_log.astype(jnp.float32))
    xh = xs.reshape(b_, L, N_HEADS, HEAD_DIM)
    y_s, new_ssm = ssd(xh, dt, a, bm.reshape(b_, L, N_GROUPS, D_STATE),
                       cm.reshape(b_, L, N_GROUPS, D_STATE), st_ssm)
    y_s = y_s + d_skip.astype(jnp.float32)[:, None] * xh.astype(jnp.float32)
    y_s = y_s.reshape(b_, L, D_INNER).astype(x.dtype) * jax.nn.silu(z)
    y_b = group_rmsnorm(y_s, ssm_norm_g) @ w_b_out
    merged = jax.nn.sigmoid(ga) * y_a + jax.nn.sigmoid(gb) * y_b
    x = x + g1 * (merged @ w_o)
    u2 = rmsnorm(x, norm2_g) * (1 + sc2) + sh2
    hmid = jnp.square(jax.nn.relu(u2 @ w_mlp1))
    x = x + g2 * (hmid @ w_mlp2)
    return x, new_a.astype(st_a.dtype), new_bconv.astype(st_bconv.dtype), new_ssm.astype(st_ssm.dtype)


def setup_inputs(seed: int = 0) -> dict:
    key = jax.random.key(seed)
    ks = jax.random.split(key, 32)
    f32 = jnp.float32

    def nrm(k, shape, scale):
        return jax.random.normal(k, shape, f32) * scale

    Ld = DEPTH
    dt0 = jnp.exp(jax.random.uniform(ks[10], (Ld, N_HEADS), f32, math.log(1e-3), math.log(1e-1)))
    return {
        'x_prompt': nrm(ks[0], (BATCH, SEQ, D_MODEL), 1.0),
        'x_sample': nrm(ks[1], (DEC_BATCH, DEC_SEQ, D_MODEL), 1.0),
        'c_prompt': nrm(ks[2], (BATCH, D_MODEL), 1.0),
        'c_sample': nrm(ks[3], (DEC_BATCH, D_MODEL), 1.0),
        'state_shortconv': nrm(ks[4], (Ld, DEC_BATCH, K_A - 1, D_CONV_A), 1.0),
        'state_ssm_conv': nrm(ks[5], (Ld, DEC_BATCH, K_B - 1, D_XBC), 1.0),
        'state_ssm': nrm(ks[6], (Ld, DEC_BATCH, N_HEADS, HEAD_DIM, D_STATE), 0.5),
        'w_ada': nrm(ks[7], (Ld, D_MODEL, 6 * D_MODEL), 0.5 * D_MODEL ** -0.5),
        'b_ada': nrm(ks[8], (Ld, 6 * D_MODEL), 0.02),
        'norm1_g': 1.0 + nrm(ks[9], (Ld, D_MODEL), 0.05),
        'w_in': nrm(ks[11], (Ld, D_MODEL, D_IN_PROJ), D_MODEL ** -0.5),
        'conv_a_w': nrm(ks[12], (Ld, K_A, D_CONV_A), K_A ** -0.5),
        'w_a_out': nrm(ks[13], (Ld, D_CONV_A, D_MODEL), D_CONV_A ** -0.5),
        'conv_b_w': nrm(ks[14], (Ld, K_B, D_XBC), K_B ** -0.5),
        'conv_b_b': nrm(ks[15], (Ld, D_XBC), 0.02),
        'dt_bias': dt0 + jnp.log(-jnp.expm1(-dt0)),
        'a_log': jnp.log(jax.random.uniform(ks[16], (Ld, N_HEADS), f32, 1.0, 16.0)),
        'd_skip': 1.0 + nrm(ks[17], (Ld, N_HEADS), 0.1),
        'ssm_norm_g': 1.0 + nrm(ks[18], (Ld, D_INNER), 0.05),
        'w_b_out': nrm(ks[19], (Ld, D_INNER, D_MODEL), D_INNER ** -0.5),
        'w_o': nrm(ks[20], (Ld, D_MODEL, D_MODEL), D_MODEL ** -0.5),
        'norm2_g': 1.0 + nrm(ks[21], (Ld, D_MODEL), 0.05),
        'w_mlp1': nrm(ks[22], (Ld, D_MODEL, D_FF), D_MODEL ** -0.5),
        'w_mlp2': nrm(ks[23], (Ld, D_FF, D_MODEL), D_FF ** -0.5),
        'norm_f_g': 1.0 + nrm(ks[24], (D_MODEL,), 0.05),
    }


def reference(x_prompt, x_sample, c_prompt, c_sample, state_shortconv, state_ssm_conv, state_ssm,
              w_ada, b_ada, norm1_g, w_in, conv_a_w, w_a_out, conv_b_w, conv_b_b, dt_bias, a_log,
              d_skip, ssm_norm_g, w_b_out, w_o, norm2_g, w_mlp1, w_mlp2, norm_f_g):
    yp, ys = x_prompt, x_sample
    bp = x_prompt.shape[0]
    pa, pbc, ps, sa, sbc, ss = [], [], [], [], [], []
    for l in range(DEPTH):
        lw = (w_ada[l], b_ada[l], norm1_g[l], w_in[l], conv_a_w[l], w_a_out[l], conv_b_w[l],
              conv_b_b[l], dt_bias[l], a_log[l], d_skip[l], ssm_norm_g[l], w_b_out[l], w_o[l],
              norm2_g[l], w_mlp1[l], w_mlp2[l])
        z_a = jnp.zeros((bp, K_A - 1, D_CONV_A), state_shortconv.dtype)
        z_bc = jnp.zeros((bp, K_B - 1, D_XBC), state_ssm_conv.dtype)
        z_s = jnp.zeros((bp, N_HEADS, HEAD_DIM, D_STATE), state_ssm.dtype)
        yp, na, nbc, ns = layer(yp, c_prompt, z_a, z_bc, z_s, *lw)
        pa.append(na); pbc.append(nbc); ps.append(ns)
        ys, na, nbc, ns = layer(ys, c_sample, state_shortconv[l], state_ssm_conv[l], state_ssm[l], *lw)
        sa.append(na); sbc.append(nbc); ss.append(ns)
    y_prompt = rmsnorm(yp, norm_f_g)
    y_sample = rmsnorm(ys, norm_f_g)
    return (y_prompt, y_sample, jnp.stack(pa), jnp.stack(pbc), jnp.stack(ps),
            jnp.stack(sa), jnp.stack(sbc), jnp.stack(ss))
```

```cpp
#include <hip/hip_runtime.h>
#include <hip/hip_cooperative_groups.h>
#include <cstdio>
#include <cstdint>
namespace cg = cooperative_groups;

#define LAS __attribute__((address_space(3)))
typedef unsigned short bf16_t;
typedef short bf16x8 __attribute__((ext_vector_type(8)));
typedef short bf16x4 __attribute__((ext_vector_type(4)));
typedef float f32x4 __attribute__((ext_vector_type(4)));
typedef float f32x2 __attribute__((ext_vector_type(2)));
typedef unsigned u32x4 __attribute__((ext_vector_type(4)));
typedef unsigned u32x2 __attribute__((ext_vector_type(2)));

constexpr int D = 1024, NBP = 8, SEQ = 2048, MP = NBP * SEQ, NBS = 128, MTOT = MP + NBS, MPAD = 16640;
constexpr int DINP = 10496, DINNER = 2048, DXBC = 3072, NH = 32, HD = 64, DS = 128, DFF = 4096, DIN = 10272;
constexpr float EPS = 1e-6f;
constexpr size_t O_YP = 0, O_YS = 16777216, O_SCP = 16908288, O_SBP = 16924672, O_SSP = 16998400, O_SCS = 19095552, O_SBS = 19357696, O_SSS = 20537344;
constexpr size_t S1 = (size_t)MPAD * 1024 * 2;
constexpr size_t OFF_WADA = 0, OFF_WIN = 12582912, OFF_WAOUT = 34078720, OFF_WBOUT = 36175872, OFF_WO = 40370176, OFF_W1 = 42467328, OFF_W2 = 50855936,
                 OFF_CA = 59244544, OFF_MOD = 59768832, OFF_DTRAW = 66060288, OFF_DTP = 68190208, OFF_ACS = 70320128, OFF_SSQ = 72450048, OFF_U = 74579968,
                 OFF_R1 = OFF_U + S1, OFF_BG = OFF_R1, OFF_CI = OFF_R1 + S1, OFF_Z = OFF_R1 + 2 * S1, OFF_XBC = OFF_R1 + 4 * S1, OFF_GA = OFF_R1 + 7 * S1, OFF_GB = OFF_R1 + 8 * S1,
                 OFF_R2 = OFF_R1 + 9 * S1, WS_END = OFF_R2 + 3 * S1;
constexpr size_t OFF_VA = OFF_U, OFF_YA = OFF_BG, OFF_MERGED = OFF_CI, OFF_YG = OFF_XBC, OFF_HMID = OFF_R1, OFF_XBCC = OFF_R2, OFF_X1 = OFF_R2;

struct Params {
    const float* in[25];
    float* out;
    unsigned char* ws;
};
enum { I_XP = 0, I_XS, I_CP, I_CS, I_STA, I_STB, I_STS, I_WADA, I_BADA, I_N1G, I_WIN, I_CAW, I_WAOUT, I_CBW, I_CBB, I_DTB, I_ALOG, I_DSKIP, I_SNG, I_WBOUT, I_WO, I_N2G, I_W1, I_W2, I_NFG };

__device__ __forceinline__ unsigned cvt_pk_bf16(float lo, float hi) { unsigned r; asm volatile("v_cvt_pk_bf16_f32 %0, %1, %2" : "=v"(r) : "v"(lo), "v"(hi)); return r; }
__device__ __forceinline__ bf16_t f2bf(float f) { unsigned u = __float_as_uint(f); u += 0x7FFFu + ((u >> 16) & 1u); return (bf16_t)(u >> 16); }
__device__ __forceinline__ float bf2f(bf16_t b) { return __uint_as_float(((unsigned)b) << 16); }
__device__ __forceinline__ float bflo(unsigned u) { return __uint_as_float(u << 16); }
__device__ __forceinline__ float bfhi(unsigned u) { return __uint_as_float(u & 0xffff0000u); }
__device__ __forceinline__ float sigmoidf_(float x) { return __builtin_amdgcn_rcpf(1.f + __expf(-x)); }
__device__ __forceinline__ float siluf_(float x) { return x * sigmoidf_(x); }
__device__ __forceinline__ float wave_sum(float v) {
#pragma unroll
    for (int o = 1; o < 64; o <<= 1) v += __shfl_xor(v, o);
    return v;
}

namespace pg8 {
#define PG8_LAS __attribute__((address_space(3)))
constexpr int BM = 256, BK = 64, HALF = 128, HTB = HALF * BK * 2, STAGE_BYTES = 8 * HTB, NXCD = 8, WGM = 8;
__host__ __device__ __forceinline__ int lds_byte(int r, int c) { const int st = (r >> 4) * 2 + (c >> 5), rr = r & 15, cc = c & 31, ob = rr * 64 + cc * 2; return st * 1024 + (ob ^ (((ob >> 9) & 1) << 5)); }
__host__ __device__ __forceinline__ void stage_rc(int b, int& R, int& C) { const int st = b / 1024, sb = b % 1024, swz = sb ^ (((sb >> 9) & 1) << 5); R = (st >> 1) * 16 + swz / 64; C = (st & 1) * 32 + (swz % 64) / 2; }
__host__ __device__ __forceinline__ int perm32(int rho) { const int n = rho >> 4, i = rho & 15; return 8 * (i >> 2) + 4 * n + (i & 3); }
struct Unit { int pm, pn; };
struct Gemm { const bf16_t* A; const bf16_t* Bt; int M, N, K; };
struct StaticOrder {
    int nM, nN, nwg, G, c;
    __host__ __device__ void init(int M, int N, int G_, int c_) { nM = M / BM; nN = N / BM; nwg = nM * nN; G = G_; c = c_; }
    __host__ __device__ bool next(int i, Unit& u) const {
        const long L = (long)i * G + c; if (L >= nwg) return false;
        int wgid = (int)L; { const int q = nwg / NXCD, r = nwg % NXCD, xcd = wgid % NXCD, off = wgid / NXCD; wgid = (xcd < r ? xcd * (q + 1) : r * (q + 1) + (xcd - r) * q) + off; }
        const int nig = WGM * nN, gid = wgid / nig, fm = gid * WGM, gsz = (nM - fm) < WGM ? (nM - fm) : WGM;
        u.pm = fm + ((wgid % nig) % gsz); u.pn = (wgid % nig) / gsz; return true;
    }
    __device__ __forceinline__ void a_ready(const Unit&) const {}
    __device__ __forceinline__ void done(const Unit&) const {}
};

template <class Epi, class Sched, bool ALIGN_EPI = false, bool SP2 = false>
__device__ __forceinline__ void gemm_phase(PG8_LAS unsigned char* lds, const Gemm g, const Sched& S, const Epi& E) {
    const int tid = threadIdx.x, wid = __builtin_amdgcn_readfirstlane(tid >> 6), lane = tid & 63, wr = wid >> 2, wc = wid & 3, fr = lane & 15, fq = lane >> 4;
    const int K = g.K, nt = K / BK;
    unsigned voffA[2], voffB[2];
#pragma unroll
    for (int i = 0; i < 2; ++i) { int R, C; stage_rc(tid * 16 + i * 8192, R, C); const int Rb = Epi::PERM ? ((R & ~31) + perm32(R & 31)) : R;
        voffA[i] = (unsigned)(R * K + C) * 2u; voffB[i] = (unsigned)(Rb * K + C) * 2u; }
    const size_t kstep = (size_t)(BK * 2);
    const size_t hstep = (size_t)HALF * K * 2;
    const size_t tstep = 2 * hstep;
    const unsigned ldsw = (unsigned)wid * 1024u;
    const int aoff = lds_byte(wr * 64 + fr, fq * 8), boff = lds_byte(wc * 32 + fr, fq * 8);
#define PG8_SA(b, h) (((b) * 2 + (h)) * HTB)
#define PG8_SB(b, h) ((4 + (b) * 2 + (h)) * HTB)
#define PG8_STAGE(bufoff, gbase, voff) do { _Pragma("unroll") for (int _i = 0; _i < 2; ++_i) \
        __builtin_amdgcn_global_load_lds((const unsigned*)((const char*)(gbase) + (voff)[_i]), (PG8_LAS unsigned*)(lds + (bufoff) + ldsw + _i * 8192), 16, 0, 0); } while (0)
#define PG8_LDA(dst, b, h) do { _Pragma("unroll") for (int m = 0; m < 4; ++m) _Pragma("unroll") for (int k = 0; k < 2; ++k) dst[m][k] = *(const PG8_LAS bf16x8*)(lds + PG8_SA(b, h) + aoff + m * 2048 + k * 1024); } while (0)
#define PG8_LDB(dst, b, h) do { _Pragma("unroll") for (int n = 0; n < 2; ++n) _Pragma("unroll") for (int k = 0; k < 2; ++k) dst[n][k] = *(const PG8_LAS bf16x8*)(lds + PG8_SB(b, h) + boff + n * 2048 + k * 1024); } while (0)
#define PG8_MMA(ai, bj, At, Bt) do { __builtin_amdgcn_s_setprio(1); _Pragma("unroll") for (int m = 0; m < 4; ++m) _Pragma("unroll") for (int n = 0; n < 2; ++n) _Pragma("unroll") for (int k = 0; k < 2; ++k) \
        acc[ai][bj][m][n] = __builtin_amdgcn_mfma_f32_16x16x32_bf16(Bt[n][k], At[m][k], acc[ai][bj][m][n], 0, 0, 0); __builtin_amdgcn_s_setprio(0); } while (0)
#define PG8_WAIT_V(n) asm volatile("s_waitcnt vmcnt(" #n ")" ::: "memory")
#define PG8_WAIT_L(n) asm volatile("s_waitcnt lgkmcnt(" #n ")" ::: "memory")
#define PG8_BAR __builtin_amdgcn_s_barrier()
#define PG8_SCHED __builtin_amdgcn_sched_barrier(0)
    Unit cur, nxt; int ui = 0;
    if (!S.next(0, cur)) return;
    f32x4 acc[2][2][4][2];
#pragma unroll
    for (int a = 0; a < 2; ++a)
#pragma unroll
        for (int b = 0; b < 2; ++b)
#pragma unroll
            for (int m = 0; m < 4; ++m)
#pragma unroll
                for (int n = 0; n < 2; ++n) acc[a][b][m][n] = (f32x4){0.f, 0.f, 0.f, 0.f};
    bf16x8 At[4][2], B0[2][2], B1[2][2];
    const char* cA = (const char*)g.A + (size_t)cur.pm * tstep; const char* cB = (const char*)g.Bt + (size_t)cur.pn * tstep;
    S.a_ready(cur);
    if constexpr (SP2) {
        PG8_STAGE(PG8_SB(0, 0), cB, voffB); PG8_STAGE(PG8_SB(0, 1), cB + hstep, voffB); PG8_STAGE(PG8_SA(0, 0), cA, voffA); PG8_STAGE(PG8_SA(0, 1), cA + hstep, voffA);
        if (wr == 1) PG8_BAR;
        PG8_WAIT_V(2); PG8_BAR;
        PG8_STAGE(PG8_SB(1, 0), cB + kstep, voffB); PG8_STAGE(PG8_SA(1, 0), cA + kstep, voffA); PG8_STAGE(PG8_SB(1, 1), cB + hstep + kstep, voffB);
        PG8_WAIT_V(6); PG8_BAR;
    } else {
        PG8_STAGE(PG8_SB(0, 0), cB, voffB); PG8_STAGE(PG8_SA(0, 0), cA, voffA); PG8_STAGE(PG8_SB(0, 1), cB + hstep, voffB); PG8_STAGE(PG8_SA(0, 1), cA + hstep, voffA);
        if (wr == 1) PG8_BAR;
        PG8_WAIT_V(4); PG8_BAR;
        PG8_STAGE(PG8_SB(1, 0), cB + kstep, voffB); PG8_STAGE(PG8_SA(1, 0), cA + kstep, voffA); PG8_STAGE(PG8_SB(1, 1), cB + hstep + kstep, voffB);
        PG8_WAIT_V(6); PG8_BAR;
    }
    for (;;) {
        const bool has_next = S.next(ui + 1, nxt);
        const char* nA = has_next ? (const char*)g.A + (size_t)nxt.pm * tstep : cA; const char* nB = has_next ? (const char*)g.Bt + (size_t)nxt.pn * tstep : cB;
        for (int t = 0; t < nt; t += 2) {
            const bool last = (t == nt - 2);
            const char* a1 = cA + (size_t)(t + 1) * kstep;
            const char* a2 = last ? nA : cA + (size_t)(t + 2) * kstep; const char* b2 = last ? nB : cB + (size_t)(t + 2) * kstep;
            const char* a3 = a2 + kstep; const char* b3 = b2 + kstep;
            if (last && has_next) S.a_ready(nxt);
            if constexpr (SP2) {
            PG8_LDB(B0, 0, 0); PG8_LDB(B1, 0, 1); PG8_SCHED; PG8_LDA(At, 0, 0); PG8_STAGE(PG8_SA(1, 1), a1 + hstep, voffA);
            PG8_WAIT_V(8); PG8_WAIT_L(0); PG8_BAR; PG8_MMA(0, 0, At, B0); PG8_MMA(0, 1, At, B1); PG8_BAR; PG8_SCHED;
            PG8_LDA(At, 0, 1); PG8_STAGE(PG8_SB(0, 0), b2, voffB); PG8_STAGE(PG8_SB(0, 1), b2 + hstep, voffB); PG8_STAGE(PG8_SA(0, 0), a2, voffA);
            PG8_WAIT_V(8); PG8_WAIT_L(0); PG8_BAR; PG8_MMA(1, 0, At, B0); PG8_MMA(1, 1, At, B1); PG8_BAR; PG8_SCHED;
            PG8_LDB(B0, 1, 0); PG8_LDB(B1, 1, 1); PG8_SCHED; PG8_LDA(At, 1, 0); PG8_STAGE(PG8_SA(0, 1), a2 + hstep, voffA);
            PG8_WAIT_V(8); PG8_WAIT_L(0); PG8_BAR; PG8_MMA(0, 0, At, B0); PG8_MMA(0, 1, At, B1); PG8_BAR; PG8_SCHED;
            PG8_LDA(At, 1, 1); PG8_STAGE(PG8_SB(1, 0), b3, voffB); PG8_STAGE(PG8_SB(1, 1), b3 + hstep, voffB); PG8_STAGE(PG8_SA(1, 0), a3, voffA);
            PG8_WAIT_V(8); PG8_WAIT_L(0); PG8_BAR; PG8_MMA(1, 0, At, B0); PG8_MMA(1, 1, At, B1); PG8_BAR; PG8_SCHED;
            } else {
            PG8_LDB(B0, 0, 0); PG8_SCHED; PG8_LDA(At, 0, 0); PG8_STAGE(PG8_SA(1, 1), a1 + hstep, voffA);
            PG8_WAIT_L(8); PG8_BAR; PG8_WAIT_L(0); PG8_MMA(0, 0, At, B0); PG8_BAR; PG8_SCHED;
            PG8_LDB(B1, 0, 1); PG8_STAGE(PG8_SB(0, 0), b2, voffB);
            PG8_BAR; PG8_WAIT_L(0); PG8_MMA(0, 1, At, B1); PG8_BAR;
            PG8_LDA(At, 0, 1); PG8_STAGE(PG8_SA(0, 0), a2, voffA);
            PG8_BAR; PG8_WAIT_L(0); PG8_MMA(1, 0, At, B0); PG8_BAR; PG8_SCHED;
            PG8_STAGE(PG8_SB(0, 1), b2 + hstep, voffB);
            PG8_WAIT_V(6); PG8_BAR; PG8_MMA(1, 1, At, B1); PG8_BAR;
            PG8_LDB(B0, 1, 0); PG8_SCHED; PG8_LDA(At, 1, 0); PG8_STAGE(PG8_SA(0, 1), a2 + hstep, voffA);
            PG8_WAIT_L(8); PG8_BAR; PG8_WAIT_L(0); PG8_MMA(0, 0, At, B0); PG8_BAR; PG8_SCHED;
            PG8_LDB(B1, 1, 1); PG8_STAGE(PG8_SB(1, 0), b3, voffB);
            PG8_BAR; PG8_WAIT_L(0); PG8_MMA(0, 1, At, B1); PG8_BAR;
            PG8_LDA(At, 1, 1); PG8_STAGE(PG8_SA(1, 0), a3, voffA);
            PG8_BAR; PG8_WAIT_L(0); PG8_MMA(1, 0, At, B0); PG8_BAR; PG8_SCHED;
            PG8_STAGE(PG8_SB(1, 1), b3 + hstep, voffB);
            PG8_WAIT_V(6); PG8_BAR; PG8_MMA(1, 1, At, B1); PG8_BAR;
            }
        }
        if constexpr (ALIGN_EPI) { if (wr == 0) PG8_BAR; }
        E(acc, cur, wr, wc, fr, fq);
        if (!has_next) break;
#pragma unroll
        for (int a = 0; a < 2; ++a)
#pragma unroll
            for (int b = 0; b < 2; ++b)
#pragma unroll
                for (int m = 0; m < 4; ++m)
#pragma unroll
                    for (int n = 0; n < 2; ++n) acc[a][b][m][n] = (f32x4){0.f, 0.f, 0.f, 0.f};
        cur = nxt; cA = nA; cB = nB; ++ui;
        if constexpr (ALIGN_EPI) { if (wr == 1) PG8_BAR; }
    }
    PG8_WAIT_V(0);
    if constexpr (!ALIGN_EPI) { if (wr == 0) PG8_BAR; }
    PG8_BAR;
#undef PG8_SA
#undef PG8_SB
#undef PG8_STAGE
#undef PG8_LDA
#undef PG8_LDB
#undef PG8_MMA
#undef PG8_WAIT_V
#undef PG8_WAIT_L
#undef PG8_BAR
#undef PG8_SCHED
}
}
using pg8::Unit;
typedef f32x4 AccT[2][2][4][2];

struct EpiF32Bias {
    static constexpr bool PERM = false;
    float* C; int ldc; const float* bias;
    __device__ __forceinline__ void operator()(const AccT& acc, const Unit& u, int wr, int wc, int fr, int fq) const {
        const int row0 = u.pm * 256 + wr * 64 + fr, col0 = u.pn * 256 + wc * 32 + 4 * fq;
#pragma unroll
        for (int ai = 0; ai < 2; ++ai)
#pragma unroll
            for (int m = 0; m < 4; ++m) { float* rowp = C + (size_t)(row0 + ai * 128 + m * 16) * ldc + col0;
#pragma unroll
                for (int bj = 0; bj < 2; ++bj)
#pragma unroll
                    for (int n = 0; n < 2; ++n) *(f32x4*)(rowp + bj * 128 + n * 16) = acc[ai][bj][m][n] + *(const f32x4*)(bias + col0 + bj * 128 + n * 16); }
    }
};
__device__ __forceinline__ u32x4 pack8(f32x4 v0, f32x4 v1) { u32x4 w; w.x = cvt_pk_bf16(v0[0], v0[1]); w.y = cvt_pk_bf16(v0[2], v0[3]); w.z = cvt_pk_bf16(v1[0], v1[1]); w.w = cvt_pk_bf16(v1[2], v1[3]); return w; }
struct EpiIn {
    static constexpr bool PERM = true;
    bf16_t *BG, *CI, *Z, *XBC, *GA, *GB; float* DT;
    __device__ __forceinline__ void operator()(const AccT& acc, const Unit& u, int wr, int wc, int fr, int fq) const {
        const int pn = u.pn, row0 = u.pm * 256 + wr * 64 + fr, cin = wc * 32 + 8 * fq;
        if (pn >= 4 && pn < 12) {
            const int col = (pn - 4) * 128 + cin;
#pragma unroll
            for (int ai = 0; ai < 2; ++ai)
#pragma unroll
                for (int m = 0; m < 4; ++m) { const size_t row = row0 + ai * 128 + m * 16;
                    *(u32x4*)(CI + row * 1024 + col) = pack8(acc[ai][0][m][0] * acc[ai][1][m][0], acc[ai][0][m][1] * acc[ai][1][m][1]); }
        } else if (pn == 40) {
            if (wc == 0) {
#pragma unroll
                for (int ai = 0; ai < 2; ++ai)
#pragma unroll
                    for (int m = 0; m < 4; ++m) { const size_t row = row0 + ai * 128 + m * 16;
                        *(f32x4*)(DT + row * 32 + 8 * fq) = acc[ai][0][m][0]; *(f32x4*)(DT + row * 32 + 8 * fq + 4) = acc[ai][0][m][1]; }
            }
        } else {
            bf16_t* O; int ldc, colt;
            if (pn < 4) { O = BG; ldc = 1024; colt = pn * 256; }
            else if (pn < 20) { O = Z; ldc = 2048; colt = (pn - 12) * 256; }
            else if (pn < 32) { O = XBC; ldc = 3072; colt = (pn - 20) * 256; }
            else if (pn < 36) { O = GA; ldc = 1024; colt = (pn - 32) * 256; }
            else { O = GB; ldc = 1024; colt = (pn - 36) * 256; }
#pragma unroll
            for (int ai = 0; ai < 2; ++ai)
#pragma unroll
                for (int m = 0; m < 4; ++m) { bf16_t* rowp = O + (size_t)(row0 + ai * 128 + m * 16) * ldc + colt + cin;
#pragma unroll
                    for (int bj = 0; bj < 2; ++bj) *(u32x4*)(rowp + bj * 128) = pack8(acc[ai][bj][m][0], acc[ai][bj][m][1]); }
        }
    }
};
template <int MODE> struct EpiGate {
    static constexpr bool PERM = true;
    bf16_t* O; const bf16_t* G; const bf16_t* Y; int ldc;
    __device__ __forceinline__ void operator()(const AccT& acc, const Unit& u, int wr, int wc, int fr, int fq) const {
        const int row0 = u.pm * 256 + wr * 64 + fr, col0 = u.pn * 256 + wc * 32 + 8 * fq;
#pragma unroll
        for (int ai = 0; ai < 2; ++ai)
#pragma unroll
            for (int m = 0; m < 4; ++m) { const size_t off = (size_t)(row0 + ai * 128 + m * 16) * ldc + col0;
#pragma unroll
                for (int bj = 0; bj < 2; ++bj) { f32x4 v0 = acc[ai][bj][m][0], v1 = acc[ai][bj][m][1];
                    if (MODE == 2) {
#pragma unroll
                        for (int j = 0; j < 4; ++j) { float a = fmaxf(v0[j], 0.f), b = fmaxf(v1[j], 0.f); v0[j] = a * a; v1[j] = b * b; }
                    } else {
                        const u32x4 gv = *(const u32x4*)(G + off + bj * 128);
                        v0[0] *= sigmoidf_(bflo(gv.x)); v0[1] *= sigmoidf_(bfhi(gv.x)); v0[2] *= sigmoidf_(bflo(gv.y)); v0[3] *= sigmoidf_(bfhi(gv.y));
                        v1[0] *= sigmoidf_(bflo(gv.z)); v1[1] *= sigmoidf_(bfhi(gv.z)); v1[2] *= sigmoidf_(bflo(gv.w)); v1[3] *= sigmoidf_(bfhi(gv.w));
                        if (MODE == 1) { const u32x4 yv = *(const u32x4*)(Y + off + bj * 128);
                            v0[0] += bflo(yv.x); v0[1] += bfhi(yv.x); v0[2] += bflo(yv.y); v0[3] += bfhi(yv.y);
                            v1[0] += bflo(yv.z); v1[1] += bfhi(yv.z); v1[2] += bflo(yv.w); v1[3] += bfhi(yv.w); }
                    }
                    *(u32x4*)(O + off + bj * 128) = pack8(v0, v1); } }
    }
};
struct EpiRes {
    static constexpr bool PERM = false;
    float* X1; const float* xp; const float* xs; const float* gate;
    __device__ __forceinline__ void operator()(const AccT& acc, const Unit& u, int wr, int wc, int fr, int fq) const {
        const int row0 = u.pm * 256 + wr * 64 + fr, col0 = u.pn * 256 + wc * 32 + 4 * fq;
#pragma unroll
        for (int ai = 0; ai < 2; ++ai)
#pragma unroll
            for (int m = 0; m < 4; ++m) { const int row = row0 + ai * 128 + m * 16;
                if (row < MTOT) {
                    const int seq = row < MP ? (row >> 11) : (NBP + row - MP);
                    const float* src = xp ? (row < MP ? xp + (size_t)row * D : xs + (size_t)(row - MP) * D) : X1 + (size_t)row * D;
                    const float* gr = gate + (size_t)seq * 6144;
#pragma unroll
                    for (int bj = 0; bj < 2; ++bj)
#pragma unroll
                        for (int n = 0; n < 2; ++n) { const int c = col0 + bj * 128 + n * 16;
                            *(f32x4*)(X1 + (size_t)row * D + c) = *(const f32x4*)(src + c) + *(const f32x4*)(gr + c) * acc[ai][bj][m][n]; }
                } }
    }
};

__device__ __forceinline__ int win_dest(int n) {
    if (n < 1024) return n;
    if (n < 2048) { const int j = n - 1024; return 1024 + (j >> 7) * 256 + (j & 127); }
    if (n < 3072) { const int j = n - 2048; return 1024 + (j >> 7) * 256 + 128 + (j & 127); }
    if (n < 8192) return n;
    if (n < 8224) return 10240 + (n - 8192);
    return n - 32;
}
__device__ __forceinline__ void transpose_tile(const float* W, int K, int N, bf16_t* WT, int kt, int ntile, bool remap, const float* kscale, LAS float* scr) {
    const int tid = threadIdx.x, k0 = kt * 64, n0 = ntile * 64, nl = tid & 63, ks = tid >> 6, n = n0 + nl;
#pragma unroll
    for (int i = 0; i < 8; ++i) { const int k = ks + 8 * i; float v = (n < N) ? W[(size_t)(k0 + k) * N + n] : 0.f; if (kscale) v *= kscale[k0 + k]; scr[nl * 65 + k] = v; }
    __syncthreads();
    const int nr = tid >> 3, kc = (tid & 7) * 8, ns = n0 + nr;
    if (ns < N) {
        const int dr = remap ? win_dest(ns) : ns;
        const LAS float* s = scr + nr * 65 + kc;
        u32x4 o; o.x = cvt_pk_bf16(s[0], s[1]); o.y = cvt_pk_bf16(s[2], s[3]); o.z = cvt_pk_bf16(s[4], s[5]); o.w = cvt_pk_bf16(s[6], s[7]);
        *(u32x4*)(WT + (size_t)dr * K + k0 + kc) = o;
    }
    __syncthreads();
}
__device__ __forceinline__ void phase0(const Params& p, LAS unsigned char* lds) {
    LAS float* scr = (LAS float*)lds;
    unsigned char* ws = p.ws;
    constexpr int T_ADA = 16 * 96, T_IN = 16 * 161, T_AO = 16 * 16, T_BO = 32 * 16, T_O = 16 * 16, T_1 = 16 * 64, T_2 = 64 * 16;
    constexpr int TOT = T_ADA + T_IN + T_AO + T_BO + T_O + T_1 + T_2;
    for (int it = blockIdx.x; it < TOT; it += gridDim.x) {
        int r = it;
        if (r < T_ADA) { transpose_tile(p.in[I_WADA], 1024, 6144, (bf16_t*)(ws + OFF_WADA), r / 96, r % 96, false, nullptr, scr); continue; } r -= T_ADA;
        if (r < T_IN) { transpose_tile(p.in[I_WIN], 1024, DIN, (bf16_t*)(ws + OFF_WIN), r / 161, r % 161, true, nullptr, scr); continue; } r -= T_IN;
        if (r < T_AO) { transpose_tile(p.in[I_WAOUT], 1024, 1024, (bf16_t*)(ws + OFF_WAOUT), r / 16, r % 16, false, nullptr, scr); continue; } r -= T_AO;
        if (r < T_BO) { transpose_tile(p.in[I_WBOUT], 2048, 1024, (bf16_t*)(ws + OFF_WBOUT), r / 16, r % 16, false, p.in[I_SNG], scr); continue; } r -= T_BO;
        if (r < T_O) { transpose_tile(p.in[I_WO], 1024, 1024, (bf16_t*)(ws + OFF_WO), r / 16, r % 16, false, nullptr, scr); continue; } r -= T_O;
        if (r < T_1) { transpose_tile(p.in[I_W1], 1024, 4096, (bf16_t*)(ws + OFF_W1), r / 64, r % 64, false, nullptr, scr); continue; } r -= T_1;
        transpose_tile(p.in[I_W2], 4096, 1024, (bf16_t*)(ws + OFF_W2), r / 16, r % 16, false, nullptr, scr);
    }
    bf16_t* cA = (bf16_t*)(ws + OFF_CA);
    for (int i = blockIdx.x * 512 + threadIdx.x; i < (NBP + NBS) * D; i += gridDim.x * 512) {
        const int row = i >> 10, k = i & 1023;
        const float v = row < NBP ? p.in[I_CP][row * D + k] : p.in[I_CS][(row - NBP) * D + k];
        cA[i] = f2bf(siluf_(v));
    }
}

__device__ __forceinline__ void rownorm_mod(const float* xrow, const float* g, const float* sc, const float* sh, bf16_t* orow, int lane) {
    f32x4 v[4]; float s = 0.f;
#pragma unroll
    for (int j = 0; j < 4; ++j) { v[j] = ((const f32x4*)xrow)[lane + 64 * j]; s += (v[j][0] * v[j][0] + v[j][1] * v[j][1]) + (v[j][2] * v[j][2] + v[j][3] * v[j][3]); }
    const float rstd = rsqrtf(wave_sum(s) * (1.f / D) + EPS);
#pragma unroll
    for (int j = 0; j < 4; ++j) { const int i4 = lane + 64 * j;
        const f32x4 gg = ((const f32x4*)g)[i4], scv = ((const f32x4*)sc)[i4], shv = ((const f32x4*)sh)[i4];
        const f32x4 o = v[j] * rstd * gg * (scv + 1.f) + shv;
        u32x2 w; w.x = cvt_pk_bf16(o[0], o[1]); w.y = cvt_pk_bf16(o[2], o[3]);
        ((u32x2*)orow)[i4] = w; }
}
__device__ __forceinline__ void phase_rownorm(const Params& p, const float* xp, const float* xs, const float* gvec, int sc_off, int sh_off, bf16_t* U) {
    const int lane = threadIdx.x & 63, gw = blockIdx.x * 8 + (threadIdx.x >> 6), NW = gridDim.x * 8;
    const float* mod = (const float*)(p.ws + OFF_MOD);
    for (int row = gw; row < MTOT; row += NW) {
        const int seq = row < MP ? (row >> 11) : (NBP + row - MP);
        const float* xrow = row < MP ? xp + (size_t)row * D : xs + (size_t)(row - MP) * D;
        rownorm_mod(xrow, gvec, mod + (size_t)seq * 6144 + sc_off, mod + (size_t)seq * 6144 + sh_off, U + (size_t)row * D, lane);
    }
}
__device__ __forceinline__ void phase_final(const Params& p) {
    const int lane = threadIdx.x & 63, gw = blockIdx.x * 8 + (threadIdx.x >> 6), NW = gridDim.x * 8;
    const float* X = (const float*)(p.ws + OFF_X1); const float* g = p.in[I_NFG];
    for (int row = gw; row < MTOT; row += NW) {
        const float* xrow = X + (size_t)row * D;
        float* orow = row < MP ? p.out + O_YP + (size_t)row * D : p.out + O_YS + (size_t)(row - MP) * D;
        f32x4 v[4]; float s = 0.f;
#pragma unroll
        for (int j = 0; j < 4; ++j) { v[j] = ((const f32x4*)xrow)[lane + 64 * j]; s += (v[j][0] * v[j][0] + v[j][1] * v[j][1]) + (v[j][2] * v[j][2] + v[j][3] * v[j][3]); }
        const float rstd = rsqrtf(wave_sum(s) * (1.f / D) + EPS);
#pragma unroll
        for (int j = 0; j < 4; ++j) ((f32x4*)orow)[lane + 64 * j] = v[j] * rstd * ((const f32x4*)g)[lane + 64 * j];
    }
}

struct F8 { f32x4 a, b; };
__device__ __forceinline__ F8 ld8bf(const bf16_t* p) { const u32x4 u = *(const u32x4*)p; F8 r; r.a = (f32x4){bflo(u.x), bfhi(u.x), bflo(u.y), bfhi(u.y)}; r.b = (f32x4){bflo(u.z), bfhi(u.z), bflo(u.w), bfhi(u.w)}; return r; }
__device__ __forceinline__ F8 ld8f(const float* p) { F8 r; r.a = *(const f32x4*)p; r.b = *(const f32x4*)(p + 4); return r; }
__device__ __forceinline__ void st8f(float* p, const F8& v) { *(f32x4*)p = v.a; *(f32x4*)(p + 4) = v.b; }
__device__ __forceinline__ F8 zero8() { F8 r; r.a = (f32x4){0.f, 0.f, 0.f, 0.f}; r.b = r.a; return r; }
__device__ __forceinline__ void phase_conv(const Params& p, LAS unsigned char* lds) {
    unsigned char* ws = p.ws;
    const bf16_t* BG = (const bf16_t*)(ws + OFF_BG); const bf16_t* CI = (const bf16_t*)(ws + OFF_CI); const bf16_t* XBC = (const bf16_t*)(ws + OFF_XBC);
    bf16_t* VA = (bf16_t*)(ws + OFF_VA); bf16_t* XC = (bf16_t*)(ws + OFF_XBCC);
    const int tid = threadIdx.x;
    for (int row = blockIdx.x; row < MTOT; row += gridDim.x) {
        const bool prm = row < MP; const int tpos = row & (SEQ - 1), b = prm ? (row >> 11) : (row - MP);
        if (tid < 128) {
            const int ch = tid * 8;
            const F8 c0 = ld8bf(CI + (size_t)row * 1024 + ch);
            F8 p1, p2;
            if (prm) { p1 = tpos >= 1 ? ld8bf(CI + (size_t)(row - 1) * 1024 + ch) : zero8(); p2 = tpos >= 2 ? ld8bf(CI + (size_t)(row - 2) * 1024 + ch) : zero8(); }
            else { p2 = ld8f(p.in[I_STA] + ((size_t)b * 2 + 0) * 1024 + ch); p1 = ld8f(p.in[I_STA] + ((size_t)b * 2 + 1) * 1024 + ch); }
            const F8 w0 = ld8f(p.in[I_CAW] + ch), w1 = ld8f(p.in[I_CAW] + 1024 + ch), w2 = ld8f(p.in[I_CAW] + 2048 + ch);
            const F8 bg = ld8bf(BG + (size_t)row * 1024 + ch);
            const f32x4 va = bg.a * (w0.a * p2.a + w1.a * p1.a + w2.a * c0.a), vb = bg.b * (w0.b * p2.b + w1.b * p1.b + w2.b * c0.b);
            *(u32x4*)(VA + (size_t)row * 1024 + ch) = pack8(va, vb);
            if (prm) { if (tpos >= SEQ - 2) st8f(p.out + O_SCP + ((size_t)b * 2 + (tpos - (SEQ - 2))) * 1024 + ch, c0); }
            else { st8f(p.out + O_SCS + ((size_t)b * 2 + 0) * 1024 + ch, p1); st8f(p.out + O_SCS + ((size_t)b * 2 + 1) * 1024 + ch, c0); }
        } else {
            const int ch = (tid - 128) * 8;
            const F8 c0 = ld8bf(XBC + (size_t)row * 3072 + ch);
            F8 p1, p2, p3;
            if (prm) { p1 = tpos >= 1 ? ld8bf(XBC + (size_t)(row - 1) * 3072 + ch) : zero8(); p2 = tpos >= 2 ? ld8bf(XBC + (size_t)(row - 2) * 3072 + ch) : zero8(); p3 = tpos >= 3 ? ld8bf(XBC + (size_t)(row - 3) * 3072 + ch) : zero8(); }
            else { p3 = ld8f(p.in[I_STB] + ((size_t)b * 3 + 0) * 3072 + ch); p2 = ld8f(p.in[I_STB] + ((size_t)b * 3 + 1) * 3072 + ch); p1 = ld8f(p.in[I_STB] + ((size_t)b * 3 + 2) * 3072 + ch); }
            const F8 w0 = ld8f(p.in[I_CBW] + ch), w1 = ld8f(p.in[I_CBW] + 3072 + ch), w2 = ld8f(p.in[I_CBW] + 6144 + ch), w3 = ld8f(p.in[I_CBW] + 9216 + ch), bb = ld8f(p.in[I_CBB] + ch);
            f32x4 va = w0.a * p3.a + w1.a * p2.a + w2.a * p1.a + w3.a * c0.a + bb.a, vb = w0.b * p3.b + w1.b * p2.b + w2.b * p1.b + w3.b * c0.b + bb.b;
#pragma unroll
            for (int j = 0; j < 4; ++j) { va[j] = siluf_(va[j]); vb[j] = siluf_(vb[j]); }
            *(u32x4*)(XC + (size_t)row * 3072 + ch) = pack8(va, vb);
            if (prm) { if (tpos >= SEQ - 3) st8f(p.out + O_SBP + ((size_t)b * 3 + (tpos - (SEQ - 3))) * 3072 + ch, c0); }
            else { st8f(p.out + O_SBS + ((size_t)b * 3 + 0) * 3072 + ch, p2); st8f(p.out + O_SBS + ((size_t)b * 3 + 1) * 3072 + ch, p1); st8f(p.out + O_SBS + ((size_t)b * 3 + 2) * 3072 + ch, c0); }
        }
    }
    const float* DTR = (const float*)(ws + OFF_DTRAW); float* DTP = (float*)(ws + OFF_DTP); float* ACS = (float*)(ws + OFF_ACS);
    LAS float* t1 = (LAS float*)lds; LAS float* t2 = t1 + 128 * 33;
    for (int it = blockIdx.x; it < 129; it += gridDim.x) {
        const int t0 = it * 128;
#pragma unroll
        for (int i = 0; i < 8; ++i) { const int idx = tid + 512 * i, r = idx >> 5, hh = idx & 31;
            const float raw = DTR[(size_t)(t0 + r) * 32 + hh] + p.in[I_DTB][hh];
            t1[r * 33 + hh] = raw > 20.f ? raw : log1pf(expf(raw)); }
        __syncthreads();
        if (tid < 32) { const float a = -expf(p.in[I_ALOG][tid]); float run = 0.f;
            for (int s = 0; s < 128; ++s) { run += t1[s * 33 + tid] * a; t2[s * 33 + tid] = run; } }
        __syncthreads();
#pragma unroll
        for (int i = 0; i < 8; ++i) { const int idx = tid + 512 * i, r = idx >> 5, hh = idx & 31;
            DTP[(size_t)(t0 + r) * 32 + hh] = t1[r * 33 + hh]; ACS[(size_t)(t0 + r) * 32 + hh] = t2[r * 33 + hh]; }
        __syncthreads();
    }
}

constexpr int RS = 272, RX = 144;
constexpr int L_C = 0, L_B = 34816, L_X = 69632, L_XW = 88064, L_H = 106496, L_ACS = 123904, L_DT = 124416;
__device__ __forceinline__ bf16x8 tr_frag(LAS unsigned char* base, int rstride, int k0, int c0, int lane) {
    const int i = lane & 15, g = lane >> 4, q = i >> 2, pp = i & 3;
    LAS unsigned char* a = base + (k0 + 8 * g + q) * rstride + (c0 + 4 * pp) * 2;
    const bf16x4 lo = __builtin_amdgcn_ds_read_tr16_b64_v4i16((LAS bf16x4*)a);
    const bf16x4 hi = __builtin_amdgcn_ds_read_tr16_b64_v4i16((LAS bf16x4*)(a + 4 * rstride));
    return (bf16x8){lo[0], lo[1], lo[2], lo[3], hi[0], hi[1], hi[2], hi[3]};
}
__device__ __forceinline__ void ssd_prompt_unit(const Params& p, LAS unsigned char* lds, int b, int h) {
    unsigned char* ws = p.ws;
    const bf16_t* XC = (const bf16_t*)(ws + OFF_XBCC); const bf16_t* Z = (const bf16_t*)(ws + OFF_Z);
    const float* DTP = (const float*)(ws + OFF_DTP); const float* ACS = (const float*)(ws + OFF_ACS);
    bf16_t* YG = (bf16_t*)(ws + OFF_YG); float* SSQ = (float*)(ws + OFF_SSQ);
    const int tid = threadIdx.x, lane = tid & 63, w = __builtin_amdgcn_readfirstlane(tid >> 6), fr = lane & 15, fq = lane >> 4, g = h >> 3;
    const float Dh = p.in[I_DSKIP][h];
    LAS float* sAcs = (LAS float*)(lds + L_ACS); LAS float* sDt = (LAS float*)(lds + L_DT);
    f32x4 hacc[4];
#pragma unroll
    for (int i = 0; i < 4; ++i) hacc[i] = (f32x4){0.f, 0.f, 0.f, 0.f};
    const int hpt = w & 3, hnb = (w >> 2) * 4;
    for (int c = 0; c < SEQ / 128; ++c) {
        const int t0 = b * SEQ + c * 128;
        u32x4 rc[4], rb[4], rx[2]; float wv[2];
        { const int ch = tid & 15, row = tid >> 4;
#pragma unroll
          for (int i = 0; i < 4; ++i) { const bf16_t* src = XC + (size_t)(t0 + row + 32 * i) * 3072; rb[i] = *(const u32x4*)(src + 2048 + g * 128 + ch * 8); rc[i] = *(const u32x4*)(src + 2560 + g * 128 + ch * 8); } }
        const float acs_last = ACS[(size_t)(t0 + 127) * 32 + h];
        { const int ch = tid & 7, row = tid >> 3;
#pragma unroll
          for (int i = 0; i < 2; ++i) { const int r = t0 + row + 64 * i; rx[i] = *(const u32x4*)(XC + (size_t)r * 3072 + h * 64 + ch * 8);
              wv[i] = __expf(acs_last - ACS[(size_t)r * 32 + h]) * DTP[(size_t)r * 32 + h]; } }
        float my_acs = 0.f, my_dt = 0.f;
        if (tid < 128) { my_acs = ACS[(size_t)(t0 + tid) * 32 + h]; my_dt = DTP[(size_t)(t0 + tid) * 32 + h]; }
        __syncthreads();
#pragma unroll
        for (int i = 0; i < 4; ++i) { u32x2 o; o.x = cvt_pk_bf16(hacc[i][0], hacc[i][1]); o.y = cvt_pk_bf16(hacc[i][2], hacc[i][3]);
            *(LAS u32x2*)(lds + L_H + (16 * hpt + fr) * RS + (16 * (hnb + i) + 4 * fq) * 2) = o; }
        { const int ch = tid & 15, row = tid >> 4;
#pragma unroll
          for (int i = 0; i < 4; ++i) { *(LAS u32x4*)(lds + L_B + (row + 32 * i) * RS + ch * 16) = rb[i]; *(LAS u32x4*)(lds + L_C + (row + 32 * i) * RS + ch * 16) = rc[i]; } }
        { const int ch = tid & 7, row = tid >> 3;
#pragma unroll
          for (int i = 0; i < 2; ++i) { *(LAS u32x4*)(lds + L_X + (row + 64 * i) * RX + ch * 16) = rx[i];
              const float s = wv[i]; u32x4 o;
              o.x = cvt_pk_bf16(bflo(rx[i].x) * s, bfhi(rx[i].x) * s); o.y = cvt_pk_bf16(bflo(rx[i].y) * s, bfhi(rx[i].y) * s);
              o.z = cvt_pk_bf16(bflo(rx[i].z) * s, bfhi(rx[i].z) * s); o.w = cvt_pk_bf16(bflo(rx[i].w) * s, bfhi(rx[i].w) * s);
              *(LAS u32x4*)(lds + L_XW + (row + 64 * i) * RX + ch * 16) = o; } }
        if (tid < 128) { sAcs[tid] = my_acs; sDt[tid] = my_dt; }
        __syncthreads();
        const int qrow = 16 * w + fr;
        bf16x8 cf[4];
#pragma unroll
        for (int kk = 0; kk < 4; ++kk) cf[kk] = *(const LAS bf16x8*)(lds + L_C + qrow * RS + (kk * 32 + fq * 8) * 2);
        f32x4 yacc[4];
#pragma unroll
        for (int i = 0; i < 4; ++i) yacc[i] = (f32x4){0.f, 0.f, 0.f, 0.f};
        const float acs_q = sAcs[qrow];
        if (c > 0) {
#pragma unroll
            for (int pt = 0; pt < 4; ++pt)
#pragma unroll
                for (int kk = 0; kk < 4; ++kk) { const bf16x8 hf = *(const LAS bf16x8*)(lds + L_H + (16 * pt + fr) * RS + (kk * 32 + fq * 8) * 2);
                    yacc[pt] = __builtin_amdgcn_mfma_f32_16x16x32_bf16(hf, cf[kk], yacc[pt], 0, 0, 0); }
            const float eq = __expf(acs_q);
#pragma unroll
            for (int pt = 0; pt < 4; ++pt) yacc[pt] = yacc[pt] * eq;
        }
#pragma unroll
        for (int st = 0; st < 8; ++st) {
            f32x4 sacc = (f32x4){0.f, 0.f, 0.f, 0.f};
#pragma unroll
            for (int kk = 0; kk < 4; ++kk) { const bf16x8 bfr = *(const LAS bf16x8*)(lds + L_B + (16 * st + fr) * RS + (kk * 32 + fq * 8) * 2);
                sacc = __builtin_amdgcn_mfma_f32_16x16x32_bf16(bfr, cf[kk], sacc, 0, 0, 0); }
            const int s0 = 16 * st + 4 * fq;
            const f32x4 as = *(const LAS f32x4*)(sAcs + s0), ds = *(const LAS f32x4*)(sDt + s0);
            float pv[4];
#pragma unroll
            for (int j = 0; j < 4; ++j) pv[j] = (s0 + j <= qrow) ? sacc[j] * __expf(acs_q - as[j]) * ds[j] : 0.f;
            u32x2 o; o.x = cvt_pk_bf16(pv[0], pv[1]); o.y = cvt_pk_bf16(pv[2], pv[3]);
            *(LAS u32x2*)(lds + L_C + qrow * RS + s0 * 2) = o;
        }
#pragma unroll
        for (int kk = 0; kk < 4; ++kk) { const bf16x8 pf = *(const LAS bf16x8*)(lds + L_C + qrow * RS + (kk * 32 + fq * 8) * 2);
#pragma unroll
            for (int pt = 0; pt < 4; ++pt) { const bf16x8 xf = tr_frag(lds + L_X, RX, kk * 32, 16 * pt, lane);
                yacc[pt] = __builtin_amdgcn_mfma_f32_16x16x32_bf16(xf, pf, yacc[pt], 0, 0, 0); } }
        { float ss = 0.f; const size_t trow = (size_t)(t0 + qrow);
#pragma unroll
          for (int pt = 0; pt < 4; ++pt) { const int pc = 16 * pt + 4 * fq;
              const u32x2 xv = *(const LAS u32x2*)(lds + L_X + qrow * RX + pc * 2);
              const u32x2 zv = *(const u32x2*)(Z + trow * 2048 + h * 64 + pc);
              const float x0 = bflo(xv.x), x1 = bfhi(xv.x), x2 = bflo(xv.y), x3 = bfhi(xv.y);
              const float g0 = (yacc[pt][0] + Dh * x0) * siluf_(bflo(zv.x)), g1 = (yacc[pt][1] + Dh * x1) * siluf_(bfhi(zv.x));
              const float g2 = (yacc[pt][2] + Dh * x2) * siluf_(bflo(zv.y)), g3 = (yacc[pt][3] + Dh * x3) * siluf_(bfhi(zv.y));
              ss += (g0 * g0 + g1 * g1) + (g2 * g2 + g3 * g3);
              u32x2 o; o.x = cvt_pk_bf16(g0, g1); o.y = cvt_pk_bf16(g2, g3);
              *(u32x2*)(YG + trow * 2048 + h * 64 + pc) = o; }
          ss += __shfl_xor(ss, 16); ss += __shfl_xor(ss, 32);
          if (fq == 0) SSQ[trow * 32 + h] = ss; }
        { const float dec = __expf(acs_last);
#pragma unroll
          for (int i = 0; i < 4; ++i) hacc[i] = hacc[i] * dec;
#pragma unroll
          for (int kk = 0; kk < 4; ++kk) { const bf16x8 xwf = tr_frag(lds + L_XW, RX, kk * 32, 16 * hpt, lane);
#pragma unroll
              for (int i = 0; i < 4; ++i) { const bf16x8 bf = tr_frag(lds + L_B, RS, kk * 32, 16 * (hnb + i), lane);
                  hacc[i] = __builtin_amdgcn_mfma_f32_16x16x32_bf16(bf, xwf, hacc[i], 0, 0, 0); } } }
    }
    float* so = p.out + O_SSP + (((size_t)b * NH + h) * HD + 16 * hpt + fr) * DS;
#pragma unroll
    for (int i = 0; i < 4; ++i) *(f32x4*)(so + 16 * (hnb + i) + 4 * fq) = hacc[i];
    __syncthreads();
}
__device__ __forceinline__ void ssd_sample_item(const Params& p, LAS unsigned char* lds, int b, int h) {
    unsigned char* ws = p.ws;
    const bf16_t* XC = (const bf16_t*)(ws + OFF_XBCC); const bf16_t* Z = (const bf16_t*)(ws + OFF_Z);
    const float* DTP = (const float*)(ws + OFF_DTP); bf16_t* YG = (bf16_t*)(ws + OFF_YG); float* SSQ = (float*)(ws + OFF_SSQ);
    LAS float* red = (LAS float*)lds;
    const int tid = threadIdx.x, n4 = tid & 31, pr = tid >> 5, r = MP + b, g = h >> 3;
    const float dt = DTP[(size_t)r * 32 + h], dA = __expf(dt * -expf(p.in[I_ALOG][h])), Dh = p.in[I_DSKIP][h];
    const bf16_t* xr = XC + (size_t)r * 3072;
    const u32x2 bu = *(const u32x2*)(xr + 2048 + g * 128 + 4 * n4), cu = *(const u32x2*)(xr + 2560 + g * 128 + 4 * n4);
    const f32x4 Bv = (f32x4){bflo(bu.x), bfhi(bu.x), bflo(bu.y), bfhi(bu.y)}, Cv = (f32x4){bflo(cu.x), bfhi(cu.x), bflo(cu.y), bfhi(cu.y)};
    const size_t sbase = (((size_t)b * NH + h) * HD) * DS;
#pragma unroll
    for (int i = 0; i < 4; ++i) { const int pp = pr + 16 * i;
        const float xv = bf2f(xr[h * 64 + pp]);
        const f32x4 h0 = *(const f32x4*)(p.in[I_STS] + sbase + (size_t)pp * DS + 4 * n4);
        const f32x4 hn = h0 * dA + Bv * (dt * xv);
        *(f32x4*)(p.out + O_SSS + sbase + (size_t)pp * DS + 4 * n4) = hn;
        float y = (hn[0] * Cv[0] + hn[1] * Cv[1]) + (hn[2] * Cv[2] + hn[3] * Cv[3]);
#pragma unroll
        for (int o = 1; o < 32; o <<= 1) y += __shfl_xor(y, o);
        if (n4 == 0) { const float gt = (y + Dh * xv) * siluf_(bf2f(Z[(size_t)r * 2048 + h * 64 + pp])); YG[(size_t)r * 2048 + h * 64 + pp] = f2bf(gt); red[pp] = gt * gt; } }
    __syncthreads();
    if (tid < 64) { const float v = wave_sum(red[tid]); if (tid == 0) SSQ[(size_t)r * 32 + h] = v; }
    __syncthreads();
}
__device__ __forceinline__ void phase_ssd(const Params& p, LAS unsigned char* lds) {
    for (int u = blockIdx.x; u < NBP * NH; u += gridDim.x) {
        const int xcd = u & 7, j = u >> 3, pair = xcd * 4 + (j >> 3), hr = j & 7;
        ssd_prompt_unit(p, lds, pair >> 2, (pair & 3) * 8 + hr);
    }
    for (int it = blockIdx.x; it < NBS * NH; it += gridDim.x) ssd_sample_item(p, lds, it >> 5, it & 31);
}
__device__ __forceinline__ void phase_gnorm(const Params& p) {
    bf16_t* YG = (bf16_t*)(p.ws + OFF_YG); const float* SSQ = (const float*)(p.ws + OFF_SSQ);
    for (int i = blockIdx.x * 512 + threadIdx.x; i < MTOT * 256; i += gridDim.x * 512) {
        const int row = i >> 8, cu = i & 255, g = cu >> 6;
        const f32x4 s0 = *(const f32x4*)(SSQ + (size_t)row * 32 + 8 * g), s1 = *(const f32x4*)(SSQ + (size_t)row * 32 + 8 * g + 4);
        const float rstd = rsqrtf(((s0[0] + s0[1]) + (s0[2] + s0[3]) + (s1[0] + s1[1]) + (s1[2] + s1[3])) * (1.f / 512.f) + EPS);
        bf16_t* q = YG + (size_t)row * 2048 + cu * 8;
        const F8 v = ld8bf(q);
        *(u32x4*)q = pack8(v.a * rstd, v.b * rstd);
    }
}

__global__ void __launch_bounds__(512, 2) fwd_megakernel(Params p) {
    extern __shared__ __attribute__((aligned(16))) unsigned char shm[];
    LAS unsigned char* lds = (LAS unsigned char*)shm;
    cg::grid_group grid = cg::this_grid();
    unsigned char* ws = p.ws;
    const int G = gridDim.x, cid = blockIdx.x;
    float* mod = (float*)(ws + OFF_MOD);
    pg8::StaticOrder S;

    phase0(p, lds);
    grid.sync();
    {
        pg8::Gemm g{(const bf16_t*)(ws + OFF_CA), (const bf16_t*)(ws + OFF_WADA), 256, 6144, 1024};
        EpiF32Bias E{mod, 6144, p.in[I_BADA]};
        S.init(g.M, g.N, G, cid); pg8::gemm_phase<EpiF32Bias, pg8::StaticOrder, true, true>(lds, g, S, E);
    }
    grid.sync();
    phase_rownorm(p, p.in[I_XP], p.in[I_XS], p.in[I_N1G], 1024, 0, (bf16_t*)(ws + OFF_U));
    grid.sync();
    {
        pg8::Gemm g{(const bf16_t*)(ws + OFF_U), (const bf16_t*)(ws + OFF_WIN), MPAD, DINP, 1024};
        EpiIn E{(bf16_t*)(ws + OFF_BG), (bf16_t*)(ws + OFF_CI), (bf16_t*)(ws + OFF_Z), (bf16_t*)(ws + OFF_XBC), (bf16_t*)(ws + OFF_GA), (bf16_t*)(ws + OFF_GB), (float*)(ws + OFF_DTRAW)};
        S.init(g.M, g.N, G, cid); pg8::gemm_phase<EpiIn, pg8::StaticOrder, true, true>(lds, g, S, E);
    }
    grid.sync();
    phase_conv(p, lds);
    grid.sync();
    phase_ssd(p, lds);
    grid.sync();
    phase_gnorm(p);
    grid.sync();
    {
        pg8::Gemm ga{(const bf16_t*)(ws + OFF_VA), (const bf16_t*)(ws + OFF_WAOUT), MPAD, 1024, 1024};
        EpiGate<0> Ea{(bf16_t*)(ws + OFF_YA), (const bf16_t*)(ws + OFF_GA), nullptr, 1024};
        S.init(ga.M, ga.N, G, cid); pg8::gemm_phase<EpiGate<0>, pg8::StaticOrder, true, true>(lds, ga, S, Ea);
        __syncthreads();
        pg8::Gemm gb{(const bf16_t*)(ws + OFF_YG), (const bf16_t*)(ws + OFF_WBOUT), MPAD, 1024, 2048};
        EpiGate<1> Eb{(bf16_t*)(ws + OFF_MERGED), (const bf16_t*)(ws + OFF_GB), (const bf16_t*)(ws + OFF_YA), 1024};
        pg8::gemm_phase<EpiGate<1>, pg8::StaticOrder, true, true>(lds, gb, S, Eb);
    }
    grid.sync();
    {
        pg8::Gemm g{(const bf16_t*)(ws + OFF_MERGED), (const bf16_t*)(ws + OFF_WO), MPAD, 1024, 1024};
        EpiRes E{(float*)(ws + OFF_X1), p.in[I_XP], p.in[I_XS], mod + 2048};
        S.init(g.M, g.N, G, cid); pg8::gemm_phase<EpiRes, pg8::StaticOrder, true, true>(lds, g, S, E);
    }
    grid.sync();
    {
        const float* X1 = (const float*)(ws + OFF_X1);
        phase_rownorm(p, X1, X1 + (size_t)MP * D, p.in[I_N2G], 4096, 3072, (bf16_t*)(ws + OFF_U));
    }
    grid.sync();
    {
        pg8::Gemm g{(const bf16_t*)(ws + OFF_U), (const bf16_t*)(ws + OFF_W1), MPAD, DFF, 1024};
        EpiGate<2> E{(bf16_t*)(ws + OFF_HMID), nullptr, nullptr, DFF};
        S.init(g.M, g.N, G, cid); pg8::gemm_phase<EpiGate<2>, pg8::StaticOrder, true, true>(lds, g, S, E);
    }
    grid.sync();
    {
        pg8::Gemm g{(const bf16_t*)(ws + OFF_HMID), (const bf16_t*)(ws + OFF_W2), MPAD, 1024, DFF};
        EpiRes E{(float*)(ws + OFF_X1), nullptr, nullptr, mod + 5120};
        S.init(g.M, g.N, G, cid); pg8::gemm_phase<EpiRes, pg8::StaticOrder, true, true>(lds, g, S, E);
    }
    grid.sync();
    phase_final(p);
}

extern "C" void kernel_launch(void* const* d_in, const int* in_sizes, int n_in, void* d_out, int out_size, void* d_ws, size_t ws_size, hipStream_t stream) {
    constexpr int LDS_BYTES = 131072;
    static int grid = 0;
    if (grid == 0) {
        if (n_in != 25 || ws_size < WS_END) { fprintf(stderr, "kernel_launch: unexpected n_in %d / ws %zu (need %zu)\n", n_in, ws_size, (size_t)WS_END); grid = -1; return; }
        int dev = 0, cus = 0, per_cu = 0;
        hipGetDevice(&dev);
        hipDeviceGetAttribute(&cus, hipDeviceAttributeMultiprocessorCount, dev);
        if (hipFuncSetAttribute((const void*)fwd_megakernel, hipFuncAttributeMaxDynamicSharedMemorySize, LDS_BYTES) != hipSuccess) { fprintf(stderr, "kernel_launch: hipFuncSetAttribute failed\n"); grid = -1; return; }
        if (hipOccupancyMaxActiveBlocksPerMultiprocessor(&per_cu, (const void*)fwd_megakernel, 512, LDS_BYTES) != hipSuccess || per_cu < 1) { fprintf(stderr, "kernel_launch: occupancy query says %d blocks per CU\n", per_cu); grid = -1; return; }
        grid = cus;
    }
    if (grid < 0) return;
    Params p{};
    for (int i = 0; i < 25; ++i) p.in[i] = (const float*)d_in[i];
    p.out = (float*)d_out; p.ws = (unsigned char*)d_ws;
    void* args[] = {&p};
    hipError_t e = hipLaunchCooperativeKernel((const void*)fwd_megakernel, dim3(grid), dim3(512), args, LDS_BYTES, stream);
    if (e != hipSuccess) fprintf(stderr, "cooperative launch failed: %s (grid %d)\n", hipGetErrorString(e), grid);
}
```

```cpp
#include <hip/hip_runtime.h>
#include <hip/hip_cooperative_groups.h>
#include <cstdio>
#include <cstdint>
namespace cg = cooperative_groups;
#define PROBE_EW 0
#define PROBE_CONV 0
#define PROBE_SSD 0
#define PROBE_SYNC 0
#define GSYNC() do { xcd_barrier(xb); if (PROBE_SYNC) xcd_barrier(xb); } while (0)

#define LAS __attribute__((address_space(3)))
typedef unsigned short bf16_t;
typedef short bf16x8 __attribute__((ext_vector_type(8)));
typedef short bf16x4 __attribute__((ext_vector_type(4)));
typedef float f32x4 __attribute__((ext_vector_type(4)));
typedef float f32x2 __attribute__((ext_vector_type(2)));
typedef unsigned u32x4 __attribute__((ext_vector_type(4)));
typedef unsigned u32x2 __attribute__((ext_vector_type(2)));

constexpr int D = 1024, NBP = 8, SEQ = 2048, MP = NBP * SEQ, NBS = 128, MTOT = MP + NBS, MPAD = 16640;
constexpr int DINP = 10496, DINNER = 2048, DXBC = 3072, NH = 32, HD = 64, DS = 128, DFF = 4096, DIN = 10272;
constexpr float EPS = 1e-6f;
constexpr size_t O_YP = 0, O_YS = 16777216, O_SCP = 16908288, O_SBP = 16924672, O_SSP = 16998400, O_SCS = 19095552, O_SBS = 19357696, O_SSS = 20537344;
constexpr size_t S1 = (size_t)MPAD * 1024 * 2;
constexpr size_t OFF_WADA = 0, OFF_WIN = 12582912, OFF_WAOUT = 34078720, OFF_WBOUT = 36175872, OFF_WO = 40370176, OFF_W1 = 42467328, OFF_W2 = 50855936,
                 OFF_CA = 59244544, OFF_MOD = 59768832, OFF_DTRAW = 66060288, OFF_DTP = 68190208, OFF_ACS = 70320128, OFF_SSQ = 72450048, OFF_U = 74579968,
                 OFF_R1 = OFF_U + S1, OFF_BG = OFF_R1, OFF_CI = OFF_R1 + S1, OFF_Z = OFF_R1 + 2 * S1, OFF_XBC = OFF_R1 + 4 * S1, OFF_GA = OFF_R1 + 7 * S1, OFF_GB = OFF_R1 + 8 * S1,
                 OFF_R2 = OFF_R1 + 9 * S1, OFF_BAR = OFF_R2 + 3 * S1, WS_END = OFF_BAR + 16384;
constexpr size_t OFF_VA = OFF_U, OFF_YA = OFF_BG, OFF_MERGED = OFF_CI, OFF_YG = OFF_XBC, OFF_HMID = OFF_R1, OFF_XBCC = OFF_R2, OFF_X1 = OFF_R2;

struct Params {
    const float* in[25];
    float* out;
    unsigned char* ws;
};
enum { I_XP = 0, I_XS, I_CP, I_CS, I_STA, I_STB, I_STS, I_WADA, I_BADA, I_N1G, I_WIN, I_CAW, I_WAOUT, I_CBW, I_CBB, I_DTB, I_ALOG, I_DSKIP, I_SNG, I_WBOUT, I_WO, I_N2G, I_W1, I_W2, I_NFG };

__device__ __forceinline__ unsigned cvt_pk_bf16(float lo, float hi) { unsigned r; asm volatile("v_cvt_pk_bf16_f32 %0, %1, %2" : "=v"(r) : "v"(lo), "v"(hi)); return r; }
__device__ __forceinline__ bf16_t f2bf(float f) { unsigned u = __float_as_uint(f); u += 0x7FFFu + ((u >> 16) & 1u); return (bf16_t)(u >> 16); }
__device__ __forceinline__ float bf2f(bf16_t b) { return __uint_as_float(((unsigned)b) << 16); }
__device__ __forceinline__ float bflo(unsigned u) { return __uint_as_float(u << 16); }
__device__ __forceinline__ float bfhi(unsigned u) { return __uint_as_float(u & 0xffff0000u); }
__device__ __forceinline__ float sigmoidf_(float x) { return __builtin_amdgcn_rcpf(1.f + __expf(-x)); }
__device__ __forceinline__ float siluf_(float x) { return x * sigmoidf_(x); }
__device__ __forceinline__ float wave_sum(float v) {
#pragma unroll
    for (int o = 1; o < 64; o <<= 1) v += __shfl_xor(v, o);
    return v;
}


#define XB_TMO      128
#define XB_XCNT(j)  (256  + 64 * (j))
#define XB_XSUB(j)  (1280 + 64 * (j))
#define XB_XGEN(j)  (2304 + 64 * (j))
#define XB_TOP      3328
#define XB_TOPGEN   3392
#define XCD_BAR_WORDS 3456
#define XB_SPIN_CAP (1u << 18)
__device__ __forceinline__ unsigned xb_ld(unsigned* p)              { return __hip_atomic_load(p, __ATOMIC_RELAXED, __HIP_MEMORY_SCOPE_AGENT); }
__device__ __forceinline__ unsigned xb_add(unsigned* p, unsigned v) { return __hip_atomic_fetch_add(p, v, __ATOMIC_RELAXED, __HIP_MEMORY_SCOPE_AGENT); }
__device__ __forceinline__ unsigned xb_xcc_id() { return (unsigned)__builtin_amdgcn_s_getreg((3 << 11) | 20) & 0xFu; }
#define XB_SPIN(cond, bar) do { unsigned _sp = 0; while (cond) { __builtin_amdgcn_s_sleep(1); \
    if ((++_sp & 255u) == 0u) { if (xb_ld(&(bar)[XB_TMO])) break; if (_sp > XB_SPIN_CAP) { atomicAdd(&(bar)[XB_TMO], 1u); break; } } } } while (0)
struct XcdBarrier { unsigned* bar; unsigned x; volatile LAS unsigned* st; };
__device__ __forceinline__ XcdBarrier xcd_barrier_post(unsigned* bar, volatile LAS unsigned* st) {
    XcdBarrier b; b.bar = bar; b.x = xb_xcc_id(); b.st = st;
    if (threadIdx.x == 0) (void)xb_add(&bar[XB_XCNT(b.x)], 1u);
    return b;
}
__device__ __forceinline__ void xcd_barrier_complete(unsigned* bar, unsigned x, unsigned& nloc, unsigned& nx) {
    const unsigned G = gridDim.x * gridDim.y * gridDim.z;
    unsigned sum, cnt, mine, sp = 0u;
    for (;;) {
        sum = 0u; cnt = 0u; mine = 0u;
#pragma unroll
        for (unsigned j = 0; j < 16; ++j) { const unsigned c = xb_ld(&bar[XB_XCNT(j)]); sum += c; cnt += (c > 0u) ? 1u : 0u; mine = (j == x) ? c : mine; }
        if (sum == G) break;
        __builtin_amdgcn_s_sleep(1);
        if ((++sp & 255u) == 0u) { if (xb_ld(&bar[XB_TMO])) break; if (sp > XB_SPIN_CAP) { atomicAdd(&bar[XB_TMO], 1u); break; } }
    }
    nloc = mine > 0u ? mine : 1u; nx = cnt > 0u ? cnt : 1u;
}
__device__ __forceinline__ void xcd_barrier(const XcdBarrier& b) {
    asm volatile("s_waitcnt vmcnt(0)" ::: "memory");
    __syncthreads();
    if (threadIdx.x == 0) {
        unsigned* bar = b.bar;
        __builtin_amdgcn_s_waitcnt(0);
        unsigned nloc = b.st[0], nx = b.st[1];
        if (nloc == 0u) { xcd_barrier_complete(bar, b.x, nloc, nx); b.st[0] = nloc; b.st[1] = nx; }
        const unsigned old = xb_add(&bar[XB_XSUB(b.x)], 1u);
        const unsigned gen = old / nloc;
        if (old + 1u == (gen + 1u) * nloc) {
            __builtin_amdgcn_fence(__ATOMIC_RELEASE, "agent");
            asm volatile("s_waitcnt vmcnt(0)" ::: "memory");
            const unsigned og = xb_add(&bar[XB_TOP], 1u);
            const unsigned tg = og / nx;
            if (og + 1u == (tg + 1u) * nx) xb_add(&bar[XB_TOPGEN], 1u);
            else XB_SPIN(xb_ld(&bar[XB_TOPGEN]) == tg, bar);
            __builtin_amdgcn_fence(__ATOMIC_ACQUIRE, "agent");
            xb_add(&bar[XB_XGEN(b.x)], 1u);
            asm volatile("s_waitcnt vmcnt(0)" ::: "memory");
        } else {
            XB_SPIN(xb_ld(&bar[XB_XGEN(b.x)]) == gen, bar);
            __builtin_amdgcn_fence(__ATOMIC_ACQUIRE, "agent");
            asm volatile("s_waitcnt vmcnt(0)" ::: "memory");
        }
    }
    __syncthreads();
}

namespace pg8 {
#define PG8_LAS __attribute__((address_space(3)))
constexpr int BM = 256, BK = 64, HALF = 128, HTB = HALF * BK * 2, STAGE_BYTES = 8 * HTB, NXCD = 8, WGM = 8;
__host__ __device__ __forceinline__ int lds_byte(int r, int c) { const int st = (r >> 4) * 2 + (c >> 5), rr = r & 15, cc = c & 31, ob = rr * 64 + cc * 2; return st * 1024 + (ob ^ (((ob >> 9) & 1) << 5)); }
__host__ __device__ __forceinline__ void stage_rc(int b, int& R, int& C) { const int st = b / 1024, sb = b % 1024, swz = sb ^ (((sb >> 9) & 1) << 5); R = (st >> 1) * 16 + swz / 64; C = (st & 1) * 32 + (swz % 64) / 2; }
__host__ __device__ __forceinline__ int perm32(int rho) { const int n = rho >> 4, i = rho & 15; return 8 * (i >> 2) + 4 * n + (i & 3); }
struct Unit { int pm, pn; };
struct Gemm { const bf16_t* A; const bf16_t* Bt; int M, N, K; };
struct StaticOrder {
    int nM, nN, nwg, G, c;
    __host__ __device__ void init(int M, int N, int G_, int c_) { nM = M / BM; nN = N / BM; nwg = nM * nN; G = G_; c = c_; }
    __host__ __device__ bool next(int i, Unit& u) const {
        const long L = (long)i * G + c; if (L >= nwg) return false;
        int wgid = (int)L; { const int q = nwg / NXCD, r = nwg % NXCD, xcd = wgid % NXCD, off = wgid / NXCD; wgid = (xcd < r ? xcd * (q + 1) : r * (q + 1) + (xcd - r) * q) + off; }
        const int nig = WGM * nN, gid = wgid / nig, fm = gid * WGM, gsz = (nM - fm) < WGM ? (nM - fm) : WGM;
        u.pm = fm + ((wgid % nig) % gsz); u.pn = (wgid % nig) / gsz; return true;
    }
    __device__ __forceinline__ void a_ready(const Unit&) const {}
    __device__ __forceinline__ void done(const Unit&) const {}
};

template <class Epi, class Sched, bool ALIGN_EPI = false, bool SP2 = false>
__device__ __forceinline__ void gemm_phase(PG8_LAS unsigned char* lds, const Gemm g, const Sched& S, const Epi& E) {
    const int tid = threadIdx.x, wid = __builtin_amdgcn_readfirstlane(tid >> 6), lane = tid & 63, wr = wid >> 2, wc = wid & 3, fr = lane & 15, fq = lane >> 4;
    const int K = g.K, nt = K / BK;
    unsigned voffA[2], voffB[2];
#pragma unroll
    for (int i = 0; i < 2; ++i) { int R, C; stage_rc(tid * 16 + i * 8192, R, C); const int Rb = Epi::PERM ? ((R & ~31) + perm32(R & 31)) : R;
        voffA[i] = (unsigned)(R * K + C) * 2u; voffB[i] = (unsigned)(Rb * K + C) * 2u; }
    const size_t kstep = (size_t)(BK * 2);
    const size_t hstep = (size_t)HALF * K * 2;
    const size_t tstep = 2 * hstep;
    const unsigned ldsw = (unsigned)wid * 1024u;
    const int aoff = lds_byte(wr * 64 + fr, fq * 8), boff = lds_byte(wc * 32 + fr, fq * 8);
#define PG8_SA(b, h) (((b) * 2 + (h)) * HTB)
#define PG8_SB(b, h) ((4 + (b) * 2 + (h)) * HTB)
#define PG8_STAGE(bufoff, gbase, voff) do { _Pragma("unroll") for (int _i = 0; _i < 2; ++_i) \
        __builtin_amdgcn_global_load_lds((const unsigned*)((const char*)(gbase) + (voff)[_i]), (PG8_LAS unsigned*)(lds + (bufoff) + ldsw + _i * 8192), 16, 0, 0); } while (0)
#define PG8_LDA(dst, b, h) do { _Pragma("unroll") for (int m = 0; m < 4; ++m) _Pragma("unroll") for (int k = 0; k < 2; ++k) dst[m][k] = *(const PG8_LAS bf16x8*)(lds + PG8_SA(b, h) + aoff + m * 2048 + k * 1024); } while (0)
#define PG8_LDB(dst, b, h) do { _Pragma("unroll") for (int n = 0; n < 2; ++n) _Pragma("unroll") for (int k = 0; k < 2; ++k) dst[n][k] = *(const PG8_LAS bf16x8*)(lds + PG8_SB(b, h) + boff + n * 2048 + k * 1024); } while (0)
#define PG8_MMA(ai, bj, At, Bt) do { __builtin_amdgcn_s_setprio(1); _Pragma("unroll") for (int m = 0; m < 4; ++m) _Pragma("unroll") for (int n = 0; n < 2; ++n) _Pragma("unroll") for (int k = 0; k < 2; ++k) \
        acc[ai][bj][m][n] = __builtin_amdgcn_mfma_f32_16x16x32_bf16(Bt[n][k], At[m][k], acc[ai][bj][m][n], 0, 0, 0); __builtin_amdgcn_s_setprio(0); } while (0)
#define PG8_WAIT_V(n) asm volatile("s_waitcnt vmcnt(" #n ")" ::: "memory")
#define PG8_WAIT_L(n) asm volatile("s_waitcnt lgkmcnt(" #n ")" ::: "memory")
#define PG8_BAR __builtin_amdgcn_s_barrier()
#define PG8_SCHED __builtin_amdgcn_sched_barrier(0)
    Unit cur, nxt; int ui = 0;
    if (!S.next(0, cur)) return;
    f32x4 acc[2][2][4][2];
#pragma unroll
    for (int a = 0; a < 2; ++a)
#pragma unroll
        for (int b = 0; b < 2; ++b)
#pragma unroll
            for (int m = 0; m < 4; ++m)
#pragma unroll
                for (int n = 0; n < 2; ++n) acc[a][b][m][n] = (f32x4){0.f, 0.f, 0.f, 0.f};
    bf16x8 At[4][2], B0[2][2], B1[2][2];
    const char* cA = (const char*)g.A + (size_t)cur.pm * tstep; const char* cB = (const char*)g.Bt + (size_t)cur.pn * tstep;
    S.a_ready(cur);
    if constexpr (SP2) {
        PG8_STAGE(PG8_SB(0, 0), cB, voffB); PG8_STAGE(PG8_SB(0, 1), cB + hstep, voffB); PG8_STAGE(PG8_SA(0, 0), cA, voffA); PG8_STAGE(PG8_SA(0, 1), cA + hstep, voffA);
        if (wr == 1) PG8_BAR;
        PG8_WAIT_V(2); PG8_BAR;
        PG8_STAGE(PG8_SB(1, 0), cB + kstep, voffB); PG8_STAGE(PG8_SA(1, 0), cA + kstep, voffA); PG8_STAGE(PG8_SB(1, 1), cB + hstep + kstep, voffB);
        PG8_WAIT_V(6); PG8_BAR;
    } else {
        PG8_STAGE(PG8_SB(0, 0), cB, voffB); PG8_STAGE(PG8_SA(0, 0), cA, voffA); PG8_STAGE(PG8_SB(0, 1), cB + hstep, voffB); PG8_STAGE(PG8_SA(0, 1), cA + hstep, voffA);
        if (wr == 1) PG8_BAR;
        PG8_WAIT_V(4); PG8_BAR;
        PG8_STAGE(PG8_SB(1, 0), cB + kstep, voffB); PG8_STAGE(PG8_SA(1, 0), cA + kstep, voffA); PG8_STAGE(PG8_SB(1, 1), cB + hstep + kstep, voffB);
        PG8_WAIT_V(6); PG8_BAR;
    }
    for (;;) {
        const bool has_next = S.next(ui + 1, nxt);
        const char* nA = has_next ? (const char*)g.A + (size_t)nxt.pm * tstep : cA; const char* nB = has_next ? (const char*)g.Bt + (size_t)nxt.pn * tstep : cB;
        for (int t = 0; t < nt; t += 2) {
            const bool last = (t == nt - 2);
            const char* a1 = cA + (size_t)(t + 1) * kstep;
            const char* a2 = last ? nA : cA + (size_t)(t + 2) * kstep; const char* b2 = last ? nB : cB + (size_t)(t + 2) * kstep;
            const char* a3 = a2 + kstep; const char* b3 = b2 + kstep;
            if (last && has_next) S.a_ready(nxt);
            if constexpr (SP2) {
            PG8_LDB(B0, 0, 0); PG8_LDB(B1, 0, 1); PG8_SCHED; PG8_LDA(At, 0, 0); PG8_STAGE(PG8_SA(1, 1), a1 + hstep, voffA);
            PG8_WAIT_V(8); PG8_WAIT_L(0); PG8_BAR; PG8_MMA(0, 0, At, B0); PG8_MMA(0, 1, At, B1); PG8_BAR; PG8_SCHED;
            PG8_LDA(At, 0, 1); PG8_STAGE(PG8_SB(0, 0), b2, voffB); PG8_STAGE(PG8_SB(0, 1), b2 + hstep, voffB); PG8_STAGE(PG8_SA(0, 0), a2, voffA);
            PG8_WAIT_V(8); PG8_WAIT_L(0); PG8_BAR; PG8_MMA(1, 0, At, B0); PG8_MMA(1, 1, At, B1); PG8_BAR; PG8_SCHED;
            PG8_LDB(B0, 1, 0); PG8_LDB(B1, 1, 1); PG8_SCHED; PG8_LDA(At, 1, 0); PG8_STAGE(PG8_SA(0, 1), a2 + hstep, voffA);
            PG8_WAIT_V(8); PG8_WAIT_L(0); PG8_BAR; PG8_MMA(0, 0, At, B0); PG8_MMA(0, 1, At, B1); PG8_BAR; PG8_SCHED;
            PG8_LDA(At, 1, 1); PG8_STAGE(PG8_SB(1, 0), b3, voffB); PG8_STAGE(PG8_SB(1, 1), b3 + hstep, voffB); PG8_STAGE(PG8_SA(1, 0), a3, voffA);
            PG8_WAIT_V(8); PG8_WAIT_L(0); PG8_BAR; PG8_MMA(1, 0, At, B0); PG8_MMA(1, 1, At, B1); PG8_BAR; PG8_SCHED;
            } else {
            PG8_LDB(B0, 0, 0); PG8_SCHED; PG8_LDA(At, 0, 0); PG8_STAGE(PG8_SA(1, 1), a1 + hstep, voffA);
            PG8_WAIT_L(8); PG8_BAR; PG8_WAIT_L(0); PG8_MMA(0, 0, At, B0); PG8_BAR; PG8_SCHED;
            PG8_LDB(B1, 0, 1); PG8_STAGE(PG8_SB(0, 0), b2, voffB);
            PG8_BAR; PG8_WAIT_L(0); PG8_MMA(0, 1, At, B1); PG8_BAR;
            PG8_LDA(At, 0, 1); PG8_STAGE(PG8_SA(0, 0), a2, voffA);
            PG8_BAR; PG8_WAIT_L(0); PG8_MMA(1, 0, At, B0); PG8_BAR; PG8_SCHED;
            PG8_STAGE(PG8_SB(0, 1), b2 + hstep, voffB);
            PG8_WAIT_V(6); PG8_BAR; PG8_MMA(1, 1, At, B1); PG8_BAR;
            PG8_LDB(B0, 1, 0); PG8_SCHED; PG8_LDA(At, 1, 0); PG8_STAGE(PG8_SA(0, 1), a2 + hstep, voffA);
            PG8_WAIT_L(8); PG8_BAR; PG8_WAIT_L(0); PG8_MMA(0, 0, At, B0); PG8_BAR; PG8_SCHED;
            PG8_LDB(B1, 1, 1); PG8_STAGE(PG8_SB(1, 0), b3, voffB);
            PG8_BAR; PG8_WAIT_L(0); PG8_MMA(0, 1, At, B1); PG8_BAR;
            PG8_LDA(At, 1, 1); PG8_STAGE(PG8_SA(1, 0), a3, voffA);
            PG8_BAR; PG8_WAIT_L(0); PG8_MMA(1, 0, At, B0); PG8_BAR; PG8_SCHED;
            PG8_STAGE(PG8_SB(1, 1), b3 + hstep, voffB);
            PG8_WAIT_V(6); PG8_BAR; PG8_MMA(1, 1, At, B1); PG8_BAR;
            }
        }
        if constexpr (ALIGN_EPI) { if (wr == 0) PG8_BAR; }
        E(acc, cur, wr, wc, fr, fq);
        if (!has_next) break;
#pragma unroll
        for (int a = 0; a < 2; ++a)
#pragma unroll
            for (int b = 0; b < 2; ++b)
#pragma unroll
                for (int m = 0; m < 4; ++m)
#pragma unroll
                    for (int n = 0; n < 2; ++n) acc[a][b][m][n] = (f32x4){0.f, 0.f, 0.f, 0.f};
        cur = nxt; cA = nA; cB = nB; ++ui;
        if constexpr (ALIGN_EPI) { if (wr == 1) PG8_BAR; }
    }
    PG8_WAIT_V(0);
    if constexpr (!ALIGN_EPI) { if (wr == 0) PG8_BAR; }
    PG8_BAR;
#undef PG8_SA
#undef PG8_SB
#undef PG8_STAGE
#undef PG8_LDA
#undef PG8_LDB
#undef PG8_MMA
#undef PG8_WAIT_V
#undef PG8_WAIT_L
#undef PG8_BAR
#undef PG8_SCHED
}
}
using pg8::Unit;
typedef f32x4 AccT[2][2][4][2];

struct EpiF32Bias {
    static constexpr bool PERM = false;
    float* C; int ldc; const float* bias;
    __device__ __forceinline__ void operator()(const AccT& acc, const Unit& u, int wr, int wc, int fr, int fq) const {
        const int row0 = u.pm * 256 + wr * 64 + fr, col0 = u.pn * 256 + wc * 32 + 4 * fq;
#pragma unroll
        for (int ai = 0; ai < 2; ++ai)
#pragma unroll
            for (int m = 0; m < 4; ++m) { float* rowp = C + (size_t)(row0 + ai * 128 + m * 16) * ldc + col0;
#pragma unroll
                for (int bj = 0; bj < 2; ++bj)
#pragma unroll
                    for (int n = 0; n < 2; ++n) *(f32x4*)(rowp + bj * 128 + n * 16) = acc[ai][bj][m][n] + *(const f32x4*)(bias + col0 + bj * 128 + n * 16); }
    }
};
__device__ __forceinline__ u32x4 pack8(f32x4 v0, f32x4 v1) { u32x4 w; w.x = cvt_pk_bf16(v0[0], v0[1]); w.y = cvt_pk_bf16(v0[2], v0[3]); w.z = cvt_pk_bf16(v1[0], v1[1]); w.w = cvt_pk_bf16(v1[2], v1[3]); return w; }
struct EpiIn {
    static constexpr bool PERM = true;
    bf16_t *BG, *CI, *Z, *XBC, *GA, *GB; float* DT;
    __device__ __forceinline__ void operator()(const AccT& acc, const Unit& u, int wr, int wc, int fr, int fq) const {
        const int pn = u.pn, row0 = u.pm * 256 + wr * 64 + fr, cin = wc * 32 + 8 * fq;
        if (pn >= 4 && pn < 12) {
            const int col = (pn - 4) * 128 + cin;
#pragma unroll
            for (int ai = 0; ai < 2; ++ai)
#pragma unroll
                for (int m = 0; m < 4; ++m) { const size_t row = row0 + ai * 128 + m * 16;
                    *(u32x4*)(CI + row * 1024 + col) = pack8(acc[ai][0][m][0] * acc[ai][1][m][0], acc[ai][0][m][1] * acc[ai][1][m][1]); }
        } else if (pn == 40) {
            if (wc == 0) {
#pragma unroll
                for (int ai = 0; ai < 2; ++ai)
#pragma unroll
                    for (int m = 0; m < 4; ++m) { const size_t row = row0 + ai * 128 + m * 16;
                        *(f32x4*)(DT + row * 32 + 8 * fq) = acc[ai][0][m][0]; *(f32x4*)(DT + row * 32 + 8 * fq + 4) = acc[ai][0][m][1]; }
            }
        } else {
            bf16_t* O; int ldc, colt;
            if (pn < 4) { O = BG; ldc = 1024; colt = pn * 256; }
            else if (pn < 20) { O = Z; ldc = 2048; colt = (pn - 12) * 256; }
            else if (pn < 32) { O = XBC; ldc = 3072; colt = (pn - 20) * 256; }
            else if (pn < 36) { O = GA; ldc = 1024; colt = (pn - 32) * 256; }
            else { O = GB; ldc = 1024; colt = (pn - 36) * 256; }
#pragma unroll
            for (int ai = 0; ai < 2; ++ai)
#pragma unroll
                for (int m = 0; m < 4; ++m) { bf16_t* rowp = O + (size_t)(row0 + ai * 128 + m * 16) * ldc + colt + cin;
#pragma unroll
                    for (int bj = 0; bj < 2; ++bj) *(u32x4*)(rowp + bj * 128) = pack8(acc[ai][bj][m][0], acc[ai][bj][m][1]); }
        }
    }
};
template <int MODE> struct EpiGate {
    static constexpr bool PERM = true;
    bf16_t* O; const bf16_t* G; const bf16_t* Y; int ldc;
    __device__ __forceinline__ void operator()(const AccT& acc, const Unit& u, int wr, int wc, int fr, int fq) const {
        const int row0 = u.pm * 256 + wr * 64 + fr, col0 = u.pn * 256 + wc * 32 + 8 * fq;
#pragma unroll
        for (int ai = 0; ai < 2; ++ai)
#pragma unroll
            for (int m = 0; m < 4; ++m) { const size_t off = (size_t)(row0 + ai * 128 + m * 16) * ldc + col0;
#pragma unroll
                for (int bj = 0; bj < 2; ++bj) { f32x4 v0 = acc[ai][bj][m][0], v1 = acc[ai][bj][m][1];
                    if (MODE == 2) {
#pragma unroll
                        for (int j = 0; j < 4; ++j) { float a = fmaxf(v0[j], 0.f), b = fmaxf(v1[j], 0.f); v0[j] = a * a; v1[j] = b * b; }
                    } else {
                        const u32x4 gv = *(const u32x4*)(G + off + bj * 128);
                        v0[0] *= sigmoidf_(bflo(gv.x)); v0[1] *= sigmoidf_(bfhi(gv.x)); v0[2] *= sigmoidf_(bflo(gv.y)); v0[3] *= sigmoidf_(bfhi(gv.y));
                        v1[0] *= sigmoidf_(bflo(gv.z)); v1[1] *= sigmoidf_(bfhi(gv.z)); v1[2] *= sigmoidf_(bflo(gv.w)); v1[3] *= sigmoidf_(bfhi(gv.w));
                        if (MODE == 1) { const u32x4 yv = *(const u32x4*)(Y + off + bj * 128);
                            v0[0] += bflo(yv.x); v0[1] += bfhi(yv.x); v0[2] += bflo(yv.y); v0[3] += bfhi(yv.y);
                            v1[0] += bflo(yv.z); v1[1] += bfhi(yv.z); v1[2] += bflo(yv.w); v1[3] += bfhi(yv.w); }
                    }
                    *(u32x4*)(O + off + bj * 128) = pack8(v0, v1); } }
    }
};
struct EpiRes {
    static constexpr bool PERM = false;
    float* X1; const float* xp; const float* xs; const float* gate;
    __device__ __forceinline__ void operator()(const AccT& acc, const Unit& u, int wr, int wc, int fr, int fq) const {
        const int row0 = u.pm * 256 + wr * 64 + fr, col0 = u.pn * 256 + wc * 32 + 4 * fq;
#pragma unroll
        for (int ai = 0; ai < 2; ++ai)
#pragma unroll
            for (int m = 0; m < 4; ++m) { const int row = row0 + ai * 128 + m * 16;
                if (row < MTOT) {
                    const int seq = row < MP ? (row >> 11) : (NBP + row - MP);
                    const float* src = xp ? (row < MP ? xp + (size_t)row * D : xs + (size_t)(row - MP) * D) : X1 + (size_t)row * D;
                    const float* gr = gate + (size_t)seq * 6144;
#pragma unroll
                    for (int bj = 0; bj < 2; ++bj)
#pragma unroll
                        for (int n = 0; n < 2; ++n) { const int c = col0 + bj * 128 + n * 16;
                            *(f32x4*)(X1 + (size_t)row * D + c) = *(const f32x4*)(src + c) + *(const f32x4*)(gr + c) * acc[ai][bj][m][n]; }
                } }
    }
};

__device__ __forceinline__ int win_dest(int n) {
    if (n < 1024) return n;
    if (n < 2048) { const int j = n - 1024; return 1024 + (j >> 7) * 256 + (j & 127); }
    if (n < 3072) { const int j = n - 2048; return 1024 + (j >> 7) * 256 + 128 + (j & 127); }
    if (n < 8192) return n;
    if (n < 8224) return 10240 + (n - 8192);
    return n - 32;
}
__device__ __forceinline__ void transpose_tile(const float* W, int K, int N, bf16_t* WT, int kt, int ntile, bool remap, const float* kscale, LAS float* scr) {
    const int tid = threadIdx.x, k0 = kt * 64, n0 = ntile * 64, nl = tid & 63, ks = tid >> 6, n = n0 + nl;
#pragma unroll
    for (int i = 0; i < 8; ++i) { const int k = ks + 8 * i; float v = (n < N) ? W[(size_t)(k0 + k) * N + n] : 0.f; if (kscale) v *= kscale[k0 + k]; scr[nl * 65 + k] = v; }
    __syncthreads();
    const int nr = tid >> 3, kc = (tid & 7) * 8, ns = n0 + nr;
    if (ns < N) {
        const int dr = remap ? win_dest(ns) : ns;
        const LAS float* s = scr + nr * 65 + kc;
        u32x4 o; o.x = cvt_pk_bf16(s[0], s[1]); o.y = cvt_pk_bf16(s[2], s[3]); o.z = cvt_pk_bf16(s[4], s[5]); o.w = cvt_pk_bf16(s[6], s[7]);
        *(u32x4*)(WT + (size_t)dr * K + k0 + kc) = o;
    }
    __syncthreads();
}
__device__ __forceinline__ void phase0(const Params& p, LAS unsigned char* lds) {
    LAS float* scr = (LAS float*)lds;
    unsigned char* ws = p.ws;
    constexpr int T_ADA = 16 * 96, T_IN = 16 * 161, T_AO = 16 * 16, T_BO = 32 * 16, T_O = 16 * 16, T_1 = 16 * 64, T_2 = 64 * 16;
    constexpr int TOT = T_ADA + T_IN + T_AO + T_BO + T_O + T_1 + T_2;
    for (int it = blockIdx.x; it < TOT; it += gridDim.x) {
        int r = it;
        if (r < T_ADA) { transpose_tile(p.in[I_WADA], 1024, 6144, (bf16_t*)(ws + OFF_WADA), r / 96, r % 96, false, nullptr, scr); continue; } r -= T_ADA;
        if (r < T_IN) { transpose_tile(p.in[I_WIN], 1024, DIN, (bf16_t*)(ws + OFF_WIN), r / 161, r % 161, true, nullptr, scr); continue; } r -= T_IN;
        if (r < T_AO) { transpose_tile(p.in[I_WAOUT], 1024, 1024, (bf16_t*)(ws + OFF_WAOUT), r / 16, r % 16, false, nullptr, scr); continue; } r -= T_AO;
        if (r < T_BO) { transpose_tile(p.in[I_WBOUT], 2048, 1024, (bf16_t*)(ws + OFF_WBOUT), r / 16, r % 16, false, p.in[I_SNG], scr); continue; } r -= T_BO;
        if (r < T_O) { transpose_tile(p.in[I_WO], 1024, 1024, (bf16_t*)(ws + OFF_WO), r / 16, r % 16, false, nullptr, scr); continue; } r -= T_O;
        if (r < T_1) { transpose_tile(p.in[I_W1], 1024, 4096, (bf16_t*)(ws + OFF_W1), r / 64, r % 64, false, nullptr, scr); continue; } r -= T_1;
        transpose_tile(p.in[I_W2], 4096, 1024, (bf16_t*)(ws + OFF_W2), r / 16, r % 16, false, nullptr, scr);
    }
    bf16_t* cA = (bf16_t*)(ws + OFF_CA);
    for (int i = blockIdx.x * 512 + threadIdx.x; i < (NBP + NBS) * D; i += gridDim.x * 512) {
        const int row = i >> 10, k = i & 1023;
        const float v = row < NBP ? p.in[I_CP][row * D + k] : p.in[I_CS][(row - NBP) * D + k];
        cA[i] = f2bf(siluf_(v));
    }
}

__device__ __forceinline__ void rownorm_mod(const float* xrow, const float* g, const float* sc, const float* sh, bf16_t* orow, int lane) {
    f32x4 v[4]; float s = 0.f;
#pragma unroll
    for (int j = 0; j < 4; ++j) { v[j] = ((const f32x4*)xrow)[lane + 64 * j]; s += (v[j][0] * v[j][0] + v[j][1] * v[j][1]) + (v[j][2] * v[j][2] + v[j][3] * v[j][3]); }
    const float rstd = rsqrtf(wave_sum(s) * (1.f / D) + EPS);
#pragma unroll
    for (int j = 0; j < 4; ++j) { const int i4 = lane + 64 * j;
        const f32x4 gg = ((const f32x4*)g)[i4], scv = ((const f32x4*)sc)[i4], shv = ((const f32x4*)sh)[i4];
        const f32x4 o = v[j] * rstd * gg * (scv + 1.f) + shv;
        u32x2 w; w.x = cvt_pk_bf16(o[0], o[1]); w.y = cvt_pk_bf16(o[2], o[3]);
        ((u32x2*)orow)[i4] = w; }
}
__device__ __forceinline__ void phase_rownorm(const Params& p, const float* xp, const float* xs, const float* gvec, int sc_off, int sh_off, bf16_t* U) {
    const int lane = threadIdx.x & 63, gw = blockIdx.x * 8 + (threadIdx.x >> 6), NW = gridDim.x * 8;
    const float* mod = (const float*)(p.ws + OFF_MOD);
    for (int row = gw; row < MTOT; row += NW) {
        const int seq = row < MP ? (row >> 11) : (NBP + row - MP);
        const float* xrow = row < MP ? xp + (size_t)row * D : xs + (size_t)(row - MP) * D;
        rownorm_mod(xrow, gvec, mod + (size_t)seq * 6144 + sc_off, mod + (size_t)seq * 6144 + sh_off, U + (size_t)row * D, lane);
    }
}
__device__ __forceinline__ void phase_final(const Params& p) {
    const int lane = threadIdx.x & 63, gw = blockIdx.x * 8 + (threadIdx.x >> 6), NW = gridDim.x * 8;
    const float* X = (const float*)(p.ws + OFF_X1); const float* g = p.in[I_NFG];
    for (int row = gw; row < MTOT; row += NW) {
        const float* xrow = X + (size_t)row * D;
        float* orow = row < MP ? p.out + O_YP + (size_t)row * D : p.out + O_YS + (size_t)(row - MP) * D;
        f32x4 v[4]; float s = 0.f;
#pragma unroll
        for (int j = 0; j < 4; ++j) { v[j] = ((const f32x4*)xrow)[lane + 64 * j]; s += (v[j][0] * v[j][0] + v[j][1] * v[j][1]) + (v[j][2] * v[j][2] + v[j][3] * v[j][3]); }
        const float rstd = rsqrtf(wave_sum(s) * (1.f / D) + EPS);
#pragma unroll
        for (int j = 0; j < 4; ++j) ((f32x4*)orow)[lane + 64 * j] = v[j] * rstd * ((const f32x4*)g)[lane + 64 * j];
    }
}

struct F8 { f32x4 a, b; };
__device__ __forceinline__ F8 ld8bf(const bf16_t* p) { const u32x4 u = *(const u32x4*)p; F8 r; r.a = (f32x4){bflo(u.x), bfhi(u.x), bflo(u.y), bfhi(u.y)}; r.b = (f32x4){bflo(u.z), bfhi(u.z), bflo(u.w), bfhi(u.w)}; return r; }
__device__ __forceinline__ F8 ld8f(const float* p) { F8 r; r.a = *(const f32x4*)p; r.b = *(const f32x4*)(p + 4); return r; }
__device__ __forceinline__ void st8f(float* p, const F8& v) { *(f32x4*)p = v.a; *(f32x4*)(p + 4) = v.b; }
__device__ __forceinline__ F8 zero8() { F8 r; r.a = (f32x4){0.f, 0.f, 0.f, 0.f}; r.b = r.a; return r; }
__device__ __forceinline__ void phase_conv(const Params& p, LAS unsigned char* lds) {
    unsigned char* ws = p.ws;
    const bf16_t* BG = (const bf16_t*)(ws + OFF_BG); const bf16_t* CI = (const bf16_t*)(ws + OFF_CI); const bf16_t* XBC = (const bf16_t*)(ws + OFF_XBC);
    bf16_t* VA = (bf16_t*)(ws + OFF_VA); bf16_t* XC = (bf16_t*)(ws + OFF_XBCC);
    const int tid = threadIdx.x;
    for (int row = blockIdx.x; row < MTOT; row += gridDim.x) {
        const bool prm = row < MP; const int tpos = row & (SEQ - 1), b = prm ? (row >> 11) : (row - MP);
        if (tid < 128) {
            const int ch = tid * 8;
            const F8 c0 = ld8bf(CI + (size_t)row * 1024 + ch);
            F8 p1, p2;
            if (prm) { p1 = tpos >= 1 ? ld8bf(CI + (size_t)(row - 1) * 1024 + ch) : zero8(); p2 = tpos >= 2 ? ld8bf(CI + (size_t)(row - 2) * 1024 + ch) : zero8(); }
            else { p2 = ld8f(p.in[I_STA] + ((size_t)b * 2 + 0) * 1024 + ch); p1 = ld8f(p.in[I_STA] + ((size_t)b * 2 + 1) * 1024 + ch); }
            const F8 w0 = ld8f(p.in[I_CAW] + ch), w1 = ld8f(p.in[I_CAW] + 1024 + ch), w2 = ld8f(p.in[I_CAW] + 2048 + ch);
            const F8 bg = ld8bf(BG + (size_t)row * 1024 + ch);
            const f32x4 va = bg.a * (w0.a * p2.a + w1.a * p1.a + w2.a * c0.a), vb = bg.b * (w0.b * p2.b + w1.b * p1.b + w2.b * c0.b);
            *(u32x4*)(VA + (size_t)row * 1024 + ch) = pack8(va, vb);
            if (prm) { if (tpos >= SEQ - 2) st8f(p.out + O_SCP + ((size_t)b * 2 + (tpos - (SEQ - 2))) * 1024 + ch, c0); }
            else { st8f(p.out + O_SCS + ((size_t)b * 2 + 0) * 1024 + ch, p1); st8f(p.out + O_SCS + ((size_t)b * 2 + 1) * 1024 + ch, c0); }
        } else {
            const int ch = (tid - 128) * 8;
            const F8 c0 = ld8bf(XBC + (size_t)row * 3072 + ch);
            F8 p1, p2, p3;
            if (prm) { p1 = tpos >= 1 ? ld8bf(XBC + (size_t)(row - 1) * 3072 + ch) : zero8(); p2 = tpos >= 2 ? ld8bf(XBC + (size_t)(row - 2) * 3072 + ch) : zero8(); p3 = tpos >= 3 ? ld8bf(XBC + (size_t)(row - 3) * 3072 + ch) : zero8(); }
            else { p3 = ld8f(p.in[I_STB] + ((size_t)b * 3 + 0) * 3072 + ch); p2 = ld8f(p.in[I_STB] + ((size_t)b * 3 + 1) * 3072 + ch); p1 = ld8f(p.in[I_STB] + ((size_t)b * 3 + 2) * 3072 + ch); }
            const F8 w0 = ld8f(p.in[I_CBW] + ch), w1 = ld8f(p.in[I_CBW] + 3072 + ch), w2 = ld8f(p.in[I_CBW] + 6144 + ch), w3 = ld8f(p.in[I_CBW] + 9216 + ch), bb = ld8f(p.in[I_CBB] + ch);
            f32x4 va = w0.a * p3.a + w1.a * p2.a + w2.a * p1.a + w3.a * c0.a + bb.a, vb = w0.b * p3.b + w1.b * p2.b + w2.b * p1.b + w3.b * c0.b + bb.b;
#pragma unroll
            for (int j = 0; j < 4; ++j) { va[j] = siluf_(va[j]); vb[j] = siluf_(vb[j]); }
            *(u32x4*)(XC + (size_t)row * 3072 + ch) = pack8(va, vb);
            if (prm) { if (tpos >= SEQ - 3) st8f(p.out + O_SBP + ((size_t)b * 3 + (tpos - (SEQ - 3))) * 3072 + ch, c0); }
            else { st8f(p.out + O_SBS + ((size_t)b * 3 + 0) * 3072 + ch, p2); st8f(p.out + O_SBS + ((size_t)b * 3 + 1) * 3072 + ch, p1); st8f(p.out + O_SBS + ((size_t)b * 3 + 2) * 3072 + ch, c0); }
        }
    }
    const float* DTR = (const float*)(ws + OFF_DTRAW); float* DTP = (float*)(ws + OFF_DTP); float* ACS = (float*)(ws + OFF_ACS);
    LAS float* t1 = (LAS float*)lds; LAS float* t2 = t1 + 128 * 33;
    for (int it = blockIdx.x; it < 129; it += gridDim.x) {
        const int t0 = it * 128;
#pragma unroll
        for (int i = 0; i < 8; ++i) { const int idx = tid + 512 * i, r = idx >> 5, hh = idx & 31;
            const float raw = DTR[(size_t)(t0 + r) * 32 + hh] + p.in[I_DTB][hh];
            t1[r * 33 + hh] = raw > 20.f ? raw : log1pf(expf(raw)); }
        __syncthreads();
        if (tid < 32) { const float a = -expf(p.in[I_ALOG][tid]); float run = 0.f;
            for (int s = 0; s < 128; ++s) { run += t1[s * 33 + tid] * a; t2[s * 33 + tid] = run; } }
        __syncthreads();
#pragma unroll
        for (int i = 0; i < 8; ++i) { const int idx = tid + 512 * i, r = idx >> 5, hh = idx & 31;
            DTP[(size_t)(t0 + r) * 32 + hh] = t1[r * 33 + hh]; ACS[(size_t)(t0 + r) * 32 + hh] = t2[r * 33 + hh]; }
        __syncthreads();
    }
}

constexpr int RS = 272, RX = 144;
constexpr int L_C = 0, L_B = 34816, L_X = 69632, L_XW = 88064, L_H = 106496, L_ACS = 123904, L_DT = 124416;
__device__ __forceinline__ bf16x8 tr_frag(LAS unsigned char* base, int rstride, int k0, int c0, int lane) {
    const int i = lane & 15, g = lane >> 4, q = i >> 2, pp = i & 3;
    LAS unsigned char* a = base + (k0 + 8 * g + q) * rstride + (c0 + 4 * pp) * 2;
    const bf16x4 lo = __builtin_amdgcn_ds_read_tr16_b64_v4i16((LAS bf16x4*)a);
    const bf16x4 hi = __builtin_amdgcn_ds_read_tr16_b64_v4i16((LAS bf16x4*)(a + 4 * rstride));
    return (bf16x8){lo[0], lo[1], lo[2], lo[3], hi[0], hi[1], hi[2], hi[3]};
}
__device__ __forceinline__ void ssd_prompt_unit(const Params& p, LAS unsigned char* lds, int b, int h) {
    unsigned char* ws = p.ws;
    const bf16_t* XC = (const bf16_t*)(ws + OFF_XBCC); const bf16_t* Z = (const bf16_t*)(ws + OFF_Z);
    const float* DTP = (const float*)(ws + OFF_DTP); const float* ACS = (const float*)(ws + OFF_ACS);
    bf16_t* YG = (bf16_t*)(ws + OFF_YG); float* SSQ = (float*)(ws + OFF_SSQ);
    const int tid = threadIdx.x, lane = tid & 63, w = __builtin_amdgcn_readfirstlane(tid >> 6), fr = lane & 15, fq = lane >> 4, g = h >> 3;
    const float Dh = p.in[I_DSKIP][h];
    LAS float* sAcs = (LAS float*)(lds + L_ACS); LAS float* sDt = (LAS float*)(lds + L_DT);
    f32x4 hacc[4];
#pragma unroll
    for (int i = 0; i < 4; ++i) hacc[i] = (f32x4){0.f, 0.f, 0.f, 0.f};
    const int hpt = w & 3, hnb = (w >> 2) * 4;
    for (int c = 0; c < SEQ / 128; ++c) {
        const int t0 = b * SEQ + c * 128;
        u32x4 rc[4], rb[4], rx[2]; float wv[2];
        { const int ch = tid & 15, row = tid >> 4;
#pragma unroll
          for (int i = 0; i < 4; ++i) { const bf16_t* src = XC + (size_t)(t0 + row + 32 * i) * 3072; rb[i] = *(const u32x4*)(src + 2048 + g * 128 + ch * 8); rc[i] = *(const u32x4*)(src + 2560 + g * 128 + ch * 8); } }
        const float acs_last = ACS[(size_t)(t0 + 127) * 32 + h];
        { const int ch = tid & 7, row = tid >> 3;
#pragma unroll
          for (int i = 0; i < 2; ++i) { const int r = t0 + row + 64 * i; rx[i] = *(const u32x4*)(XC + (size_t)r * 3072 + h * 64 + ch * 8);
              wv[i] = __expf(acs_last - ACS[(size_t)r * 32 + h]) * DTP[(size_t)r * 32 + h]; } }
        float my_acs = 0.f, my_dt = 0.f;
        if (tid < 128) { my_acs = ACS[(size_t)(t0 + tid) * 32 + h]; my_dt = DTP[(size_t)(t0 + tid) * 32 + h]; }
        __syncthreads();
#pragma unroll
        for (int i = 0; i < 4; ++i) { u32x2 o; o.x = cvt_pk_bf16(hacc[i][0], hacc[i][1]); o.y = cvt_pk_bf16(hacc[i][2], hacc[i][3]);
            *(LAS u32x2*)(lds + L_H + (16 * hpt + fr) * RS + (16 * (hnb + i) + 4 * fq) * 2) = o; }
        { const int ch = tid & 15, row = tid >> 4;
#pragma unroll
          for (int i = 0; i < 4; ++i) { *(LAS u32x4*)(lds + L_B + (row + 32 * i) * RS + ch * 16) = rb[i]; *(LAS u32x4*)(lds + L_C + (row + 32 * i) * RS + ch * 16) = rc[i]; } }
        { const int ch = tid & 7, row = tid >> 3;
#pragma unroll
          for (int i = 0; i < 2; ++i) { *(LAS u32x4*)(lds + L_X + (row + 64 * i) * RX + ch * 16) = rx[i];
              const float s = wv[i]; u32x4 o;
              o.x = cvt_pk_bf16(bflo(rx[i].x) * s, bfhi(rx[i].x) * s); o.y = cvt_pk_bf16(bflo(rx[i].y) * s, bfhi(rx[i].y) * s);
              o.z = cvt_pk_bf16(bflo(rx[i].z) * s, bfhi(rx[i].z) * s); o.w = cvt_pk_bf16(bflo(rx[i].w) * s, bfhi(rx[i].w) * s);
              *(LAS u32x4*)(lds + L_XW + (row + 64 * i) * RX + ch * 16) = o; } }
        if (tid < 128) { sAcs[tid] = my_acs; sDt[tid] = my_dt; }
        __syncthreads();
        const int qrow = 16 * w + fr;
        bf16x8 cf[4];
#pragma unroll
        for (int kk = 0; kk < 4; ++kk) cf[kk] = *(const LAS bf16x8*)(lds + L_C + qrow * RS + (kk * 32 + fq * 8) * 2);
        f32x4 yacc[4];
#pragma unroll
        for (int i = 0; i < 4; ++i) yacc[i] = (f32x4){0.f, 0.f, 0.f, 0.f};
        const float acs_q = sAcs[qrow];
        if (c > 0) {
#pragma unroll
            for (int pt = 0; pt < 4; ++pt)
#pragma unroll
                for (int kk = 0; kk < 4; ++kk) { const bf16x8 hf = *(const LAS bf16x8*)(lds + L_H + (16 * pt + fr) * RS + (kk * 32 + fq * 8) * 2);
                    yacc[pt] = __builtin_amdgcn_mfma_f32_16x16x32_bf16(hf, cf[kk], yacc[pt], 0, 0, 0); }
            const float eq = __expf(acs_q);
#pragma unroll
            for (int pt = 0; pt < 4; ++pt) yacc[pt] = yacc[pt] * eq;
        }
#pragma unroll
        for (int st = 0; st < 8; ++st) {
            f32x4 sacc = (f32x4){0.f, 0.f, 0.f, 0.f};
#pragma unroll
            for (int kk = 0; kk < 4; ++kk) { const bf16x8 bfr = *(const LAS bf16x8*)(lds + L_B + (16 * st + fr) * RS + (kk * 32 + fq * 8) * 2);
                sacc = __builtin_amdgcn_mfma_f32_16x16x32_bf16(bfr, cf[kk], sacc, 0, 0, 0); }
            const int s0 = 16 * st + 4 * fq;
            const f32x4 as = *(const LAS f32x4*)(sAcs + s0), ds = *(const LAS f32x4*)(sDt + s0);
            float pv[4];
#pragma unroll
            for (int j = 0; j < 4; ++j) pv[j] = (s0 + j <= qrow) ? sacc[j] * __expf(acs_q - as[j]) * ds[j] : 0.f;
            u32x2 o; o.x = cvt_pk_bf16(pv[0], pv[1]); o.y = cvt_pk_bf16(pv[2], pv[3]);
            *(LAS u32x2*)(lds + L_C + qrow * RS + s0 * 2) = o;
        }
#pragma unroll
        for (int kk = 0; kk < 4; ++kk) { const bf16x8 pf = *(const LAS bf16x8*)(lds + L_C + qrow * RS + (kk * 32 + fq * 8) * 2);
#pragma unroll
            for (int pt = 0; pt < 4; ++pt) { const bf16x8 xf = tr_frag(lds + L_X, RX, kk * 32, 16 * pt, lane);
                yacc[pt] = __builtin_amdgcn_mfma_f32_16x16x32_bf16(xf, pf, yacc[pt], 0, 0, 0); } }
        { float ss = 0.f; const size_t trow = (size_t)(t0 + qrow);
#pragma unroll
          for (int pt = 0; pt < 4; ++pt) { const int pc = 16 * pt + 4 * fq;
              const u32x2 xv = *(const LAS u32x2*)(lds + L_X + qrow * RX + pc * 2);
              const u32x2 zv = *(const u32x2*)(Z + trow * 2048 + h * 64 + pc);
              const float x0 = bflo(xv.x), x1 = bfhi(xv.x), x2 = bflo(xv.y), x3 = bfhi(xv.y);
              const float g0 = (yacc[pt][0] + Dh * x0) * siluf_(bflo(zv.x)), g1 = (yacc[pt][1] + Dh * x1) * siluf_(bfhi(zv.x));
              const float g2 = (yacc[pt][2] + Dh * x2) * siluf_(bflo(zv.y)), g3 = (yacc[pt][3] + Dh * x3) * siluf_(bfhi(zv.y));
              ss += (g0 * g0 + g1 * g1) + (g2 * g2 + g3 * g3);
              u32x2 o; o.x = cvt_pk_bf16(g0, g1); o.y = cvt_pk_bf16(g2, g3);
              *(u32x2*)(YG + trow * 2048 + h * 64 + pc) = o; }
          ss += __shfl_xor(ss, 16); ss += __shfl_xor(ss, 32);
          if (fq == 0) SSQ[trow * 32 + h] = ss; }
        { const float dec = __expf(acs_last);
#pragma unroll
          for (int i = 0; i < 4; ++i) hacc[i] = hacc[i] * dec;
#pragma unroll
          for (int kk = 0; kk < 4; ++kk) { const bf16x8 xwf = tr_frag(lds + L_XW, RX, kk * 32, 16 * hpt, lane);
#pragma unroll
              for (int i = 0; i < 4; ++i) { const bf16x8 bf = tr_frag(lds + L_B, RS, kk * 32, 16 * (hnb + i), lane);
                  hacc[i] = __builtin_amdgcn_mfma_f32_16x16x32_bf16(bf, xwf, hacc[i], 0, 0, 0); } } }
    }
    float* so = p.out + O_SSP + (((size_t)b * NH + h) * HD + 16 * hpt + fr) * DS;
#pragma unroll
    for (int i = 0; i < 4; ++i) *(f32x4*)(so + 16 * (hnb + i) + 4 * fq) = hacc[i];
    __syncthreads();
}
__device__ __forceinline__ void ssd_sample_item(const Params& p, LAS unsigned char* lds, int b, int h) {
    unsigned char* ws = p.ws;
    const bf16_t* XC = (const bf16_t*)(ws + OFF_XBCC); const bf16_t* Z = (const bf16_t*)(ws + OFF_Z);
    const float* DTP = (const float*)(ws + OFF_DTP); bf16_t* YG = (bf16_t*)(ws + OFF_YG); float* SSQ = (float*)(ws + OFF_SSQ);
    LAS float* red = (LAS float*)lds;
    const int tid = threadIdx.x, n4 = tid & 31, pr = tid >> 5, r = MP + b, g = h >> 3;
    const float dt = DTP[(size_t)r * 32 + h], dA = __expf(dt * -expf(p.in[I_ALOG][h])), Dh = p.in[I_DSKIP][h];
    const bf16_t* xr = XC + (size_t)r * 3072;
    const u32x2 bu = *(const u32x2*)(xr + 2048 + g * 128 + 4 * n4), cu = *(const u32x2*)(xr + 2560 + g * 128 + 4 * n4);
    const f32x4 Bv = (f32x4){bflo(bu.x), bfhi(bu.x), bflo(bu.y), bfhi(bu.y)}, Cv = (f32x4){bflo(cu.x), bfhi(cu.x), bflo(cu.y), bfhi(cu.y)};
    const size_t sbase = (((size_t)b * NH + h) * HD) * DS;
#pragma unroll
    for (int i = 0; i < 4; ++i) { const int pp = pr + 16 * i;
        const float xv = bf2f(xr[h * 64 + pp]);
        const f32x4 h0 = *(const f32x4*)(p.in[I_STS] + sbase + (size_t)pp * DS + 4 * n4);
        const f32x4 hn = h0 * dA + Bv * (dt * xv);
        *(f32x4*)(p.out + O_SSS + sbase + (size_t)pp * DS + 4 * n4) = hn;
        float y = (hn[0] * Cv[0] + hn[1] * Cv[1]) + (hn[2] * Cv[2] + hn[3] * Cv[3]);
#pragma unroll
        for (int o = 1; o < 32; o <<= 1) y += __shfl_xor(y, o);
        if (n4 == 0) { const float gt = (y + Dh * xv) * siluf_(bf2f(Z[(size_t)r * 2048 + h * 64 + pp])); YG[(size_t)r * 2048 + h * 64 + pp] = f2bf(gt); red[pp] = gt * gt; } }
    __syncthreads();
    if (tid < 64) { const float v = wave_sum(red[tid]); if (tid == 0) SSQ[(size_t)r * 32 + h] = v; }
    __syncthreads();
}
__device__ __forceinline__ void phase_ssd(const Params& p, LAS unsigned char* lds) {
    for (int u = blockIdx.x; u < NBP * NH; u += gridDim.x) {
        const int xcd = u & 7, j = u >> 3, pair = xcd * 4 + (j >> 3), hr = j & 7;
        ssd_prompt_unit(p, lds, pair >> 2, (pair & 3) * 8 + hr);
    }
    for (int it = blockIdx.x; it < NBS * NH; it += gridDim.x) ssd_sample_item(p, lds, it >> 5, it & 31);
}
__device__ __forceinline__ void phase_gnorm(const Params& p) {
    bf16_t* YG = (bf16_t*)(p.ws + OFF_YG); const float* SSQ = (const float*)(p.ws + OFF_SSQ);
    for (int i = blockIdx.x * 512 + threadIdx.x; i < MTOT * 256; i += gridDim.x * 512) {
        const int row = i >> 8, cu = i & 255, g = cu >> 6;
        const f32x4 s0 = *(const f32x4*)(SSQ + (size_t)row * 32 + 8 * g), s1 = *(const f32x4*)(SSQ + (size_t)row * 32 + 8 * g + 4);
        const float rstd = rsqrtf(((s0[0] + s0[1]) + (s0[2] + s0[3]) + (s1[0] + s1[1]) + (s1[2] + s1[3])) * (1.f / 512.f) + EPS);
        bf16_t* q = YG + (size_t)row * 2048 + cu * 8;
        const F8 v = ld8bf(q);
        *(u32x4*)q = pack8(v.a * rstd, v.b * rstd);
    }
}

__global__ void __launch_bounds__(512, 2) fwd_megakernel(Params p) {
    extern __shared__ __attribute__((aligned(16))) unsigned char shm[];
    LAS unsigned char* lds = (LAS unsigned char*)shm;
    cg::grid_group grid = cg::this_grid();
    unsigned char* ws = p.ws;
    const int G = gridDim.x, cid = blockIdx.x;
    float* mod = (float*)(ws + OFF_MOD);
    pg8::StaticOrder S;
    volatile LAS unsigned* xst = (volatile LAS unsigned*)(lds + 131072);
    if (threadIdx.x == 0) { xst[0] = 0u; xst[1] = 0u; }
    __syncthreads();
    XcdBarrier xb = xcd_barrier_post((unsigned*)(ws + OFF_BAR), xst);

    phase0(p, lds);
    if (PROBE_EW) { __syncthreads(); phase0(p, lds); }
    grid.sync();
    {
        pg8::Gemm g{(const bf16_t*)(ws + OFF_CA), (const bf16_t*)(ws + OFF_WADA), 256, 6144, 1024};
        EpiF32Bias E{mod, 6144, p.in[I_BADA]};
        S.init(g.M, g.N, G, cid); pg8::gemm_phase<EpiF32Bias, pg8::StaticOrder, true, true>(lds, g, S, E);
    }
    GSYNC();
    phase_rownorm(p, p.in[I_XP], p.in[I_XS], p.in[I_N1G], 1024, 0, (bf16_t*)(ws + OFF_U));
    if (PROBE_EW) phase_rownorm(p, p.in[I_XP], p.in[I_XS], p.in[I_N1G], 1024, 0, (bf16_t*)(ws + OFF_U));
    GSYNC();
    {
        pg8::Gemm g{(const bf16_t*)(ws + OFF_U), (const bf16_t*)(ws + OFF_WIN), MPAD, DINP, 1024};
        EpiIn E{(bf16_t*)(ws + OFF_BG), (bf16_t*)(ws + OFF_CI), (bf16_t*)(ws + OFF_Z), (bf16_t*)(ws + OFF_XBC), (bf16_t*)(ws + OFF_GA), (bf16_t*)(ws + OFF_GB), (float*)(ws + OFF_DTRAW)};
        S.init(g.M, g.N, G, cid); pg8::gemm_phase<EpiIn, pg8::StaticOrder, true, true>(lds, g, S, E);
    }
    GSYNC();
    phase_conv(p, lds);
    if (PROBE_CONV) { __syncthreads(); phase_conv(p, lds); }
    GSYNC();
    phase_ssd(p, lds);
    if (PROBE_SSD) { __syncthreads(); phase_ssd(p, lds); }
    GSYNC();
    phase_gnorm(p);
    GSYNC();
    {
        pg8::Gemm ga{(const bf16_t*)(ws + OFF_VA), (const bf16_t*)(ws + OFF_WAOUT), MPAD, 1024, 1024};
        EpiGate<0> Ea{(bf16_t*)(ws + OFF_YA), (const bf16_t*)(ws + OFF_GA), nullptr, 1024};
        S.init(ga.M, ga.N, G, cid); pg8::gemm_phase<EpiGate<0>, pg8::StaticOrder, true, true>(lds, ga, S, Ea);
        __syncthreads();
        pg8::Gemm gb{(const bf16_t*)(ws + OFF_YG), (const bf16_t*)(ws + OFF_WBOUT), MPAD, 1024, 2048};
        EpiGate<1> Eb{(bf16_t*)(ws + OFF_MERGED), (const bf16_t*)(ws + OFF_GB), (const bf16_t*)(ws + OFF_YA), 1024};
        pg8::gemm_phase<EpiGate<1>, pg8::StaticOrder, true, true>(lds, gb, S, Eb);
    }
    GSYNC();
    {
        pg8::Gemm g{(const bf16_t*)(ws + OFF_MERGED), (const bf16_t*)(ws + OFF_WO), MPAD, 1024, 1024};
        EpiRes E{(float*)(ws + OFF_X1), p.in[I_XP], p.in[I_XS], mod + 2048};
        S.init(g.M, g.N, G, cid); pg8::gemm_phase<EpiRes, pg8::StaticOrder, true, true>(lds, g, S, E);
    }
    GSYNC();
    {
        const float* X1 = (const float*)(ws + OFF_X1);
        phase_rownorm(p, X1, X1 + (size_t)MP * D, p.in[I_N2G], 4096, 3072, (bf16_t*)(ws + OFF_U));
        if (PROBE_EW) phase_rownorm(p, X1, X1 + (size_t)MP * D, p.in[I_N2G], 4096, 3072, (bf16_t*)(ws + OFF_U));
    }
    GSYNC();
    {
        pg8::Gemm g{(const bf16_t*)(ws + OFF_U), (const bf16_t*)(ws + OFF_W1), MPAD, DFF, 1024};
        EpiGate<2> E{(bf16_t*)(ws + OFF_HMID), nullptr, nullptr, DFF};
        S.init(g.M, g.N, G, cid); pg8::gemm_phase<EpiGate<2>, pg8::StaticOrder, true, true>(lds, g, S, E);
    }
    GSYNC();
    {
        pg8::Gemm g{(const bf16_t*)(ws + OFF_HMID), (const bf16_t*)(ws + OFF_W2), MPAD, 1024, DFF};
        EpiRes E{(float*)(ws + OFF_X1), nullptr, nullptr, mod + 5120};
        S.init(g.M, g.N, G, cid); pg8::gemm_phase<EpiRes, pg8::StaticOrder, true, true>(lds, g, S, E);
    }
    GSYNC();
    phase_final(p);
    if (PROBE_EW) phase_final(p);
}

extern "C" void kernel_launch(void* const* d_in, const int* in_sizes, int n_in, void* d_out, int out_size, void* d_ws, size_t ws_size, hipStream_t stream) {
    constexpr int LDS_BYTES = 131072 + 16;
    static int grid = 0;
    if (grid == 0) {
        if (n_in != 25 || ws_size < WS_END) { fprintf(stderr, "kernel_launch: unexpected n_in %d / ws %zu (need %zu)\n", n_in, ws_size, (size_t)WS_END); grid = -1; return; }
        int dev = 0, cus = 0, per_cu = 0;
        (void)hipGetDevice(&dev);
        (void)hipDeviceGetAttribute(&cus, hipDeviceAttributeMultiprocessorCount, dev);
        if (hipFuncSetAttribute((const void*)fwd_megakernel, hipFuncAttributeMaxDynamicSharedMemorySize, LDS_BYTES) != hipSuccess) { fprintf(stderr, "kernel_launch: hipFuncSetAttribute failed\n"); grid = -1; return; }
        if (hipOccupancyMaxActiveBlocksPerMultiprocessor(&per_cu, (const void*)fwd_megakernel, 512, LDS_BYTES) != hipSuccess || per_cu < 1) { fprintf(stderr, "kernel_launch: occupancy query says %d blocks per CU\n", per_cu); grid = -1; return; }
        grid = cus;
    }
    if (grid < 0) return;
    Params p{};
    for (int i = 0; i < 25; ++i) p.in[i] = (const float*)d_in[i];
    p.out = (float*)d_out; p.ws = (unsigned char*)d_ws;
    (void)hipMemsetAsync((unsigned char*)d_ws + OFF_BAR, 0, 16384, stream);
    void* args[] = {&p};
    hipError_t e = hipLaunchCooperativeKernel((const void*)fwd_megakernel, dim3(grid), dim3(512), args, LDS_BYTES, stream);
    if (e != hipSuccess) fprintf(stderr, "cooperative launch failed: %s (grid %d)\n", hipGetErrorString(e), grid);
}
```

```cpp
#include <hip/hip_runtime.h>
#include <hip/hip_cooperative_groups.h>
#include <cstdio>
#include <cstdint>
namespace cg = cooperative_groups;
#define PROBE_EW 0
#define PROBE_CONV 0
#define PROBE_SSD 0
#define PROBE_SYNC 0
#define GSYNC() do { xcd_barrier(xb); if (PROBE_SYNC) xcd_barrier(xb); } while (0)

#define LAS __attribute__((address_space(3)))
typedef unsigned short bf16_t;
typedef short bf16x8 __attribute__((ext_vector_type(8)));
typedef short bf16x4 __attribute__((ext_vector_type(4)));
typedef float f32x4 __attribute__((ext_vector_type(4)));
typedef float f32x2 __attribute__((ext_vector_type(2)));
typedef unsigned u32x4 __attribute__((ext_vector_type(4)));
typedef unsigned u32x2 __attribute__((ext_vector_type(2)));

constexpr int D = 1024, NBP = 8, SEQ = 2048, MP = NBP * SEQ, NBS = 128, MTOT = MP + NBS, MPAD = 16640;
constexpr int DINP = 10496, DINNER = 2048, DXBC = 3072, NH = 32, HD = 64, DS = 128, DFF = 4096, DIN = 10272;
constexpr float EPS = 1e-6f;
constexpr size_t O_YP = 0, O_YS = 16777216, O_SCP = 16908288, O_SBP = 16924672, O_SSP = 16998400, O_SCS = 19095552, O_SBS = 19357696, O_SSS = 20537344;
constexpr size_t S1 = (size_t)MPAD * 1024 * 2;
constexpr size_t OFF_WADA = 0, OFF_WIN = 12582912, OFF_WAOUT = 34078720, OFF_WBOUT = 36175872, OFF_WO = 40370176, OFF_W1 = 42467328, OFF_W2 = 50855936,
                 OFF_CA = 59244544, OFF_MOD = 59768832, OFF_DTRAW = 66060288, OFF_DTP = 68190208, OFF_ACS = 70320128, OFF_SSQ = 72450048, OFF_U = 74579968,
                 OFF_R1 = OFF_U + S1, OFF_BG = OFF_R1, OFF_CI = OFF_R1 + S1, OFF_Z = OFF_R1 + 2 * S1, OFF_XBC = OFF_R1 + 4 * S1, OFF_GA = OFF_R1 + 7 * S1, OFF_GB = OFF_R1 + 8 * S1,
                 OFF_R2 = OFF_R1 + 9 * S1, OFF_BAR = OFF_R2 + 3 * S1, WS_END = OFF_BAR + 16384;
constexpr size_t OFF_VA = OFF_U, OFF_YA = OFF_BG, OFF_MERGED = OFF_CI, OFF_YG = OFF_XBC, OFF_HMID = OFF_R1, OFF_XBCC = OFF_R2, OFF_X1 = OFF_R2;

struct Params {
    const float* in[25];
    float* out;
    unsigned char* ws;
};
enum { I_XP = 0, I_XS, I_CP, I_CS, I_STA, I_STB, I_STS, I_WADA, I_BADA, I_N1G, I_WIN, I_CAW, I_WAOUT, I_CBW, I_CBB, I_DTB, I_ALOG, I_DSKIP, I_SNG, I_WBOUT, I_WO, I_N2G, I_W1, I_W2, I_NFG };

__device__ __forceinline__ unsigned cvt_pk_bf16(float lo, float hi) { unsigned r; asm volatile("v_cvt_pk_bf16_f32 %0, %1, %2" : "=v"(r) : "v"(lo), "v"(hi)); return r; }
__device__ __forceinline__ bf16_t f2bf(float f) { unsigned u = __float_as_uint(f); u += 0x7FFFu + ((u >> 16) & 1u); return (bf16_t)(u >> 16); }
__device__ __forceinline__ float bf2f(bf16_t b) { return __uint_as_float(((unsigned)b) << 16); }
__device__ __forceinline__ float bflo(unsigned u) { return __uint_as_float(u << 16); }
__device__ __forceinline__ float bfhi(unsigned u) { return __uint_as_float(u & 0xffff0000u); }
__device__ __forceinline__ float sigmoidf_(float x) { return __builtin_amdgcn_rcpf(1.f + __expf(-x)); }
__device__ __forceinline__ float siluf_(float x) { return x * sigmoidf_(x); }
__device__ __forceinline__ float wave_sum(float v) {
#pragma unroll
    for (int o = 1; o < 64; o <<= 1) v += __shfl_xor(v, o);
    return v;
}


#define XB_TMO      128
#define XB_XCNT(j)  (256  + 64 * (j))
#define XB_XSUB(j)  (1280 + 64 * (j))
#define XB_XGEN(j)  (2304 + 64 * (j))
#define XB_TOP      3328
#define XB_TOPGEN   3392
#define XCD_BAR_WORDS 3456
#define XB_SPIN_CAP (1u << 18)
__device__ __forceinline__ unsigned xb_ld(unsigned* p)              { return __hip_atomic_load(p, __ATOMIC_RELAXED, __HIP_MEMORY_SCOPE_AGENT); }
__device__ __forceinline__ unsigned xb_add(unsigned* p, unsigned v) { return __hip_atomic_fetch_add(p, v, __ATOMIC_RELAXED, __HIP_MEMORY_SCOPE_AGENT); }
__device__ __forceinline__ unsigned xb_xcc_id() { return (unsigned)__builtin_amdgcn_s_getreg((3 << 11) | 20) & 0xFu; }
#define XB_SPIN(cond, bar) do { unsigned _sp = 0; while (cond) { __builtin_amdgcn_s_sleep(1); \
    if ((++_sp & 255u) == 0u) { if (xb_ld(&(bar)[XB_TMO])) break; if (_sp > XB_SPIN_CAP) { atomicAdd(&(bar)[XB_TMO], 1u); break; } } } } while (0)
struct XcdBarrier { unsigned* bar; unsigned x; volatile LAS unsigned* st; };
__device__ __forceinline__ XcdBarrier xcd_barrier_post(unsigned* bar, volatile LAS unsigned* st) {
    XcdBarrier b; b.bar = bar; b.x = xb_xcc_id(); b.st = st;
    if (threadIdx.x == 0) (void)xb_add(&bar[XB_XCNT(b.x)], 1u);
    return b;
}
__device__ __forceinline__ void xcd_barrier_complete(unsigned* bar, unsigned x, unsigned& nloc, unsigned& nx) {
    const unsigned G = gridDim.x * gridDim.y * gridDim.z;
    unsigned sum, cnt, mine, sp = 0u;
    for (;;) {
        sum = 0u; cnt = 0u; mine = 0u;
#pragma unroll
        for (unsigned j = 0; j < 16; ++j) { const unsigned c = xb_ld(&bar[XB_XCNT(j)]); sum += c; cnt += (c > 0u) ? 1u : 0u; mine = (j == x) ? c : mine; }
        if (sum == G) break;
        __builtin_amdgcn_s_sleep(1);
        if ((++sp & 255u) == 0u) { if (xb_ld(&bar[XB_TMO])) break; if (sp > XB_SPIN_CAP) { atomicAdd(&bar[XB_TMO], 1u); break; } }
    }
    nloc = mine > 0u ? mine : 1u; nx = cnt > 0u ? cnt : 1u;
}
__device__ __forceinline__ void xcd_barrier(const XcdBarrier& b) {
    asm volatile("s_waitcnt vmcnt(0)" ::: "memory");
    __syncthreads();
    if (threadIdx.x == 0) {
        unsigned* bar = b.bar;
        __builtin_amdgcn_s_waitcnt(0);
        unsigned nloc = b.st[0], nx = b.st[1];
        if (nloc == 0u) { xcd_barrier_complete(bar, b.x, nloc, nx); b.st[0] = nloc; b.st[1] = nx; }
        const unsigned old = xb_add(&bar[XB_XSUB(b.x)], 1u);
        const unsigned gen = old / nloc;
        if (old + 1u == (gen + 1u) * nloc) {
            __builtin_amdgcn_fence(__ATOMIC_RELEASE, "agent");
            asm volatile("s_waitcnt vmcnt(0)" ::: "memory");
            const unsigned og = xb_add(&bar[XB_TOP], 1u);
            const unsigned tg = og / nx;
            if (og + 1u == (tg + 1u) * nx) xb_add(&bar[XB_TOPGEN], 1u);
            else XB_SPIN(xb_ld(&bar[XB_TOPGEN]) == tg, bar);
            __builtin_amdgcn_fence(__ATOMIC_ACQUIRE, "agent");
            xb_add(&bar[XB_XGEN(b.x)], 1u);
            asm volatile("s_waitcnt vmcnt(0)" ::: "memory");
        } else {
            XB_SPIN(xb_ld(&bar[XB_XGEN(b.x)]) == gen, bar);
            __builtin_amdgcn_fence(__ATOMIC_ACQUIRE, "agent");
            asm volatile("s_waitcnt vmcnt(0)" ::: "memory");
        }
    }
    __syncthreads();
}

namespace pg8 {
#define PG8_LAS __attribute__((address_space(3)))
constexpr int BM = 256, BK = 64, HALF = 128, HTB = HALF * BK * 2, STAGE_BYTES = 8 * HTB, NXCD = 8, WGM = 8;
__host__ __device__ __forceinline__ int lds_byte(int r, int c) { const int st = (r >> 4) * 2 + (c >> 5), rr = r & 15, cc = c & 31, ob = rr * 64 + cc * 2; return st * 1024 + (ob ^ (((ob >> 9) & 1) << 5)); }
__host__ __device__ __forceinline__ void stage_rc(int b, int& R, int& C) { const int st = b / 1024, sb = b % 1024, swz = sb ^ (((sb >> 9) & 1) << 5); R = (st >> 1) * 16 + swz / 64; C = (st & 1) * 32 + (swz % 64) / 2; }
__host__ __device__ __forceinline__ int perm32(int rho) { const int n = rho >> 4, i = rho & 15; return 8 * (i >> 2) + 4 * n + (i & 3); }
struct Unit { int pm, pn; };
struct Gemm { const bf16_t* A; const bf16_t* Bt; int M, N, K; };
struct StaticOrder {
    int nM, nN, nwg, G, c;
    __host__ __device__ void init(int M, int N, int G_, int c_) { nM = M / BM; nN = N / BM; nwg = nM * nN; G = G_; c = c_; }
    __host__ __device__ bool next(int i, Unit& u) const {
        const long L = (long)i * G + c; if (L >= nwg) return false;
        int wgid = (int)L; { const int q = nwg / NXCD, r = nwg % NXCD, xcd = wgid % NXCD, off = wgid / NXCD; wgid = (xcd < r ? xcd * (q + 1) : r * (q + 1) + (xcd - r) * q) + off; }
        const int nig = WGM * nN, gid = wgid / nig, fm = gid * WGM, gsz = (nM - fm) < WGM ? (nM - fm) : WGM;
        u.pm = fm + ((wgid % nig) % gsz); u.pn = (wgid % nig) / gsz; return true;
    }
    __device__ __forceinline__ void a_ready(const Unit&) const {}
    __device__ __forceinline__ void done(const Unit&) const {}
};

template <class Epi, class Sched, bool ALIGN_EPI = false, bool SP2 = false>
__device__ __forceinline__ void gemm_phase(PG8_LAS unsigned char* lds, const Gemm g, const Sched& S, const Epi& E) {
    const int tid = threadIdx.x, wid = __builtin_amdgcn_readfirstlane(tid >> 6), lane = tid & 63, wr = wid >> 2, wc = wid & 3, fr = lane & 15, fq = lane >> 4;
    const int K = g.K, nt = K / BK;
    unsigned voffA[2], voffB[2];
#pragma unroll
    for (int i = 0; i < 2; ++i) { int R, C; stage_rc(tid * 16 + i * 8192, R, C); const int Rb = Epi::PERM ? ((R & ~31) + perm32(R & 31)) : R;
        voffA[i] = (unsigned)(R * K + C) * 2u; voffB[i] = (unsigned)(Rb * K + C) * 2u; }
    const size_t kstep = (size_t)(BK * 2);
    const size_t hstep = (size_t)HALF * K * 2;
    const size_t tstep = 2 * hstep;
    const unsigned ldsw = (unsigned)wid * 1024u;
    const int aoff = lds_byte(wr * 64 + fr, fq * 8), boff = lds_byte(wc * 32 + fr, fq * 8);
#define PG8_SA(b, h) (((b) * 2 + (h)) * HTB)
#define PG8_SB(b, h) ((4 + (b) * 2 + (h)) * HTB)
#define PG8_STAGE(bufoff, gbase, voff) do { _Pragma("unroll") for (int _i = 0; _i < 2; ++_i) \
        __builtin_amdgcn_global_load_lds((const unsigned*)((const char*)(gbase) + (voff)[_i]), (PG8_LAS unsigned*)(lds + (bufoff) + ldsw + _i * 8192), 16, 0, 0); } while (0)
#define PG8_LDA(dst, b, h) do { _Pragma("unroll") for (int m = 0; m < 4; ++m) _Pragma("unroll") for (int k = 0; k < 2; ++k) dst[m][k] = *(const PG8_LAS bf16x8*)(lds + PG8_SA(b, h) + aoff + m * 2048 + k * 1024); } while (0)
#define PG8_LDB(dst, b, h) do { _Pragma("unroll") for (int n = 0; n < 2; ++n) _Pragma("unroll") for (int k = 0; k < 2; ++k) dst[n][k] = *(const PG8_LAS bf16x8*)(lds + PG8_SB(b, h) + boff + n * 2048 + k * 1024); } while (0)
#define PG8_MMA(ai, bj, At, Bt) do { __builtin_amdgcn_s_setprio(1); _Pragma("unroll") for (int m = 0; m < 4; ++m) _Pragma("unroll") for (int n = 0; n < 2; ++n) _Pragma("unroll") for (int k = 0; k < 2; ++k) \
        acc[ai][bj][m][n] = __builtin_amdgcn_mfma_f32_16x16x32_bf16(Bt[n][k], At[m][k], acc[ai][bj][m][n], 0, 0, 0); __builtin_amdgcn_s_setprio(0); } while (0)
#define PG8_WAIT_V(n) asm volatile("s_waitcnt vmcnt(" #n ")" ::: "memory")
#define PG8_WAIT_L(n) asm volatile("s_waitcnt lgkmcnt(" #n ")" ::: "memory")
#define PG8_BAR __builtin_amdgcn_s_barrier()
#define PG8_SCHED __builtin_amdgcn_sched_barrier(0)
    Unit cur, nxt; int ui = 0;
    if (!S.next(0, cur)) return;
    f32x4 acc[2][2][4][2];
#pragma unroll
    for (int a = 0; a < 2; ++a)
#pragma unroll
        for (int b = 0; b < 2; ++b)
#pragma unroll
            for (int m = 0; m < 4; ++m)
#pragma unroll
                for (int n = 0; n < 2; ++n) acc[a][b][m][n] = (f32x4){0.f, 0.f, 0.f, 0.f};
    bf16x8 At[4][2], B0[2][2], B1[2][2];
    const char* cA = (const char*)g.A + (size_t)cur.pm * tstep; const char* cB = (const char*)g.Bt + (size_t)cur.pn * tstep;
    S.a_ready(cur);
    if constexpr (SP2) {
        PG8_STAGE(PG8_SB(0, 0), cB, voffB); PG8_STAGE(PG8_SB(0, 1), cB + hstep, voffB); PG8_STAGE(PG8_SA(0, 0), cA, voffA); PG8_STAGE(PG8_SA(0, 1), cA + hstep, voffA);
        if (wr == 1) PG8_BAR;
        PG8_WAIT_V(2); PG8_BAR;
        PG8_STAGE(PG8_SB(1, 0), cB + kstep, voffB); PG8_STAGE(PG8_SA(1, 0), cA + kstep, voffA); PG8_STAGE(PG8_SB(1, 1), cB + hstep + kstep, voffB);
        PG8_WAIT_V(6); PG8_BAR;
    } else {
        PG8_STAGE(PG8_SB(0, 0), cB, voffB); PG8_STAGE(PG8_SA(0, 0), cA, voffA); PG8_STAGE(PG8_SB(0, 1), cB + hstep, voffB); PG8_STAGE(PG8_SA(0, 1), cA + hstep, voffA);
        if (wr == 1) PG8_BAR;
        PG8_WAIT_V(4); PG8_BAR;
        PG8_STAGE(PG8_SB(1, 0), cB + kstep, voffB); PG8_STAGE(PG8_SA(1, 0), cA + kstep, voffA); PG8_STAGE(PG8_SB(1, 1), cB + hstep + kstep, voffB);
        PG8_WAIT_V(6); PG8_BAR;
    }
    for (;;) {
        const bool has_next = S.next(ui + 1, nxt);
        const char* nA = has_next ? (const char*)g.A + (size_t)nxt.pm * tstep : cA; const char* nB = has_next ? (const char*)g.Bt + (size_t)nxt.pn * tstep : cB;
        for (int t = 0; t < nt; t += 2) {
            const bool last = (t == nt - 2);
            const char* a1 = cA + (size_t)(t + 1) * kstep;
            const char* a2 = last ? nA : cA + (size_t)(t + 2) * kstep; const char* b2 = last ? nB : cB + (size_t)(t + 2) * kstep;
            const char* a3 = a2 + kstep; const char* b3 = b2 + kstep;
            if (last && has_next) S.a_ready(nxt);
            if constexpr (SP2) {
            PG8_LDB(B0, 0, 0); PG8_LDB(B1, 0, 1); PG8_SCHED; PG8_LDA(At, 0, 0); PG8_STAGE(PG8_SA(1, 1), a1 + hstep, voffA);
            PG8_WAIT_V(8); PG8_WAIT_L(0); PG8_BAR; PG8_MMA(0, 0, At, B0); PG8_MMA(0, 1, At, B1); PG8_BAR; PG8_SCHED;
            PG8_LDA(At, 0, 1); PG8_STAGE(PG8_SB(0, 0), b2, voffB); PG8_STAGE(PG8_SB(0, 1), b2 + hstep, voffB); PG8_STAGE(PG8_SA(0, 0), a2, voffA);
            PG8_WAIT_V(8); PG8_WAIT_L(0); PG8_BAR; PG8_MMA(1, 0, At, B0); PG8_MMA(1, 1, At, B1); PG8_BAR; PG8_SCHED;
            PG8_LDB(B0, 1, 0); PG8_LDB(B1, 1, 1); PG8_SCHED; PG8_LDA(At, 1, 0); PG8_STAGE(PG8_SA(0, 1), a2 + hstep, voffA);
            PG8_WAIT_V(8); PG8_WAIT_L(0); PG8_BAR; PG8_MMA(0, 0, At, B0); PG8_MMA(0, 1, At, B1); PG8_BAR; PG8_SCHED;
            PG8_LDA(At, 1, 1); PG8_STAGE(PG8_SB(1, 0), b3, voffB); PG8_STAGE(PG8_SB(1, 1), b3 + hstep, voffB); PG8_STAGE(PG8_SA(1, 0), a3, voffA);
            PG8_WAIT_V(8); PG8_WAIT_L(0); PG8_BAR; PG8_MMA(1, 0, At, B0); PG8_MMA(1, 1, At, B1); PG8_BAR; PG8_SCHED;
            } else {
            PG8_LDB(B0, 0, 0); PG8_SCHED; PG8_LDA(At, 0, 0); PG8_STAGE(PG8_SA(1, 1), a1 + hstep, voffA);
            PG8_WAIT_L(8); PG8_BAR; PG8_WAIT_L(0); PG8_MMA(0, 0, At, B0); PG8_BAR; PG8_SCHED;
            PG8_LDB(B1, 0, 1); PG8_STAGE(PG8_SB(0, 0), b2, voffB);
            PG8_BAR; PG8_WAIT_L(0); PG8_MMA(0, 1, At, B1); PG8_BAR;
            PG8_LDA(At, 0, 1); PG8_STAGE(PG8_SA(0, 0), a2, voffA);
            PG8_BAR; PG8_WAIT_L(0); PG8_MMA(1, 0, At, B0); PG8_BAR; PG8_SCHED;
            PG8_STAGE(PG8_SB(0, 1), b2 + hstep, voffB);
            PG8_WAIT_V(6); PG8_BAR; PG8_MMA(1, 1, At, B1); PG8_BAR;
            PG8_LDB(B0, 1, 0); PG8_SCHED; PG8_LDA(At, 1, 0); PG8_STAGE(PG8_SA(0, 1), a2 + hstep, voffA);
            PG8_WAIT_L(8); PG8_BAR; PG8_WAIT_L(0); PG8_MMA(0, 0, At, B0); PG8_BAR; PG8_SCHED;
            PG8_LDB(B1, 1, 1); PG8_STAGE(PG8_SB(1, 0), b3, voffB);
            PG8_BAR; PG8_WAIT_L(0); PG8_MMA(0, 1, At, B1); PG8_BAR;
            PG8_LDA(At, 1, 1); PG8_STAGE(PG8_SA(1, 0), a3, voffA);
            PG8_BAR; PG8_WAIT_L(0); PG8_MMA(1, 0, At, B0); PG8_BAR; PG8_SCHED;
            PG8_STAGE(PG8_SB(1, 1), b3 + hstep, voffB);
            PG8_WAIT_V(6); PG8_BAR; PG8_MMA(1, 1, At, B1); PG8_BAR;
            }
        }
        if constexpr (ALIGN_EPI) { if (wr == 0) PG8_BAR; }
        E(acc, cur, wr, wc, fr, fq);
        if (!has_next) break;
#pragma unroll
        for (int a = 0; a < 2; ++a)
#pragma unroll
            for (int b = 0; b < 2; ++b)
#pragma unroll
                for (int m = 0; m < 4; ++m)
#pragma unroll
                    for (int n = 0; n < 2; ++n) acc[a][b][m][n] = (f32x4){0.f, 0.f, 0.f, 0.f};
        cur = nxt; cA = nA; cB = nB; ++ui;
        if constexpr (ALIGN_EPI) { if (wr == 1) PG8_BAR; }
    }
    PG8_WAIT_V(0);
    if constexpr (!ALIGN_EPI) { if (wr == 0) PG8_BAR; }
    PG8_BAR;
#undef PG8_SA
#undef PG8_SB
#undef PG8_STAGE
#undef PG8_LDA
#undef PG8_LDB
#undef PG8_MMA
#undef PG8_WAIT_V
#undef PG8_WAIT_L
#undef PG8_BAR
#undef PG8_SCHED
}
}
using pg8::Unit;
typedef f32x4 AccT[2][2][4][2];

struct EpiF32Bias {
    static constexpr bool PERM = false;
    float* C; int ldc; const float* bias;
    __device__ __forceinline__ void operator()(const AccT& acc, const Unit& u, int wr, int wc, int fr, int fq) const {
        const int row0 = u.pm * 256 + wr * 64 + fr, col0 = u.pn * 256 + wc * 32 + 4 * fq;
#pragma unroll
        for (int ai = 0; ai < 2; ++ai)
#pragma unroll
            for (int m = 0; m < 4; ++m) { float* rowp = C + (size_t)(row0 + ai * 128 + m * 16) * ldc + col0;
#pragma unroll
                for (int bj = 0; bj < 2; ++bj)
#pragma unroll
                    for (int n = 0; n < 2; ++n) *(f32x4*)(rowp + bj * 128 + n * 16) = acc[ai][bj][m][n] + *(const f32x4*)(bias + col0 + bj * 128 + n * 16); }
    }
};
__device__ __forceinline__ u32x4 pack8(f32x4 v0, f32x4 v1) { u32x4 w; w.x = cvt_pk_bf16(v0[0], v0[1]); w.y = cvt_pk_bf16(v0[2], v0[3]); w.z = cvt_pk_bf16(v1[0], v1[1]); w.w = cvt_pk_bf16(v1[2], v1[3]); return w; }
struct EpiIn {
    static constexpr bool PERM = true;
    bf16_t *BG, *CI, *Z, *XBC, *GA, *GB; float* DT;
    __device__ __forceinline__ void operator()(const AccT& acc, const Unit& u, int wr, int wc, int fr, int fq) const {
        const int pn = u.pn, row0 = u.pm * 256 + wr * 64 + fr, cin = wc * 32 + 8 * fq;
        if (pn >= 4 && pn < 12) {
            const int col = (pn - 4) * 128 + cin;
#pragma unroll
            for (int ai = 0; ai < 2; ++ai)
#pragma unroll
                for (int m = 0; m < 4; ++m) { const size_t row = row0 + ai * 128 + m * 16;
                    *(u32x4*)(CI + row * 1024 + col) = pack8(acc[ai][0][m][0] * acc[ai][1][m][0], acc[ai][0][m][1] * acc[ai][1][m][1]); }
        } else if (pn == 40) {
            if (wc == 0) {
#pragma unroll
                for (int ai = 0; ai < 2; ++ai)
#pragma unroll
                    for (int m = 0; m < 4; ++m) { const size_t row = row0 + ai * 128 + m * 16;
                        *(f32x4*)(DT + row * 32 + 8 * fq) = acc[ai][0][m][0]; *(f32x4*)(DT + row * 32 + 8 * fq + 4) = acc[ai][0][m][1]; }
            }
        } else {
            bf16_t* O; int ldc, colt;
            if (pn < 4) { O = BG; ldc = 1024; colt = pn * 256; }
            else if (pn < 20) { O = Z; ldc = 2048; colt = (pn - 12) * 256; }
            else if (pn < 32) { O = XBC; ldc = 3072; colt = (pn - 20) * 256; }
            else if (pn < 36) { O = GA; ldc = 1024; colt = (pn - 32) * 256; }
            else { O = GB; ldc = 1024; colt = (pn - 36) * 256; }
#pragma unroll
            for (int ai = 0; ai < 2; ++ai)
#pragma unroll
                for (int m = 0; m < 4; ++m) { bf16_t* rowp = O + (size_t)(row0 + ai * 128 + m * 16) * ldc + colt + cin;
#pragma unroll
                    for (int bj = 0; bj < 2; ++bj) *(u32x4*)(rowp + bj * 128) = pack8(acc[ai][bj][m][0], acc[ai][bj][m][1]); }
        }
    }
};
template <int MODE> struct EpiGate {
    static constexpr bool PERM = true;
    bf16_t* O; const bf16_t* G; const bf16_t* Y; int ldc;
    __device__ __forceinline__ void operator()(const AccT& acc, const Unit& u, int wr, int wc, int fr, int fq) const {
        const int row0 = u.pm * 256 + wr * 64 + fr, col0 = u.pn * 256 + wc * 32 + 8 * fq;
#pragma unroll
        for (int ai = 0; ai < 2; ++ai)
#pragma unroll
            for (int m = 0; m < 4; ++m) { const size_t off = (size_t)(row0 + ai * 128 + m * 16) * ldc + col0;
#pragma unroll
                for (int bj = 0; bj < 2; ++bj) { f32x4 v0 = acc[ai][bj][m][0], v1 = acc[ai][bj][m][1];
                    if (MODE == 2) {
#pragma unroll
                        for (int j = 0; j < 4; ++j) { float a = fmaxf(v0[j], 0.f), b = fmaxf(v1[j], 0.f); v0[j] = a * a; v1[j] = b * b; }
                    } else {
                        const u32x4 gv = *(const u32x4*)(G + off + bj * 128);
                        v0[0] *= sigmoidf_(bflo(gv.x)); v0[1] *= sigmoidf_(bfhi(gv.x)); v0[2] *= sigmoidf_(bflo(gv.y)); v0[3] *= sigmoidf_(bfhi(gv.y));
                        v1[0] *= sigmoidf_(bflo(gv.z)); v1[1] *= sigmoidf_(bfhi(gv.z)); v1[2] *= sigmoidf_(bflo(gv.w)); v1[3] *= sigmoidf_(bfhi(gv.w));
                        if (MODE == 1) { const u32x4 yv = *(const u32x4*)(Y + off + bj * 128);
                            v0[0] += bflo(yv.x); v0[1] += bfhi(yv.x); v0[2] += bflo(yv.y); v0[3] += bfhi(yv.y);
                            v1[0] += bflo(yv.z); v1[1] += bfhi(yv.z); v1[2] += bflo(yv.w); v1[3] += bfhi(yv.w); }
                    }
                    *(u32x4*)(O + off + bj * 128) = pack8(v0, v1); } }
    }
};
struct EpiRes {
    static constexpr bool PERM = false;
    float* X1; const float* xp; const float* xs; const float* gate;
    __device__ __forceinline__ void operator()(const AccT& acc, const Unit& u, int wr, int wc, int fr, int fq) const {
        const int row0 = u.pm * 256 + wr * 64 + fr, col0 = u.pn * 256 + wc * 32 + 4 * fq;
#pragma unroll
        for (int ai = 0; ai < 2; ++ai)
#pragma unroll
            for (int m = 0; m < 4; ++m) { const int row = row0 + ai * 128 + m * 16;
                if (row < MTOT) {
                    const int seq = row < MP ? (row >> 11) : (NBP + row - MP);
                    const float* src = xp ? (row < MP ? xp + (size_t)row * D : xs + (size_t)(row - MP) * D) : X1 + (size_t)row * D;
                    const float* gr = gate + (size_t)seq * 6144;
#pragma unroll
                    for (int bj = 0; bj < 2; ++bj)
#pragma unroll
                        for (int n = 0; n < 2; ++n) { const int c = col0 + bj * 128 + n * 16;
                            *(f32x4*)(X1 + (size_t)row * D + c) = *(const f32x4*)(src + c) + *(const f32x4*)(gr + c) * acc[ai][bj][m][n]; }
                } }
    }
};

__device__ __forceinline__ int win_dest(int n) {
    if (n < 1024) return n;
    if (n < 2048) { const int j = n - 1024; return 1024 + (j >> 7) * 256 + (j & 127); }
    if (n < 3072) { const int j = n - 2048; return 1024 + (j >> 7) * 256 + 128 + (j & 127); }
    if (n < 8192) return n;
    if (n < 8224) return 10240 + (n - 8192);
    return n - 32;
}
__device__ __forceinline__ void transpose_tile(const float* W, int K, int N, bf16_t* WT, int kt, int ntile, bool remap, const float* kscale, LAS float* scr) {
    const int tid = threadIdx.x, k0 = kt * 64, n0 = ntile * 64, nl = tid & 63, ks = tid >> 6, n = n0 + nl;
#pragma unroll
    for (int i = 0; i < 8; ++i) { const int k = ks + 8 * i; float v = (n < N) ? W[(size_t)(k0 + k) * N + n] : 0.f; if (kscale) v *= kscale[k0 + k]; scr[nl * 65 + k] = v; }
    __syncthreads();
    const int nr = tid >> 3, kc = (tid & 7) * 8, ns = n0 + nr;
    if (ns < N) {
        const int dr = remap ? win_dest(ns) : ns;
        const LAS float* s = scr + nr * 65 + kc;
        u32x4 o; o.x = cvt_pk_bf16(s[0], s[1]); o.y = cvt_pk_bf16(s[2], s[3]); o.z = cvt_pk_bf16(s[4], s[5]); o.w = cvt_pk_bf16(s[6], s[7]);
        *(u32x4*)(WT + (size_t)dr * K + k0 + kc) = o;
    }
    __syncthreads();
}
__device__ __forceinline__ void phase0(const Params& p, LAS unsigned char* lds) {
    LAS float* scr = (LAS float*)lds;
    unsigned char* ws = p.ws;
    constexpr int T_ADA = 16 * 96, T_IN = 16 * 161, T_AO = 16 * 16, T_BO = 32 * 16, T_O = 16 * 16, T_1 = 16 * 64, T_2 = 64 * 16;
    constexpr int TOT = T_ADA + T_IN + T_AO + T_BO + T_O + T_1 + T_2;
    for (int it = blockIdx.x; it < TOT; it += gridDim.x) {
        int r = it;
        if (r < T_ADA) { transpose_tile(p.in[I_WADA], 1024, 6144, (bf16_t*)(ws + OFF_WADA), r / 96, r % 96, false, nullptr, scr); continue; } r -= T_ADA;
        if (r < T_IN) { transpose_tile(p.in[I_WIN], 1024, DIN, (bf16_t*)(ws + OFF_WIN), r / 161, r % 161, true, nullptr, scr); continue; } r -= T_IN;
        if (r < T_AO) { transpose_tile(p.in[I_WAOUT], 1024, 1024, (bf16_t*)(ws + OFF_WAOUT), r / 16, r % 16, false, nullptr, scr); continue; } r -= T_AO;
        if (r < T_BO) { transpose_tile(p.in[I_WBOUT], 2048, 1024, (bf16_t*)(ws + OFF_WBOUT), r / 16, r % 16, false, p.in[I_SNG], scr); continue; } r -= T_BO;
        if (r < T_O) { transpose_tile(p.in[I_WO], 1024, 1024, (bf16_t*)(ws + OFF_WO), r / 16, r % 16, false, nullptr, scr); continue; } r -= T_O;
        if (r < T_1) { transpose_tile(p.in[I_W1], 1024, 4096, (bf16_t*)(ws + OFF_W1), r / 64, r % 64, false, nullptr, scr); continue; } r -= T_1;
        transpose_tile(p.in[I_W2], 4096, 1024, (bf16_t*)(ws + OFF_W2), r / 16, r % 16, false, nullptr, scr);
    }
    bf16_t* cA = (bf16_t*)(ws + OFF_CA);
    for (int i = blockIdx.x * 512 + threadIdx.x; i < (NBP + NBS) * D; i += gridDim.x * 512) {
        const int row = i >> 10, k = i & 1023;
        const float v = row < NBP ? p.in[I_CP][row * D + k] : p.in[I_CS][(row - NBP) * D + k];
        cA[i] = f2bf(siluf_(v));
    }
}

__device__ __forceinline__ void rownorm_mod(const float* xrow, const float* g, const float* sc, const float* sh, bf16_t* orow, int lane) {
    f32x4 v[4]; float s = 0.f;
#pragma unroll
    for (int j = 0; j < 4; ++j) { v[j] = ((const f32x4*)xrow)[lane + 64 * j]; s += (v[j][0] * v[j][0] + v[j][1] * v[j][1]) + (v[j][2] * v[j][2] + v[j][3] * v[j][3]); }
    const float rstd = rsqrtf(wave_sum(s) * (1.f / D) + EPS);
#pragma unroll
    for (int j = 0; j < 4; ++j) { const int i4 = lane + 64 * j;
        const f32x4 gg = ((const f32x4*)g)[i4], scv = ((const f32x4*)sc)[i4], shv = ((const f32x4*)sh)[i4];
        const f32x4 o = v[j] * rstd * gg * (scv + 1.f) + shv;
        u32x2 w; w.x = cvt_pk_bf16(o[0], o[1]); w.y = cvt_pk_bf16(o[2], o[3]);
        ((u32x2*)orow)[i4] = w; }
}
__device__ __forceinline__ void phase_rownorm(const Params& p, const float* xp, const float* xs, const float* gvec, int sc_off, int sh_off, bf16_t* U) {
    const int lane = threadIdx.x & 63, gw = blockIdx.x * 8 + (threadIdx.x >> 6), NW = gridDim.x * 8;
    const float* mod = (const float*)(p.ws + OFF_MOD);
    for (int row = gw; row < MTOT; row += NW) {
        const int seq = row < MP ? (row >> 11) : (NBP + row - MP);
        const float* xrow = row < MP ? xp + (size_t)row * D : xs + (size_t)(row - MP) * D;
        rownorm_mod(xrow, gvec, mod + (size_t)seq * 6144 + sc_off, mod + (size_t)seq * 6144 + sh_off, U + (size_t)row * D, lane);
    }
}
__device__ __forceinline__ void phase_final(const Params& p) {
    const int lane = threadIdx.x & 63, gw = blockIdx.x * 8 + (threadIdx.x >> 6), NW = gridDim.x * 8;
    const float* X = (const float*)(p.ws + OFF_X1); const float* g = p.in[I_NFG];
    for (int row = gw; row < MTOT; row += NW) {
        const float* xrow = X + (size_t)row * D;
        float* orow = row < MP ? p.out + O_YP + (size_t)row * D : p.out + O_YS + (size_t)(row - MP) * D;
        f32x4 v[4]; float s = 0.f;
#pragma unroll
        for (int j = 0; j < 4; ++j) { v[j] = ((const f32x4*)xrow)[lane + 64 * j]; s += (v[j][0] * v[j][0] + v[j][1] * v[j][1]) + (v[j][2] * v[j][2] + v[j][3] * v[j][3]); }
        const float rstd = rsqrtf(wave_sum(s) * (1.f / D) + EPS);
#pragma unroll
        for (int j = 0; j < 4; ++j) ((f32x4*)orow)[lane + 64 * j] = v[j] * rstd * ((const f32x4*)g)[lane + 64 * j];
    }
}

struct F8 { f32x4 a, b; };
__device__ __forceinline__ F8 ld8bf(const bf16_t* p) { const u32x4 u = *(const u32x4*)p; F8 r; r.a = (f32x4){bflo(u.x), bfhi(u.x), bflo(u.y), bfhi(u.y)}; r.b = (f32x4){bflo(u.z), bfhi(u.z), bflo(u.w), bfhi(u.w)}; return r; }
__device__ __forceinline__ F8 cv8(const u32x4 u) { F8 r; r.a = (f32x4){bflo(u.x), bfhi(u.x), bflo(u.y), bfhi(u.y)}; r.b = (f32x4){bflo(u.z), bfhi(u.z), bflo(u.w), bfhi(u.w)}; return r; }
__device__ __forceinline__ F8 ld8f(const float* p) { F8 r; r.a = *(const f32x4*)p; r.b = *(const f32x4*)(p + 4); return r; }
__device__ __forceinline__ void st8f(float* p, const F8& v) { *(f32x4*)p = v.a; *(f32x4*)(p + 4) = v.b; }
__device__ __forceinline__ F8 zero8() { F8 r; r.a = (f32x4){0.f, 0.f, 0.f, 0.f}; r.b = r.a; return r; }
__device__ __forceinline__ void phase_conv(const Params& p, LAS unsigned char* lds) {
    unsigned char* ws = p.ws;
    const bf16_t* BG = (const bf16_t*)(ws + OFF_BG); const bf16_t* CI = (const bf16_t*)(ws + OFF_CI); const bf16_t* XBC = (const bf16_t*)(ws + OFF_XBC);
    bf16_t* VA = (bf16_t*)(ws + OFF_VA); bf16_t* XC = (bf16_t*)(ws + OFF_XBCC);
    const int tid = threadIdx.x;
    for (int it = blockIdx.x; it < MP / 8 + NBS; it += gridDim.x) {
        if (it < MP / 8) {
            const int r0 = it * 8, tpos0 = r0 & (SEQ - 1), b = r0 >> 11;
            if (tid < 128) {
                const int ch = tid * 8;
                u32x4 raw[10], bgr[8];
#pragma unroll
                for (int i = 0; i < 10; ++i) raw[i] = (tpos0 - 2 + i >= 0) ? *(const u32x4*)(CI + (size_t)(r0 - 2 + i) * 1024 + ch) : (u32x4){0u, 0u, 0u, 0u};
#pragma unroll
                for (int i = 0; i < 8; ++i) bgr[i] = *(const u32x4*)(BG + (size_t)(r0 + i) * 1024 + ch);
                const F8 w0 = ld8f(p.in[I_CAW] + ch), w1 = ld8f(p.in[I_CAW] + 1024 + ch), w2 = ld8f(p.in[I_CAW] + 2048 + ch);
#pragma unroll
                for (int i = 0; i < 8; ++i) { const F8 p2 = cv8(raw[i]), p1 = cv8(raw[i + 1]), c0 = cv8(raw[i + 2]), bg = cv8(bgr[i]);
                    const f32x4 va = bg.a * (w0.a * p2.a + w1.a * p1.a + w2.a * c0.a), vb = bg.b * (w0.b * p2.b + w1.b * p1.b + w2.b * c0.b);
                    *(u32x4*)(VA + (size_t)(r0 + i) * 1024 + ch) = pack8(va, vb);
                    if (tpos0 + i >= SEQ - 2) st8f(p.out + O_SCP + ((size_t)b * 2 + (tpos0 + i - (SEQ - 2))) * 1024 + ch, c0); }
            } else {
                const int ch = (tid - 128) * 8;
                u32x4 raw[11];
#pragma unroll
                for (int i = 0; i < 11; ++i) raw[i] = (tpos0 - 3 + i >= 0) ? *(const u32x4*)(XBC + (size_t)(r0 - 3 + i) * 3072 + ch) : (u32x4){0u, 0u, 0u, 0u};
                const F8 w0 = ld8f(p.in[I_CBW] + ch), w1 = ld8f(p.in[I_CBW] + 3072 + ch), w2 = ld8f(p.in[I_CBW] + 6144 + ch), w3 = ld8f(p.in[I_CBW] + 9216 + ch), bb = ld8f(p.in[I_CBB] + ch);
#pragma unroll
                for (int i = 0; i < 8; ++i) { const F8 p3 = cv8(raw[i]), p2 = cv8(raw[i + 1]), p1 = cv8(raw[i + 2]), c0 = cv8(raw[i + 3]);
                    f32x4 va = w0.a * p3.a + w1.a * p2.a + w2.a * p1.a + w3.a * c0.a + bb.a, vb = w0.b * p3.b + w1.b * p2.b + w2.b * p1.b + w3.b * c0.b + bb.b;
#pragma unroll
                    for (int j = 0; j < 4; ++j) { va[j] = siluf_(va[j]); vb[j] = siluf_(vb[j]); }
                    *(u32x4*)(XC + (size_t)(r0 + i) * 3072 + ch) = pack8(va, vb);
                    if (tpos0 + i >= SEQ - 3) st8f(p.out + O_SBP + ((size_t)b * 3 + (tpos0 + i - (SEQ - 3))) * 3072 + ch, c0); }
            }
        } else {
            const int b = it - MP / 8, row = MP + b;
            if (tid < 128) {
                const int ch = tid * 8;
                const F8 c0 = ld8bf(CI + (size_t)row * 1024 + ch);
                const F8 p2 = ld8f(p.in[I_STA] + ((size_t)b * 2 + 0) * 1024 + ch), p1 = ld8f(p.in[I_STA] + ((size_t)b * 2 + 1) * 1024 + ch);
                const F8 w0 = ld8f(p.in[I_CAW] + ch), w1 = ld8f(p.in[I_CAW] + 1024 + ch), w2 = ld8f(p.in[I_CAW] + 2048 + ch);
                const F8 bg = ld8bf(BG + (size_t)row * 1024 + ch);
                const f32x4 va = bg.a * (w0.a * p2.a + w1.a * p1.a + w2.a * c0.a), vb = bg.b * (w0.b * p2.b + w1.b * p1.b + w2.b * c0.b);
                *(u32x4*)(VA + (size_t)row * 1024 + ch) = pack8(va, vb);
                st8f(p.out + O_SCS + ((size_t)b * 2 + 0) * 1024 + ch, p1); st8f(p.out + O_SCS + ((size_t)b * 2 + 1) * 1024 + ch, c0);
            } else {
                const int ch = (tid - 128) * 8;
                const F8 c0 = ld8bf(XBC + (size_t)row * 3072 + ch);
                const F8 p3 = ld8f(p.in[I_STB] + ((size_t)b * 3 + 0) * 3072 + ch), p2 = ld8f(p.in[I_STB] + ((size_t)b * 3 + 1) * 3072 + ch), p1 = ld8f(p.in[I_STB] + ((size_t)b * 3 + 2) * 3072 + ch);
                const F8 w0 = ld8f(p.in[I_CBW] + ch), w1 = ld8f(p.in[I_CBW] + 3072 + ch), w2 = ld8f(p.in[I_CBW] + 6144 + ch), w3 = ld8f(p.in[I_CBW] + 9216 + ch), bb = ld8f(p.in[I_CBB] + ch);
                f32x4 va = w0.a * p3.a + w1.a * p2.a + w2.a * p1.a + w3.a * c0.a + bb.a, vb = w0.b * p3.b + w1.b * p2.b + w2.b * p1.b + w3.b * c0.b + bb.b;
#pragma unroll
                for (int j = 0; j < 4; ++j) { va[j] = siluf_(va[j]); vb[j] = siluf_(vb[j]); }
                *(u32x4*)(XC + (size_t)row * 3072 + ch) = pack8(va, vb);
                st8f(p.out + O_SBS + ((size_t)b * 3 + 0) * 3072 + ch, p2); st8f(p.out + O_SBS + ((size_t)b * 3 + 1) * 3072 + ch, p1); st8f(p.out + O_SBS + ((size_t)b * 3 + 2) * 3072 + ch, c0);
            }
        }
    }
    const float* DTR = (const float*)(ws + OFF_DTRAW); float* DTP = (float*)(ws + OFF_DTP); float* ACS = (float*)(ws + OFF_ACS);
    LAS float* t1 = (LAS float*)lds; LAS float* t2 = t1 + 128 * 33;
    for (int it = blockIdx.x; it < 129; it += gridDim.x) {
        const int t0 = it * 128;
#pragma unroll
        for (int i = 0; i < 8; ++i) { const int idx = tid + 512 * i, r = idx >> 5, hh = idx & 31;
            const float raw = DTR[(size_t)(t0 + r) * 32 + hh] + p.in[I_DTB][hh];
            t1[r * 33 + hh] = raw > 20.f ? raw : log1pf(expf(raw)); }
        __syncthreads();
        if (tid < 32) { const float a = -expf(p.in[I_ALOG][tid]); float run = 0.f;
            for (int s = 0; s < 128; ++s) { run += t1[s * 33 + tid] * a; t2[s * 33 + tid] = run; } }
        __syncthreads();
#pragma unroll
        for (int i = 0; i < 8; ++i) { const int idx = tid + 512 * i, r = idx >> 5, hh = idx & 31;
            DTP[(size_t)(t0 + r) * 32 + hh] = t1[r * 33 + hh]; ACS[(size_t)(t0 + r) * 32 + hh] = t2[r * 33 + hh]; }
        __syncthreads();
    }
}

constexpr int RS = 272, RX = 144;
constexpr int L_C = 0, L_B = 34816, L_X = 69632, L_XW = 88064, L_H = 106496, L_ACS = 123904, L_DT = 124416;
__device__ __forceinline__ bf16x8 tr_frag(LAS unsigned char* base, int rstride, int k0, int c0, int lane) {
    const int i = lane & 15, g = lane >> 4, q = i >> 2, pp = i & 3;
    LAS unsigned char* a = base + (k0 + 8 * g + q) * rstride + (c0 + 4 * pp) * 2;
    const bf16x4 lo = __builtin_amdgcn_ds_read_tr16_b64_v4i16((LAS bf16x4*)a);
    const bf16x4 hi = __builtin_amdgcn_ds_read_tr16_b64_v4i16((LAS bf16x4*)(a + 4 * rstride));
    return (bf16x8){lo[0], lo[1], lo[2], lo[3], hi[0], hi[1], hi[2], hi[3]};
}
__device__ __forceinline__ void ssd_prompt_unit(const Params& p, LAS unsigned char* lds, int b, int h) {
    unsigned char* ws = p.ws;
    const bf16_t* XC = (const bf16_t*)(ws + OFF_XBCC); const bf16_t* Z = (const bf16_t*)(ws + OFF_Z);
    const float* DTP = (const float*)(ws + OFF_DTP); const float* ACS = (const float*)(ws + OFF_ACS);
    bf16_t* YG = (bf16_t*)(ws + OFF_YG); float* SSQ = (float*)(ws + OFF_SSQ);
    const int tid = threadIdx.x, lane = tid & 63, w = __builtin_amdgcn_readfirstlane(tid >> 6), fr = lane & 15, fq = lane >> 4, g = h >> 3;
    const float Dh = p.in[I_DSKIP][h];
    LAS float* sAcs = (LAS float*)(lds + L_ACS); LAS float* sDt = (LAS float*)(lds + L_DT);
    f32x4 hacc[4];
#pragma unroll
    for (int i = 0; i < 4; ++i) hacc[i] = (f32x4){0.f, 0.f, 0.f, 0.f};
    const int hpt = w & 3, hnb = (w >> 2) * 4;
    for (int c = 0; c < SEQ / 128; ++c) {
        const int t0 = b * SEQ + c * 128;
        u32x4 rc[4], rb[4], rx[2]; float wv[2];
        { const int ch = tid & 15, row = tid >> 4;
#pragma unroll
          for (int i = 0; i < 4; ++i) { const bf16_t* src = XC + (size_t)(t0 + row + 32 * i) * 3072; rb[i] = *(const u32x4*)(src + 2048 + g * 128 + ch * 8); rc[i] = *(const u32x4*)(src + 2560 + g * 128 + ch * 8); } }
        const float acs_last = ACS[(size_t)(t0 + 127) * 32 + h];
        { const int ch = tid & 7, row = tid >> 3;
#pragma unroll
          for (int i = 0; i < 2; ++i) { const int r = t0 + row + 64 * i; rx[i] = *(const u32x4*)(XC + (size_t)r * 3072 + h * 64 + ch * 8);
              wv[i] = __expf(acs_last - ACS[(size_t)r * 32 + h]) * DTP[(size_t)r * 32 + h]; } }
        float my_acs = 0.f, my_dt = 0.f;
        if (tid < 128) { my_acs = ACS[(size_t)(t0 + tid) * 32 + h]; my_dt = DTP[(size_t)(t0 + tid) * 32 + h]; }
        __syncthreads();
#pragma unroll
        for (int i = 0; i < 4; ++i) { u32x2 o; o.x = cvt_pk_bf16(hacc[i][0], hacc[i][1]); o.y = cvt_pk_bf16(hacc[i][2], hacc[i][3]);
            *(LAS u32x2*)(lds + L_H + (16 * hpt + fr) * RS + (16 * (hnb + i) + 4 * fq) * 2) = o; }
        { const int ch = tid & 15, row = tid >> 4;
#pragma unroll
          for (int i = 0; i < 4; ++i) { *(LAS u32x4*)(lds + L_B + (row + 32 * i) * RS + ch * 16) = rb[i]; *(LAS u32x4*)(lds + L_C + (row + 32 * i) * RS + ch * 16) = rc[i]; } }
        { const int ch = tid & 7, row = tid >> 3;
#pragma unroll
          for (int i = 0; i < 2; ++i) { *(LAS u32x4*)(lds + L_X + (row + 64 * i) * RX + ch * 16) = rx[i];
              const float s = wv[i]; u32x4 o;
              o.x = cvt_pk_bf16(bflo(rx[i].x) * s, bfhi(rx[i].x) * s); o.y = cvt_pk_bf16(bflo(rx[i].y) * s, bfhi(rx[i].y) * s);
              o.z = cvt_pk_bf16(bflo(rx[i].z) * s, bfhi(rx[i].z) * s); o.w = cvt_pk_bf16(bflo(rx[i].w) * s, bfhi(rx[i].w) * s);
              *(LAS u32x4*)(lds + L_XW + (row + 64 * i) * RX + ch * 16) = o; } }
        if (tid < 128) { sAcs[tid] = my_acs; sDt[tid] = my_dt; }
        __syncthreads();
        const int qrow = 16 * w + fr;
        bf16x8 cf[4];
#pragma unroll
        for (int kk = 0; kk < 4; ++kk) cf[kk] = *(const LAS bf16x8*)(lds + L_C + qrow * RS + (kk * 32 + fq * 8) * 2);
        f32x4 yacc[4];
#pragma unroll
        for (int i = 0; i < 4; ++i) yacc[i] = (f32x4){0.f, 0.f, 0.f, 0.f};
        const float acs_q = sAcs[qrow];
        if (c > 0) {
#pragma unroll
            for (int pt = 0; pt < 4; ++pt)
#pragma unroll
                for (int kk = 0; kk < 4; ++kk) { const bf16x8 hf = *(const LAS bf16x8*)(lds + L_H + (16 * pt + fr) * RS + (kk * 32 + fq * 8) * 2);
                    yacc[pt] = __builtin_amdgcn_mfma_f32_16x16x32_bf16(hf, cf[kk], yacc[pt], 0, 0, 0); }
            const float eq = __expf(acs_q);
#pragma unroll
            for (int pt = 0; pt < 4; ++pt) yacc[pt] = yacc[pt] * eq;
        }
#pragma unroll
        for (int st = 0; st < 8; ++st) {
            f32x4 sacc = (f32x4){0.f, 0.f, 0.f, 0.f};
#pragma unroll
            for (int kk = 0; kk < 4; ++kk) { const bf16x8 bfr = *(const LAS bf16x8*)(lds + L_B + (16 * st + fr) * RS + (kk * 32 + fq * 8) * 2);
                sacc = __builtin_amdgcn_mfma_f32_16x16x32_bf16(bfr, cf[kk], sacc, 0, 0, 0); }
            const int s0 = 16 * st + 4 * fq;
            const f32x4 as = *(const LAS f32x4*)(sAcs + s0), ds = *(const LAS f32x4*)(sDt + s0);
            float pv[4];
#pragma unroll
            for (int j = 0; j < 4; ++j) pv[j] = (s0 + j <= qrow) ? sacc[j] * __expf(acs_q - as[j]) * ds[j] : 0.f;
            u32x2 o; o.x = cvt_pk_bf16(pv[0], pv[1]); o.y = cvt_pk_bf16(pv[2], pv[3]);
            *(LAS u32x2*)(lds + L_C + qrow * RS + s0 * 2) = o;
        }
#pragma unroll
        for (int kk = 0; kk < 4; ++kk) { const bf16x8 pf = *(const LAS bf16x8*)(lds + L_C + qrow * RS + (kk * 32 + fq * 8) * 2);
#pragma unroll
            for (int pt = 0; pt < 4; ++pt) { const bf16x8 xf = tr_frag(lds + L_X, RX, kk * 32, 16 * pt, lane);
                yacc[pt] = __builtin_amdgcn_mfma_f32_16x16x32_bf16(xf, pf, yacc[pt], 0, 0, 0); } }
        { float ss = 0.f; const size_t trow = (size_t)(t0 + qrow);
#pragma unroll
          for (int pt = 0; pt < 4; ++pt) { const int pc = 16 * pt + 4 * fq;
              const u32x2 xv = *(const LAS u32x2*)(lds + L_X + qrow * RX + pc * 2);
              const u32x2 zv = *(const u32x2*)(Z + trow * 2048 + h * 64 + pc);
              const float x0 = bflo(xv.x), x1 = bfhi(xv.x), x2 = bflo(xv.y), x3 = bfhi(xv.y);
              const float g0 = (yacc[pt][0] + Dh * x0) * siluf_(bflo(zv.x)), g1 = (yacc[pt][1] + Dh * x1) * siluf_(bfhi(zv.x));
              const float g2 = (yacc[pt][2] + Dh * x2) * siluf_(bflo(zv.y)), g3 = (yacc[pt][3] + Dh * x3) * siluf_(bfhi(zv.y));
              ss += (g0 * g0 + g1 * g1) + (g2 * g2 + g3 * g3);
              u32x2 o; o.x = cvt_pk_bf16(g0, g1); o.y = cvt_pk_bf16(g2, g3);
              *(u32x2*)(YG + trow * 2048 + h * 64 + pc) = o; }
          ss += __shfl_xor(ss, 16); ss += __shfl_xor(ss, 32);
          if (fq == 0) SSQ[trow * 32 + h] = ss; }
        { const float dec = __expf(acs_last);
#pragma unroll
          for (int i = 0; i < 4; ++i) hacc[i] = hacc[i] * dec;
#pragma unroll
          for (int kk = 0; kk < 4; ++kk) { const bf16x8 xwf = tr_frag(lds + L_XW, RX, kk * 32, 16 * hpt, lane);
#pragma unroll
              for (int i = 0; i < 4; ++i) { const bf16x8 bf = tr_frag(lds + L_B, RS, kk * 32, 16 * (hnb + i), lane);
                  hacc[i] = __builtin_amdgcn_mfma_f32_16x16x32_bf16(bf, xwf, hacc[i], 0, 0, 0); } } }
    }
    float* so = p.out + O_SSP + (((size_t)b * NH + h) * HD + 16 * hpt + fr) * DS;
#pragma unroll
    for (int i = 0; i < 4; ++i) *(f32x4*)(so + 16 * (hnb + i) + 4 * fq) = hacc[i];
    __syncthreads();
}
__device__ __forceinline__ void ssd_sample_item(const Params& p, LAS unsigned char* lds, int b, int h) {
    unsigned char* ws = p.ws;
    const bf16_t* XC = (const bf16_t*)(ws + OFF_XBCC); const bf16_t* Z = (const bf16_t*)(ws + OFF_Z);
    const float* DTP = (const float*)(ws + OFF_DTP); bf16_t* YG = (bf16_t*)(ws + OFF_YG); float* SSQ = (float*)(ws + OFF_SSQ);
    LAS float* red = (LAS float*)lds;
    const int tid = threadIdx.x, n4 = tid & 31, pr = tid >> 5, r = MP + b, g = h >> 3;
    const float dt = DTP[(size_t)r * 32 + h], dA = __expf(dt * -expf(p.in[I_ALOG][h])), Dh = p.in[I_DSKIP][h];
    const bf16_t* xr = XC + (size_t)r * 3072;
    const u32x2 bu = *(const u32x2*)(xr + 2048 + g * 128 + 4 * n4), cu = *(const u32x2*)(xr + 2560 + g * 128 + 4 * n4);
    const f32x4 Bv = (f32x4){bflo(bu.x), bfhi(bu.x), bflo(bu.y), bfhi(bu.y)}, Cv = (f32x4){bflo(cu.x), bfhi(cu.x), bflo(cu.y), bfhi(cu.y)};
    const size_t sbase = (((size_t)b * NH + h) * HD) * DS;
#pragma unroll
    for (int i = 0; i < 4; ++i) { const int pp = pr + 16 * i;
        const float xv = bf2f(xr[h * 64 + pp]);
        const f32x4 h0 = *(const f32x4*)(p.in[I_STS] + sbase + (size_t)pp * DS + 4 * n4);
        const f32x4 hn = h0 * dA + Bv * (dt * xv);
        *(f32x4*)(p.out + O_SSS + sbase + (size_t)pp * DS + 4 * n4) = hn;
        float y = (hn[0] * Cv[0] + hn[1] * Cv[1]) + (hn[2] * Cv[2] + hn[3] * Cv[3]);
#pragma unroll
        for (int o = 1; o < 32; o <<= 1) y += __shfl_xor(y, o);
        if (n4 == 0) { const float gt = (y + Dh * xv) * siluf_(bf2f(Z[(size_t)r * 2048 + h * 64 + pp])); YG[(size_t)r * 2048 + h * 64 + pp] = f2bf(gt); red[pp] = gt * gt; } }
    __syncthreads();
    if (tid < 64) { const float v = wave_sum(red[tid]); if (tid == 0) SSQ[(size_t)r * 32 + h] = v; }
    __syncthreads();
}
__device__ __forceinline__ void phase_ssd(const Params& p, LAS unsigned char* lds) {
    for (int u = blockIdx.x; u < NBP * NH; u += gridDim.x) {
        const int xcd = u & 7, j = u >> 3, pair = xcd * 4 + (j >> 3), hr = j & 7;
        ssd_prompt_unit(p, lds, pair >> 2, (pair & 3) * 8 + hr);
    }
    for (int it = blockIdx.x; it < NBS * NH; it += gridDim.x) ssd_sample_item(p, lds, it >> 5, it & 31);
}
__device__ __forceinline__ void phase_gnorm(const Params& p) {
    bf16_t* YG = (bf16_t*)(p.ws + OFF_YG); const float* SSQ = (const float*)(p.ws + OFF_SSQ);
    for (int i = blockIdx.x * 512 + threadIdx.x; i < MTOT * 256; i += gridDim.x * 512) {
        const int row = i >> 8, cu = i & 255, g = cu >> 6;
        const f32x4 s0 = *(const f32x4*)(SSQ + (size_t)row * 32 + 8 * g), s1 = *(const f32x4*)(SSQ + (size_t)row * 32 + 8 * g + 4);
        const float rstd = rsqrtf(((s0[0] + s0[1]) + (s0[2] + s0[3]) + (s1[0] + s1[1]) + (s1[2] + s1[3])) * (1.f / 512.f) + EPS);
        bf16_t* q = YG + (size_t)row * 2048 + cu * 8;
        const F8 v = ld8bf(q);
        *(u32x4*)q = pack8(v.a * rstd, v.b * rstd);
    }
}

__global__ void __launch_bounds__(512, 2) fwd_megakernel(Params p) {
    extern __shared__ __attribute__((aligned(16))) unsigned char shm[];
    LAS unsigned char* lds = (LAS unsigned char*)shm;
    cg::grid_group grid = cg::this_grid();
    unsigned char* ws = p.ws;
    const int G = gridDim.x, cid = blockIdx.x;
    float* mod = (float*)(ws + OFF_MOD);
    pg8::StaticOrder S;
    volatile LAS unsigned* xst = (volatile LAS unsigned*)(lds + 131072);
    if (threadIdx.x == 0) { xst[0] = 0u; xst[1] = 0u; }
    __syncthreads();
    XcdBarrier xb = xcd_barrier_post((unsigned*)(ws + OFF_BAR), xst);

    phase0(p, lds);
    if (PROBE_EW) { __syncthreads(); phase0(p, lds); }
    grid.sync();
    {
        pg8::Gemm g{(const bf16_t*)(ws + OFF_CA), (const bf16_t*)(ws + OFF_WADA), 256, 6144, 1024};
        EpiF32Bias E{mod, 6144, p.in[I_BADA]};
        S.init(g.M, g.N, G, cid); pg8::gemm_phase<EpiF32Bias, pg8::StaticOrder, true, true>(lds, g, S, E);
    }
    GSYNC();
    phase_rownorm(p, p.in[I_XP], p.in[I_XS], p.in[I_N1G], 1024, 0, (bf16_t*)(ws + OFF_U));
    if (PROBE_EW) phase_rownorm(p, p.in[I_XP], p.in[I_XS], p.in[I_N1G], 1024, 0, (bf16_t*)(ws + OFF_U));
    GSYNC();
    {
        pg8::Gemm g{(const bf16_t*)(ws + OFF_U), (const bf16_t*)(ws + OFF_WIN), MPAD, DINP, 1024};
        EpiIn E{(bf16_t*)(ws + OFF_BG), (bf16_t*)(ws + OFF_CI), (bf16_t*)(ws + OFF_Z), (bf16_t*)(ws + OFF_XBC), (bf16_t*)(ws + OFF_GA), (bf16_t*)(ws + OFF_GB), (float*)(ws + OFF_DTRAW)};
        S.init(g.M, g.N, G, cid); pg8::gemm_phase<EpiIn, pg8::StaticOrder, true, true>(lds, g, S, E);
    }
    GSYNC();
    phase_conv(p, lds);
    if (PROBE_CONV) { __syncthreads(); phase_conv(p, lds); }
    GSYNC();
    phase_ssd(p, lds);
    if (PROBE_SSD) { __syncthreads(); phase_ssd(p, lds); }
    GSYNC();
    phase_gnorm(p);
    GSYNC();
    {
        pg8::Gemm ga{(const bf16_t*)(ws + OFF_VA), (const bf16_t*)(ws + OFF_WAOUT), MPAD, 1024, 1024};
        EpiGate<0> Ea{(bf16_t*)(ws + OFF_YA), (const bf16_t*)(ws + OFF_GA), nullptr, 1024};
        S.init(ga.M, ga.N, G, cid); pg8::gemm_phase<EpiGate<0>, pg8::StaticOrder, true, true>(lds, ga, S, Ea);
        __syncthreads();
        pg8::Gemm gb{(const bf16_t*)(ws + OFF_YG), (const bf16_t*)(ws + OFF_WBOUT), MPAD, 1024, 2048};
        EpiGate<1> Eb{(bf16_t*)(ws + OFF_MERGED), (const bf16_t*)(ws + OFF_GB), (const bf16_t*)(ws + OFF_YA), 1024};
        pg8::gemm_phase<EpiGate<1>, pg8::StaticOrder, true, true>(lds, gb, S, Eb);
    }
    GSYNC();
    {
        pg8::Gemm g{(const bf16_t*)(ws + OFF_MERGED), (const bf16_t*)(ws + OFF_WO), MPAD, 1024, 1024};
        EpiRes E{(float*)(ws + OFF_X1), p.in[I_XP], p.in[I_XS], mod + 2048};
        S.init(g.M, g.N, G, cid); pg8::gemm_phase<EpiRes, pg8::StaticOrder, true, true>(lds, g, S, E);
    }
    GSYNC();
    {
        const float* X1 = (const float*)(ws + OFF_X1);
        phase_rownorm(p, X1, X1 + (size_t)MP * D, p.in[I_N2G], 4096, 3072, (bf16_t*)(ws + OFF_U));
        if (PROBE_EW) phase_rownorm(p, X1, X1 + (size_t)MP * D, p.in[I_N2G], 4096, 3072, (bf16_t*)(ws + OFF_U));
    }
    GSYNC();
    {
        pg8::Gemm g{(const bf16_t*)(ws + OFF_U), (const bf16_t*)(ws + OFF_W1), MPAD, DFF, 1024};
        EpiGate<2> E{(bf16_t*)(ws + OFF_HMID), nullptr, nullptr, DFF};
        S.init(g.M, g.N, G, cid); pg8::gemm_phase<EpiGate<2>, pg8::StaticOrder, true, true>(lds, g, S, E);
    }
    GSYNC();
    {
        pg8::Gemm g{(const bf16_t*)(ws + OFF_HMID), (const bf16_t*)(ws + OFF_W2), MPAD, 1024, DFF};
        EpiRes E{(float*)(ws + OFF_X1), nullptr, nullptr, mod + 5120};
        S.init(g.M, g.N, G, cid); pg8::gemm_phase<EpiRes, pg8::StaticOrder, true, true>(lds, g, S, E);
    }
    GSYNC();
    phase_final(p);
    if (PROBE_EW) phase_final(p);
}

extern "C" void kernel_launch(void* const* d_in, const int* in_sizes, int n_in, void* d_out, int out_size, void* d_ws, size_t ws_size, hipStream_t stream) {
    constexpr int LDS_BYTES = 131072 + 16;
    static int grid = 0;
    if (grid == 0) {
        if (n_in != 25 || ws_size < WS_END) { fprintf(stderr, "kernel_launch: unexpected n_in %d / ws %zu (need %zu)\n", n_in, ws_size, (size_t)WS_END); grid = -1; return; }
        int dev = 0, cus = 0, per_cu = 0;
        (void)hipGetDevice(&dev);
        (void)hipDeviceGetAttribute(&cus, hipDeviceAttributeMultiprocessorCount, dev);
        if (hipFuncSetAttribute((const void*)fwd_megakernel, hipFuncAttributeMaxDynamicSharedMemorySize, LDS_BYTES) != hipSuccess) { fprintf(stderr, "kernel_launch: hipFuncSetAttribute failed\n"); grid = -1; return; }
        if (hipOccupancyMaxActiveBlocksPerMultiprocessor(&per_cu, (const void*)fwd_megakernel, 512, LDS_BYTES) != hipSuccess || per_cu < 1) { fprintf(stderr, "kernel_launch: occupancy query says %d blocks per CU\n", per_cu); grid = -1; return; }
        grid = cus;
    }
    if (grid < 0) return;
    Params p{};
    for (int i = 0; i < 25; ++i) p.in[i] = (const float*)d_in[i];
    p.out = (float*)d_out; p.ws = (unsigned char*)d_ws;
    (void)hipMemsetAsync((unsigned char*)d_ws + OFF_BAR, 0, 16384, stream);
    void* args[] = {&p};
    hipError_t e = hipLaunchCooperativeKernel((const void*)fwd_megakernel, dim3(grid), dim3(512), args, LDS_BYTES, stream);
    if (e != hipSuccess) fprintf(stderr, "cooperative launch failed: %s (grid %d)\n", hipGetErrorString(e), grid);
}
```

```cpp
#include <hip/hip_runtime.h>
#include <hip/hip_cooperative_groups.h>
#include <cstdio>
#include <cstdint>
namespace cg = cooperative_groups;
#define PROBE_EW 0
#define PROBE_CONV 0
#define PROBE_SSD 0
#define PROBE_SYNC 0
#define GSYNC() do { xcd_barrier(xb); if (PROBE_SYNC) xcd_barrier(xb); } while (0)

#define LAS __attribute__((address_space(3)))
typedef unsigned short bf16_t;
typedef short bf16x8 __attribute__((ext_vector_type(8)));
typedef short bf16x4 __attribute__((ext_vector_type(4)));
typedef float f32x4 __attribute__((ext_vector_type(4)));
typedef float f32x2 __attribute__((ext_vector_type(2)));
typedef unsigned u32x4 __attribute__((ext_vector_type(4)));
typedef unsigned u32x2 __attribute__((ext_vector_type(2)));

constexpr int D = 1024, NBP = 8, SEQ = 2048, MP = NBP * SEQ, NBS = 128, MTOT = MP + NBS, MPAD = 16640;
constexpr int DINP = 10496, DINNER = 2048, DXBC = 3072, NH = 32, HD = 64, DS = 128, DFF = 4096, DIN = 10272;
constexpr float EPS = 1e-6f;
constexpr size_t O_YP = 0, O_YS = 16777216, O_SCP = 16908288, O_SBP = 16924672, O_SSP = 16998400, O_SCS = 19095552, O_SBS = 19357696, O_SSS = 20537344;
constexpr size_t S1 = (size_t)MPAD * 1024 * 2;
constexpr size_t OFF_WADA = 0, OFF_WIN = 12582912, OFF_WAOUT = 34078720, OFF_WBOUT = 36175872, OFF_WO = 40370176, OFF_W1 = 42467328, OFF_W2 = 50855936,
                 OFF_CA = 59244544, OFF_MOD = 59768832, OFF_DTRAW = 66060288, OFF_DTP = 68190208, OFF_ACS = 70320128, OFF_SSQ = 72450048, OFF_U = 74579968,
                 OFF_R1 = OFF_U + S1, OFF_BG = OFF_R1, OFF_CI = OFF_R1 + S1, OFF_Z = OFF_R1 + 2 * S1, OFF_XBC = OFF_R1 + 4 * S1, OFF_GA = OFF_R1 + 7 * S1, OFF_GB = OFF_R1 + 8 * S1,
                 OFF_R2 = OFF_R1 + 9 * S1, OFF_BAR = OFF_R2 + 3 * S1, WS_END = OFF_BAR + 16384;
constexpr size_t OFF_VA = OFF_U, OFF_YA = OFF_BG, OFF_MERGED = OFF_CI, OFF_YG = OFF_XBC, OFF_HMID = OFF_R1, OFF_XBCC = OFF_R2, OFF_X1 = OFF_R2;

struct Params {
    const float* in[25];
    float* out;
    unsigned char* ws;
};
enum { I_XP = 0, I_XS, I_CP, I_CS, I_STA, I_STB, I_STS, I_WADA, I_BADA, I_N1G, I_WIN, I_CAW, I_WAOUT, I_CBW, I_CBB, I_DTB, I_ALOG, I_DSKIP, I_SNG, I_WBOUT, I_WO, I_N2G, I_W1, I_W2, I_NFG };

__device__ __forceinline__ unsigned cvt_pk_bf16(float lo, float hi) { unsigned r; asm volatile("v_cvt_pk_bf16_f32 %0, %1, %2" : "=v"(r) : "v"(lo), "v"(hi)); return r; }
__device__ __forceinline__ bf16_t f2bf(float f) { unsigned u = __float_as_uint(f); u += 0x7FFFu + ((u >> 16) & 1u); return (bf16_t)(u >> 16); }
__device__ __forceinline__ float bf2f(bf16_t b) { return __uint_as_float(((unsigned)b) << 16); }
__device__ __forceinline__ float bflo(unsigned u) { return __uint_as_float(u << 16); }
__device__ __forceinline__ float bfhi(unsigned u) { return __uint_as_float(u & 0xffff0000u); }
__device__ __forceinline__ float sigmoidf_(float x) { return __builtin_amdgcn_rcpf(1.f + __expf(-x)); }
__device__ __forceinline__ float siluf_(float x) { return x * sigmoidf_(x); }
__device__ __forceinline__ float wave_sum(float v) {
#pragma unroll
    for (int o = 1; o < 64; o <<= 1) v += __shfl_xor(v, o);
    return v;
}


#define XB_TMO      128
#define XB_XCNT(j)  (256  + 64 * (j))
#define XB_XSUB(j)  (1280 + 64 * (j))
#define XB_XGEN(j)  (2304 + 64 * (j))
#define XB_TOP      3328
#define XB_TOPGEN   3392
#define XCD_BAR_WORDS 3456
#define XB_SPIN_CAP (1u << 18)
__device__ __forceinline__ unsigned xb_ld(unsigned* p)              { return __hip_atomic_load(p, __ATOMIC_RELAXED, __HIP_MEMORY_SCOPE_AGENT); }
__device__ __forceinline__ unsigned xb_add(unsigned* p, unsigned v) { return __hip_atomic_fetch_add(p, v, __ATOMIC_RELAXED, __HIP_MEMORY_SCOPE_AGENT); }
__device__ __forceinline__ unsigned xb_xcc_id() { return (unsigned)__builtin_amdgcn_s_getreg((3 << 11) | 20) & 0xFu; }
#define XB_SPIN(cond, bar) do { unsigned _sp = 0; while (cond) { __builtin_amdgcn_s_sleep(1); \
    if ((++_sp & 255u) == 0u) { if (xb_ld(&(bar)[XB_TMO])) break; if (_sp > XB_SPIN_CAP) { atomicAdd(&(bar)[XB_TMO], 1u); break; } } } } while (0)
struct XcdBarrier { unsigned* bar; unsigned x; volatile LAS unsigned* st; };
__device__ __forceinline__ XcdBarrier xcd_barrier_post(unsigned* bar, volatile LAS unsigned* st) {
    XcdBarrier b; b.bar = bar; b.x = xb_xcc_id(); b.st = st;
    if (threadIdx.x == 0) (void)xb_add(&bar[XB_XCNT(b.x)], 1u);
    return b;
}
__device__ __forceinline__ void xcd_barrier_complete(unsigned* bar, unsigned x, unsigned& nloc, unsigned& nx) {
    const unsigned G = gridDim.x * gridDim.y * gridDim.z;
    unsigned sum, cnt, mine, sp = 0u;
    for (;;) {
        sum = 0u; cnt = 0u; mine = 0u;
#pragma unroll
        for (unsigned j = 0; j < 16; ++j) { const unsigned c = xb_ld(&bar[XB_XCNT(j)]); sum += c; cnt += (c > 0u) ? 1u : 0u; mine = (j == x) ? c : mine; }
        if (sum == G) break;
        __builtin_amdgcn_s_sleep(1);
        if ((++sp & 255u) == 0u) { if (xb_ld(&bar[XB_TMO])) break; if (sp > XB_SPIN_CAP) { atomicAdd(&bar[XB_TMO], 1u); break; } }
    }
    nloc = mine > 0u ? mine : 1u; nx = cnt > 0u ? cnt : 1u;
}
__device__ __forceinline__ void xcd_barrier(const XcdBarrier& b) {
    asm volatile("s_waitcnt vmcnt(0)" ::: "memory");
    __syncthreads();
    if (threadIdx.x == 0) {
        unsigned* bar = b.bar;
        __builtin_amdgcn_s_waitcnt(0);
        unsigned nloc = b.st[0], nx = b.st[1];
        if (nloc == 0u) { xcd_barrier_complete(bar, b.x, nloc, nx); b.st[0] = nloc; b.st[1] = nx; }
        const unsigned old = xb_add(&bar[XB_XSUB(b.x)], 1u);
        const unsigned gen = old / nloc;
        if (old + 1u == (gen + 1u) * nloc) {
            __builtin_amdgcn_fence(__ATOMIC_RELEASE, "agent");
            asm volatile("s_waitcnt vmcnt(0)" ::: "memory");
            const unsigned og = xb_add(&bar[XB_TOP], 1u);
            const unsigned tg = og / nx;
            if (og + 1u == (tg + 1u) * nx) xb_add(&bar[XB_TOPGEN], 1u);
            else XB_SPIN(xb_ld(&bar[XB_TOPGEN]) == tg, bar);
            __builtin_amdgcn_fence(__ATOMIC_ACQUIRE, "agent");
            xb_add(&bar[XB_XGEN(b.x)], 1u);
            asm volatile("s_waitcnt vmcnt(0)" ::: "memory");
        } else {
            XB_SPIN(xb_ld(&bar[XB_XGEN(b.x)]) == gen, bar);
            __builtin_amdgcn_fence(__ATOMIC_ACQUIRE, "agent");
            asm volatile("s_waitcnt vmcnt(0)" ::: "memory");
        }
    }
    __syncthreads();
}

namespace pg8 {
#define PG8_LAS __attribute__((address_space(3)))
constexpr int BM = 256, BK = 64, HALF = 128, HTB = HALF * BK * 2, STAGE_BYTES = 8 * HTB, NXCD = 8, WGM = 8;
__host__ __device__ __forceinline__ int lds_byte(int r, int c) { const int st = (r >> 4) * 2 + (c >> 5), rr = r & 15, cc = c & 31, ob = rr * 64 + cc * 2; return st * 1024 + (ob ^ (((ob >> 9) & 1) << 5)); }
__host__ __device__ __forceinline__ void stage_rc(int b, int& R, int& C) { const int st = b / 1024, sb = b % 1024, swz = sb ^ (((sb >> 9) & 1) << 5); R = (st >> 1) * 16 + swz / 64; C = (st & 1) * 32 + (swz % 64) / 2; }
__host__ __device__ __forceinline__ int perm32(int rho) { const int n = rho >> 4, i = rho & 15; return 8 * (i >> 2) + 4 * n + (i & 3); }
struct Unit { int pm, pn; };
struct Gemm { const bf16_t* A; const bf16_t* Bt; int M, N, K; };
struct StaticOrder {
    int nM, nN, nwg, G, c;
    __host__ __device__ void init(int M, int N, int G_, int c_) { nM = M / BM; nN = N / BM; nwg = nM * nN; G = G_; c = c_; }
    __host__ __device__ bool next(int i, Unit& u) const {
        const long L = (long)i * G + c; if (L >= nwg) return false;
        int wgid = (int)L; { const int q = nwg / NXCD, r = nwg % NXCD, xcd = wgid % NXCD, off = wgid / NXCD; wgid = (xcd < r ? xcd * (q + 1) : r * (q + 1) + (xcd - r) * q) + off; }
        const int nig = WGM * nN, gid = wgid / nig, fm = gid * WGM, gsz = (nM - fm) < WGM ? (nM - fm) : WGM;
        u.pm = fm + ((wgid % nig) % gsz); u.pn = (wgid % nig) / gsz; return true;
    }
    __device__ __forceinline__ void a_ready(const Unit&) const {}
    __device__ __forceinline__ void done(const Unit&) const {}
};

template <class Epi, class Sched, bool ALIGN_EPI = false, bool SP2 = false>
__device__ __forceinline__ void gemm_phase(PG8_LAS unsigned char* lds, const Gemm g, const Sched& S, const Epi& E) {
    const int tid = threadIdx.x, wid = __builtin_amdgcn_readfirstlane(tid >> 6), lane = tid & 63, wr = wid >> 2, wc = wid & 3, fr = lane & 15, fq = lane >> 4;
    const int K = g.K, nt = K / BK;
    unsigned voffA[2], voffB[2];
#pragma unroll
    for (int i = 0; i < 2; ++i) { int R, C; stage_rc(tid * 16 + i * 8192, R, C); const int Rb = Epi::PERM ? ((R & ~31) + perm32(R & 31)) : R;
        voffA[i] = (unsigned)(R * K + C) * 2u; voffB[i] = (unsigned)(Rb * K + C) * 2u; }
    const size_t kstep = (size_t)(BK * 2);
    const size_t hstep = (size_t)HALF * K * 2;
    const size_t tstep = 2 * hstep;
    const unsigned ldsw = (unsigned)wid * 1024u;
    const int aoff = lds_byte(wr * 64 + fr, fq * 8), boff = lds_byte(wc * 32 + fr, fq * 8);
#define PG8_SA(b, h) (((b) * 2 + (h)) * HTB)
#define PG8_SB(b, h) ((4 + (b) * 2 + (h)) * HTB)
#define PG8_STAGE(bufoff, gbase, voff) do { _Pragma("unroll") for (int _i = 0; _i < 2; ++_i) \
        __builtin_amdgcn_global_load_lds((const unsigned*)((const char*)(gbase) + (voff)[_i]), (PG8_LAS unsigned*)(lds + (bufoff) + ldsw + _i * 8192), 16, 0, 0); } while (0)
#define PG8_LDA(dst, b, h) do { _Pragma("unroll") for (int m = 0; m < 4; ++m) _Pragma("unroll") for (int k = 0; k < 2; ++k) dst[m][k] = *(const PG8_LAS bf16x8*)(lds + PG8_SA(b, h) + aoff + m * 2048 + k * 1024); } while (0)
#define PG8_LDB(dst, b, h) do { _Pragma("unroll") for (int n = 0; n < 2; ++n) _Pragma("unroll") for (int k = 0; k < 2; ++k) dst[n][k] = *(const PG8_LAS bf16x8*)(lds + PG8_SB(b, h) + boff + n * 2048 + k * 1024); } while (0)
#define PG8_MMA(ai, bj, At, Bt) do { __builtin_amdgcn_s_setprio(1); _Pragma("unroll") for (int m = 0; m < 4; ++m) _Pragma("unroll") for (int n = 0; n < 2; ++n) _Pragma("unroll") for (int k = 0; k < 2; ++k) \
        acc[ai][bj][m][n] = __builtin_amdgcn_mfma_f32_16x16x32_bf16(Bt[n][k], At[m][k], acc[ai][bj][m][n], 0, 0, 0); __builtin_amdgcn_s_setprio(0); } while (0)
#define PG8_WAIT_V(n) asm volatile("s_waitcnt vmcnt(" #n ")" ::: "memory")
#define PG8_WAIT_L(n) asm volatile("s_waitcnt lgkmcnt(" #n ")" ::: "memory")
#define PG8_BAR __builtin_amdgcn_s_barrier()
#define PG8_SCHED __builtin_amdgcn_sched_barrier(0)
    Unit cur, nxt; int ui = 0;
    if (!S.next(0, cur)) return;
    f32x4 acc[2][2][4][2];
#pragma unroll
    for (int a = 0; a < 2; ++a)
#pragma unroll
        for (int b = 0; b < 2; ++b)
#pragma unroll
            for (int m = 0; m < 4; ++m)
#pragma unroll
                for (int n = 0; n < 2; ++n) acc[a][b][m][n] = (f32x4){0.f, 0.f, 0.f, 0.f};
    bf16x8 At[4][2], B0[2][2], B1[2][2];
    const char* cA = (const char*)g.A + (size_t)cur.pm * tstep; const char* cB = (const char*)g.Bt + (size_t)cur.pn * tstep;
    S.a_ready(cur);
    if constexpr (SP2) {
        PG8_STAGE(PG8_SB(0, 0), cB, voffB); PG8_STAGE(PG8_SB(0, 1), cB + hstep, voffB); PG8_STAGE(PG8_SA(0, 0), cA, voffA); PG8_STAGE(PG8_SA(0, 1), cA + hstep, voffA);
        if (wr == 1) PG8_BAR;
        PG8_WAIT_V(2); PG8_BAR;
        PG8_STAGE(PG8_SB(1, 0), cB + kstep, voffB); PG8_STAGE(PG8_SA(1, 0), cA + kstep, voffA); PG8_STAGE(PG8_SB(1, 1), cB + hstep + kstep, voffB);
        PG8_WAIT_V(6); PG8_BAR;
    } else {
        PG8_STAGE(PG8_SB(0, 0), cB, voffB); PG8_STAGE(PG8_SA(0, 0), cA, voffA); PG8_STAGE(PG8_SB(0, 1), cB + hstep, voffB); PG8_STAGE(PG8_SA(0, 1), cA + hstep, voffA);
        if (wr == 1) PG8_BAR;
        PG8_WAIT_V(4); PG8_BAR;
        PG8_STAGE(PG8_SB(1, 0), cB + kstep, voffB); PG8_STAGE(PG8_SA(1, 0), cA + kstep, voffA); PG8_STAGE(PG8_SB(1, 1), cB + hstep + kstep, voffB);
        PG8_WAIT_V(6); PG8_BAR;
    }
    for (;;) {
        const bool has_next = S.next(ui + 1, nxt);
        const char* nA = has_next ? (const char*)g.A + (size_t)nxt.pm * tstep : cA; const char* nB = has_next ? (const char*)g.Bt + (size_t)nxt.pn * tstep : cB;
        for (int t = 0; t < nt; t += 2) {
            const bool last = (t == nt - 2);
            const char* a1 = cA + (size_t)(t + 1) * kstep;
            const char* a2 = last ? nA : cA + (size_t)(t + 2) * kstep; const char* b2 = last ? nB : cB + (size_t)(t + 2) * kstep;
            const char* a3 = a2 + kstep; const char* b3 = b2 + kstep;
            if (last && has_next) S.a_ready(nxt);
            if constexpr (SP2) {
            PG8_LDB(B0, 0, 0); PG8_LDB(B1, 0, 1); PG8_SCHED; PG8_LDA(At, 0, 0); PG8_STAGE(PG8_SA(1, 1), a1 + hstep, voffA);
            PG8_WAIT_V(8); PG8_WAIT_L(0); PG8_BAR; PG8_MMA(0, 0, At, B0); PG8_MMA(0, 1, At, B1); PG8_BAR; PG8_SCHED;
            PG8_LDA(At, 0, 1); PG8_STAGE(PG8_SB(0, 0), b2, voffB); PG8_STAGE(PG8_SB(0, 1), b2 + hstep, voffB); PG8_STAGE(PG8_SA(0, 0), a2, voffA);
            PG8_WAIT_V(8); PG8_WAIT_L(0); PG8_BAR; PG8_MMA(1, 0, At, B0); PG8_MMA(1, 1, At, B1); PG8_BAR; PG8_SCHED;
            PG8_LDB(B0, 1, 0); PG8_LDB(B1, 1, 1); PG8_SCHED; PG8_LDA(At, 1, 0); PG8_STAGE(PG8_SA(0, 1), a2 + hstep, voffA);
            PG8_WAIT_V(8); PG8_WAIT_L(0); PG8_BAR; PG8_MMA(0, 0, At, B0); PG8_MMA(0, 1, At, B1); PG8_BAR; PG8_SCHED;
            PG8_LDA(At, 1, 1); PG8_STAGE(PG8_SB(1, 0), b3, voffB); PG8_STAGE(PG8_SB(1, 1), b3 + hstep, voffB); PG8_STAGE(PG8_SA(1, 0), a3, voffA);
            PG8_WAIT_V(8); PG8_WAIT_L(0); PG8_BAR; PG8_MMA(1, 0, At, B0); PG8_MMA(1, 1, At, B1); PG8_BAR; PG8_SCHED;
            } else {
            PG8_LDB(B0, 0, 0); PG8_SCHED; PG8_LDA(At, 0, 0); PG8_STAGE(PG8_SA(1, 1), a1 + hstep, voffA);
            PG8_WAIT_L(8); PG8_BAR; PG8_WAIT_L(0); PG8_MMA(0, 0, At, B0); PG8_BAR; PG8_SCHED;
            PG8_LDB(B1, 0, 1); PG8_STAGE(PG8_SB(0, 0), b2, voffB);
            PG8_BAR; PG8_WAIT_L(0); PG8_MMA(0, 1, At, B1); PG8_BAR;
            PG8_LDA(At, 0, 1); PG8_STAGE(PG8_SA(0, 0), a2, voffA);
            PG8_BAR; PG8_WAIT_L(0); PG8_MMA(1, 0, At, B0); PG8_BAR; PG8_SCHED;
            PG8_STAGE(PG8_SB(0, 1), b2 + hstep, voffB);
            PG8_WAIT_V(6); PG8_BAR; PG8_MMA(1, 1, At, B1); PG8_BAR;
            PG8_LDB(B0, 1, 0); PG8_SCHED; PG8_LDA(At, 1, 0); PG8_STAGE(PG8_SA(0, 1), a2 + hstep, voffA);
            PG8_WAIT_L(8); PG8_BAR; PG8_WAIT_L(0); PG8_MMA(0, 0, At, B0); PG8_BAR; PG8_SCHED;
            PG8_LDB(B1, 1, 1); PG8_STAGE(PG8_SB(1, 0), b3, voffB);
            PG8_BAR; PG8_WAIT_L(0); PG8_MMA(0, 1, At, B1); PG8_BAR;
            PG8_LDA(At, 1, 1); PG8_STAGE(PG8_SA(1, 0), a3, voffA);
            PG8_BAR; PG8_WAIT_L(0); PG8_MMA(1, 0, At, B0); PG8_BAR; PG8_SCHED;
            PG8_STAGE(PG8_SB(1, 1), b3 + hstep, voffB);
            PG8_WAIT_V(6); PG8_BAR; PG8_MMA(1, 1, At, B1); PG8_BAR;
            }
        }
        if constexpr (ALIGN_EPI) { if (wr == 0) PG8_BAR; }
        E(acc, cur, wr, wc, fr, fq);
        if (!has_next) break;
#pragma unroll
        for (int a = 0; a < 2; ++a)
#pragma unroll
            for (int b = 0; b < 2; ++b)
#pragma unroll
                for (int m = 0; m < 4; ++m)
#pragma unroll
                    for (int n = 0; n < 2; ++n) acc[a][b][m][n] = (f32x4){0.f, 0.f, 0.f, 0.f};
        cur = nxt; cA = nA; cB = nB; ++ui;
        if constexpr (ALIGN_EPI) { if (wr == 1) PG8_BAR; }
    }
    PG8_WAIT_V(0);
    if constexpr (!ALIGN_EPI) { if (wr == 0) PG8_BAR; }
    PG8_BAR;
#undef PG8_SA
#undef PG8_SB
#undef PG8_STAGE
#undef PG8_LDA
#undef PG8_LDB
#undef PG8_MMA
#undef PG8_WAIT_V
#undef PG8_WAIT_L
#undef PG8_BAR
#undef PG8_SCHED
}
}
using pg8::Unit;
typedef f32x4 AccT[2][2][4][2];

struct EpiF32Bias {
    static constexpr bool PERM = false;
    float* C; int ldc; const float* bias;
    __device__ __forceinline__ void operator()(const AccT& acc, const Unit& u, int wr, int wc, int fr, int fq) const {
        const int row0 = u.pm * 256 + wr * 64 + fr, col0 = u.pn * 256 + wc * 32 + 4 * fq;
#pragma unroll
        for (int ai = 0; ai < 2; ++ai)
#pragma unroll
            for (int m = 0; m < 4; ++m) { float* rowp = C + (size_t)(row0 + ai * 128 + m * 16) * ldc + col0;
#pragma unroll
                for (int bj = 0; bj < 2; ++bj)
#pragma unroll
                    for (int n = 0; n < 2; ++n) *(f32x4*)(rowp + bj * 128 + n * 16) = acc[ai][bj][m][n] + *(const f32x4*)(bias + col0 + bj * 128 + n * 16); }
    }
};
__device__ __forceinline__ u32x4 pack8(f32x4 v0, f32x4 v1) { u32x4 w; w.x = cvt_pk_bf16(v0[0], v0[1]); w.y = cvt_pk_bf16(v0[2], v0[3]); w.z = cvt_pk_bf16(v1[0], v1[1]); w.w = cvt_pk_bf16(v1[2], v1[3]); return w; }
struct EpiIn {
    static constexpr bool PERM = true;
    bf16_t *BG, *CI, *Z, *XBC, *GA, *GB; float* DT;
    __device__ __forceinline__ void operator()(const AccT& acc, const Unit& u, int wr, int wc, int fr, int fq) const {
        const int pn = u.pn, row0 = u.pm * 256 + wr * 64 + fr, cin = wc * 32 + 8 * fq;
        if (pn >= 4 && pn < 12) {
            const int col = (pn - 4) * 128 + cin;
#pragma unroll
            for (int ai = 0; ai < 2; ++ai)
#pragma unroll
                for (int m = 0; m < 4; ++m) { const size_t row = row0 + ai * 128 + m * 16;
                    *(u32x4*)(CI + row * 1024 + col) = pack8(acc[ai][0][m][0] * acc[ai][1][m][0], acc[ai][0][m][1] * acc[ai][1][m][1]); }
        } else if (pn == 40) {
            if (wc == 0) {
#pragma unroll
                for (int ai = 0; ai < 2; ++ai)
#pragma unroll
                    for (int m = 0; m < 4; ++m) { const size_t row = row0 + ai * 128 + m * 16;
                        *(f32x4*)(DT + row * 32 + 8 * fq) = acc[ai][0][m][0]; *(f32x4*)(DT + row * 32 + 8 * fq + 4) = acc[ai][0][m][1]; }
            }
        } else {
            bf16_t* O; int ldc, colt;
            if (pn < 4) { O = BG; ldc = 1024; colt = pn * 256; }
            else if (pn < 20) { O = Z; ldc = 2048; colt = (pn - 12) * 256; }
            else if (pn < 32) { O = XBC; ldc = 3072; colt = (pn - 20) * 256; }
            else if (pn < 36) { O = GA; ldc = 1024; colt = (pn - 32) * 256; }
            else { O = GB; ldc = 1024; colt = (pn - 36) * 256; }
#pragma unroll
            for (int ai = 0; ai < 2; ++ai)
#pragma unroll
                for (int m = 0; m < 4; ++m) { bf16_t* rowp = O + (size_t)(row0 + ai * 128 + m * 16) * ldc + colt + cin;
#pragma unroll
                    for (int bj = 0; bj < 2; ++bj) *(u32x4*)(rowp + bj * 128) = pack8(acc[ai][bj][m][0], acc[ai][bj][m][1]); }
        }
    }
};
template <int MODE> struct EpiGate {
    static constexpr bool PERM = true;
    bf16_t* O; const bf16_t* G; const bf16_t* Y; int ldc;
    __device__ __forceinline__ void operator()(const AccT& acc, const Unit& u, int wr, int wc, int fr, int fq) const {
        const int row0 = u.pm * 256 + wr * 64 + fr, col0 = u.pn * 256 + wc * 32 + 8 * fq;
#pragma unroll
        for (int ai = 0; ai < 2; ++ai)
#pragma unroll
            for (int m = 0; m < 4; ++m) { const size_t off = (size_t)(row0 + ai * 128 + m * 16) * ldc + col0;
#pragma unroll
                for (int bj = 0; bj < 2; ++bj) { f32x4 v0 = acc[ai][bj][m][0], v1 = acc[ai][bj][m][1];
                    if (MODE == 2) {
#pragma unroll
                        for (int j = 0; j < 4; ++j) { float a = fmaxf(v0[j], 0.f), b = fmaxf(v1[j], 0.f); v0[j] = a * a; v1[j] = b * b; }
                    } else {
                        const u32x4 gv = *(const u32x4*)(G + off + bj * 128);
                        v0[0] *= sigmoidf_(bflo(gv.x)); v0[1] *= sigmoidf_(bfhi(gv.x)); v0[2] *= sigmoidf_(bflo(gv.y)); v0[3] *= sigmoidf_(bfhi(gv.y));
                        v1[0] *= sigmoidf_(bflo(gv.z)); v1[1] *= sigmoidf_(bfhi(gv.z)); v1[2] *= sigmoidf_(bflo(gv.w)); v1[3] *= sigmoidf_(bfhi(gv.w));
                        if (MODE == 1) { const u32x4 yv = *(const u32x4*)(Y + off + bj * 128);
                            v0[0] += bflo(yv.x); v0[1] += bfhi(yv.x); v0[2] += bflo(yv.y); v0[3] += bfhi(yv.y);
                            v1[0] += bflo(yv.z); v1[1] += bfhi(yv.z); v1[2] += bflo(yv.w); v1[3] += bfhi(yv.w); }
                    }
                    *(u32x4*)(O + off + bj * 128) = pack8(v0, v1); } }
    }
};
struct EpiRes {
    static constexpr bool PERM = false;
    float* X1; const float* xp; const float* xs; const float* gate;
    __device__ __forceinline__ void operator()(const AccT& acc, const Unit& u, int wr, int wc, int fr, int fq) const {
        const int row0 = u.pm * 256 + wr * 64 + fr, col0 = u.pn * 256 + wc * 32 + 4 * fq;
#pragma unroll
        for (int ai = 0; ai < 2; ++ai)
#pragma unroll
            for (int m = 0; m < 4; ++m) { const int row = row0 + ai * 128 + m * 16;
                if (row < MTOT) {
                    const int seq = row < MP ? (row >> 11) : (NBP + row - MP);
                    const float* src = xp ? (row < MP ? xp + (size_t)row * D : xs + (size_t)(row - MP) * D) : X1 + (size_t)row * D;
                    const float* gr = gate + (size_t)seq * 6144;
#pragma unroll
                    for (int bj = 0; bj < 2; ++bj)
#pragma unroll
                        for (int n = 0; n < 2; ++n) { const int c = col0 + bj * 128 + n * 16;
                            *(f32x4*)(X1 + (size_t)row * D + c) = *(const f32x4*)(src + c) + *(const f32x4*)(gr + c) * acc[ai][bj][m][n]; }
                } }
    }
};


template <int KS, class Epi>
__device__ __forceinline__ void skinny_gemm(LAS unsigned char* lds, const bf16_t* A, const bf16_t* Bt, int N, int K, const Epi& E) {
    constexpr int RT = 8 / KS;
    const int tid = threadIdx.x, lane = tid & 63, w = __builtin_amdgcn_readfirstlane(tid >> 6), fr = lane & 15, fq = lane >> 4;
    const int nitems = (N / 16) * KS, klen = K / KS;
    LAS f32x4* red = (LAS f32x4*)lds;
    for (int it = blockIdx.x; it < nitems; it += gridDim.x) {
        const int ct = it / KS, rg = it % KS, rt = rg * RT + (w % RT), kq = w / RT;
        const bf16_t* ap = A + (size_t)(16 * rt + fr) * K + kq * klen + fq * 8;
        const bf16_t* bp = Bt + (size_t)(16 * ct + fr) * K + kq * klen + fq * 8;
        f32x4 acc0 = (f32x4){0.f, 0.f, 0.f, 0.f}, acc1 = acc0;
        for (int k = 0; k < klen; k += 256) {
            bf16x8 a[8], b[8];
#pragma unroll
            for (int j = 0; j < 8; ++j) { a[j] = *(const bf16x8*)(ap + k + 32 * j); b[j] = *(const bf16x8*)(bp + k + 32 * j); }
#pragma unroll
            for (int j = 0; j < 8; j += 2) { acc0 = __builtin_amdgcn_mfma_f32_16x16x32_bf16(b[j], a[j], acc0, 0, 0, 0); acc1 = __builtin_amdgcn_mfma_f32_16x16x32_bf16(b[j + 1], a[j + 1], acc1, 0, 0, 0); }
        }
        f32x4 acc = acc0 + acc1;
        if (KS > 1) {
            if (kq > 0) red[w * 64 + lane] = acc;
            __syncthreads();
            if (kq == 0) {
#pragma unroll
                for (int q = 1; q < KS; ++q) acc = acc + red[(w + q * RT) * 64 + lane];
                E(16 * rt + fr, 16 * ct + 4 * fq, acc);
            }
            __syncthreads();
        } else E(16 * rt + fr, 16 * ct + 4 * fq, acc);
    }
}
__device__ __forceinline__ f32x4 cv4(const u32x2 u) { return (f32x4){bflo(u.x), bfhi(u.x), bflo(u.y), bfhi(u.y)}; }
__device__ __forceinline__ u32x2 pack4(const f32x4 v) { u32x2 o; o.x = cvt_pk_bf16(v[0], v[1]); o.y = cvt_pk_bf16(v[2], v[3]); return o; }
template <int MODE> struct SkGate {
    bf16_t* O; const bf16_t* G; const bf16_t* Y; int ldc;
    __device__ __forceinline__ void operator()(int r, int c, f32x4 v) const {
        const size_t off = (size_t)(MP + r) * ldc + c;
        if (MODE == 2) {
#pragma unroll
            for (int j = 0; j < 4; ++j) { const float a = fmaxf(v[j], 0.f); v[j] = a * a; }
        } else {
            const f32x4 g = cv4(*(const u32x2*)(G + off));
#pragma unroll
            for (int j = 0; j < 4; ++j) v[j] *= sigmoidf_(g[j]);
            if (MODE == 1) v = v + cv4(*(const u32x2*)(Y + off));
        }
        *(u32x2*)(O + off) = pack4(v);
    }
};
struct SkRes {
    float* X1; const float* xs; const float* gate;
    __device__ __forceinline__ void operator()(int r, int c, f32x4 v) const {
        float* o = X1 + (size_t)(MP + r) * D + c;
        const f32x4 src = xs ? *(const f32x4*)(xs + (size_t)r * D + c) : *(const f32x4*)o;
        *(f32x4*)o = src + *(const f32x4*)(gate + (size_t)(NBP + r) * 6144 + c) * v;
    }
};

__device__ __forceinline__ int win_dest(int n) {
    if (n < 1024) return n;
    if (n < 2048) { const int j = n - 1024; return 1024 + (j >> 7) * 256 + (j & 127); }
    if (n < 3072) { const int j = n - 2048; return 1024 + (j >> 7) * 256 + 128 + (j & 127); }
    if (n < 8192) return n;
    if (n < 8224) return 10240 + (n - 8192);
    return n - 32;
}
__device__ __forceinline__ void transpose_tile(const float* W, int K, int N, bf16_t* WT, int kt, int ntile, bool remap, const float* kscale, LAS float* scr) {
    const int tid = threadIdx.x, k0 = kt * 64, n0 = ntile * 64, nl = tid & 63, ks = tid >> 6, n = n0 + nl;
#pragma unroll
    for (int i = 0; i < 8; ++i) { const int k = ks + 8 * i; float v = (n < N) ? W[(size_t)(k0 + k) * N + n] : 0.f; if (kscale) v *= kscale[k0 + k]; scr[nl * 65 + k] = v; }
    __syncthreads();
    const int nr = tid >> 3, kc = (tid & 7) * 8, ns = n0 + nr;
    if (ns < N) {
        const int dr = remap ? win_dest(ns) : ns;
        const LAS float* s = scr + nr * 65 + kc;
        u32x4 o; o.x = cvt_pk_bf16(s[0], s[1]); o.y = cvt_pk_bf16(s[2], s[3]); o.z = cvt_pk_bf16(s[4], s[5]); o.w = cvt_pk_bf16(s[6], s[7]);
        *(u32x4*)(WT + (size_t)dr * K + k0 + kc) = o;
    }
    __syncthreads();
}
__device__ __forceinline__ void phase0(const Params& p, LAS unsigned char* lds, int part) {
    LAS float* scr = (LAS float*)lds;
    unsigned char* ws = p.ws;
    constexpr int T_ADA = 16 * 96, T_IN = 16 * 161, T_AO = 16 * 16, T_BO = 32 * 16, T_O = 16 * 16, T_1 = 16 * 64, T_2 = 64 * 16;
    constexpr int TOT = T_ADA + T_IN + T_AO + T_BO + T_O + T_1 + T_2;
    constexpr int NMOD = 24;
    if (part == 0) {
        for (int it = blockIdx.x; it < T_ADA; it += gridDim.x) transpose_tile(p.in[I_WADA], 1024, 6144, (bf16_t*)(ws + OFF_WADA), it / 96, it % 96, false, nullptr, scr);
        bf16_t* cA = (bf16_t*)(ws + OFF_CA);
        for (int i = blockIdx.x * 512 + threadIdx.x; i < (NBP + NBS) * D; i += gridDim.x * 512) {
            const int row = i >> 10, k = i & 1023;
            const float v = row < NBP ? p.in[I_CP][row * D + k] : p.in[I_CS][(row - NBP) * D + k];
            cA[i] = f2bf(siluf_(v));
        }
        return;
    }
    for (int it = T_ADA + (int)blockIdx.x - NMOD; it < TOT; it += (int)gridDim.x - NMOD) {
        int r = it - T_ADA;
        if (r < T_IN) { transpose_tile(p.in[I_WIN], 1024, DIN, (bf16_t*)(ws + OFF_WIN), r / 161, r % 161, true, nullptr, scr); continue; } r -= T_IN;
        if (r < T_AO) { transpose_tile(p.in[I_WAOUT], 1024, 1024, (bf16_t*)(ws + OFF_WAOUT), r / 16, r % 16, false, nullptr, scr); continue; } r -= T_AO;
        if (r < T_BO) { transpose_tile(p.in[I_WBOUT], 2048, 1024, (bf16_t*)(ws + OFF_WBOUT), r / 16, r % 16, false, p.in[I_SNG], scr); continue; } r -= T_BO;
        if (r < T_O) { transpose_tile(p.in[I_WO], 1024, 1024, (bf16_t*)(ws + OFF_WO), r / 16, r % 16, false, nullptr, scr); continue; } r -= T_O;
        if (r < T_1) { transpose_tile(p.in[I_W1], 1024, 4096, (bf16_t*)(ws + OFF_W1), r / 64, r % 64, false, nullptr, scr); continue; } r -= T_1;
        transpose_tile(p.in[I_W2], 4096, 1024, (bf16_t*)(ws + OFF_W2), r / 16, r % 16, false, nullptr, scr);
    }
}

__device__ __forceinline__ void rownorm_mod(const float* xrow, const float* g, const float* sc, const float* sh, bf16_t* orow, int lane) {
    f32x4 v[4]; float s = 0.f;
#pragma unroll
    for (int j = 0; j < 4; ++j) { v[j] = ((const f32x4*)xrow)[lane + 64 * j]; s += (v[j][0] * v[j][0] + v[j][1] * v[j][1]) + (v[j][2] * v[j][2] + v[j][3] * v[j][3]); }
    const float rstd = rsqrtf(wave_sum(s) * (1.f / D) + EPS);
#pragma unroll
    for (int j = 0; j < 4; ++j) { const int i4 = lane + 64 * j;
        const f32x4 gg = ((const f32x4*)g)[i4], scv = ((const f32x4*)sc)[i4], shv = ((const f32x4*)sh)[i4];
        const f32x4 o = v[j] * rstd * gg * (scv + 1.f) + shv;
        u32x2 w; w.x = cvt_pk_bf16(o[0], o[1]); w.y = cvt_pk_bf16(o[2], o[3]);
        ((u32x2*)orow)[i4] = w; }
}
__device__ __forceinline__ void phase_rownorm(const Params& p, const float* xp, const float* xs, const float* gvec, int sc_off, int sh_off, bf16_t* U) {
    const int lane = threadIdx.x & 63, gw = blockIdx.x * 8 + (threadIdx.x >> 6), NW = gridDim.x * 8;
    const float* mod = (const float*)(p.ws + OFF_MOD);
    for (int row = gw; row < MTOT; row += NW) {
        const int seq = row < MP ? (row >> 11) : (NBP + row - MP);
        const float* xrow = row < MP ? xp + (size_t)row * D : xs + (size_t)(row - MP) * D;
        rownorm_mod(xrow, gvec, mod + (size_t)seq * 6144 + sc_off, mod + (size_t)seq * 6144 + sh_off, U + (size_t)row * D, lane);
    }
}
__device__ __forceinline__ void phase_final(const Params& p) {
    const int lane = threadIdx.x & 63, gw = blockIdx.x * 8 + (threadIdx.x >> 6), NW = gridDim.x * 8;
    const float* X = (const float*)(p.ws + OFF_X1); const float* g = p.in[I_NFG];
    for (int row = gw; row < MTOT; row += NW) {
        const float* xrow = X + (size_t)row * D;
        float* orow = row < MP ? p.out + O_YP + (size_t)row * D : p.out + O_YS + (size_t)(row - MP) * D;
        f32x4 v[4]; float s = 0.f;
#pragma unroll
        for (int j = 0; j < 4; ++j) { v[j] = ((const f32x4*)xrow)[lane + 64 * j]; s += (v[j][0] * v[j][0] + v[j][1] * v[j][1]) + (v[j][2] * v[j][2] + v[j][3] * v[j][3]); }
        const float rstd = rsqrtf(wave_sum(s) * (1.f / D) + EPS);
#pragma unroll
        for (int j = 0; j < 4; ++j) ((f32x4*)orow)[lane + 64 * j] = v[j] * rstd * ((const f32x4*)g)[lane + 64 * j];
    }
}

struct F8 { f32x4 a, b; };
__device__ __forceinline__ F8 ld8bf(const bf16_t* p) { const u32x4 u = *(const u32x4*)p; F8 r; r.a = (f32x4){bflo(u.x), bfhi(u.x), bflo(u.y), bfhi(u.y)}; r.b = (f32x4){bflo(u.z), bfhi(u.z), bflo(u.w), bfhi(u.w)}; return r; }
__device__ __forceinline__ F8 cv8(const u32x4 u) { F8 r; r.a = (f32x4){bflo(u.x), bfhi(u.x), bflo(u.y), bfhi(u.y)}; r.b = (f32x4){bflo(u.z), bfhi(u.z), bflo(u.w), bfhi(u.w)}; return r; }
__device__ __forceinline__ F8 ld8f(const float* p) { F8 r; r.a = *(const f32x4*)p; r.b = *(const f32x4*)(p + 4); return r; }
__device__ __forceinline__ void st8f(float* p, const F8& v) { *(f32x4*)p = v.a; *(f32x4*)(p + 4) = v.b; }
__device__ __forceinline__ F8 zero8() { F8 r; r.a = (f32x4){0.f, 0.f, 0.f, 0.f}; r.b = r.a; return r; }
__device__ __forceinline__ void phase_conv(const Params& p, LAS unsigned char* lds) {
    unsigned char* ws = p.ws;
    const bf16_t* BG = (const bf16_t*)(ws + OFF_BG); const bf16_t* CI = (const bf16_t*)(ws + OFF_CI); const bf16_t* XBC = (const bf16_t*)(ws + OFF_XBC);
    bf16_t* VA = (bf16_t*)(ws + OFF_VA); bf16_t* XC = (bf16_t*)(ws + OFF_XBCC);
    const int tid = threadIdx.x;
    for (int it = blockIdx.x; it < MP / 8 + NBS; it += gridDim.x) {
        if (it < MP / 8) {
            const int r0 = it * 8, tpos0 = r0 & (SEQ - 1), b = r0 >> 11;
            if (tid < 128) {
                const int ch = tid * 8;
                u32x4 raw[10], bgr[8];
#pragma unroll
                for (int i = 0; i < 10; ++i) raw[i] = (tpos0 - 2 + i >= 0) ? *(const u32x4*)(CI + (size_t)(r0 - 2 + i) * 1024 + ch) : (u32x4){0u, 0u, 0u, 0u};
#pragma unroll
                for (int i = 0; i < 8; ++i) bgr[i] = *(const u32x4*)(BG + (size_t)(r0 + i) * 1024 + ch);
                const F8 w0 = ld8f(p.in[I_CAW] + ch), w1 = ld8f(p.in[I_CAW] + 1024 + ch), w2 = ld8f(p.in[I_CAW] + 2048 + ch);
#pragma unroll
                for (int i = 0; i < 8; ++i) { const F8 p2 = cv8(raw[i]), p1 = cv8(raw[i + 1]), c0 = cv8(raw[i + 2]), bg = cv8(bgr[i]);
                    const f32x4 va = bg.a * (w0.a * p2.a + w1.a * p1.a + w2.a * c0.a), vb = bg.b * (w0.b * p2.b + w1.b * p1.b + w2.b * c0.b);
                    *(u32x4*)(VA + (size_t)(r0 + i) * 1024 + ch) = pack8(va, vb);
                    if (tpos0 + i >= SEQ - 2) st8f(p.out + O_SCP + ((size_t)b * 2 + (tpos0 + i - (SEQ - 2))) * 1024 + ch, c0); }
            } else {
                const int ch = (tid - 128) * 8;
                u32x4 raw[11];
#pragma unroll
                for (int i = 0; i < 11; ++i) raw[i] = (tpos0 - 3 + i >= 0) ? *(const u32x4*)(XBC + (size_t)(r0 - 3 + i) * 3072 + ch) : (u32x4){0u, 0u, 0u, 0u};
                const F8 w0 = ld8f(p.in[I_CBW] + ch), w1 = ld8f(p.in[I_CBW] + 3072 + ch), w2 = ld8f(p.in[I_CBW] + 6144 + ch), w3 = ld8f(p.in[I_CBW] + 9216 + ch), bb = ld8f(p.in[I_CBB] + ch);
#pragma unroll
                for (int i = 0; i < 8; ++i) { const F8 p3 = cv8(raw[i]), p2 = cv8(raw[i + 1]), p1 = cv8(raw[i + 2]), c0 = cv8(raw[i + 3]);
                    f32x4 va = w0.a * p3.a + w1.a * p2.a + w2.a * p1.a + w3.a * c0.a + bb.a, vb = w0.b * p3.b + w1.b * p2.b + w2.b * p1.b + w3.b * c0.b + bb.b;
#pragma unroll
                    for (int j = 0; j < 4; ++j) { va[j] = siluf_(va[j]); vb[j] = siluf_(vb[j]); }
                    *(u32x4*)(XC + (size_t)(r0 + i) * 3072 + ch) = pack8(va, vb);
                    if (tpos0 + i >= SEQ - 3) st8f(p.out + O_SBP + ((size_t)b * 3 + (tpos0 + i - (SEQ - 3))) * 3072 + ch, c0); }
            }
        } else {
            const int b = it - MP / 8, row = MP + b;
            if (tid < 128) {
                const int ch = tid * 8;
                const F8 c0 = ld8bf(CI + (size_t)row * 1024 + ch);
                const F8 p2 = ld8f(p.in[I_STA] + ((size_t)b * 2 + 0) * 1024 + ch), p1 = ld8f(p.in[I_STA] + ((size_t)b * 2 + 1) * 1024 + ch);
                const F8 w0 = ld8f(p.in[I_CAW] + ch), w1 = ld8f(p.in[I_CAW] + 1024 + ch), w2 = ld8f(p.in[I_CAW] + 2048 + ch);
                const F8 bg = ld8bf(BG + (size_t)row * 1024 + ch);
                const f32x4 va = bg.a * (w0.a * p2.a + w1.a * p1.a + w2.a * c0.a), vb = bg.b * (w0.b * p2.b + w1.b * p1.b + w2.b * c0.b);
                *(u32x4*)(VA + (size_t)row * 1024 + ch) = pack8(va, vb);
                st8f(p.out + O_SCS + ((size_t)b * 2 + 0) * 1024 + ch, p1); st8f(p.out + O_SCS + ((size_t)b * 2 + 1) * 1024 + ch, c0);
            } else {
                const int ch = (tid - 128) * 8;
                const F8 c0 = ld8bf(XBC + (size_t)row * 3072 + ch);
                const F8 p3 = ld8f(p.in[I_STB] + ((size_t)b * 3 + 0) * 3072 + ch), p2 = ld8f(p.in[I_STB] + ((size_t)b * 3 + 1) * 3072 + ch), p1 = ld8f(p.in[I_STB] + ((size_t)b * 3 + 2) * 3072 + ch);
                const F8 w0 = ld8f(p.in[I_CBW] + ch), w1 = ld8f(p.in[I_CBW] + 3072 + ch), w2 = ld8f(p.in[I_CBW] + 6144 + ch), w3 = ld8f(p.in[I_CBW] + 9216 + ch), bb = ld8f(p.in[I_CBB] + ch);
                f32x4 va = w0.a * p3.a + w1.a * p2.a + w2.a * p1.a + w3.a * c0.a + bb.a, vb = w0.b * p3.b + w1.b * p2.b + w2.b * p1.b + w3.b * c0.b + bb.b;
#pragma unroll
                for (int j = 0; j < 4; ++j) { va[j] = siluf_(va[j]); vb[j] = siluf_(vb[j]); }
                *(u32x4*)(XC + (size_t)row * 3072 + ch) = pack8(va, vb);
                st8f(p.out + O_SBS + ((size_t)b * 3 + 0) * 3072 + ch, p2); st8f(p.out + O_SBS + ((size_t)b * 3 + 1) * 3072 + ch, p1); st8f(p.out + O_SBS + ((size_t)b * 3 + 2) * 3072 + ch, c0);
            }
        }
    }
    const float* DTR = (const float*)(ws + OFF_DTRAW); float* DTP = (float*)(ws + OFF_DTP); float* ACS = (float*)(ws + OFF_ACS);
    LAS float* t1 = (LAS float*)lds; LAS float* t2 = t1 + 128 * 33;
    for (int it = blockIdx.x; it < 129; it += gridDim.x) {
        const int t0 = it * 128;
#pragma unroll
        for (int i = 0; i < 8; ++i) { const int idx = tid + 512 * i, r = idx >> 5, hh = idx & 31;
            const float raw = DTR[(size_t)(t0 + r) * 32 + hh] + p.in[I_DTB][hh];
            t1[r * 33 + hh] = raw > 20.f ? raw : log1pf(expf(raw)); }
        __syncthreads();
        if (tid < 32) { const float a = -expf(p.in[I_ALOG][tid]); float run = 0.f;
            for (int s = 0; s < 128; ++s) { run += t1[s * 33 + tid] * a; t2[s * 33 + tid] = run; } }
        __syncthreads();
#pragma unroll
        for (int i = 0; i < 8; ++i) { const int idx = tid + 512 * i, r = idx >> 5, hh = idx & 31;
            DTP[(size_t)(t0 + r) * 32 + hh] = t1[r * 33 + hh]; ACS[(size_t)(t0 + r) * 32 + hh] = t2[r * 33 + hh]; }
        __syncthreads();
    }
}

constexpr int RS = 272, RX = 144;
constexpr int L_C = 0, L_B = 34816, L_X = 69632, L_XW = 88064, L_H = 106496, L_ACS = 123904, L_DT = 124416;
__device__ __forceinline__ bf16x8 tr_frag(LAS unsigned char* base, int rstride, int k0, int c0, int lane) {
    const int i = lane & 15, g = lane >> 4, q = i >> 2, pp = i & 3;
    LAS unsigned char* a = base + (k0 + 8 * g + q) * rstride + (c0 + 4 * pp) * 2;
    const bf16x4 lo = __builtin_amdgcn_ds_read_tr16_b64_v4i16((LAS bf16x4*)a);
    const bf16x4 hi = __builtin_amdgcn_ds_read_tr16_b64_v4i16((LAS bf16x4*)(a + 4 * rstride));
    return (bf16x8){lo[0], lo[1], lo[2], lo[3], hi[0], hi[1], hi[2], hi[3]};
}
__device__ __forceinline__ void ssd_prompt_unit(const Params& p, LAS unsigned char* lds, int b, int h) {
    unsigned char* ws = p.ws;
    const bf16_t* XC = (const bf16_t*)(ws + OFF_XBCC); const bf16_t* Z = (const bf16_t*)(ws + OFF_Z);
    const float* DTP = (const float*)(ws + OFF_DTP); const float* ACS = (const float*)(ws + OFF_ACS);
    bf16_t* YG = (bf16_t*)(ws + OFF_YG); float* SSQ = (float*)(ws + OFF_SSQ);
    const int tid = threadIdx.x, lane = tid & 63, w = __builtin_amdgcn_readfirstlane(tid >> 6), fr = lane & 15, fq = lane >> 4, g = h >> 3;
    const float Dh = p.in[I_DSKIP][h];
    LAS float* sAcs = (LAS float*)(lds + L_ACS); LAS float* sDt = (LAS float*)(lds + L_DT);
    f32x4 hacc[4];
#pragma unroll
    for (int i = 0; i < 4; ++i) hacc[i] = (f32x4){0.f, 0.f, 0.f, 0.f};
    const int hpt = w & 3, hnb = (w >> 2) * 4;
    for (int c = 0; c < SEQ / 128; ++c) {
        const int t0 = b * SEQ + c * 128;
        u32x4 rc[4], rb[4], rx[2]; float wv[2];
        { const int ch = tid & 15, row = tid >> 4;
#pragma unroll
          for (int i = 0; i < 4; ++i) { const bf16_t* src = XC + (size_t)(t0 + row + 32 * i) * 3072; rb[i] = *(const u32x4*)(src + 2048 + g * 128 + ch * 8); rc[i] = *(const u32x4*)(src + 2560 + g * 128 + ch * 8); } }
        const float acs_last = ACS[(size_t)(t0 + 127) * 32 + h];
        { const int ch = tid & 7, row = tid >> 3;
#pragma unroll
          for (int i = 0; i < 2; ++i) { const int r = t0 + row + 64 * i; rx[i] = *(const u32x4*)(XC + (size_t)r * 3072 + h * 64 + ch * 8);
              wv[i] = __expf(acs_last - ACS[(size_t)r * 32 + h]) * DTP[(size_t)r * 32 + h]; } }
        float my_acs = 0.f, my_dt = 0.f;
        if (tid < 128) { my_acs = ACS[(size_t)(t0 + tid) * 32 + h]; my_dt = DTP[(size_t)(t0 + tid) * 32 + h]; }
        __syncthreads();
#pragma unroll
        for (int i = 0; i < 4; ++i) { u32x2 o; o.x = cvt_pk_bf16(hacc[i][0], hacc[i][1]); o.y = cvt_pk_bf16(hacc[i][2], hacc[i][3]);
            *(LAS u32x2*)(lds + L_H + (16 * hpt + fr) * RS + (16 * (hnb + i) + 4 * fq) * 2) = o; }
        { const int ch = tid & 15, row = tid >> 4;
#pragma unroll
          for (int i = 0; i < 4; ++i) { *(LAS u32x4*)(lds + L_B + (row + 32 * i) * RS + ch * 16) = rb[i]; *(LAS u32x4*)(lds + L_C + (row + 32 * i) * RS + ch * 16) = rc[i]; } }
        { const int ch = tid & 7, row = tid >> 3;
#pragma unroll
          for (int i = 0; i < 2; ++i) { *(LAS u32x4*)(lds + L_X + (row + 64 * i) * RX + ch * 16) = rx[i];
              const float s = wv[i]; u32x4 o;
              o.x = cvt_pk_bf16(bflo(rx[i].x) * s, bfhi(rx[i].x) * s); o.y = cvt_pk_bf16(bflo(rx[i].y) * s, bfhi(rx[i].y) * s);
              o.z = cvt_pk_bf16(bflo(rx[i].z) * s, bfhi(rx[i].z) * s); o.w = cvt_pk_bf16(bflo(rx[i].w) * s, bfhi(rx[i].w) * s);
              *(LAS u32x4*)(lds + L_XW + (row + 64 * i) * RX + ch * 16) = o; } }
        if (tid < 128) { sAcs[tid] = my_acs; sDt[tid] = my_dt; }
        __syncthreads();
        const int qrow = 16 * w + fr;
        bf16x8 cf[4];
#pragma unroll
        for (int kk = 0; kk < 4; ++kk) cf[kk] = *(const LAS bf16x8*)(lds + L_C + qrow * RS + (kk * 32 + fq * 8) * 2);
        f32x4 yacc[4];
#pragma unroll
        for (int i = 0; i < 4; ++i) yacc[i] = (f32x4){0.f, 0.f, 0.f, 0.f};
        const float acs_q = sAcs[qrow];
        if (c > 0) {
#pragma unroll
            for (int pt = 0; pt < 4; ++pt)
#pragma unroll
                for (int kk = 0; kk < 4; ++kk) { const bf16x8 hf = *(const LAS bf16x8*)(lds + L_H + (16 * pt + fr) * RS + (kk * 32 + fq * 8) * 2);
                    yacc[pt] = __builtin_amdgcn_mfma_f32_16x16x32_bf16(hf, cf[kk], yacc[pt], 0, 0, 0); }
            const float eq = __expf(acs_q);
#pragma unroll
            for (int pt = 0; pt < 4; ++pt) yacc[pt] = yacc[pt] * eq;
        }
#pragma unroll
        for (int st = 0; st < 8; ++st) {
            f32x4 sacc = (f32x4){0.f, 0.f, 0.f, 0.f};
#pragma unroll
            for (int kk = 0; kk < 4; ++kk) { const bf16x8 bfr = *(const LAS bf16x8*)(lds + L_B + (16 * st + fr) * RS + (kk * 32 + fq * 8) * 2);
                sacc = __builtin_amdgcn_mfma_f32_16x16x32_bf16(bfr, cf[kk], sacc, 0, 0, 0); }
            const int s0 = 16 * st + 4 * fq;
            const f32x4 as = *(const LAS f32x4*)(sAcs + s0), ds = *(const LAS f32x4*)(sDt + s0);
            float pv[4];
#pragma unroll
            for (int j = 0; j < 4; ++j) pv[j] = (s0 + j <= qrow) ? sacc[j] * __expf(acs_q - as[j]) * ds[j] : 0.f;
            u32x2 o; o.x = cvt_pk_bf16(pv[0], pv[1]); o.y = cvt_pk_bf16(pv[2], pv[3]);
            *(LAS u32x2*)(lds + L_C + qrow * RS + s0 * 2) = o;
        }
#pragma unroll
        for (int kk = 0; kk < 4; ++kk) { const bf16x8 pf = *(const LAS bf16x8*)(lds + L_C + qrow * RS + (kk * 32 + fq * 8) * 2);
#pragma unroll
            for (int pt = 0; pt < 4; ++pt) { const bf16x8 xf = tr_frag(lds + L_X, RX, kk * 32, 16 * pt, lane);
                yacc[pt] = __builtin_amdgcn_mfma_f32_16x16x32_bf16(xf, pf, yacc[pt], 0, 0, 0); } }
        { float ss = 0.f; const size_t trow = (size_t)(t0 + qrow);
#pragma unroll
          for (int pt = 0; pt < 4; ++pt) { const int pc = 16 * pt + 4 * fq;
              const u32x2 xv = *(const LAS u32x2*)(lds + L_X + qrow * RX + pc * 2);
              const u32x2 zv = *(const u32x2*)(Z + trow * 2048 + h * 64 + pc);
              const float x0 = bflo(xv.x), x1 = bfhi(xv.x), x2 = bflo(xv.y), x3 = bfhi(xv.y);
              const float g0 = (yacc[pt][0] + Dh * x0) * siluf_(bflo(zv.x)), g1 = (yacc[pt][1] + Dh * x1) * siluf_(bfhi(zv.x));
              const float g2 = (yacc[pt][2] + Dh * x2) * siluf_(bflo(zv.y)), g3 = (yacc[pt][3] + Dh * x3) * siluf_(bfhi(zv.y));
              ss += (g0 * g0 + g1 * g1) + (g2 * g2 + g3 * g3);
              u32x2 o; o.x = cvt_pk_bf16(g0, g1); o.y = cvt_pk_bf16(g2, g3);
              *(u32x2*)(YG + trow * 2048 + h * 64 + pc) = o; }
          ss += __shfl_xor(ss, 16); ss += __shfl_xor(ss, 32);
          if (fq == 0) SSQ[trow * 32 + h] = ss; }
        { const float dec = __expf(acs_last);
#pragma unroll
          for (int i = 0; i < 4; ++i) hacc[i] = hacc[i] * dec;
#pragma unroll
          for (int kk = 0; kk < 4; ++kk) { const bf16x8 xwf = tr_frag(lds + L_XW, RX, kk * 32, 16 * hpt, lane);
#pragma unroll
              for (int i = 0; i < 4; ++i) { const bf16x8 bf = tr_frag(lds + L_B, RS, kk * 32, 16 * (hnb + i), lane);
                  hacc[i] = __builtin_amdgcn_mfma_f32_16x16x32_bf16(bf, xwf, hacc[i], 0, 0, 0); } } }
    }
    float* so = p.out + O_SSP + (((size_t)b * NH + h) * HD + 16 * hpt + fr) * DS;
#pragma unroll
    for (int i = 0; i < 4; ++i) *(f32x4*)(so + 16 * (hnb + i) + 4 * fq) = hacc[i];
    __syncthreads();
}
__device__ __forceinline__ void ssd_sample_item(const Params& p, LAS unsigned char* lds, int b, int h) {
    unsigned char* ws = p.ws;
    const bf16_t* XC = (const bf16_t*)(ws + OFF_XBCC); const bf16_t* Z = (const bf16_t*)(ws + OFF_Z);
    const float* DTP = (const float*)(ws + OFF_DTP); bf16_t* YG = (bf16_t*)(ws + OFF_YG); float* SSQ = (float*)(ws + OFF_SSQ);
    LAS float* red = (LAS float*)lds;
    const int tid = threadIdx.x, n4 = tid & 31, pr = tid >> 5, r = MP + b, g = h >> 3;
    const float dt = DTP[(size_t)r * 32 + h], dA = __expf(dt * -expf(p.in[I_ALOG][h])), Dh = p.in[I_DSKIP][h];
    const bf16_t* xr = XC + (size_t)r * 3072;
    const u32x2 bu = *(const u32x2*)(xr + 2048 + g * 128 + 4 * n4), cu = *(const u32x2*)(xr + 2560 + g * 128 + 4 * n4);
    const f32x4 Bv = (f32x4){bflo(bu.x), bfhi(bu.x), bflo(bu.y), bfhi(bu.y)}, Cv = (f32x4){bflo(cu.x), bfhi(cu.x), bflo(cu.y), bfhi(cu.y)};
    const size_t sbase = (((size_t)b * NH + h) * HD) * DS;
#pragma unroll
    for (int i = 0; i < 4; ++i) { const int pp = pr + 16 * i;
        const float xv = bf2f(xr[h * 64 + pp]);
        const f32x4 h0 = *(const f32x4*)(p.in[I_STS] + sbase + (size_t)pp * DS + 4 * n4);
        const f32x4 hn = h0 * dA + Bv * (dt * xv);
        *(f32x4*)(p.out + O_SSS + sbase + (size_t)pp * DS + 4 * n4) = hn;
        float y = (hn[0] * Cv[0] + hn[1] * Cv[1]) + (hn[2] * Cv[2] + hn[3] * Cv[3]);
#pragma unroll
        for (int o = 1; o < 32; o <<= 1) y += __shfl_xor(y, o);
        if (n4 == 0) { const float gt = (y + Dh * xv) * siluf_(bf2f(Z[(size_t)r * 2048 + h * 64 + pp])); YG[(size_t)r * 2048 + h * 64 + pp] = f2bf(gt); red[pp] = gt * gt; } }
    __syncthreads();
    if (tid < 64) { const float v = wave_sum(red[tid]); if (tid == 0) SSQ[(size_t)r * 32 + h] = v; }
    __syncthreads();
}
__device__ __forceinline__ void phase_ssd(const Params& p, LAS unsigned char* lds) {
    for (int u = blockIdx.x; u < NBP * NH; u += gridDim.x) {
        const int xcd = u & 7, j = u >> 3, pair = xcd * 4 + (j >> 3), hr = j & 7;
        ssd_prompt_unit(p, lds, pair >> 2, (pair & 3) * 8 + hr);
    }
    for (int it = blockIdx.x; it < NBS * NH; it += gridDim.x) ssd_sample_item(p, lds, it >> 5, it & 31);
}
__device__ __forceinline__ void phase_gnorm(const Params& p) {
    bf16_t* YG = (bf16_t*)(p.ws + OFF_YG); const float* SSQ = (const float*)(p.ws + OFF_SSQ);
    for (int i = blockIdx.x * 512 + threadIdx.x; i < MTOT * 256; i += gridDim.x * 512) {
        const int row = i >> 8, cu = i & 255, g = cu >> 6;
        const f32x4 s0 = *(const f32x4*)(SSQ + (size_t)row * 32 + 8 * g), s1 = *(const f32x4*)(SSQ + (size_t)row * 32 + 8 * g + 4);
        const float rstd = rsqrtf(((s0[0] + s0[1]) + (s0[2] + s0[3]) + (s1[0] + s1[1]) + (s1[2] + s1[3])) * (1.f / 512.f) + EPS);
        bf16_t* q = YG + (size_t)row * 2048 + cu * 8;
        const F8 v = ld8bf(q);
        *(u32x4*)q = pack8(v.a * rstd, v.b * rstd);
    }
}

__global__ void __launch_bounds__(512, 2) fwd_megakernel(Params p) {
    extern __shared__ __attribute__((aligned(16))) unsigned char shm[];
    LAS unsigned char* lds = (LAS unsigned char*)shm;
    cg::grid_group grid = cg::this_grid();
    unsigned char* ws = p.ws;
    const int G = gridDim.x, cid = blockIdx.x;
    float* mod = (float*)(ws + OFF_MOD);
    pg8::StaticOrder S;
    volatile LAS unsigned* xst = (volatile LAS unsigned*)(lds + 131072);
    if (threadIdx.x == 0) { xst[0] = 0u; xst[1] = 0u; }
    __syncthreads();
    XcdBarrier xb = xcd_barrier_post((unsigned*)(ws + OFF_BAR), xst);

    phase0(p, lds, 0);
    grid.sync();
    if (cid < 24) {
        pg8::Gemm g{(const bf16_t*)(ws + OFF_CA), (const bf16_t*)(ws + OFF_WADA), 256, 6144, 1024};
        EpiF32Bias E{mod, 6144, p.in[I_BADA]};
        S.init(g.M, g.N, 24, cid); pg8::gemm_phase<EpiF32Bias, pg8::StaticOrder, true, true>(lds, g, S, E);
    } else phase0(p, lds, 1);
    GSYNC();
    phase_rownorm(p, p.in[I_XP], p.in[I_XS], p.in[I_N1G], 1024, 0, (bf16_t*)(ws + OFF_U));
    if (PROBE_EW) phase_rownorm(p, p.in[I_XP], p.in[I_XS], p.in[I_N1G], 1024, 0, (bf16_t*)(ws + OFF_U));
    GSYNC();
    {
        pg8::Gemm g{(const bf16_t*)(ws + OFF_U), (const bf16_t*)(ws + OFF_WIN), MPAD, DINP, 1024};
        EpiIn E{(bf16_t*)(ws + OFF_BG), (bf16_t*)(ws + OFF_CI), (bf16_t*)(ws + OFF_Z), (bf16_t*)(ws + OFF_XBC), (bf16_t*)(ws + OFF_GA), (bf16_t*)(ws + OFF_GB), (float*)(ws + OFF_DTRAW)};
        S.init(g.M, g.N, G, cid); pg8::gemm_phase<EpiIn, pg8::StaticOrder, true, true>(lds, g, S, E);
    }
    GSYNC();
    phase_conv(p, lds);
    if (PROBE_CONV) { __syncthreads(); phase_conv(p, lds); }
    GSYNC();
    phase_ssd(p, lds);
    if (PROBE_SSD) { __syncthreads(); phase_ssd(p, lds); }
    GSYNC();
    phase_gnorm(p);
    GSYNC();
    {
        pg8::Gemm ga{(const bf16_t*)(ws + OFF_VA), (const bf16_t*)(ws + OFF_WAOUT), MP, 1024, 1024};
        EpiGate<0> Ea{(bf16_t*)(ws + OFF_YA), (const bf16_t*)(ws + OFF_GA), nullptr, 1024};
        S.init(ga.M, ga.N, G, cid); pg8::gemm_phase<EpiGate<0>, pg8::StaticOrder, true, true>(lds, ga, S, Ea);
        __syncthreads();
        pg8::Gemm gb{(const bf16_t*)(ws + OFF_YG), (const bf16_t*)(ws + OFF_WBOUT), MP, 1024, 2048};
        EpiGate<1> Eb{(bf16_t*)(ws + OFF_MERGED), (const bf16_t*)(ws + OFF_GB), (const bf16_t*)(ws + OFF_YA), 1024};
        pg8::gemm_phase<EpiGate<1>, pg8::StaticOrder, true, true>(lds, gb, S, Eb);
        __syncthreads();
        SkGate<0> Sa{(bf16_t*)(ws + OFF_YA), (const bf16_t*)(ws + OFF_GA), nullptr, 1024};
        skinny_gemm<4>(lds, (const bf16_t*)(ws + OFF_VA) + (size_t)MP * 1024, (const bf16_t*)(ws + OFF_WAOUT), 1024, 1024, Sa);
        SkGate<1> Sb{(bf16_t*)(ws + OFF_MERGED), (const bf16_t*)(ws + OFF_GB), (const bf16_t*)(ws + OFF_YA), 1024};
        skinny_gemm<4>(lds, (const bf16_t*)(ws + OFF_YG) + (size_t)MP * 2048, (const bf16_t*)(ws + OFF_WBOUT), 1024, 2048, Sb);
    }
    GSYNC();
    {
        pg8::Gemm g{(const bf16_t*)(ws + OFF_MERGED), (const bf16_t*)(ws + OFF_WO), MP, 1024, 1024};
        EpiRes E{(float*)(ws + OFF_X1), p.in[I_XP], p.in[I_XS], mod + 2048};
        S.init(g.M, g.N, G, cid); pg8::gemm_phase<EpiRes, pg8::StaticOrder, true, true>(lds, g, S, E);
        __syncthreads();
        SkRes Sk{(float*)(ws + OFF_X1), p.in[I_XS], mod + 2048};
        skinny_gemm<4>(lds, (const bf16_t*)(ws + OFF_MERGED) + (size_t)MP * 1024, (const bf16_t*)(ws + OFF_WO), 1024, 1024, Sk);
    }
    GSYNC();
    {
        const float* X1 = (const float*)(ws + OFF_X1);
        phase_rownorm(p, X1, X1 + (size_t)MP * D, p.in[I_N2G], 4096, 3072, (bf16_t*)(ws + OFF_U));
        if (PROBE_EW) phase_rownorm(p, X1, X1 + (size_t)MP * D, p.in[I_N2G], 4096, 3072, (bf16_t*)(ws + OFF_U));
    }
    GSYNC();
    {
        pg8::Gemm g{(const bf16_t*)(ws + OFF_U), (const bf16_t*)(ws + OFF_W1), MP, DFF, 1024};
        EpiGate<2> E{(bf16_t*)(ws + OFF_HMID), nullptr, nullptr, DFF};
        S.init(g.M, g.N, G, cid); pg8::gemm_phase<EpiGate<2>, pg8::StaticOrder, true, true>(lds, g, S, E);
        __syncthreads();
        SkGate<2> Sk{(bf16_t*)(ws + OFF_HMID), nullptr, nullptr, DFF};
        skinny_gemm<1>(lds, (const bf16_t*)(ws + OFF_U) + (size_t)MP * 1024, (const bf16_t*)(ws + OFF_W1), DFF, 1024, Sk);
    }
    GSYNC();
    {
        pg8::Gemm g{(const bf16_t*)(ws + OFF_HMID), (const bf16_t*)(ws + OFF_W2), MP, 1024, DFF};
        EpiRes E{(float*)(ws + OFF_X1), nullptr, nullptr, mod + 5120};
        S.init(g.M, g.N, G, cid); pg8::gemm_phase<EpiRes, pg8::StaticOrder, true, true>(lds, g, S, E);
        __syncthreads();
        SkRes Sk{(float*)(ws + OFF_X1), nullptr, mod + 5120};
        skinny_gemm<4>(lds, (const bf16_t*)(ws + OFF_HMID) + (size_t)MP * DFF, (const bf16_t*)(ws + OFF_W2), 1024, DFF, Sk);
    }
    GSYNC();
    phase_final(p);
    if (PROBE_EW) phase_final(p);
}

extern "C" void kernel_launch(void* const* d_in, const int* in_sizes, int n_in, void* d_out, int out_size, void* d_ws, size_t ws_size, hipStream_t stream) {
    constexpr int LDS_BYTES = 131072 + 16;
    static int grid = 0;
    if (grid == 0) {
        if (n_in != 25 || ws_size < WS_END) { fprintf(stderr, "kernel_launch: unexpected n_in %d / ws %zu (need %zu)\n", n_in, ws_size, (size_t)WS_END); grid = -1; return; }
        int dev = 0, cus = 0, per_cu = 0;
        (void)hipGetDevice(&dev);
        (void)hipDeviceGetAttribute(&cus, hipDeviceAttributeMultiprocessorCount, dev);
        if (hipFuncSetAttribute((const void*)fwd_megakernel, hipFuncAttributeMaxDynamicSharedMemorySize, LDS_BYTES) != hipSuccess) { fprintf(stderr, "kernel_launch: hipFuncSetAttribute failed\n"); grid = -1; return; }
        if (hipOccupancyMaxActiveBlocksPerMultiprocessor(&per_cu, (const void*)fwd_megakernel, 512, LDS_BYTES) != hipSuccess || per_cu < 1) { fprintf(stderr, "kernel_launch: occupancy query says %d blocks per CU\n", per_cu); grid = -1; return; }
        grid = cus;
    }
    if (grid < 0) return;
    Params p{};
    for (int i = 0; i < 25; ++i) p.in[i] = (const float*)d_in[i];
    p.out = (float*)d_out; p.ws = (unsigned char*)d_ws;
    (void)hipMemsetAsync((unsigned char*)d_ws + OFF_BAR, 0, 16384, stream);
    void* args[] = {&p};
    hipError_t e = hipLaunchCooperativeKernel((const void*)fwd_megakernel, dim3(grid), dim3(512), args, LDS_BYTES, stream);
    if (e != hipSuccess) fprintf(stderr, "cooperative launch failed: %s (grid %d)\n", hipGetErrorString(e), grid);
}
```

```cpp
#include <hip/hip_runtime.h>
#include <hip/hip_cooperative_groups.h>
#include <cstdio>
#include <cstdint>
namespace cg = cooperative_groups;
#define PROBE_EW 0
#define PROBE_CONV 0
#define PROBE_SSD 0
#define PROBE_SYNC 0
#define GSYNC() do { xcd_barrier(xb); if (PROBE_SYNC) xcd_barrier(xb); } while (0)

#define LAS __attribute__((address_space(3)))
typedef unsigned short bf16_t;
typedef short bf16x8 __attribute__((ext_vector_type(8)));
typedef short bf16x4 __attribute__((ext_vector_type(4)));
typedef float f32x4 __attribute__((ext_vector_type(4)));
typedef float f32x2 __attribute__((ext_vector_type(2)));
typedef unsigned u32x4 __attribute__((ext_vector_type(4)));
typedef unsigned u32x2 __attribute__((ext_vector_type(2)));

constexpr int D = 1024, NBP = 8, SEQ = 2048, MP = NBP * SEQ, NBS = 128, MTOT = MP + NBS, MPAD = 16640;
constexpr int DINP = 10496, DINNER = 2048, DXBC = 3072, NH = 32, HD = 64, DS = 128, DFF = 4096, DIN = 10272;
constexpr float EPS = 1e-6f;
constexpr size_t O_YP = 0, O_YS = 16777216, O_SCP = 16908288, O_SBP = 16924672, O_SSP = 16998400, O_SCS = 19095552, O_SBS = 19357696, O_SSS = 20537344;
constexpr size_t S1 = (size_t)MPAD * 1024 * 2;
constexpr size_t OFF_WADA = 0, OFF_WIN = 12582912, OFF_WAOUT = 34078720, OFF_WBOUT = 36175872, OFF_WO = 40370176, OFF_W1 = 42467328, OFF_W2 = 50855936,
                 OFF_CA = 59244544, OFF_MOD = 59768832, OFF_DTRAW = 66060288, OFF_DTP = 68190208, OFF_ACS = 70320128, OFF_SSQ = 72450048, OFF_U = 74579968,
                 OFF_R1 = OFF_U + S1, OFF_BG = OFF_R1, OFF_CI = OFF_R1 + S1, OFF_Z = OFF_R1 + 2 * S1, OFF_XBC = OFF_R1 + 4 * S1, OFF_GA = OFF_R1 + 7 * S1, OFF_GB = OFF_R1 + 8 * S1,
                 OFF_R2 = OFF_R1 + 9 * S1, OFF_BAR = OFF_R2 + 3 * S1, WS_END = OFF_BAR + 16384;
constexpr size_t OFF_VA = OFF_U, OFF_YA = OFF_BG, OFF_MERGED = OFF_CI, OFF_YG = OFF_XBC, OFF_HMID = OFF_R1, OFF_XBCC = OFF_R2, OFF_X1 = OFF_R2;

struct Params {
    const float* in[25];
    float* out;
    unsigned char* ws;
};
enum { I_XP = 0, I_XS, I_CP, I_CS, I_STA, I_STB, I_STS, I_WADA, I_BADA, I_N1G, I_WIN, I_CAW, I_WAOUT, I_CBW, I_CBB, I_DTB, I_ALOG, I_DSKIP, I_SNG, I_WBOUT, I_WO, I_N2G, I_W1, I_W2, I_NFG };

__device__ __forceinline__ unsigned cvt_pk_bf16(float lo, float hi) { unsigned r; asm volatile("v_cvt_pk_bf16_f32 %0, %1, %2" : "=v"(r) : "v"(lo), "v"(hi)); return r; }
__device__ __forceinline__ bf16_t f2bf(float f) { unsigned u = __float_as_uint(f); u += 0x7FFFu + ((u >> 16) & 1u); return (bf16_t)(u >> 16); }
__device__ __forceinline__ float bf2f(bf16_t b) { return __uint_as_float(((unsigned)b) << 16); }
__device__ __forceinline__ float bflo(unsigned u) { return __uint_as_float(u << 16); }
__device__ __forceinline__ float bfhi(unsigned u) { return __uint_as_float(u & 0xffff0000u); }
__device__ __forceinline__ float sigmoidf_(float x) { return __builtin_amdgcn_rcpf(1.f + __expf(-x)); }
__device__ __forceinline__ float siluf_(float x) { return x * sigmoidf_(x); }
__device__ __forceinline__ f32x4 cv4(const u32x2 u) { return (f32x4){bflo(u.x), bfhi(u.x), bflo(u.y), bfhi(u.y)}; }
__device__ __forceinline__ int fresh_tid() { int t = threadIdx.x; asm volatile("" : "+v"(t)); __builtin_assume(t >= 0 && t < 512); return t; }
__device__ __forceinline__ float wave_sum(float v) {
#pragma unroll
    for (int o = 1; o < 64; o <<= 1) v += __shfl_xor(v, o);
    return v;
}


#define XB_TMO      128
#define XB_XCNT(j)  (256  + 64 * (j))
#define XB_XSUB(j)  (1280 + 64 * (j))
#define XB_XGEN(j)  (2304 + 64 * (j))
#define XB_TOP      3328
#define XB_TOPGEN   3392
#define XCD_BAR_WORDS 3456
#define XB_SPIN_CAP (1u << 18)
__device__ __forceinline__ unsigned xb_ld(unsigned* p)              { return __hip_atomic_load(p, __ATOMIC_RELAXED, __HIP_MEMORY_SCOPE_AGENT); }
__device__ __forceinline__ unsigned xb_add(unsigned* p, unsigned v) { return __hip_atomic_fetch_add(p, v, __ATOMIC_RELAXED, __HIP_MEMORY_SCOPE_AGENT); }
__device__ __forceinline__ unsigned xb_xcc_id() { return (unsigned)__builtin_amdgcn_s_getreg((3 << 11) | 20) & 0xFu; }
#define XB_SPIN(cond, bar) do { unsigned _sp = 0; while (cond) { __builtin_amdgcn_s_sleep(1); \
    if ((++_sp & 255u) == 0u) { if (xb_ld(&(bar)[XB_TMO])) break; if (_sp > XB_SPIN_CAP) { atomicAdd(&(bar)[XB_TMO], 1u); break; } } } } while (0)
struct XcdBarrier { unsigned* bar; unsigned x; volatile LAS unsigned* st; };
__device__ __forceinline__ XcdBarrier xcd_barrier_post(unsigned* bar, volatile LAS unsigned* st) {
    XcdBarrier b; b.bar = bar; b.x = xb_xcc_id(); b.st = st;
    if (threadIdx.x == 0) (void)xb_add(&bar[XB_XCNT(b.x)], 1u);
    return b;
}
__device__ __forceinline__ void xcd_barrier_complete(unsigned* bar, unsigned x, unsigned& nloc, unsigned& nx) {
    const unsigned G = gridDim.x * gridDim.y * gridDim.z;
    unsigned sum, cnt, mine, sp = 0u;
    for (;;) {
        sum = 0u; cnt = 0u; mine = 0u;
#pragma unroll
        for (unsigned j = 0; j < 16; ++j) { const unsigned c = xb_ld(&bar[XB_XCNT(j)]); sum += c; cnt += (c > 0u) ? 1u : 0u; mine = (j == x) ? c : mine; }
        if (sum == G) break;
        __builtin_amdgcn_s_sleep(1);
        if ((++sp & 255u) == 0u) { if (xb_ld(&bar[XB_TMO])) break; if (sp > XB_SPIN_CAP) { atomicAdd(&bar[XB_TMO], 1u); break; } }
    }
    nloc = mine > 0u ? mine : 1u; nx = cnt > 0u ? cnt : 1u;
}
__device__ __forceinline__ void xcd_barrier(const XcdBarrier& b) {
    asm volatile("s_waitcnt vmcnt(0)" ::: "memory");
    __syncthreads();
    if (threadIdx.x == 0) {
        unsigned* bar = b.bar;
        __builtin_amdgcn_s_waitcnt(0);
        unsigned nloc = b.st[0], nx = b.st[1];
        if (nloc == 0u) { xcd_barrier_complete(bar, b.x, nloc, nx); b.st[0] = nloc; b.st[1] = nx; }
        const unsigned old = xb_add(&bar[XB_XSUB(b.x)], 1u);
        const unsigned gen = old / nloc;
        if (old + 1u == (gen + 1u) * nloc) {
            __builtin_amdgcn_fence(__ATOMIC_RELEASE, "agent");
            asm volatile("s_waitcnt vmcnt(0)" ::: "memory");
            const unsigned og = xb_add(&bar[XB_TOP], 1u);
            const unsigned tg = og / nx;
            if (og + 1u == (tg + 1u) * nx) xb_add(&bar[XB_TOPGEN], 1u);
            else XB_SPIN(xb_ld(&bar[XB_TOPGEN]) == tg, bar);
            __builtin_amdgcn_fence(__ATOMIC_ACQUIRE, "agent");
            xb_add(&bar[XB_XGEN(b.x)], 1u);
            asm volatile("s_waitcnt vmcnt(0)" ::: "memory");
        } else {
            XB_SPIN(xb_ld(&bar[XB_XGEN(b.x)]) == gen, bar);
            __builtin_amdgcn_fence(__ATOMIC_ACQUIRE, "agent");
            asm volatile("s_waitcnt vmcnt(0)" ::: "memory");
        }
    }
    __syncthreads();
}

namespace pg8 {
#define PG8_LAS __attribute__((address_space(3)))
constexpr int BM = 256, BK = 64, HALF = 128, HTB = HALF * BK * 2, STAGE_BYTES = 8 * HTB, NXCD = 8, WGM = 8;
__host__ __device__ __forceinline__ int lds_byte(int r, int c) { const int st = (r >> 4) * 2 + (c >> 5), rr = r & 15, cc = c & 31, ob = rr * 64 + cc * 2; return st * 1024 + (ob ^ (((ob >> 9) & 1) << 5)); }
__host__ __device__ __forceinline__ void stage_rc(int b, int& R, int& C) { const int st = b / 1024, sb = b % 1024, swz = sb ^ (((sb >> 9) & 1) << 5); R = (st >> 1) * 16 + swz / 64; C = (st & 1) * 32 + (swz % 64) / 2; }
__host__ __device__ __forceinline__ int perm32(int rho) { const int n = rho >> 4, i = rho & 15; return 8 * (i >> 2) + 4 * n + (i & 3); }
struct Unit { int pm, pn; };
struct Gemm { const bf16_t* A; const bf16_t* Bt; int M, N, K; };
struct StaticOrder {
    int nM, nN, nwg, G, c;
    __host__ __device__ void init(int M, int N, int G_, int c_) { nM = M / BM; nN = N / BM; nwg = nM * nN; G = G_; c = c_; }
    __host__ __device__ bool next(int i, Unit& u) const {
        const long L = (long)i * G + c; if (L >= nwg) return false;
        int wgid = (int)L; { const int q = nwg / NXCD, r = nwg % NXCD, xcd = wgid % NXCD, off = wgid / NXCD; wgid = (xcd < r ? xcd * (q + 1) : r * (q + 1) + (xcd - r) * q) + off; }
        const int nig = WGM * nN, gid = wgid / nig, fm = gid * WGM, gsz = (nM - fm) < WGM ? (nM - fm) : WGM;
        u.pm = fm + ((wgid % nig) % gsz); u.pn = (wgid % nig) / gsz; return true;
    }
    __device__ __forceinline__ void a_ready(const Unit&) const {}
    __device__ __forceinline__ void done(const Unit&) const {}
};

template <class Epi, class Sched, bool ALIGN_EPI = false, bool SP2 = false>
__device__ __forceinline__ void gemm_phase(PG8_LAS unsigned char* lds, const Gemm g, const Sched& S, const Epi& E) {
    const int tid = fresh_tid(), wid = __builtin_amdgcn_readfirstlane(tid >> 6), lane = tid & 63, wr = wid >> 2, wc = wid & 3, fr = lane & 15, fq = lane >> 4;
    const int K = g.K, nt = K / BK;
    unsigned voffA[2], voffB[2];
#pragma unroll
    for (int i = 0; i < 2; ++i) { int R, C; stage_rc(tid * 16 + i * 8192, R, C); const int Rb = Epi::PERM ? ((R & ~31) + perm32(R & 31)) : R;
        voffA[i] = (unsigned)(R * K + C) * 2u; voffB[i] = (unsigned)(Rb * K + C) * 2u; }
    const size_t kstep = (size_t)(BK * 2);
    const size_t hstep = (size_t)HALF * K * 2;
    const size_t tstep = 2 * hstep;
    const unsigned ldsw = (unsigned)wid * 1024u;
    const int aoff = lds_byte(wr * 64 + fr, fq * 8), boff = lds_byte(wc * 32 + fr, fq * 8);
#define PG8_SA(b, h) (((b) * 2 + (h)) * HTB)
#define PG8_SB(b, h) ((4 + (b) * 2 + (h)) * HTB)
#define PG8_STAGE(bufoff, gbase, voff) do { _Pragma("unroll") for (int _i = 0; _i < 2; ++_i) \
        __builtin_amdgcn_global_load_lds((const unsigned*)((const char*)(gbase) + (voff)[_i]), (PG8_LAS unsigned*)(lds + (bufoff) + ldsw + _i * 8192), 16, 0, 0); } while (0)
#define PG8_LDA(dst, b, h) do { _Pragma("unroll") for (int m = 0; m < 4; ++m) _Pragma("unroll") for (int k = 0; k < 2; ++k) dst[m][k] = *(const PG8_LAS bf16x8*)(lds + PG8_SA(b, h) + aoff + m * 2048 + k * 1024); } while (0)
#define PG8_LDB(dst, b, h) do { _Pragma("unroll") for (int n = 0; n < 2; ++n) _Pragma("unroll") for (int k = 0; k < 2; ++k) dst[n][k] = *(const PG8_LAS bf16x8*)(lds + PG8_SB(b, h) + boff + n * 2048 + k * 1024); } while (0)
#define PG8_MMA(ai, bj, At, Bt) do { __builtin_amdgcn_s_setprio(1); _Pragma("unroll") for (int m = 0; m < 4; ++m) _Pragma("unroll") for (int n = 0; n < 2; ++n) _Pragma("unroll") for (int k = 0; k < 2; ++k) \
        acc[ai][bj][m][n] = __builtin_amdgcn_mfma_f32_16x16x32_bf16(Bt[n][k], At[m][k], acc[ai][bj][m][n], 0, 0, 0); __builtin_amdgcn_s_setprio(0); } while (0)
#define PG8_WAIT_V(n) asm volatile("s_waitcnt vmcnt(" #n ")" ::: "memory")
#define PG8_WAIT_L(n) asm volatile("s_waitcnt lgkmcnt(" #n ")" ::: "memory")
#define PG8_BAR __builtin_amdgcn_s_barrier()
#define PG8_SCHED __builtin_amdgcn_sched_barrier(0)
    Unit cur, nxt; int ui = 0;
    if (!S.next(0, cur)) return;
    f32x4 acc[2][2][4][2];
#pragma unroll
    for (int a = 0; a < 2; ++a)
#pragma unroll
        for (int b = 0; b < 2; ++b)
#pragma unroll
            for (int m = 0; m < 4; ++m)
#pragma unroll
                for (int n = 0; n < 2; ++n) acc[a][b][m][n] = (f32x4){0.f, 0.f, 0.f, 0.f};
    bf16x8 At[4][2], B0[2][2], B1[2][2];
    const char* cA = (const char*)g.A + (size_t)cur.pm * tstep; const char* cB = (const char*)g.Bt + (size_t)cur.pn * tstep;
    S.a_ready(cur);
    if constexpr (SP2) {
        PG8_STAGE(PG8_SB(0, 0), cB, voffB); PG8_STAGE(PG8_SB(0, 1), cB + hstep, voffB); PG8_STAGE(PG8_SA(0, 0), cA, voffA); PG8_STAGE(PG8_SA(0, 1), cA + hstep, voffA);
        if (wr == 1) PG8_BAR;
        PG8_WAIT_V(2); PG8_BAR;
        PG8_STAGE(PG8_SB(1, 0), cB + kstep, voffB); PG8_STAGE(PG8_SA(1, 0), cA + kstep, voffA); PG8_STAGE(PG8_SB(1, 1), cB + hstep + kstep, voffB);
        PG8_WAIT_V(6); PG8_BAR;
    } else {
        PG8_STAGE(PG8_SB(0, 0), cB, voffB); PG8_STAGE(PG8_SA(0, 0), cA, voffA); PG8_STAGE(PG8_SB(0, 1), cB + hstep, voffB); PG8_STAGE(PG8_SA(0, 1), cA + hstep, voffA);
        if (wr == 1) PG8_BAR;
        PG8_WAIT_V(4); PG8_BAR;
        PG8_STAGE(PG8_SB(1, 0), cB + kstep, voffB); PG8_STAGE(PG8_SA(1, 0), cA + kstep, voffA); PG8_STAGE(PG8_SB(1, 1), cB + hstep + kstep, voffB);
        PG8_WAIT_V(6); PG8_BAR;
    }
    for (;;) {
        const bool has_next = S.next(ui + 1, nxt);
        const char* nA = has_next ? (const char*)g.A + (size_t)nxt.pm * tstep : cA; const char* nB = has_next ? (const char*)g.Bt + (size_t)nxt.pn * tstep : cB;
        for (int t = 0; t < nt; t += 2) {
            const bool last = (t == nt - 2);
            const char* a1 = cA + (size_t)(t + 1) * kstep;
            const char* a2 = last ? nA : cA + (size_t)(t + 2) * kstep; const char* b2 = last ? nB : cB + (size_t)(t + 2) * kstep;
            const char* a3 = a2 + kstep; const char* b3 = b2 + kstep;
            if (last && has_next) S.a_ready(nxt);
            if constexpr (SP2) {
            PG8_LDB(B0, 0, 0); PG8_LDB(B1, 0, 1); PG8_SCHED; PG8_LDA(At, 0, 0); PG8_STAGE(PG8_SA(1, 1), a1 + hstep, voffA);
            PG8_WAIT_V(8); PG8_WAIT_L(0); PG8_BAR; PG8_MMA(0, 0, At, B0); PG8_MMA(0, 1, At, B1); PG8_BAR; PG8_SCHED;
            PG8_LDA(At, 0, 1); PG8_STAGE(PG8_SB(0, 0), b2, voffB); PG8_STAGE(PG8_SB(0, 1), b2 + hstep, voffB); PG8_STAGE(PG8_SA(0, 0), a2, voffA);
            PG8_WAIT_V(8); PG8_WAIT_L(0); PG8_BAR; PG8_MMA(1, 0, At, B0); PG8_MMA(1, 1, At, B1); PG8_BAR; PG8_SCHED;
            PG8_LDB(B0, 1, 0); PG8_LDB(B1, 1, 1); PG8_SCHED; PG8_LDA(At, 1, 0); PG8_STAGE(PG8_SA(0, 1), a2 + hstep, voffA);
            PG8_WAIT_V(8); PG8_WAIT_L(0); PG8_BAR; PG8_MMA(0, 0, At, B0); PG8_MMA(0, 1, At, B1); PG8_BAR; PG8_SCHED;
            PG8_LDA(At, 1, 1); PG8_STAGE(PG8_SB(1, 0), b3, voffB); PG8_STAGE(PG8_SB(1, 1), b3 + hstep, voffB); PG8_STAGE(PG8_SA(1, 0), a3, voffA);
            PG8_WAIT_V(8); PG8_WAIT_L(0); PG8_BAR; PG8_MMA(1, 0, At, B0); PG8_MMA(1, 1, At, B1); PG8_BAR; PG8_SCHED;
            } else {
            PG8_LDB(B0, 0, 0); PG8_SCHED; PG8_LDA(At, 0, 0); PG8_STAGE(PG8_SA(1, 1), a1 + hstep, voffA);
            PG8_WAIT_L(8); PG8_BAR; PG8_WAIT_L(0); PG8_MMA(0, 0, At, B0); PG8_BAR; PG8_SCHED;
            PG8_LDB(B1, 0, 1); PG8_STAGE(PG8_SB(0, 0), b2, voffB);
            PG8_BAR; PG8_WAIT_L(0); PG8_MMA(0, 1, At, B1); PG8_BAR;
            PG8_LDA(At, 0, 1); PG8_STAGE(PG8_SA(0, 0), a2, voffA);
            PG8_BAR; PG8_WAIT_L(0); PG8_MMA(1, 0, At, B0); PG8_BAR; PG8_SCHED;
            PG8_STAGE(PG8_SB(0, 1), b2 + hstep, voffB);
            PG8_WAIT_V(6); PG8_BAR; PG8_MMA(1, 1, At, B1); PG8_BAR;
            PG8_LDB(B0, 1, 0); PG8_SCHED; PG8_LDA(At, 1, 0); PG8_STAGE(PG8_SA(0, 1), a2 + hstep, voffA);
            PG8_WAIT_L(8); PG8_BAR; PG8_WAIT_L(0); PG8_MMA(0, 0, At, B0); PG8_BAR; PG8_SCHED;
            PG8_LDB(B1, 1, 1); PG8_STAGE(PG8_SB(1, 0), b3, voffB);
            PG8_BAR; PG8_WAIT_L(0); PG8_MMA(0, 1, At, B1); PG8_BAR;
            PG8_LDA(At, 1, 1); PG8_STAGE(PG8_SA(1, 0), a3, voffA);
            PG8_BAR; PG8_WAIT_L(0); PG8_MMA(1, 0, At, B0); PG8_BAR; PG8_SCHED;
            PG8_STAGE(PG8_SB(1, 1), b3 + hstep, voffB);
            PG8_WAIT_V(6); PG8_BAR; PG8_MMA(1, 1, At, B1); PG8_BAR;
            }
        }
        if constexpr (ALIGN_EPI) { if (wr == 0) PG8_BAR; }
        E(acc, cur, wr, wc, fr, fq);
        if (!has_next) break;
#pragma unroll
        for (int a = 0; a < 2; ++a)
#pragma unroll
            for (int b = 0; b < 2; ++b)
#pragma unroll
                for (int m = 0; m < 4; ++m)
#pragma unroll
                    for (int n = 0; n < 2; ++n) acc[a][b][m][n] = (f32x4){0.f, 0.f, 0.f, 0.f};
        cur = nxt; cA = nA; cB = nB; ++ui;
        if constexpr (ALIGN_EPI) { if (wr == 1) PG8_BAR; }
    }
    PG8_WAIT_V(0);
    if constexpr (!ALIGN_EPI) { if (wr == 0) PG8_BAR; }
    PG8_BAR;
#undef PG8_SA
#undef PG8_SB
#undef PG8_STAGE
#undef PG8_LDA
#undef PG8_LDB
#undef PG8_MMA
#undef PG8_WAIT_V
#undef PG8_WAIT_L
#undef PG8_BAR
#undef PG8_SCHED
}
}
using pg8::Unit;
typedef f32x4 AccT[2][2][4][2];

struct EpiF32Bias {
    static constexpr bool PERM = false;
    float* C; int ldc; const float* bias;
    __device__ __forceinline__ void operator()(const AccT& acc, const Unit& u, int wr, int wc, int fr, int fq) const {
        const int row0 = u.pm * 256 + wr * 64 + fr, col0 = u.pn * 256 + wc * 32 + 4 * fq;
#pragma unroll
        for (int ai = 0; ai < 2; ++ai)
#pragma unroll
            for (int m = 0; m < 4; ++m) { float* rowp = C + (size_t)(row0 + ai * 128 + m * 16) * ldc + col0;
#pragma unroll
                for (int bj = 0; bj < 2; ++bj)
#pragma unroll
                    for (int n = 0; n < 2; ++n) *(f32x4*)(rowp + bj * 128 + n * 16) = acc[ai][bj][m][n] + *(const f32x4*)(bias + col0 + bj * 128 + n * 16); }
    }
};
__device__ __forceinline__ u32x4 pack8(f32x4 v0, f32x4 v1) { u32x4 w; w.x = cvt_pk_bf16(v0[0], v0[1]); w.y = cvt_pk_bf16(v0[2], v0[3]); w.z = cvt_pk_bf16(v1[0], v1[1]); w.w = cvt_pk_bf16(v1[2], v1[3]); return w; }
struct EpiIn {
    static constexpr bool PERM = true;
    bf16_t *BG, *CI, *Z, *XBC, *GA, *GB; float* DT;
    __device__ __forceinline__ void operator()(const AccT& acc, const Unit& u, int wr, int wc, int fr, int fq) const {
        const int pn = u.pn, row0 = u.pm * 256 + wr * 64 + fr, cin = wc * 32 + 8 * fq;
        if (pn >= 4 && pn < 12) {
            const int col = (pn - 4) * 128 + cin;
#pragma unroll
            for (int ai = 0; ai < 2; ++ai)
#pragma unroll
                for (int m = 0; m < 4; ++m) { const size_t row = row0 + ai * 128 + m * 16;
                    *(u32x4*)(CI + row * 1024 + col) = pack8(acc[ai][0][m][0] * acc[ai][1][m][0], acc[ai][0][m][1] * acc[ai][1][m][1]); }
        } else if (pn == 40) {
            if (wc == 0) {
#pragma unroll
                for (int ai = 0; ai < 2; ++ai)
#pragma unroll
                    for (int m = 0; m < 4; ++m) { const size_t row = row0 + ai * 128 + m * 16;
                        *(f32x4*)(DT + row * 32 + 8 * fq) = acc[ai][0][m][0]; *(f32x4*)(DT + row * 32 + 8 * fq + 4) = acc[ai][0][m][1]; }
            }
        } else {
            bf16_t* O; int ldc, colt;
            if (pn < 4) { O = BG; ldc = 1024; colt = pn * 256; }
            else if (pn < 20) { O = Z; ldc = 2048; colt = (pn - 12) * 256; }
            else if (pn < 32) { O = XBC; ldc = 3072; colt = (pn - 20) * 256; }
            else if (pn < 36) { O = GA; ldc = 1024; colt = (pn - 32) * 256; }
            else { O = GB; ldc = 1024; colt = (pn - 36) * 256; }
#pragma unroll
            for (int ai = 0; ai < 2; ++ai)
#pragma unroll
                for (int m = 0; m < 4; ++m) { bf16_t* rowp = O + (size_t)(row0 + ai * 128 + m * 16) * ldc + colt + cin;
#pragma unroll
                    for (int bj = 0; bj < 2; ++bj) *(u32x4*)(rowp + bj * 128) = pack8(acc[ai][bj][m][0], acc[ai][bj][m][1]); }
        }
    }
};
template <int MODE> struct EpiGate {
    static constexpr bool PERM = true;
    bf16_t* O; const bf16_t* G; const bf16_t* Y; int ldc;
    __device__ __forceinline__ void operator()(const AccT& acc, const Unit& u, int wr, int wc, int fr, int fq) const {
        const int row0 = u.pm * 256 + wr * 64 + fr, col0 = u.pn * 256 + wc * 32 + 8 * fq;
#pragma unroll
        for (int ai = 0; ai < 2; ++ai)
#pragma unroll
            for (int m = 0; m < 4; ++m) { const size_t off = (size_t)(row0 + ai * 128 + m * 16) * ldc + col0;
#pragma unroll
                for (int bj = 0; bj < 2; ++bj) { f32x4 v0 = acc[ai][bj][m][0], v1 = acc[ai][bj][m][1];
                    if (MODE == 2) {
#pragma unroll
                        for (int j = 0; j < 4; ++j) { float a = fmaxf(v0[j], 0.f), b = fmaxf(v1[j], 0.f); v0[j] = a * a; v1[j] = b * b; }
                    } else {
                        const u32x4 gv = *(const u32x4*)(G + off + bj * 128);
                        v0[0] *= sigmoidf_(bflo(gv.x)); v0[1] *= sigmoidf_(bfhi(gv.x)); v0[2] *= sigmoidf_(bflo(gv.y)); v0[3] *= sigmoidf_(bfhi(gv.y));
                        v1[0] *= sigmoidf_(bflo(gv.z)); v1[1] *= sigmoidf_(bfhi(gv.z)); v1[2] *= sigmoidf_(bflo(gv.w)); v1[3] *= sigmoidf_(bfhi(gv.w));
                        if (MODE == 1) { const u32x4 yv = *(const u32x4*)(Y + off + bj * 128);
                            v0[0] += bflo(yv.x); v0[1] += bfhi(yv.x); v0[2] += bflo(yv.y); v0[3] += bfhi(yv.y);
                            v1[0] += bflo(yv.z); v1[1] += bfhi(yv.z); v1[2] += bflo(yv.w); v1[3] += bfhi(yv.w); }
                    }
                    *(u32x4*)(O + off + bj * 128) = pack8(v0, v1); } }
    }
};
struct EpiRes {
    static constexpr bool PERM = false;
    float* X1; const float* xp; const float* xs; const float* gate;
    __device__ __forceinline__ void operator()(const AccT& acc, const Unit& u, int wr, int wc, int fr, int fq) const {
        const int row0 = u.pm * 256 + wr * 64 + fr, col0 = u.pn * 256 + wc * 32 + 4 * fq;
#pragma unroll
        for (int ai = 0; ai < 2; ++ai)
#pragma unroll
            for (int m = 0; m < 4; ++m) { const int row = row0 + ai * 128 + m * 16;
                if (row < MTOT) {
                    const int seq = row < MP ? (row >> 11) : (NBP + row - MP);
                    const float* src = xp ? (row < MP ? xp + (size_t)row * D : xs + (size_t)(row - MP) * D) : X1 + (size_t)row * D;
                    const float* gr = gate + (size_t)seq * 6144;
#pragma unroll
                    for (int bj = 0; bj < 2; ++bj)
#pragma unroll
                        for (int n = 0; n < 2; ++n) { const int c = col0 + bj * 128 + n * 16;
                            *(f32x4*)(X1 + (size_t)row * D + c) = *(const f32x4*)(src + c) + *(const f32x4*)(gr + c) * acc[ai][bj][m][n]; }
                } }
    }
};


template <int KS, class Epi>
__device__ __forceinline__ void skinny_gemm(LAS unsigned char* lds, const bf16_t* A, const bf16_t* Bt, int N, int K, const Epi& E) {
    constexpr int RT = 8 / KS;
    const int tid = fresh_tid(), lane = tid & 63, w = __builtin_amdgcn_readfirstlane(tid >> 6), fr = lane & 15, fq = lane >> 4;
    const int nitems = (N / 16) * KS, klen = K / KS;
    LAS f32x4* red = (LAS f32x4*)lds;
    for (int it = blockIdx.x; it < nitems; it += gridDim.x) {
        const int ct = it / KS, rg = it % KS, rt = rg * RT + (w % RT), kq = w / RT;
        const bf16_t* ap = A + (size_t)(16 * rt + fr) * K + kq * klen + fq * 8;
        const bf16_t* bp = Bt + (size_t)(16 * ct + fr) * K + kq * klen + fq * 8;
        f32x4 acc0 = (f32x4){0.f, 0.f, 0.f, 0.f}, acc1 = acc0;
        for (int k = 0; k < klen; k += 256) {
            bf16x8 a[8], b[8];
#pragma unroll
            for (int j = 0; j < 8; ++j) { a[j] = *(const bf16x8*)(ap + k + 32 * j); b[j] = *(const bf16x8*)(bp + k + 32 * j); }
#pragma unroll
            for (int j = 0; j < 8; j += 2) { acc0 = __builtin_amdgcn_mfma_f32_16x16x32_bf16(b[j], a[j], acc0, 0, 0, 0); acc1 = __builtin_amdgcn_mfma_f32_16x16x32_bf16(b[j + 1], a[j + 1], acc1, 0, 0, 0); }
        }
        f32x4 acc = acc0 + acc1;
        if (KS > 1) {
            if (kq > 0) red[w * 64 + lane] = acc;
            __syncthreads();
            if (kq == 0) {
#pragma unroll
                for (int q = 1; q < KS; ++q) acc = acc + red[(w + q * RT) * 64 + lane];
                E(16 * rt + fr, 16 * ct + 4 * fq, acc);
            }
            __syncthreads();
        } else E(16 * rt + fr, 16 * ct + 4 * fq, acc);
    }
}
__device__ __forceinline__ u32x2 pack4(const f32x4 v) { u32x2 o; o.x = cvt_pk_bf16(v[0], v[1]); o.y = cvt_pk_bf16(v[2], v[3]); return o; }
template <int MODE> struct SkGate {
    bf16_t* O; const bf16_t* G; const bf16_t* Y; int ldc;
    __device__ __forceinline__ void operator()(int r, int c, f32x4 v) const {
        const size_t off = (size_t)(MP + r) * ldc + c;
        if (MODE == 2) {
#pragma unroll
            for (int j = 0; j < 4; ++j) { const float a = fmaxf(v[j], 0.f); v[j] = a * a; }
        } else {
            const f32x4 g = cv4(*(const u32x2*)(G + off));
#pragma unroll
            for (int j = 0; j < 4; ++j) v[j] *= sigmoidf_(g[j]);
            if (MODE == 1) v = v + cv4(*(const u32x2*)(Y + off));
        }
        *(u32x2*)(O + off) = pack4(v);
    }
};
struct SkRes {
    float* X1; const float* xs; const float* gate;
    __device__ __forceinline__ void operator()(int r, int c, f32x4 v) const {
        float* o = X1 + (size_t)(MP + r) * D + c;
        const f32x4 src = xs ? *(const f32x4*)(xs + (size_t)r * D + c) : *(const f32x4*)o;
        *(f32x4*)o = src + *(const f32x4*)(gate + (size_t)(NBP + r) * 6144 + c) * v;
    }
};

__device__ __forceinline__ int win_dest(int n) {
    if (n < 1024) return n;
    if (n < 2048) { const int j = n - 1024; return 1024 + (j >> 7) * 256 + (j & 127); }
    if (n < 3072) { const int j = n - 2048; return 1024 + (j >> 7) * 256 + 128 + (j & 127); }
    if (n < 8192) return n;
    if (n < 8224) return 10240 + (n - 8192);
    return n - 32;
}
__device__ __forceinline__ void transpose_tile(const float* W, int K, int N, bf16_t* WT, int kt, int ntile, bool remap, const float* kscale, LAS float* scr) {
    const int tid = threadIdx.x, k0 = kt * 64, n0 = ntile * 64, nl = tid & 63, ks = tid >> 6, n = n0 + nl;
#pragma unroll
    for (int i = 0; i < 8; ++i) { const int k = ks + 8 * i; float v = (n < N) ? W[(size_t)(k0 + k) * N + n] : 0.f; if (kscale) v *= kscale[k0 + k]; scr[nl * 65 + k] = v; }
    __syncthreads();
    const int nr = tid >> 3, kc = (tid & 7) * 8, ns = n0 + nr;
    if (ns < N) {
        const int dr = remap ? win_dest(ns) : ns;
        const LAS float* s = scr + nr * 65 + kc;
        u32x4 o; o.x = cvt_pk_bf16(s[0], s[1]); o.y = cvt_pk_bf16(s[2], s[3]); o.z = cvt_pk_bf16(s[4], s[5]); o.w = cvt_pk_bf16(s[6], s[7]);
        *(u32x4*)(WT + (size_t)dr * K + k0 + kc) = o;
    }
    __syncthreads();
}
__device__ __forceinline__ void phase0(const Params& p, LAS unsigned char* lds, int part) {
    LAS float* scr = (LAS float*)lds;
    unsigned char* ws = p.ws;
    constexpr int T_ADA = 16 * 96, T_IN = 16 * 161, T_AO = 16 * 16, T_BO = 32 * 16, T_O = 16 * 16, T_1 = 16 * 64, T_2 = 64 * 16;
    constexpr int TOT = T_ADA + T_IN + T_AO + T_BO + T_O + T_1 + T_2;
    constexpr int NMOD = 24;
    if (part == 0) {
        for (int it = blockIdx.x; it < T_ADA; it += gridDim.x) transpose_tile(p.in[I_WADA], 1024, 6144, (bf16_t*)(ws + OFF_WADA), it / 96, it % 96, false, nullptr, scr);
        bf16_t* cA = (bf16_t*)(ws + OFF_CA);
        for (int i = blockIdx.x * 512 + threadIdx.x; i < (NBP + NBS) * D; i += gridDim.x * 512) {
            const int row = i >> 10, k = i & 1023;
            const float v = row < NBP ? p.in[I_CP][row * D + k] : p.in[I_CS][(row - NBP) * D + k];
            cA[i] = f2bf(siluf_(v));
        }
        return;
    }
    for (int it = T_ADA + (int)blockIdx.x - NMOD; it < TOT; it += (int)gridDim.x - NMOD) {
        int r = it - T_ADA;
        if (r < T_IN) { transpose_tile(p.in[I_WIN], 1024, DIN, (bf16_t*)(ws + OFF_WIN), r / 161, r % 161, true, nullptr, scr); continue; } r -= T_IN;
        if (r < T_AO) { transpose_tile(p.in[I_WAOUT], 1024, 1024, (bf16_t*)(ws + OFF_WAOUT), r / 16, r % 16, false, nullptr, scr); continue; } r -= T_AO;
        if (r < T_BO) { transpose_tile(p.in[I_WBOUT], 2048, 1024, (bf16_t*)(ws + OFF_WBOUT), r / 16, r % 16, false, p.in[I_SNG], scr); continue; } r -= T_BO;
        if (r < T_O) { transpose_tile(p.in[I_WO], 1024, 1024, (bf16_t*)(ws + OFF_WO), r / 16, r % 16, false, nullptr, scr); continue; } r -= T_O;
        if (r < T_1) { transpose_tile(p.in[I_W1], 1024, 4096, (bf16_t*)(ws + OFF_W1), r / 64, r % 64, false, nullptr, scr); continue; } r -= T_1;
        transpose_tile(p.in[I_W2], 4096, 1024, (bf16_t*)(ws + OFF_W2), r / 16, r % 16, false, nullptr, scr);
    }
}

__device__ __forceinline__ void rownorm_mod(const float* xrow, const float* g, const float* sc, const float* sh, bf16_t* orow, int lane) {
    f32x4 v[4]; float s = 0.f;
#pragma unroll
    for (int j = 0; j < 4; ++j) { v[j] = ((const f32x4*)xrow)[lane + 64 * j]; s += (v[j][0] * v[j][0] + v[j][1] * v[j][1]) + (v[j][2] * v[j][2] + v[j][3] * v[j][3]); }
    const float rstd = rsqrtf(wave_sum(s) * (1.f / D) + EPS);
#pragma unroll
    for (int j = 0; j < 4; ++j) { const int i4 = lane + 64 * j;
        const f32x4 gg = ((const f32x4*)g)[i4], scv = ((const f32x4*)sc)[i4], shv = ((const f32x4*)sh)[i4];
        const f32x4 o = v[j] * rstd * gg * (scv + 1.f) + shv;
        u32x2 w; w.x = cvt_pk_bf16(o[0], o[1]); w.y = cvt_pk_bf16(o[2], o[3]);
        ((u32x2*)orow)[i4] = w; }
}
__device__ __forceinline__ void phase_rownorm(const Params& p, const float* xp, const float* xs, const float* gvec, int sc_off, int sh_off, bf16_t* U) {
    const int tid_ = fresh_tid(), lane = tid_ & 63, gw = blockIdx.x * 8 + (tid_ >> 6), NW = gridDim.x * 8;
    const float* mod = (const float*)(p.ws + OFF_MOD);
    for (int row = gw; row < MTOT; row += NW) {
        const int seq = row < MP ? (row >> 11) : (NBP + row - MP);
        const float* xrow = row < MP ? xp + (size_t)row * D : xs + (size_t)(row - MP) * D;
        rownorm_mod(xrow, gvec, mod + (size_t)seq * 6144 + sc_off, mod + (size_t)seq * 6144 + sh_off, U + (size_t)row * D, lane);
    }
}
__device__ __forceinline__ void phase_final(const Params& p) {
    const int tid_ = fresh_tid(), lane = tid_ & 63, gw = blockIdx.x * 8 + (tid_ >> 6), NW = gridDim.x * 8;
    const float* X = (const float*)(p.ws + OFF_X1); const float* g = p.in[I_NFG];
    for (int row = gw; row < MTOT; row += NW) {
        const float* xrow = X + (size_t)row * D;
        float* orow = row < MP ? p.out + O_YP + (size_t)row * D : p.out + O_YS + (size_t)(row - MP) * D;
        f32x4 v[4]; float s = 0.f;
#pragma unroll
        for (int j = 0; j < 4; ++j) { v[j] = ((const f32x4*)xrow)[lane + 64 * j]; s += (v[j][0] * v[j][0] + v[j][1] * v[j][1]) + (v[j][2] * v[j][2] + v[j][3] * v[j][3]); }
        const float rstd = rsqrtf(wave_sum(s) * (1.f / D) + EPS);
#pragma unroll
        for (int j = 0; j < 4; ++j) ((f32x4*)orow)[lane + 64 * j] = v[j] * rstd * ((const f32x4*)g)[lane + 64 * j];
    }
}

struct F8 { f32x4 a, b; };
__device__ __forceinline__ F8 ld8bf(const bf16_t* p) { const u32x4 u = *(const u32x4*)p; F8 r; r.a = (f32x4){bflo(u.x), bfhi(u.x), bflo(u.y), bfhi(u.y)}; r.b = (f32x4){bflo(u.z), bfhi(u.z), bflo(u.w), bfhi(u.w)}; return r; }
__device__ __forceinline__ F8 cv8(const u32x4 u) { F8 r; r.a = (f32x4){bflo(u.x), bfhi(u.x), bflo(u.y), bfhi(u.y)}; r.b = (f32x4){bflo(u.z), bfhi(u.z), bflo(u.w), bfhi(u.w)}; return r; }
__device__ __forceinline__ F8 ld8f(const float* p) { F8 r; r.a = *(const f32x4*)p; r.b = *(const f32x4*)(p + 4); return r; }
__device__ __forceinline__ void st8f(float* p, const F8& v) { *(f32x4*)p = v.a; *(f32x4*)(p + 4) = v.b; }
__device__ __forceinline__ F8 zero8() { F8 r; r.a = (f32x4){0.f, 0.f, 0.f, 0.f}; r.b = r.a; return r; }
__device__ __forceinline__ void phase_conv(const Params& p, LAS unsigned char* lds) {
    unsigned char* ws = p.ws;
    const bf16_t* BG = (const bf16_t*)(ws + OFF_BG); const bf16_t* CI = (const bf16_t*)(ws + OFF_CI); const bf16_t* XBC = (const bf16_t*)(ws + OFF_XBC);
    bf16_t* VA = (bf16_t*)(ws + OFF_VA); bf16_t* XC = (bf16_t*)(ws + OFF_XBCC);
    const int tid = threadIdx.x;
    for (int it = blockIdx.x; it < MP / 8 + NBS; it += gridDim.x) {
        if (it < MP / 8) {
            const int r0 = it * 8, tpos0 = r0 & (SEQ - 1), b = r0 >> 11;
            if (tid < 128) {
                const int ch = tid * 8;
                u32x4 raw[10], bgr[8];
#pragma unroll
                for (int i = 0; i < 10; ++i) raw[i] = (tpos0 - 2 + i >= 0) ? *(const u32x4*)(CI + (size_t)(r0 - 2 + i) * 1024 + ch) : (u32x4){0u, 0u, 0u, 0u};
#pragma unroll
                for (int i = 0; i < 8; ++i) bgr[i] = *(const u32x4*)(BG + (size_t)(r0 + i) * 1024 + ch);
                const F8 w0 = ld8f(p.in[I_CAW] + ch), w1 = ld8f(p.in[I_CAW] + 1024 + ch), w2 = ld8f(p.in[I_CAW] + 2048 + ch);
#pragma unroll
                for (int i = 0; i < 8; ++i) { const F8 p2 = cv8(raw[i]), p1 = cv8(raw[i + 1]), c0 = cv8(raw[i + 2]), bg = cv8(bgr[i]);
                    const f32x4 va = bg.a * (w0.a * p2.a + w1.a * p1.a + w2.a * c0.a), vb = bg.b * (w0.b * p2.b + w1.b * p1.b + w2.b * c0.b);
                    *(u32x4*)(VA + (size_t)(r0 + i) * 1024 + ch) = pack8(va, vb);
                    if (tpos0 + i >= SEQ - 2) st8f(p.out + O_SCP + ((size_t)b * 2 + (tpos0 + i - (SEQ - 2))) * 1024 + ch, c0); }
            } else {
                const int ch = (tid - 128) * 8;
                u32x4 raw[11];
#pragma unroll
                for (int i = 0; i < 11; ++i) raw[i] = (tpos0 - 3 + i >= 0) ? *(const u32x4*)(XBC + (size_t)(r0 - 3 + i) * 3072 + ch) : (u32x4){0u, 0u, 0u, 0u};
                const F8 w0 = ld8f(p.in[I_CBW] + ch), w1 = ld8f(p.in[I_CBW] + 3072 + ch), w2 = ld8f(p.in[I_CBW] + 6144 + ch), w3 = ld8f(p.in[I_CBW] + 9216 + ch), bb = ld8f(p.in[I_CBB] + ch);
#pragma unroll
                for (int i = 0; i < 8; ++i) { const F8 p3 = cv8(raw[i]), p2 = cv8(raw[i + 1]), p1 = cv8(raw[i + 2]), c0 = cv8(raw[i + 3]);
                    f32x4 va = w0.a * p3.a + w1.a * p2.a + w2.a * p1.a + w3.a * c0.a + bb.a, vb = w0.b * p3.b + w1.b * p2.b + w2.b * p1.b + w3.b * c0.b + bb.b;
#pragma unroll
                    for (int j = 0; j < 4; ++j) { va[j] = siluf_(va[j]); vb[j] = siluf_(vb[j]); }
                    *(u32x4*)(XC + (size_t)(r0 + i) * 3072 + ch) = pack8(va, vb);
                    if (tpos0 + i >= SEQ - 3) st8f(p.out + O_SBP + ((size_t)b * 3 + (tpos0 + i - (SEQ - 3))) * 3072 + ch, c0); }
            }
        } else {
            const int b = it - MP / 8, row = MP + b;
            if (tid < 128) {
                const int ch = tid * 8;
                const F8 c0 = ld8bf(CI + (size_t)row * 1024 + ch);
                const F8 p2 = ld8f(p.in[I_STA] + ((size_t)b * 2 + 0) * 1024 + ch), p1 = ld8f(p.in[I_STA] + ((size_t)b * 2 + 1) * 1024 + ch);
                const F8 w0 = ld8f(p.in[I_CAW] + ch), w1 = ld8f(p.in[I_CAW] + 1024 + ch), w2 = ld8f(p.in[I_CAW] + 2048 + ch);
                const F8 bg = ld8bf(BG + (size_t)row * 1024 + ch);
                const f32x4 va = bg.a * (w0.a * p2.a + w1.a * p1.a + w2.a * c0.a), vb = bg.b * (w0.b * p2.b + w1.b * p1.b + w2.b * c0.b);
                *(u32x4*)(VA + (size_t)row * 1024 + ch) = pack8(va, vb);
                st8f(p.out + O_SCS + ((size_t)b * 2 + 0) * 1024 + ch, p1); st8f(p.out + O_SCS + ((size_t)b * 2 + 1) * 1024 + ch, c0);
            } else {
                const int ch = (tid - 128) * 8;
                const F8 c0 = ld8bf(XBC + (size_t)row * 3072 + ch);
                const F8 p3 = ld8f(p.in[I_STB] + ((size_t)b * 3 + 0) * 3072 + ch), p2 = ld8f(p.in[I_STB] + ((size_t)b * 3 + 1) * 3072 + ch), p1 = ld8f(p.in[I_STB] + ((size_t)b * 3 + 2) * 3072 + ch);
                const F8 w0 = ld8f(p.in[I_CBW] + ch), w1 = ld8f(p.in[I_CBW] + 3072 + ch), w2 = ld8f(p.in[I_CBW] + 6144 + ch), w3 = ld8f(p.in[I_CBW] + 9216 + ch), bb = ld8f(p.in[I_CBB] + ch);
                f32x4 va = w0.a * p3.a + w1.a * p2.a + w2.a * p1.a + w3.a * c0.a + bb.a, vb = w0.b * p3.b + w1.b * p2.b + w2.b * p1.b + w3.b * c0.b + bb.b;
#pragma unroll
                for (int j = 0; j < 4; ++j) { va[j] = siluf_(va[j]); vb[j] = siluf_(vb[j]); }
                *(u32x4*)(XC + (size_t)row * 3072 + ch) = pack8(va, vb);
                st8f(p.out + O_SBS + ((size_t)b * 3 + 0) * 3072 + ch, p2); st8f(p.out + O_SBS + ((size_t)b * 3 + 1) * 3072 + ch, p1); st8f(p.out + O_SBS + ((size_t)b * 3 + 2) * 3072 + ch, c0);
            }
        }
    }
    const float* DTR = (const float*)(ws + OFF_DTRAW); float* DTP = (float*)(ws + OFF_DTP); float* ACS = (float*)(ws + OFF_ACS);
    LAS float* t1 = (LAS float*)lds; LAS float* t2 = t1 + 128 * 33;
    for (int it = blockIdx.x; it < 129; it += gridDim.x) {
        const int t0 = it * 128;
#pragma unroll
        for (int i = 0; i < 8; ++i) { const int idx = tid + 512 * i, r = idx >> 5, hh = idx & 31;
            const float raw = DTR[(size_t)(t0 + r) * 32 + hh] + p.in[I_DTB][hh];
            t1[r * 33 + hh] = raw > 20.f ? raw : log1pf(expf(raw)); }
        __syncthreads();
        if (tid < 32) { const float a = -expf(p.in[I_ALOG][tid]); float run = 0.f;
            for (int s = 0; s < 128; ++s) { run += t1[s * 33 + tid] * a; t2[s * 33 + tid] = run; } }
        __syncthreads();
#pragma unroll
        for (int i = 0; i < 8; ++i) { const int idx = tid + 512 * i, r = idx >> 5, hh = idx & 31;
            DTP[(size_t)(t0 + r) * 32 + hh] = t1[r * 33 + hh]; ACS[(size_t)(t0 + r) * 32 + hh] = t2[r * 33 + hh]; }
        __syncthreads();
    }
}

constexpr int RS = 272, RX = 144;
constexpr int L_C = 0, L_B = 34816, L_X = 69632, L_XW = 88064, L_H = 106496, L_ACS = 123904, L_DT = 124416;
__device__ __forceinline__ bf16x8 tr_frag(LAS unsigned char* base, int rstride, int k0, int c0, int lane) {
    const int i = lane & 15, g = lane >> 4, q = i >> 2, pp = i & 3;
    LAS unsigned char* a = base + (k0 + 8 * g + q) * rstride + (c0 + 4 * pp) * 2;
    const bf16x4 lo = __builtin_amdgcn_ds_read_tr16_b64_v4i16((LAS bf16x4*)a);
    const bf16x4 hi = __builtin_amdgcn_ds_read_tr16_b64_v4i16((LAS bf16x4*)(a + 4 * rstride));
    return (bf16x8){lo[0], lo[1], lo[2], lo[3], hi[0], hi[1], hi[2], hi[3]};
}
constexpr int L_RED = 124928, L_CF = 125056;
__device__ __forceinline__ void ssd_unit(const Params& p, LAS unsigned char* lds, int b, int h, int sbase) {
    unsigned char* ws = p.ws;
    const bf16_t* XC = (const bf16_t*)(ws + OFF_XBCC); const bf16_t* Z = (const bf16_t*)(ws + OFF_Z);
    const float* DTP = (const float*)(ws + OFF_DTP); const float* ACS = (const float*)(ws + OFF_ACS);
    bf16_t* YG = (bf16_t*)(ws + OFF_YG); float* SSQ = (float*)(ws + OFF_SSQ);
    const int tid = fresh_tid(), lane = tid & 63, w = __builtin_amdgcn_readfirstlane(tid >> 6), fr = lane & 15, fq = lane >> 4, g = h >> 3;
    const float Dh = p.in[I_DSKIP][h];
    LAS float* sAcs = (LAS float*)(lds + L_ACS); LAS float* sDt = (LAS float*)(lds + L_DT); LAS float* red = (LAS float*)(lds + L_RED);
    f32x4 hacc[4];
#pragma unroll
    for (int i = 0; i < 4; ++i) hacc[i] = (f32x4){0.f, 0.f, 0.f, 0.f};
    const int hpt = w & 3, hnb = (w >> 2) * 4;
    const int n4 = tid & 31, pr = tid >> 5;
    u32x4 rc[4], rb[4], rx[2]; float wv[2], my_acs = 0.f, my_dt = 0.f, acs_last_n;
#define SSD_PREFETCH(cc) do { const int _t0 = b * SEQ + (cc) * 128; \
        { const int ch = tid & 15, row = tid >> 4; _Pragma("unroll") for (int i = 0; i < 4; ++i) { const bf16_t* src = XC + (size_t)(_t0 + row + 32 * i) * 3072; rb[i] = *(const u32x4*)(src + 2048 + g * 128 + ch * 8); rc[i] = *(const u32x4*)(src + 2560 + g * 128 + ch * 8); } } \
        acs_last_n = ACS[(size_t)(_t0 + 127) * 32 + h]; \
        { const int ch = tid & 7, row = tid >> 3; _Pragma("unroll") for (int i = 0; i < 2; ++i) { const int r = _t0 + row + 64 * i; rx[i] = *(const u32x4*)(XC + (size_t)r * 3072 + h * 64 + ch * 8); \
              wv[i] = __expf(acs_last_n - ACS[(size_t)r * 32 + h]) * DTP[(size_t)r * 32 + h]; } } \
        if (tid < 128) { my_acs = ACS[(size_t)(_t0 + tid) * 32 + h]; my_dt = DTP[(size_t)(_t0 + tid) * 32 + h]; } } while (0)
    SSD_PREFETCH(0);
    int prev_sr = -1, prev_sh = 0;
    for (int c = 0; c < SEQ / 128; ++c) {
        const int t0 = b * SEQ + c * 128;
        __syncthreads();
        if (tid == 0 && prev_sr >= 0) { float v = 0.f;
#pragma unroll
            for (int i = 0; i < 16; ++i) v += red[i];
            SSQ[(size_t)prev_sr * 32 + prev_sh] = v; }
#pragma unroll
        for (int i = 0; i < 4; ++i) { u32x2 o; o.x = cvt_pk_bf16(hacc[i][0], hacc[i][1]); o.y = cvt_pk_bf16(hacc[i][2], hacc[i][3]);
            *(LAS u32x2*)(lds + L_H + (16 * hpt + fr) * RS + (16 * (hnb + i) + 4 * fq) * 2) = o; }
        { const int ch = tid & 15, row = tid >> 4;
#pragma unroll
          for (int i = 0; i < 4; ++i) { *(LAS u32x4*)(lds + L_B + (row + 32 * i) * RS + ch * 16) = rb[i]; *(LAS u32x4*)(lds + L_C + (row + 32 * i) * RS + ch * 16) = rc[i]; } }
        { const int ch = tid & 7, row = tid >> 3;
#pragma unroll
          for (int i = 0; i < 2; ++i) { *(LAS u32x4*)(lds + L_X + (row + 64 * i) * RX + ch * 16) = rx[i];
              const float s = wv[i]; u32x4 o;
              o.x = cvt_pk_bf16(bflo(rx[i].x) * s, bfhi(rx[i].x) * s); o.y = cvt_pk_bf16(bflo(rx[i].y) * s, bfhi(rx[i].y) * s);
              o.z = cvt_pk_bf16(bflo(rx[i].z) * s, bfhi(rx[i].z) * s); o.w = cvt_pk_bf16(bflo(rx[i].w) * s, bfhi(rx[i].w) * s);
              *(LAS u32x4*)(lds + L_XW + (row + 64 * i) * RX + ch * 16) = o; } }
        if (tid < 128) { sAcs[tid] = my_acs; sDt[tid] = my_dt; }
        const float acs_last = acs_last_n;
        __syncthreads();
        const int qt = w < 4 ? w : 11 - w, qrow = 16 * qt + fr;
        const size_t trow = (size_t)(t0 + qrow);
        u32x2 zv[4];
#pragma unroll
        for (int pt = 0; pt < 4; ++pt) zv[pt] = *(const u32x2*)(Z + trow * 2048 + h * 64 + 16 * pt + 4 * fq);
        const int sit = sbase + 256 * c; const bool has_s = sit < NBS * NH;
        const int sb = sit >> 5, sh = sit & 31, sr = MP + sb, sg = sh >> 3;
        f32x4 h0[4]; u32x2 sbu, scu; float sdt = 0.f, sxv[4], szv[4];
        const size_t sbase_off = (((size_t)sb * NH + sh) * HD) * DS;
        if (has_s) {
            const bf16_t* xr = XC + (size_t)sr * 3072;
#pragma unroll
            for (int i = 0; i < 4; ++i) { const int pp = pr + 16 * i; h0[i] = __builtin_nontemporal_load((const f32x4*)(p.in[I_STS] + sbase_off + (size_t)pp * DS + 4 * n4));
                sxv[i] = bf2f(xr[sh * 64 + pp]); szv[i] = bf2f(Z[(size_t)sr * 2048 + sh * 64 + pp]); }
            sbu = *(const u32x2*)(xr + 2048 + sg * 128 + 4 * n4); scu = *(const u32x2*)(xr + 2560 + sg * 128 + 4 * n4);
            sdt = DTP[(size_t)sr * 32 + sh];
        }
        bf16x8 cf[4];
#pragma unroll
        for (int kk = 0; kk < 4; ++kk) cf[kk] = *(const LAS bf16x8*)(lds + L_C + qrow * RS + (kk * 32 + fq * 8) * 2);
        f32x4 yacc[4];
#pragma unroll
        for (int i = 0; i < 4; ++i) yacc[i] = (f32x4){0.f, 0.f, 0.f, 0.f};
        const float acs_q = sAcs[qrow], acs_q0 = sAcs[16 * qt];
        LAS float* cfac = (LAS float*)(lds + L_CF) + w * 128;
#pragma unroll
        for (int i = 0; i < 2; ++i) { const int sidx = lane + 64 * i; if (sidx < 16 * qt) cfac[sidx] = __expf(acs_q0 - sAcs[sidx]) * sDt[sidx]; }
        const float r_q = __expf(acs_q - acs_q0);
        if (c > 0) {
#pragma unroll
            for (int pp = 0; pp < 2; ++pp) {
                bf16x8 hf[2][4];
#pragma unroll
                for (int a = 0; a < 2; ++a)
#pragma unroll
                    for (int kk = 0; kk < 4; ++kk) hf[a][kk] = *(const LAS bf16x8*)(lds + L_H + (16 * (2 * pp + a) + fr) * RS + (kk * 32 + fq * 8) * 2);
#pragma unroll
                for (int kk = 0; kk < 4; ++kk)
#pragma unroll
                    for (int a = 0; a < 2; ++a) yacc[2 * pp + a] = __builtin_amdgcn_mfma_f32_16x16x32_bf16(hf[a][kk], cf[kk], yacc[2 * pp + a], 0, 0, 0);
            }
            const float eq = __expf(acs_q);
#pragma unroll
            for (int pt = 0; pt < 4; ++pt) yacc[pt] = yacc[pt] * eq;
        }
        for (int sp = 0; 2 * sp <= qt; ++sp) {
            const bool two = 2 * sp + 1 <= qt;
            bf16x8 bfr[2][4];
#pragma unroll
            for (int kk = 0; kk < 4; ++kk) bfr[0][kk] = *(const LAS bf16x8*)(lds + L_B + (16 * (2 * sp) + fr) * RS + (kk * 32 + fq * 8) * 2);
            if (two) {
#pragma unroll
                for (int kk = 0; kk < 4; ++kk) bfr[1][kk] = *(const LAS bf16x8*)(lds + L_B + (16 * (2 * sp + 1) + fr) * RS + (kk * 32 + fq * 8) * 2);
            }
            f32x4 sacc[2];
            sacc[0] = (f32x4){0.f, 0.f, 0.f, 0.f}; sacc[1] = sacc[0];
#pragma unroll
            for (int kk = 0; kk < 4; ++kk) sacc[0] = __builtin_amdgcn_mfma_f32_16x16x32_bf16(bfr[0][kk], cf[kk], sacc[0], 0, 0, 0);
            if (two) {
#pragma unroll
                for (int kk = 0; kk < 4; ++kk) sacc[1] = __builtin_amdgcn_mfma_f32_16x16x32_bf16(bfr[1][kk], cf[kk], sacc[1], 0, 0, 0);
            }
#pragma unroll
            for (int a = 0; a < 2; ++a) { const int st = 2 * sp + a, s0 = 16 * st + 4 * fq;
                float pv[4];
                if (st < qt) { const f32x4 cc = *(const LAS f32x4*)(cfac + s0);
#pragma unroll
                    for (int j = 0; j < 4; ++j) pv[j] = sacc[a][j] * r_q * cc[j];
                } else if (st == qt) { const f32x4 as = *(const LAS f32x4*)(sAcs + s0), ds = *(const LAS f32x4*)(sDt + s0);
#pragma unroll
                    for (int j = 0; j < 4; ++j) pv[j] = (s0 + j <= qrow) ? sacc[a][j] * __expf(acs_q - as[j]) * ds[j] : 0.f;
                } else {
#pragma unroll
                    for (int j = 0; j < 4; ++j) pv[j] = 0.f;
                }
                u32x2 o; o.x = cvt_pk_bf16(pv[0], pv[1]); o.y = cvt_pk_bf16(pv[2], pv[3]);
                *(LAS u32x2*)(lds + L_C + qrow * RS + s0 * 2) = o; }
        }
        if (c + 1 < SEQ / 128) SSD_PREFETCH(c + 1);
        for (int kk = 0; kk <= (qt >> 1); ++kk) {
            bf16x8 xf[4];
            const bf16x8 pf = *(const LAS bf16x8*)(lds + L_C + qrow * RS + (kk * 32 + fq * 8) * 2);
#pragma unroll
            for (int pt = 0; pt < 4; ++pt) xf[pt] = tr_frag(lds + L_X, RX, kk * 32, 16 * pt, lane);
#pragma unroll
            for (int pt = 0; pt < 4; ++pt) yacc[pt] = __builtin_amdgcn_mfma_f32_16x16x32_bf16(xf[pt], pf, yacc[pt], 0, 0, 0);
        }
        { float ss = 0.f;
#pragma unroll
          for (int pt = 0; pt < 4; ++pt) { const int pc = 16 * pt + 4 * fq;
              const u32x2 xv = *(const LAS u32x2*)(lds + L_X + qrow * RX + pc * 2);
              const float x0 = bflo(xv.x), x1 = bfhi(xv.x), x2 = bflo(xv.y), x3 = bfhi(xv.y);
              const float g0 = (yacc[pt][0] + Dh * x0) * siluf_(bflo(zv[pt].x)), g1 = (yacc[pt][1] + Dh * x1) * siluf_(bfhi(zv[pt].x));
              const float g2 = (yacc[pt][2] + Dh * x2) * siluf_(bflo(zv[pt].y)), g3 = (yacc[pt][3] + Dh * x3) * siluf_(bfhi(zv[pt].y));
              ss += (g0 * g0 + g1 * g1) + (g2 * g2 + g3 * g3);
              u32x2 o; o.x = cvt_pk_bf16(g0, g1); o.y = cvt_pk_bf16(g2, g3);
              *(u32x2*)(YG + trow * 2048 + h * 64 + pc) = o; }
          ss += __shfl_xor(ss, 16); ss += __shfl_xor(ss, 32);
          if (fq == 0) SSQ[trow * 32 + h] = ss; }
        { const float dec = __expf(acs_last);
#pragma unroll
          for (int i = 0; i < 4; ++i) hacc[i] = hacc[i] * dec;
#pragma unroll
          for (int kp = 0; kp < 2; ++kp) {
              bf16x8 xwf[2], bf[2][4];
#pragma unroll
              for (int a = 0; a < 2; ++a) { const int kk = 2 * kp + a;
                  xwf[a] = tr_frag(lds + L_XW, RX, kk * 32, 16 * hpt, lane);
#pragma unroll
                  for (int i = 0; i < 4; ++i) bf[a][i] = tr_frag(lds + L_B, RS, kk * 32, 16 * (hnb + i), lane); }
              __builtin_amdgcn_sched_barrier(0);
#pragma unroll
              for (int a = 0; a < 2; ++a)
#pragma unroll
                  for (int i = 0; i < 4; ++i) hacc[i] = __builtin_amdgcn_mfma_f32_16x16x32_bf16(bf[a][i], xwf[a], hacc[i], 0, 0, 0);
          } }
        prev_sr = -1;
        if (has_s) {
            const float dA = __expf(sdt * -expf(p.in[I_ALOG][sh])), sD = p.in[I_DSKIP][sh];
            const f32x4 Bv = cv4(sbu), Cv = cv4(scu);
            float part = 0.f;
#pragma unroll
            for (int i = 0; i < 4; ++i) { const int pp = pr + 16 * i;
                const f32x4 hn = h0[i] * dA + Bv * (sdt * sxv[i]);
                __builtin_nontemporal_store(hn, (f32x4*)(p.out + O_SSS + sbase_off + (size_t)pp * DS + 4 * n4));
                float y = (hn[0] * Cv[0] + hn[1] * Cv[1]) + (hn[2] * Cv[2] + hn[3] * Cv[3]);
#pragma unroll
                for (int o = 1; o < 32; o <<= 1) y += __shfl_xor(y, o);
                const float gt = (y + sD * sxv[i]) * siluf_(szv[i]);
                if (n4 == 0) YG[(size_t)sr * 2048 + sh * 64 + pp] = f2bf(gt);
                part += gt * gt; }
            if (n4 == 0) red[pr] = part;
            prev_sr = sr; prev_sh = sh;
        }
    }
#undef SSD_PREFETCH
    float* so = p.out + O_SSP + (((size_t)b * NH + h) * HD + 16 * hpt + fr) * DS;
#pragma unroll
    for (int i = 0; i < 4; ++i) *(f32x4*)(so + 16 * (hnb + i) + 4 * fq) = hacc[i];
    __syncthreads();
    if (tid == 0 && prev_sr >= 0) { float v = 0.f;
#pragma unroll
        for (int i = 0; i < 16; ++i) v += red[i];
        SSQ[(size_t)prev_sr * 32 + prev_sh] = v; }
    __syncthreads();
}
__device__ __forceinline__ void phase_ssd(const Params& p, LAS unsigned char* lds) {
    for (int u = blockIdx.x; u < NBP * NH; u += gridDim.x) {
        const int xcd = u & 7, j = u >> 3, pair = xcd * 4 + (j >> 3), hr = j & 7;
        ssd_unit(p, lds, pair >> 2, (pair & 3) * 8 + hr, u);
    }
}
__device__ __forceinline__ void phase_gnorm(const Params& p) {
    bf16_t* YG = (bf16_t*)(p.ws + OFF_YG); const float* SSQ = (const float*)(p.ws + OFF_SSQ);
    for (int i = blockIdx.x * 512 + fresh_tid(); i < MTOT * 256; i += gridDim.x * 512) {
        const int row = i >> 8, cu = i & 255, g = cu >> 6;
        const f32x4 s0 = *(const f32x4*)(SSQ + (size_t)row * 32 + 8 * g), s1 = *(const f32x4*)(SSQ + (size_t)row * 32 + 8 * g + 4);
        const float rstd = rsqrtf(((s0[0] + s0[1]) + (s0[2] + s0[3]) + (s1[0] + s1[1]) + (s1[2] + s1[3])) * (1.f / 512.f) + EPS);
        bf16_t* q = YG + (size_t)row * 2048 + cu * 8;
        const F8 v = ld8bf(q);
        *(u32x4*)q = pack8(v.a * rstd, v.b * rstd);
    }
}

__global__ void __launch_bounds__(512, 2) fwd_megakernel(Params p) {
    extern __shared__ __attribute__((aligned(16))) unsigned char shm[];
    LAS unsigned char* lds = (LAS unsigned char*)shm;
    cg::grid_group grid = cg::this_grid();
    unsigned char* ws = p.ws;
    const int G = gridDim.x, cid = blockIdx.x;
    float* mod = (float*)(ws + OFF_MOD);
    pg8::StaticOrder S;
    volatile LAS unsigned* xst = (volatile LAS unsigned*)(lds + 131072);
    if (threadIdx.x == 0) { xst[0] = 0u; xst[1] = 0u; }
    __syncthreads();
    XcdBarrier xb = xcd_barrier_post((unsigned*)(ws + OFF_BAR), xst);

    phase0(p, lds, 0);
    grid.sync();
    if (cid < 24) {
        pg8::Gemm g{(const bf16_t*)(ws + OFF_CA), (const bf16_t*)(ws + OFF_WADA), 256, 6144, 1024};
        EpiF32Bias E{mod, 6144, p.in[I_BADA]};
        S.init(g.M, g.N, 24, cid); pg8::gemm_phase<EpiF32Bias, pg8::StaticOrder, true, true>(lds, g, S, E);
    } else phase0(p, lds, 1);
    GSYNC();
    phase_rownorm(p, p.in[I_XP], p.in[I_XS], p.in[I_N1G], 1024, 0, (bf16_t*)(ws + OFF_U));
    if (PROBE_EW) phase_rownorm(p, p.in[I_XP], p.in[I_XS], p.in[I_N1G], 1024, 0, (bf16_t*)(ws + OFF_U));
    GSYNC();
    {
        pg8::Gemm g{(const bf16_t*)(ws + OFF_U), (const bf16_t*)(ws + OFF_WIN), MPAD, DINP, 1024};
        EpiIn E{(bf16_t*)(ws + OFF_BG), (bf16_t*)(ws + OFF_CI), (bf16_t*)(ws + OFF_Z), (bf16_t*)(ws + OFF_XBC), (bf16_t*)(ws + OFF_GA), (bf16_t*)(ws + OFF_GB), (float*)(ws + OFF_DTRAW)};
        S.init(g.M, g.N, G, cid); pg8::gemm_phase<EpiIn, pg8::StaticOrder, true, true>(lds, g, S, E);
    }
    GSYNC();
    phase_conv(p, lds);
    if (PROBE_CONV) { __syncthreads(); phase_conv(p, lds); }
    GSYNC();
    phase_ssd(p, lds);
    if (PROBE_SSD) { __syncthreads(); phase_ssd(p, lds); }
    GSYNC();
    phase_gnorm(p);
    GSYNC();
    {
        pg8::Gemm ga{(const bf16_t*)(ws + OFF_VA), (const bf16_t*)(ws + OFF_WAOUT), MP, 1024, 1024};
        EpiGate<0> Ea{(bf16_t*)(ws + OFF_YA), (const bf16_t*)(ws + OFF_GA), nullptr, 1024};
        S.init(ga.M, ga.N, G, cid); pg8::gemm_phase<EpiGate<0>, pg8::StaticOrder, true, true>(lds, ga, S, Ea);
        __syncthreads();
        pg8::Gemm gb{(const bf16_t*)(ws + OFF_YG), (const bf16_t*)(ws + OFF_WBOUT), MP, 1024, 2048};
        EpiGate<1> Eb{(bf16_t*)(ws + OFF_MERGED), (const bf16_t*)(ws + OFF_GB), (const bf16_t*)(ws + OFF_YA), 1024};
        pg8::gemm_phase<EpiGate<1>, pg8::StaticOrder, true, true>(lds, gb, S, Eb);
        __syncthreads();
        SkGate<0> Sa{(bf16_t*)(ws + OFF_YA), (const bf16_t*)(ws + OFF_GA), nullptr, 1024};
        skinny_gemm<4>(lds, (const bf16_t*)(ws + OFF_VA) + (size_t)MP * 1024, (const bf16_t*)(ws + OFF_WAOUT), 1024, 1024, Sa);
        SkGate<1> Sb{(bf16_t*)(ws + OFF_MERGED), (const bf16_t*)(ws + OFF_GB), (const bf16_t*)(ws + OFF_YA), 1024};
        skinny_gemm<4>(lds, (const bf16_t*)(ws + OFF_YG) + (size_t)MP * 2048, (const bf16_t*)(ws + OFF_WBOUT), 1024, 2048, Sb);
    }
    GSYNC();
    {
        pg8::Gemm g{(const bf16_t*)(ws + OFF_MERGED), (const bf16_t*)(ws + OFF_WO), MP, 1024, 1024};
        EpiRes E{(float*)(ws + OFF_X1), p.in[I_XP], p.in[I_XS], mod + 2048};
        S.init(g.M, g.N, G, cid); pg8::gemm_phase<EpiRes, pg8::StaticOrder, true, true>(lds, g, S, E);
        __syncthreads();
        SkRes Sk{(float*)(ws + OFF_X1), p.in[I_XS], mod + 2048};
        skinny_gemm<4>(lds, (const bf16_t*)(ws + OFF_MERGED) + (size_t)MP * 1024, (const bf16_t*)(ws + OFF_WO), 1024, 1024, Sk);
    }
    GSYNC();
    {
        const float* X1 = (const float*)(ws + OFF_X1);
        phase_rownorm(p, X1, X1 + (size_t)MP * D, p.in[I_N2G], 4096, 3072, (bf16_t*)(ws + OFF_U));
        if (PROBE_EW) phase_rownorm(p, X1, X1 + (size_t)MP * D, p.in[I_N2G], 4096, 3072, (bf16_t*)(ws + OFF_U));
    }
    GSYNC();
    {
        pg8::Gemm g{(const bf16_t*)(ws + OFF_U), (const bf16_t*)(ws + OFF_W1), MP, DFF, 1024};
        EpiGate<2> E{(bf16_t*)(ws + OFF_HMID), nullptr, nullptr, DFF};
        S.init(g.M, g.N, G, cid); pg8::gemm_phase<EpiGate<2>, pg8::StaticOrder, true, true>(lds, g, S, E);
        __syncthreads();
        SkGate<2> Sk{(bf16_t*)(ws + OFF_HMID), nullptr, nullptr, DFF};
        skinny_gemm<1>(lds, (const bf16_t*)(ws + OFF_U) + (size_t)MP * 1024, (const bf16_t*)(ws + OFF_W1), DFF, 1024, Sk);
    }
    GSYNC();
    {
        pg8::Gemm g{(const bf16_t*)(ws + OFF_HMID), (const bf16_t*)(ws + OFF_W2), MP, 1024, DFF};
        EpiRes E{(float*)(ws + OFF_X1), nullptr, nullptr, mod + 5120};
        S.init(g.M, g.N, G, cid); pg8::gemm_phase<EpiRes, pg8::StaticOrder, true, true>(lds, g, S, E);
        __syncthreads();
        SkRes Sk{(float*)(ws + OFF_X1), nullptr, mod + 5120};
        skinny_gemm<4>(lds, (const bf16_t*)(ws + OFF_HMID) + (size_t)MP * DFF, (const bf16_t*)(ws + OFF_W2), 1024, DFF, Sk);
    }
    GSYNC();
    phase_final(p);
    if (PROBE_EW) phase_final(p);
}

extern "C" void kernel_launch(void* const* d_in, const int* in_sizes, int n_in, void* d_out, int out_size, void* d_ws, size_t ws_size, hipStream_t stream) {
    constexpr int LDS_BYTES = 131072 + 16;
    static int grid = 0;
    if (grid == 0) {
        if (n_in != 25 || ws_size < WS_END) { fprintf(stderr, "kernel_launch: unexpected n_in %d / ws %zu (need %zu)\n", n_in, ws_size, (size_t)WS_END); grid = -1; return; }
        int dev = 0, cus = 0, per_cu = 0;
        (void)hipGetDevice(&dev);
        (void)hipDeviceGetAttribute(&cus, hipDeviceAttributeMultiprocessorCount, dev);
        if (hipFuncSetAttribute((const void*)fwd_megakernel, hipFuncAttributeMaxDynamicSharedMemorySize, LDS_BYTES) != hipSuccess) { fprintf(stderr, "kernel_launch: hipFuncSetAttribute failed\n"); grid = -1; return; }
        if (hipOccupancyMaxActiveBlocksPerMultiprocessor(&per_cu, (const void*)fwd_megakernel, 512, LDS_BYTES) != hipSuccess || per_cu < 1) { fprintf(stderr, "kernel_launch: occupancy query says %d blocks per CU\n", per_cu); grid = -1; return; }
        grid = cus;
    }
    if (grid < 0) return;
    Params p{};
    for (int i = 0; i < 25; ++i) p.in[i] = (const float*)d_in[i];
    p.out = (float*)d_out; p.ws = (unsigned char*)d_ws;
    (void)hipMemsetAsync((unsigned char*)d_ws + OFF_BAR, 0, 16384, stream);
    void* args[] = {&p};
    hipError_t e = hipLaunchCooperativeKernel((const void*)fwd_megakernel, dim3(grid), dim3(512), args, LDS_BYTES, stream);
    if (e != hipSuccess) fprintf(stderr, "cooperative launch failed: %s (grid %d)\n", hipGetErrorString(e), grid);
}
```

```cpp
#include <hip/hip_runtime.h>
#include <hip/hip_cooperative_groups.h>
#include <cstdio>
#include <cstdint>
namespace cg = cooperative_groups;
#define PROBE_EW 0
#define PROBE_CONV 0
#define PROBE_SSD 0
#define PROBE_SYNC 0
#define PROBE_INPROJ 0
#define PROBE_MLP1 0
#define GSYNC() do { xcd_barrier(xb); if (PROBE_SYNC) xcd_barrier(xb); } while (0)

#define LAS __attribute__((address_space(3)))
typedef unsigned short bf16_t;
typedef short bf16x8 __attribute__((ext_vector_type(8)));
typedef short bf16x4 __attribute__((ext_vector_type(4)));
typedef float f32x4 __attribute__((ext_vector_type(4)));
typedef float f32x2 __attribute__((ext_vector_type(2)));
typedef unsigned u32x4 __attribute__((ext_vector_type(4)));
typedef unsigned u32x2 __attribute__((ext_vector_type(2)));

constexpr int D = 1024, NBP = 8, SEQ = 2048, MP = NBP * SEQ, NBS = 128, MTOT = MP + NBS, MPAD = 16640;
constexpr int DINP = 10496, DINNER = 2048, DXBC = 3072, NH = 32, HD = 64, DS = 128, DFF = 4096, DIN = 10272;
constexpr float EPS = 1e-6f;
constexpr size_t O_YP = 0, O_YS = 16777216, O_SCP = 16908288, O_SBP = 16924672, O_SSP = 16998400, O_SCS = 19095552, O_SBS = 19357696, O_SSS = 20537344;
constexpr size_t S1 = (size_t)MPAD * 1024 * 2;
constexpr size_t OFF_WADA = 0, OFF_WIN = 12582912, OFF_WAOUT = 34078720, OFF_WBOUT = 36175872, OFF_WO = 40370176, OFF_W1 = 42467328, OFF_W2 = 50855936,
                 OFF_CA = 59244544, OFF_MOD = 59768832, OFF_DTRAW = 66060288, OFF_DTP = 68190208, OFF_ACS = 70320128, OFF_SSQ = 72450048, OFF_U = 74579968,
                 OFF_R1 = OFF_U + S1, OFF_BG = OFF_R1, OFF_CI = OFF_R1 + S1, OFF_Z = OFF_R1 + 2 * S1, OFF_XBC = OFF_R1 + 4 * S1, OFF_GA = OFF_R1 + 7 * S1, OFF_GB = OFF_R1 + 8 * S1,
                 OFF_R2 = OFF_R1 + 9 * S1, OFF_BAR = OFF_R2 + 3 * S1, WS_END = OFF_BAR + 16384;
constexpr size_t OFF_VA = OFF_U, OFF_YA = OFF_BG, OFF_MERGED = OFF_CI, OFF_YG = OFF_XBC, OFF_HMID = OFF_R1, OFF_XBCC = OFF_R2, OFF_X1 = OFF_R2;

struct Params {
    const float* in[25];
    float* out;
    unsigned char* ws;
};
enum { I_XP = 0, I_XS, I_CP, I_CS, I_STA, I_STB, I_STS, I_WADA, I_BADA, I_N1G, I_WIN, I_CAW, I_WAOUT, I_CBW, I_CBB, I_DTB, I_ALOG, I_DSKIP, I_SNG, I_WBOUT, I_WO, I_N2G, I_W1, I_W2, I_NFG };

__device__ __forceinline__ unsigned cvt_pk_bf16(float lo, float hi) { unsigned r; asm volatile("v_cvt_pk_bf16_f32 %0, %1, %2" : "=v"(r) : "v"(lo), "v"(hi)); return r; }
__device__ __forceinline__ bf16_t f2bf(float f) { unsigned u = __float_as_uint(f); u += 0x7FFFu + ((u >> 16) & 1u); return (bf16_t)(u >> 16); }
__device__ __forceinline__ float bf2f(bf16_t b) { return __uint_as_float(((unsigned)b) << 16); }
__device__ __forceinline__ float bflo(unsigned u) { return __uint_as_float(u << 16); }
__device__ __forceinline__ float bfhi(unsigned u) { return __uint_as_float(u & 0xffff0000u); }
__device__ __forceinline__ float sigmoidf_(float x) { return __builtin_amdgcn_rcpf(1.f + __expf(-x)); }
__device__ __forceinline__ float siluf_(float x) { return x * sigmoidf_(x); }
__device__ __forceinline__ f32x4 cv4(const u32x2 u) { return (f32x4){bflo(u.x), bfhi(u.x), bflo(u.y), bfhi(u.y)}; }
__device__ __forceinline__ int fresh_tid() { int t = threadIdx.x; asm volatile("" : "+v"(t)); __builtin_assume(t >= 0 && t < 512); return t; }
__device__ __forceinline__ float wave_sum(float v) {
#pragma unroll
    for (int o = 1; o < 64; o <<= 1) v += __shfl_xor(v, o);
    return v;
}


#define XB_TMO      128
#define XB_XCNT(j)  (256  + 64 * (j))
#define XB_XSUB(j)  (1280 + 64 * (j))
#define XB_XGEN(j)  (2304 + 64 * (j))
#define XB_TOP      3328
#define XB_TOPGEN   3392
#define XCD_BAR_WORDS 3456
#define XB_SPIN_CAP (1u << 18)
__device__ __forceinline__ unsigned xb_ld(unsigned* p)              { return __hip_atomic_load(p, __ATOMIC_RELAXED, __HIP_MEMORY_SCOPE_AGENT); }
__device__ __forceinline__ unsigned xb_add(unsigned* p, unsigned v) { return __hip_atomic_fetch_add(p, v, __ATOMIC_RELAXED, __HIP_MEMORY_SCOPE_AGENT); }
__device__ __forceinline__ unsigned xb_xcc_id() { return (unsigned)__builtin_amdgcn_s_getreg((3 << 11) | 20) & 0xFu; }
#define XB_SPIN(cond, bar) do { unsigned _sp = 0; while (cond) { __builtin_amdgcn_s_sleep(1); \
    if ((++_sp & 255u) == 0u) { if (xb_ld(&(bar)[XB_TMO])) break; if (_sp > XB_SPIN_CAP) { atomicAdd(&(bar)[XB_TMO], 1u); break; } } } } while (0)
struct XcdBarrier { unsigned* bar; unsigned x; volatile LAS unsigned* st; };
__device__ __forceinline__ XcdBarrier xcd_barrier_post(unsigned* bar, volatile LAS unsigned* st) {
    XcdBarrier b; b.bar = bar; b.x = xb_xcc_id(); b.st = st;
    if (threadIdx.x == 0) (void)xb_add(&bar[XB_XCNT(b.x)], 1u);
    return b;
}
__device__ __forceinline__ void xcd_barrier_complete(unsigned* bar, unsigned x, unsigned& nloc, unsigned& nx) {
    const unsigned G = gridDim.x * gridDim.y * gridDim.z;
    unsigned sum, cnt, mine, sp = 0u;
    for (;;) {
        sum = 0u; cnt = 0u; mine = 0u;
#pragma unroll
        for (unsigned j = 0; j < 16; ++j) { const unsigned c = xb_ld(&bar[XB_XCNT(j)]); sum += c; cnt += (c > 0u) ? 1u : 0u; mine = (j == x) ? c : mine; }
        if (sum == G) break;
        __builtin_amdgcn_s_sleep(1);
        if ((++sp & 255u) == 0u) { if (xb_ld(&bar[XB_TMO])) break; if (sp > XB_SPIN_CAP) { atomicAdd(&bar[XB_TMO], 1u); break; } }
    }
    nloc = mine > 0u ? mine : 1u; nx = cnt > 0u ? cnt : 1u;
}
__device__ __forceinline__ void xcd_barrier(const XcdBarrier& b) {
    asm volatile("s_waitcnt vmcnt(0)" ::: "memory");
    __syncthreads();
    if (threadIdx.x == 0) {
        unsigned* bar = b.bar;
        __builtin_amdgcn_s_waitcnt(0);
        unsigned nloc = b.st[0], nx = b.st[1];
        if (nloc == 0u) { xcd_barrier_complete(bar, b.x, nloc, nx); b.st[0] = nloc; b.st[1] = nx; }
        const unsigned old = xb_add(&bar[XB_XSUB(b.x)], 1u);
        const unsigned gen = old / nloc;
        if (old + 1u == (gen + 1u) * nloc) {
            __builtin_amdgcn_fence(__ATOMIC_RELEASE, "agent");
            asm volatile("s_waitcnt vmcnt(0)" ::: "memory");
            const unsigned og = xb_add(&bar[XB_TOP], 1u);
            const unsigned tg = og / nx;
            if (og + 1u == (tg + 1u) * nx) xb_add(&bar[XB_TOPGEN], 1u);
            else XB_SPIN(xb_ld(&bar[XB_TOPGEN]) == tg, bar);
            __builtin_amdgcn_fence(__ATOMIC_ACQUIRE, "agent");
            xb_add(&bar[XB_XGEN(b.x)], 1u);
            asm volatile("s_waitcnt vmcnt(0)" ::: "memory");
        } else {
            XB_SPIN(xb_ld(&bar[XB_XGEN(b.x)]) == gen, bar);
            __builtin_amdgcn_fence(__ATOMIC_ACQUIRE, "agent");
            asm volatile("s_waitcnt vmcnt(0)" ::: "memory");
        }
    }
    __syncthreads();
}

namespace pg8 {
#define PG8_LAS __attribute__((address_space(3)))
constexpr int BM = 256, BK = 64, HALF = 128, HTB = HALF * BK * 2, STAGE_BYTES = 8 * HTB, NXCD = 8, WGM = 8;
__host__ __device__ __forceinline__ int lds_byte(int r, int c) { const int st = (r >> 4) * 2 + (c >> 5), rr = r & 15, cc = c & 31, ob = rr * 64 + cc * 2; return st * 1024 + (ob ^ (((ob >> 9) & 1) << 5)); }
__host__ __device__ __forceinline__ void stage_rc(int b, int& R, int& C) { const int st = b / 1024, sb = b % 1024, swz = sb ^ (((sb >> 9) & 1) << 5); R = (st >> 1) * 16 + swz / 64; C = (st & 1) * 32 + (swz % 64) / 2; }
__host__ __device__ __forceinline__ int perm32(int rho) { const int n = rho >> 4, i = rho & 15; return 8 * (i >> 2) + 4 * n + (i & 3); }
struct Unit { int pm, pn; };
struct Gemm { const bf16_t* A; const bf16_t* Bt; int M, N, K; };
struct StaticOrder {
    int nM, nN, nwg, G, c;
    __host__ __device__ void init(int M, int N, int G_, int c_) { nM = M / BM; nN = N / BM; nwg = nM * nN; G = G_; c = c_; }
    __host__ __device__ bool next(int i, Unit& u) const {
        const long L = (long)i * G + c; if (L >= nwg) return false;
        int wgid = (int)L; { const int q = nwg / NXCD, r = nwg % NXCD, xcd = wgid % NXCD, off = wgid / NXCD; wgid = (xcd < r ? xcd * (q + 1) : r * (q + 1) + (xcd - r) * q) + off; }
        const int nig = WGM * nN, gid = wgid / nig, fm = gid * WGM, gsz = (nM - fm) < WGM ? (nM - fm) : WGM;
        u.pm = fm + ((wgid % nig) % gsz); u.pn = (wgid % nig) / gsz; return true;
    }
    __device__ __forceinline__ void a_ready(const Unit&) const {}
    __device__ __forceinline__ void done(const Unit&) const {}
};

template <class Epi, class Sched, bool ALIGN_EPI = false, bool SP2 = false>
__device__ __forceinline__ void gemm_phase(PG8_LAS unsigned char* lds, const Gemm g, const Sched& S, const Epi& E) {
    const int tid = fresh_tid(), wid = __builtin_amdgcn_readfirstlane(tid >> 6), lane = tid & 63, wr = wid >> 2, wc = wid & 3, fr = lane & 15, fq = lane >> 4;
    const int K = g.K, nt = K / BK;
    unsigned voffA[2], voffB[2];
#pragma unroll
    for (int i = 0; i < 2; ++i) { int R, C; stage_rc(tid * 16 + i * 8192, R, C); const int Rb = Epi::PERM ? ((R & ~31) + perm32(R & 31)) : R;
        voffA[i] = (unsigned)(R * K + C) * 2u; voffB[i] = (unsigned)(Rb * K + C) * 2u; }
    const size_t kstep = (size_t)(BK * 2);
    const size_t hstep = (size_t)HALF * K * 2;
    const size_t tstep = 2 * hstep;
    const unsigned ldsw = (unsigned)wid * 1024u;
    const int aoff = lds_byte(wr * 64 + fr, fq * 8), boff = lds_byte(wc * 32 + fr, fq * 8);
#define PG8_SA(b, h) (((b) * 2 + (h)) * HTB)
#define PG8_SB(b, h) ((4 + (b) * 2 + (h)) * HTB)
#define PG8_STAGE(bufoff, gbase, voff) do { _Pragma("unroll") for (int _i = 0; _i < 2; ++_i) \
        __builtin_amdgcn_global_load_lds((const unsigned*)((const char*)(gbase) + (voff)[_i]), (PG8_LAS unsigned*)(lds + (bufoff) + ldsw + _i * 8192), 16, 0, 0); } while (0)
#define PG8_LDA(dst, b, h) do { _Pragma("unroll") for (int m = 0; m < 4; ++m) _Pragma("unroll") for (int k = 0; k < 2; ++k) dst[m][k] = *(const PG8_LAS bf16x8*)(lds + PG8_SA(b, h) + aoff + m * 2048 + k * 1024); } while (0)
#define PG8_LDB(dst, b, h) do { _Pragma("unroll") for (int n = 0; n < 2; ++n) _Pragma("unroll") for (int k = 0; k < 2; ++k) dst[n][k] = *(const PG8_LAS bf16x8*)(lds + PG8_SB(b, h) + boff + n * 2048 + k * 1024); } while (0)
#define PG8_MMA(ai, bj, At, Bt) do { __builtin_amdgcn_s_setprio(1); _Pragma("unroll") for (int m = 0; m < 4; ++m) _Pragma("unroll") for (int n = 0; n < 2; ++n) _Pragma("unroll") for (int k = 0; k < 2; ++k) \
        acc[ai][bj][m][n] = __builtin_amdgcn_mfma_f32_16x16x32_bf16(Bt[n][k], At[m][k], acc[ai][bj][m][n], 0, 0, 0); __builtin_amdgcn_s_setprio(0); } while (0)
#define PG8_WAIT_V(n) asm volatile("s_waitcnt vmcnt(" #n ")" ::: "memory")
#define PG8_WAIT_L(n) asm volatile("s_waitcnt lgkmcnt(" #n ")" ::: "memory")
#define PG8_BAR __builtin_amdgcn_s_barrier()
#define PG8_SCHED __builtin_amdgcn_sched_barrier(0)
    Unit cur, nxt; int ui = 0;
    if (!S.next(0, cur)) return;
    f32x4 acc[2][2][4][2];
#pragma unroll
    for (int a = 0; a < 2; ++a)
#pragma unroll
        for (int b = 0; b < 2; ++b)
#pragma unroll
            for (int m = 0; m < 4; ++m)
#pragma unroll
                for (int n = 0; n < 2; ++n) acc[a][b][m][n] = (f32x4){0.f, 0.f, 0.f, 0.f};
    bf16x8 At[4][2], B0[2][2], B1[2][2];
    const char* cA = (const char*)g.A + (size_t)cur.pm * tstep; const char* cB = (const char*)g.Bt + (size_t)cur.pn * tstep;
    S.a_ready(cur);
    if constexpr (SP2) {
        PG8_STAGE(PG8_SB(0, 0), cB, voffB); PG8_STAGE(PG8_SB(0, 1), cB + hstep, voffB); PG8_STAGE(PG8_SA(0, 0), cA, voffA); PG8_STAGE(PG8_SA(0, 1), cA + hstep, voffA);
        if (wr == 1) PG8_BAR;
        PG8_WAIT_V(2); PG8_BAR;
        PG8_STAGE(PG8_SB(1, 0), cB + kstep, voffB); PG8_STAGE(PG8_SA(1, 0), cA + kstep, voffA); PG8_STAGE(PG8_SB(1, 1), cB + hstep + kstep, voffB);
        PG8_WAIT_V(6); PG8_BAR;
    } else {
        PG8_STAGE(PG8_SB(0, 0), cB, voffB); PG8_STAGE(PG8_SA(0, 0), cA, voffA); PG8_STAGE(PG8_SB(0, 1), cB + hstep, voffB); PG8_STAGE(PG8_SA(0, 1), cA + hstep, voffA);
        if (wr == 1) PG8_BAR;
        PG8_WAIT_V(4); PG8_BAR;
        PG8_STAGE(PG8_SB(1, 0), cB + kstep, voffB); PG8_STAGE(PG8_SA(1, 0), cA + kstep, voffA); PG8_STAGE(PG8_SB(1, 1), cB + hstep + kstep, voffB);
        PG8_WAIT_V(6); PG8_BAR;
    }
    for (;;) {
        const bool has_next = S.next(ui + 1, nxt);
        const char* nA = has_next ? (const char*)g.A + (size_t)nxt.pm * tstep : cA; const char* nB = has_next ? (const char*)g.Bt + (size_t)nxt.pn * tstep : cB;
        for (int t = 0; t < nt; t += 2) {
            const bool last = (t == nt - 2);
            const char* a1 = cA + (size_t)(t + 1) * kstep;
            const char* a2 = last ? nA : cA + (size_t)(t + 2) * kstep; const char* b2 = last ? nB : cB + (size_t)(t + 2) * kstep;
            const char* a3 = a2 + kstep; const char* b3 = b2 + kstep;
            if (last && has_next) S.a_ready(nxt);
            if constexpr (SP2) {
            PG8_LDB(B0, 0, 0); PG8_LDB(B1, 0, 1); PG8_SCHED; PG8_LDA(At, 0, 0); PG8_STAGE(PG8_SA(1, 1), a1 + hstep, voffA);
            PG8_WAIT_V(8); PG8_WAIT_L(0); PG8_BAR; PG8_MMA(0, 0, At, B0); PG8_MMA(0, 1, At, B1); PG8_BAR; PG8_SCHED;
            PG8_LDA(At, 0, 1); PG8_STAGE(PG8_SB(0, 0), b2, voffB); PG8_STAGE(PG8_SB(0, 1), b2 + hstep, voffB); PG8_STAGE(PG8_SA(0, 0), a2, voffA);
            PG8_WAIT_V(8); PG8_WAIT_L(0); PG8_BAR; PG8_MMA(1, 0, At, B0); PG8_MMA(1, 1, At, B1); PG8_BAR; PG8_SCHED;
            PG8_LDB(B0, 1, 0); PG8_LDB(B1, 1, 1); PG8_SCHED; PG8_LDA(At, 1, 0); PG8_STAGE(PG8_SA(0, 1), a2 + hstep, voffA);
            PG8_WAIT_V(8); PG8_WAIT_L(0); PG8_BAR; PG8_MMA(0, 0, At, B0); PG8_MMA(0, 1, At, B1); PG8_BAR; PG8_SCHED;
            PG8_LDA(At, 1, 1); PG8_STAGE(PG8_SB(1, 0), b3, voffB); PG8_STAGE(PG8_SB(1, 1), b3 + hstep, voffB); PG8_STAGE(PG8_SA(1, 0), a3, voffA);
            PG8_WAIT_V(8); PG8_WAIT_L(0); PG8_BAR; PG8_MMA(1, 0, At, B0); PG8_MMA(1, 1, At, B1); PG8_BAR; PG8_SCHED;
            } else {
            PG8_LDB(B0, 0, 0); PG8_SCHED; PG8_LDA(At, 0, 0); PG8_STAGE(PG8_SA(1, 1), a1 + hstep, voffA);
            PG8_WAIT_L(8); PG8_BAR; PG8_WAIT_L(0); PG8_MMA(0, 0, At, B0); PG8_BAR; PG8_SCHED;
            PG8_LDB(B1, 0, 1); PG8_STAGE(PG8_SB(0, 0), b2, voffB);
            PG8_BAR; PG8_WAIT_L(0); PG8_MMA(0, 1, At, B1); PG8_BAR;
            PG8_LDA(At, 0, 1); PG8_STAGE(PG8_SA(0, 0), a2, voffA);
            PG8_BAR; PG8_WAIT_L(0); PG8_MMA(1, 0, At, B0); PG8_BAR; PG8_SCHED;
            PG8_STAGE(PG8_SB(0, 1), b2 + hstep, voffB);
            PG8_WAIT_V(6); PG8_BAR; PG8_MMA(1, 1, At, B1); PG8_BAR;
            PG8_LDB(B0, 1, 0); PG8_SCHED; PG8_LDA(At, 1, 0); PG8_STAGE(PG8_SA(0, 1), a2 + hstep, voffA);
            PG8_WAIT_L(8); PG8_BAR; PG8_WAIT_L(0); PG8_MMA(0, 0, At, B0); PG8_BAR; PG8_SCHED;
            PG8_LDB(B1, 1, 1); PG8_STAGE(PG8_SB(1, 0), b3, voffB);
            PG8_BAR; PG8_WAIT_L(0); PG8_MMA(0, 1, At, B1); PG8_BAR;
            PG8_LDA(At, 1, 1); PG8_STAGE(PG8_SA(1, 0), a3, voffA);
            PG8_BAR; PG8_WAIT_L(0); PG8_MMA(1, 0, At, B0); PG8_BAR; PG8_SCHED;
            PG8_STAGE(PG8_SB(1, 1), b3 + hstep, voffB);
            PG8_WAIT_V(6); PG8_BAR; PG8_MMA(1, 1, At, B1); PG8_BAR;
            }
        }
        if constexpr (ALIGN_EPI) { if (wr == 0) PG8_BAR; }
        E(acc, cur, wr, wc, fr, fq);
        if (!has_next) break;
#pragma unroll
        for (int a = 0; a < 2; ++a)
#pragma unroll
            for (int b = 0; b < 2; ++b)
#pragma unroll
                for (int m = 0; m < 4; ++m)
#pragma unroll
                    for (int n = 0; n < 2; ++n) acc[a][b][m][n] = (f32x4){0.f, 0.f, 0.f, 0.f};
        cur = nxt; cA = nA; cB = nB; ++ui;
        if constexpr (ALIGN_EPI) { if (wr == 1) PG8_BAR; }
    }
    PG8_WAIT_V(0);
    if constexpr (!ALIGN_EPI) { if (wr == 0) PG8_BAR; }
    PG8_BAR;
#undef PG8_SA
#undef PG8_SB
#undef PG8_STAGE
#undef PG8_LDA
#undef PG8_LDB
#undef PG8_MMA
#undef PG8_WAIT_V
#undef PG8_WAIT_L
#undef PG8_BAR
#undef PG8_SCHED
}
}
using pg8::Unit;
typedef f32x4 AccT[2][2][4][2];

struct EpiF32Bias {
    static constexpr bool PERM = false;
    float* C; int ldc; const float* bias;
    __device__ __forceinline__ void operator()(const AccT& acc, const Unit& u, int wr, int wc, int fr, int fq) const {
        const int row0 = u.pm * 256 + wr * 64 + fr, col0 = u.pn * 256 + wc * 32 + 4 * fq;
        f32x4 bv[2][2];
#pragma unroll
        for (int bj = 0; bj < 2; ++bj)
#pragma unroll
            for (int n = 0; n < 2; ++n) bv[bj][n] = *(const f32x4*)(bias + col0 + bj * 128 + n * 16);
#pragma unroll
        for (int ai = 0; ai < 2; ++ai)
#pragma unroll
            for (int m = 0; m < 4; ++m) { float* rowp = C + (size_t)(row0 + ai * 128 + m * 16) * ldc + col0;
#pragma unroll
                for (int bj = 0; bj < 2; ++bj)
#pragma unroll
                    for (int n = 0; n < 2; ++n) *(f32x4*)(rowp + bj * 128 + n * 16) = acc[ai][bj][m][n] + bv[bj][n]; }
    }
};
__device__ __forceinline__ u32x4 pack8(f32x4 v0, f32x4 v1) { u32x4 w; w.x = cvt_pk_bf16(v0[0], v0[1]); w.y = cvt_pk_bf16(v0[2], v0[3]); w.z = cvt_pk_bf16(v1[0], v1[1]); w.w = cvt_pk_bf16(v1[2], v1[3]); return w; }
struct EpiIn {
    static constexpr bool PERM = true;
    bf16_t *BG, *CI, *Z, *XBC, *GA, *GB; float* DT;
    __device__ __forceinline__ void operator()(const AccT& acc, const Unit& u, int wr, int wc, int fr, int fq) const {
        const int pn = u.pn, row0 = u.pm * 256 + wr * 64 + fr, cin = wc * 32 + 8 * fq;
        if (pn >= 4 && pn < 12) {
            const int col = (pn - 4) * 128 + cin;
#pragma unroll
            for (int ai = 0; ai < 2; ++ai)
#pragma unroll
                for (int m = 0; m < 4; ++m) { const size_t row = row0 + ai * 128 + m * 16;
                    *(u32x4*)(CI + row * 1024 + col) = pack8(acc[ai][0][m][0] * acc[ai][1][m][0], acc[ai][0][m][1] * acc[ai][1][m][1]); }
        } else if (pn == 40) {
            if (wc == 0) {
#pragma unroll
                for (int ai = 0; ai < 2; ++ai)
#pragma unroll
                    for (int m = 0; m < 4; ++m) { const size_t row = row0 + ai * 128 + m * 16;
                        *(f32x4*)(DT + row * 32 + 8 * fq) = acc[ai][0][m][0]; *(f32x4*)(DT + row * 32 + 8 * fq + 4) = acc[ai][0][m][1]; }
            }
        } else {
            bf16_t* O; int ldc, colt;
            if (pn < 4) { O = BG; ldc = 1024; colt = pn * 256; }
            else if (pn < 20) { O = Z; ldc = 2048; colt = (pn - 12) * 256; }
            else if (pn < 32) { O = XBC; ldc = 3072; colt = (pn - 20) * 256; }
            else if (pn < 36) { O = GA; ldc = 1024; colt = (pn - 32) * 256; }
            else { O = GB; ldc = 1024; colt = (pn - 36) * 256; }
#pragma unroll
            for (int ai = 0; ai < 2; ++ai)
#pragma unroll
                for (int m = 0; m < 4; ++m) { bf16_t* rowp = O + (size_t)(row0 + ai * 128 + m * 16) * ldc + colt + cin;
#pragma unroll
                    for (int bj = 0; bj < 2; ++bj) *(u32x4*)(rowp + bj * 128) = pack8(acc[ai][bj][m][0], acc[ai][bj][m][1]); }
        }
    }
};
template <int MODE> struct EpiGate {
    static constexpr bool PERM = true;
    bf16_t* O; const bf16_t* G; const bf16_t* Y; int ldc;
    __device__ __forceinline__ void operator()(const AccT& acc, const Unit& u, int wr, int wc, int fr, int fq) const {
        const int row0 = u.pm * 256 + wr * 64 + fr, col0 = u.pn * 256 + wc * 32 + 8 * fq;
#pragma unroll
        for (int ai = 0; ai < 2; ++ai) {
            u32x4 gv[4][2], yv[4][2];
            if (MODE != 2) {
#pragma unroll
                for (int m = 0; m < 4; ++m)
#pragma unroll
                    for (int bj = 0; bj < 2; ++bj) { const size_t off = (size_t)(row0 + ai * 128 + m * 16) * ldc + col0 + bj * 128;
                        gv[m][bj] = *(const u32x4*)(G + off); if (MODE == 1) yv[m][bj] = *(const u32x4*)(Y + off); }
            }
#pragma unroll
            for (int m = 0; m < 4; ++m)
#pragma unroll
                for (int bj = 0; bj < 2; ++bj) { const size_t off = (size_t)(row0 + ai * 128 + m * 16) * ldc + col0 + bj * 128;
                    f32x4 v0 = acc[ai][bj][m][0], v1 = acc[ai][bj][m][1];
                    if (MODE == 2) {
#pragma unroll
                        for (int j = 0; j < 4; ++j) { float a = fmaxf(v0[j], 0.f), b = fmaxf(v1[j], 0.f); v0[j] = a * a; v1[j] = b * b; }
                    } else {
                        const u32x4 g = gv[m][bj];
                        v0[0] *= sigmoidf_(bflo(g.x)); v0[1] *= sigmoidf_(bfhi(g.x)); v0[2] *= sigmoidf_(bflo(g.y)); v0[3] *= sigmoidf_(bfhi(g.y));
                        v1[0] *= sigmoidf_(bflo(g.z)); v1[1] *= sigmoidf_(bfhi(g.z)); v1[2] *= sigmoidf_(bflo(g.w)); v1[3] *= sigmoidf_(bfhi(g.w));
                        if (MODE == 1) { const u32x4 y = yv[m][bj];
                            v0[0] += bflo(y.x); v0[1] += bfhi(y.x); v0[2] += bflo(y.y); v0[3] += bfhi(y.y);
                            v1[0] += bflo(y.z); v1[1] += bfhi(y.z); v1[2] += bflo(y.w); v1[3] += bfhi(y.w); }
                    }
                    *(u32x4*)(O + off) = pack8(v0, v1); }
        }
    }
};
struct EpiRes {
    static constexpr bool PERM = false;
    float* X1; const float* xp; const float* xs; const float* gate;
    __device__ __forceinline__ void operator()(const AccT& acc, const Unit& u, int wr, int wc, int fr, int fq) const {
        const int row0 = u.pm * 256 + wr * 64 + fr, col0 = u.pn * 256 + wc * 32 + 4 * fq;
        const float* src = xp ? xp : X1;
        const float* gr = gate + (size_t)(u.pm >> 3) * 6144 + col0;
        f32x4 gv[2][2];
#pragma unroll
        for (int bj = 0; bj < 2; ++bj)
#pragma unroll
            for (int n = 0; n < 2; ++n) gv[bj][n] = *(const f32x4*)(gr + bj * 128 + n * 16);
#pragma unroll
        for (int ai = 0; ai < 2; ++ai) {
            f32x4 xv[4][2][2];
#pragma unroll
            for (int m = 0; m < 4; ++m)
#pragma unroll
                for (int bj = 0; bj < 2; ++bj)
#pragma unroll
                    for (int n = 0; n < 2; ++n) xv[m][bj][n] = *(const f32x4*)(src + (size_t)(row0 + ai * 128 + m * 16) * D + col0 + bj * 128 + n * 16);
#pragma unroll
            for (int m = 0; m < 4; ++m)
#pragma unroll
                for (int bj = 0; bj < 2; ++bj)
#pragma unroll
                    for (int n = 0; n < 2; ++n) *(f32x4*)(X1 + (size_t)(row0 + ai * 128 + m * 16) * D + col0 + bj * 128 + n * 16) = xv[m][bj][n] + gv[bj][n] * acc[ai][bj][m][n];
        }
    }
};

template <int KS, class Epi>
__device__ __forceinline__ void skinny_gemm(LAS unsigned char* lds, const bf16_t* A, const bf16_t* Bt, int N, int K, const Epi& E) {
    constexpr int RT = 8 / KS;
    const int tid = fresh_tid(), lane = tid & 63, w = __builtin_amdgcn_readfirstlane(tid >> 6), fr = lane & 15, fq = lane >> 4;
    const int nitems = (N / 16) * KS, klen = K / KS;
    LAS f32x4* red = (LAS f32x4*)lds;
    for (int it = blockIdx.x; it < nitems; it += gridDim.x) {
        const int ct = it / KS, rg = it % KS, rt = rg * RT + (w % RT), kq = w / RT;
        const bf16_t* ap = A + (size_t)(16 * rt + fr) * K + kq * klen + fq * 8;
        const bf16_t* bp = Bt + (size_t)(16 * ct + fr) * K + kq * klen + fq * 8;
        f32x4 acc0 = (f32x4){0.f, 0.f, 0.f, 0.f}, acc1 = acc0;
        for (int k = 0; k < klen; k += 256) {
            bf16x8 a[8], b[8];
#pragma unroll
            for (int j = 0; j < 8; ++j) { a[j] = *(const bf16x8*)(ap + k + 32 * j); b[j] = *(const bf16x8*)(bp + k + 32 * j); }
#pragma unroll
            for (int j = 0; j < 8; j += 2) { acc0 = __builtin_amdgcn_mfma_f32_16x16x32_bf16(b[j], a[j], acc0, 0, 0, 0); acc1 = __builtin_amdgcn_mfma_f32_16x16x32_bf16(b[j + 1], a[j + 1], acc1, 0, 0, 0); }
        }
        f32x4 acc = acc0 + acc1;
        if (KS > 1) {
            if (kq > 0) red[w * 64 + lane] = acc;
            __syncthreads();
            if (kq == 0) {
#pragma unroll
                for (int q = 1; q < KS; ++q) acc = acc + red[(w + q * RT) * 64 + lane];
                E(16 * rt + fr, 16 * ct + 4 * fq, acc);
            }
            __syncthreads();
        } else E(16 * rt + fr, 16 * ct + 4 * fq, acc);
    }
}
__device__ __forceinline__ u32x2 pack4(const f32x4 v) { u32x2 o; o.x = cvt_pk_bf16(v[0], v[1]); o.y = cvt_pk_bf16(v[2], v[3]); return o; }
template <int MODE> struct SkGate {
    bf16_t* O; const bf16_t* G; const bf16_t* Y; int ldc;
    __device__ __forceinline__ void operator()(int r, int c, f32x4 v) const {
        const size_t off = (size_t)(MP + r) * ldc + c;
        if (MODE == 2) {
#pragma unroll
            for (int j = 0; j < 4; ++j) { const float a = fmaxf(v[j], 0.f); v[j] = a * a; }
        } else {
            const f32x4 g = cv4(*(const u32x2*)(G + off));
#pragma unroll
            for (int j = 0; j < 4; ++j) v[j] *= sigmoidf_(g[j]);
            if (MODE == 1) v = v + cv4(*(const u32x2*)(Y + off));
        }
        *(u32x2*)(O + off) = pack4(v);
    }
};
struct SkRes {
    float* X1; const float* xs; const float* gate;
    __device__ __forceinline__ void operator()(int r, int c, f32x4 v) const {
        float* o = X1 + (size_t)(MP + r) * D + c;
        const f32x4 src = xs ? *(const f32x4*)(xs + (size_t)r * D + c) : *(const f32x4*)o;
        *(f32x4*)o = src + *(const f32x4*)(gate + (size_t)(NBP + r) * 6144 + c) * v;
    }
};

__device__ __forceinline__ int win_dest(int n) {
    if (n < 1024) return n;
    if (n < 2048) { const int j = n - 1024; return 1024 + (j >> 7) * 256 + (j & 127); }
    if (n < 3072) { const int j = n - 2048; return 1024 + (j >> 7) * 256 + 128 + (j & 127); }
    if (n < 8192) return n;
    if (n < 8224) return 10240 + (n - 8192);
    return n - 32;
}
__device__ __forceinline__ void transpose_tile(const float* W, int K, int N, bf16_t* WT, int kt, int ntile, bool remap, const float* kscale, LAS float* scr) {
    const int tid = threadIdx.x, k0 = kt * 64, n0 = ntile * 64, nl = tid & 63, ks = tid >> 6, n = n0 + nl;
#pragma unroll
    for (int i = 0; i < 8; ++i) { const int k = ks + 8 * i; float v = (n < N) ? W[(size_t)(k0 + k) * N + n] : 0.f; if (kscale) v *= kscale[k0 + k]; scr[nl * 65 + k] = v; }
    __syncthreads();
    const int nr = tid >> 3, kc = (tid & 7) * 8, ns = n0 + nr;
    if (ns < N) {
        const int dr = remap ? win_dest(ns) : ns;
        const LAS float* s = scr + nr * 65 + kc;
        u32x4 o; o.x = cvt_pk_bf16(s[0], s[1]); o.y = cvt_pk_bf16(s[2], s[3]); o.z = cvt_pk_bf16(s[4], s[5]); o.w = cvt_pk_bf16(s[6], s[7]);
        *(u32x4*)(WT + (size_t)dr * K + k0 + kc) = o;
    }
    __syncthreads();
}
__device__ __forceinline__ void phase0(const Params& p, LAS unsigned char* lds, int part) {
    LAS float* scr = (LAS float*)lds;
    unsigned char* ws = p.ws;
    constexpr int T_ADA = 16 * 96, T_IN = 16 * 161, T_AO = 16 * 16, T_BO = 32 * 16, T_O = 16 * 16, T_1 = 16 * 64, T_2 = 64 * 16;
    constexpr int TOT = T_ADA + T_IN + T_AO + T_BO + T_O + T_1 + T_2;
    constexpr int NMOD = 24;
    if (part == 0) {
        for (int it = blockIdx.x; it < T_ADA; it += gridDim.x) transpose_tile(p.in[I_WADA], 1024, 6144, (bf16_t*)(ws + OFF_WADA), it / 96, it % 96, false, nullptr, scr);
        bf16_t* cA = (bf16_t*)(ws + OFF_CA);
        for (int i = blockIdx.x * 512 + threadIdx.x; i < (NBP + NBS) * D; i += gridDim.x * 512) {
            const int row = i >> 10, k = i & 1023;
            const float v = row < NBP ? p.in[I_CP][row * D + k] : p.in[I_CS][(row - NBP) * D + k];
            cA[i] = f2bf(siluf_(v));
        }
        return;
    }
    if (part == 1) {
        for (int r = (int)blockIdx.x - NMOD; r < T_IN; r += (int)gridDim.x - NMOD) transpose_tile(p.in[I_WIN], 1024, DIN, (bf16_t*)(ws + OFF_WIN), r / 161, r % 161, true, nullptr, scr);
        return;
    }
    constexpr int FIRST2 = (65 * 41) % 256;
    const int nw2 = (int)gridDim.x > FIRST2 ? (int)gridDim.x - FIRST2 : (int)gridDim.x, w2 = (int)gridDim.x > FIRST2 ? (int)blockIdx.x - FIRST2 : (int)blockIdx.x;
    if (w2 < 0) return;
    for (int it = w2; it < T_AO + T_BO + T_O + T_1 + T_2; it += nw2) {
        int r = it;
        if (r < T_AO) { transpose_tile(p.in[I_WAOUT], 1024, 1024, (bf16_t*)(ws + OFF_WAOUT), r / 16, r % 16, false, nullptr, scr); continue; } r -= T_AO;
        if (r < T_BO) { transpose_tile(p.in[I_WBOUT], 2048, 1024, (bf16_t*)(ws + OFF_WBOUT), r / 16, r % 16, false, p.in[I_SNG], scr); continue; } r -= T_BO;
        if (r < T_O) { transpose_tile(p.in[I_WO], 1024, 1024, (bf16_t*)(ws + OFF_WO), r / 16, r % 16, false, nullptr, scr); continue; } r -= T_O;
        if (r < T_1) { transpose_tile(p.in[I_W1], 1024, 4096, (bf16_t*)(ws + OFF_W1), r / 64, r % 64, false, nullptr, scr); continue; } r -= T_1;
        transpose_tile(p.in[I_W2], 4096, 1024, (bf16_t*)(ws + OFF_W2), r / 16, r % 16, false, nullptr, scr);
    }
}

__device__ __forceinline__ void rownorm_mod(const float* xrow, const float* g, const float* sc, const float* sh, bf16_t* orow, int lane) {
    f32x4 v[4]; float s = 0.f;
#pragma unroll
    for (int j = 0; j < 4; ++j) { v[j] = ((const f32x4*)xrow)[lane + 64 * j]; s += (v[j][0] * v[j][0] + v[j][1] * v[j][1]) + (v[j][2] * v[j][2] + v[j][3] * v[j][3]); }
    const float rstd = rsqrtf(wave_sum(s) * (1.f / D) + EPS);
#pragma unroll
    for (int j = 0; j < 4; ++j) { const int i4 = lane + 64 * j;
        const f32x4 gg = ((const f32x4*)g)[i4], scv = ((const f32x4*)sc)[i4], shv = ((const f32x4*)sh)[i4];
        const f32x4 o = v[j] * rstd * gg * (scv + 1.f) + shv;
        u32x2 w; w.x = cvt_pk_bf16(o[0], o[1]); w.y = cvt_pk_bf16(o[2], o[3]);
        ((u32x2*)orow)[i4] = w; }
}
__device__ __forceinline__ void phase_rownorm(const Params& p, const float* xp, const float* xs, const float* gvec, int sc_off, int sh_off, bf16_t* U) {
    const int tid_ = fresh_tid(), lane = tid_ & 63, gw = blockIdx.x * 8 + (tid_ >> 6), NW = gridDim.x * 8;
    const float* mod = (const float*)(p.ws + OFF_MOD);
    for (int row = gw; row < MTOT; row += NW) {
        const int seq = row < MP ? (row >> 11) : (NBP + row - MP);
        const float* xrow = row < MP ? xp + (size_t)row * D : xs + (size_t)(row - MP) * D;
        rownorm_mod(xrow, gvec, mod + (size_t)seq * 6144 + sc_off, mod + (size_t)seq * 6144 + sh_off, U + (size_t)row * D, lane);
    }
}
__device__ __forceinline__ void phase_final(const Params& p) {
    const int tid_ = fresh_tid(), lane = tid_ & 63, gw = blockIdx.x * 8 + (tid_ >> 6), NW = gridDim.x * 8;
    const float* X = (const float*)(p.ws + OFF_X1); const float* g = p.in[I_NFG];
    for (int row = gw; row < MTOT; row += NW) {
        const float* xrow = X + (size_t)row * D;
        float* orow = row < MP ? p.out + O_YP + (size_t)row * D : p.out + O_YS + (size_t)(row - MP) * D;
        f32x4 v[4]; float s = 0.f;
#pragma unroll
        for (int j = 0; j < 4; ++j) { v[j] = ((const f32x4*)xrow)[lane + 64 * j]; s += (v[j][0] * v[j][0] + v[j][1] * v[j][1]) + (v[j][2] * v[j][2] + v[j][3] * v[j][3]); }
        const float rstd = rsqrtf(wave_sum(s) * (1.f / D) + EPS);
#pragma unroll
        for (int j = 0; j < 4; ++j) ((f32x4*)orow)[lane + 64 * j] = v[j] * rstd * ((const f32x4*)g)[lane + 64 * j];
    }
}

struct F8 { f32x4 a, b; };
__device__ __forceinline__ F8 ld8bf(const bf16_t* p) { const u32x4 u = *(const u32x4*)p; F8 r; r.a = (f32x4){bflo(u.x), bfhi(u.x), bflo(u.y), bfhi(u.y)}; r.b = (f32x4){bflo(u.z), bfhi(u.z), bflo(u.w), bfhi(u.w)}; return r; }
__device__ __forceinline__ F8 cv8(const u32x4 u) { F8 r; r.a = (f32x4){bflo(u.x), bfhi(u.x), bflo(u.y), bfhi(u.y)}; r.b = (f32x4){bflo(u.z), bfhi(u.z), bflo(u.w), bfhi(u.w)}; return r; }
__device__ __forceinline__ F8 ld8f(const float* p) { F8 r; r.a = *(const f32x4*)p; r.b = *(const f32x4*)(p + 4); return r; }
__device__ __forceinline__ void st8f(float* p, const F8& v) { *(f32x4*)p = v.a; *(f32x4*)(p + 4) = v.b; }
__device__ __forceinline__ F8 zero8() { F8 r; r.a = (f32x4){0.f, 0.f, 0.f, 0.f}; r.b = r.a; return r; }
__device__ __forceinline__ void phase_conv(const Params& p, LAS unsigned char* lds) {
    unsigned char* ws = p.ws;
    const bf16_t* BG = (const bf16_t*)(ws + OFF_BG); const bf16_t* CI = (const bf16_t*)(ws + OFF_CI); const bf16_t* XBC = (const bf16_t*)(ws + OFF_XBC);
    bf16_t* VA = (bf16_t*)(ws + OFF_VA); bf16_t* XC = (bf16_t*)(ws + OFF_XBCC);
    const int tid = threadIdx.x;
    for (int it = blockIdx.x; it < MP / 8 + NBS; it += gridDim.x) {
        if (it < MP / 8) {
            const int r0 = it * 8, tpos0 = r0 & (SEQ - 1), b = r0 >> 11;
            if (tid < 128) {
                const int ch = tid * 8;
                u32x4 raw[10], bgr[8];
#pragma unroll
                for (int i = 0; i < 10; ++i) raw[i] = (tpos0 - 2 + i >= 0) ? *(const u32x4*)(CI + (size_t)(r0 - 2 + i) * 1024 + ch) : (u32x4){0u, 0u, 0u, 0u};
#pragma unroll
                for (int i = 0; i < 8; ++i) bgr[i] = *(const u32x4*)(BG + (size_t)(r0 + i) * 1024 + ch);
                const F8 w0 = ld8f(p.in[I_CAW] + ch), w1 = ld8f(p.in[I_CAW] + 1024 + ch), w2 = ld8f(p.in[I_CAW] + 2048 + ch);
#pragma unroll
                for (int i = 0; i < 8; ++i) { const F8 p2 = cv8(raw[i]), p1 = cv8(raw[i + 1]), c0 = cv8(raw[i + 2]), bg = cv8(bgr[i]);
                    const f32x4 va = bg.a * (w0.a * p2.a + w1.a * p1.a + w2.a * c0.a), vb = bg.b * (w0.b * p2.b + w1.b * p1.b + w2.b * c0.b);
                    *(u32x4*)(VA + (size_t)(r0 + i) * 1024 + ch) = pack8(va, vb);
                    if (tpos0 + i >= SEQ - 2) st8f(p.out + O_SCP + ((size_t)b * 2 + (tpos0 + i - (SEQ - 2))) * 1024 + ch, c0); }
            } else {
                const int ch = (tid - 128) * 8;
                u32x4 raw[11];
#pragma unroll
                for (int i = 0; i < 11; ++i) raw[i] = (tpos0 - 3 + i >= 0) ? *(const u32x4*)(XBC + (size_t)(r0 - 3 + i) * 3072 + ch) : (u32x4){0u, 0u, 0u, 0u};
                const F8 w0 = ld8f(p.in[I_CBW] + ch), w1 = ld8f(p.in[I_CBW] + 3072 + ch), w2 = ld8f(p.in[I_CBW] + 6144 + ch), w3 = ld8f(p.in[I_CBW] + 9216 + ch), bb = ld8f(p.in[I_CBB] + ch);
#pragma unroll
                for (int i = 0; i < 8; ++i) { const F8 p3 = cv8(raw[i]), p2 = cv8(raw[i + 1]), p1 = cv8(raw[i + 2]), c0 = cv8(raw[i + 3]);
                    f32x4 va = w0.a * p3.a + w1.a * p2.a + w2.a * p1.a + w3.a * c0.a + bb.a, vb = w0.b * p3.b + w1.b * p2.b + w2.b * p1.b + w3.b * c0.b + bb.b;
#pragma unroll
                    for (int j = 0; j < 4; ++j) { va[j] = siluf_(va[j]); vb[j] = siluf_(vb[j]); }
                    *(u32x4*)(XC + (size_t)(r0 + i) * 3072 + ch) = pack8(va, vb);
                    if (tpos0 + i >= SEQ - 3) st8f(p.out + O_SBP + ((size_t)b * 3 + (tpos0 + i - (SEQ - 3))) * 3072 + ch, c0); }
            }
        } else {
            const int b = it - MP / 8, row = MP + b;
            if (tid < 128) {
                const int ch = tid * 8;
                const F8 c0 = ld8bf(CI + (size_t)row * 1024 + ch);
                const F8 p2 = ld8f(p.in[I_STA] + ((size_t)b * 2 + 0) * 1024 + ch), p1 = ld8f(p.in[I_STA] + ((size_t)b * 2 + 1) * 1024 + ch);
                const F8 w0 = ld8f(p.in[I_CAW] + ch), w1 = ld8f(p.in[I_CAW] + 1024 + ch), w2 = ld8f(p.in[I_CAW] + 2048 + ch);
                const F8 bg = ld8bf(BG + (size_t)row * 1024 + ch);
                const f32x4 va = bg.a * (w0.a * p2.a + w1.a * p1.a + w2.a * c0.a), vb = bg.b * (w0.b * p2.b + w1.b * p1.b + w2.b * c0.b);
                *(u32x4*)(VA + (size_t)row * 1024 + ch) = pack8(va, vb);
                st8f(p.out + O_SCS + ((size_t)b * 2 + 0) * 1024 + ch, p1); st8f(p.out + O_SCS + ((size_t)b * 2 + 1) * 1024 + ch, c0);
            } else {
                const int ch = (tid - 128) * 8;
                const F8 c0 = ld8bf(XBC + (size_t)row * 3072 + ch);
                const F8 p3 = ld8f(p.in[I_STB] + ((size_t)b * 3 + 0) * 3072 + ch), p2 = ld8f(p.in[I_STB] + ((size_t)b * 3 + 1) * 3072 + ch), p1 = ld8f(p.in[I_STB] + ((size_t)b * 3 + 2) * 3072 + ch);
                const F8 w0 = ld8f(p.in[I_CBW] + ch), w1 = ld8f(p.in[I_CBW] + 3072 + ch), w2 = ld8f(p.in[I_CBW] + 6144 + ch), w3 = ld8f(p.in[I_CBW] + 9216 + ch), bb = ld8f(p.in[I_CBB] + ch);
                f32x4 va = w0.a * p3.a + w1.a * p2.a + w2.a * p1.a + w3.a * c0.a + bb.a, vb = w0.b * p3.b + w1.b * p2.b + w2.b * p1.b + w3.b * c0.b + bb.b;
#pragma unroll
                for (int j = 0; j < 4; ++j) { va[j] = siluf_(va[j]); vb[j] = siluf_(vb[j]); }
                *(u32x4*)(XC + (size_t)row * 3072 + ch) = pack8(va, vb);
                st8f(p.out + O_SBS + ((size_t)b * 3 + 0) * 3072 + ch, p2); st8f(p.out + O_SBS + ((size_t)b * 3 + 1) * 3072 + ch, p1); st8f(p.out + O_SBS + ((size_t)b * 3 + 2) * 3072 + ch, c0);
            }
        }
    }
    const float* DTR = (const float*)(ws + OFF_DTRAW); float* DTP = (float*)(ws + OFF_DTP); float* ACS = (float*)(ws + OFF_ACS);
    LAS float* t1 = (LAS float*)lds; LAS float* t2 = t1 + 128 * 33;
    for (int it = blockIdx.x; it < 129; it += gridDim.x) {
        const int t0 = it * 128;
#pragma unroll
        for (int i = 0; i < 8; ++i) { const int idx = tid + 512 * i, r = idx >> 5, hh = idx & 31;
            const float raw = DTR[(size_t)(t0 + r) * 32 + hh] + p.in[I_DTB][hh];
            t1[r * 33 + hh] = raw > 20.f ? raw : log1pf(expf(raw)); }
        __syncthreads();
        if (tid < 32) { const float a = -expf(p.in[I_ALOG][tid]); float run = 0.f;
            for (int s = 0; s < 128; ++s) { run += t1[s * 33 + tid] * a; t2[s * 33 + tid] = run; } }
        __syncthreads();
#pragma unroll
        for (int i = 0; i < 8; ++i) { const int idx = tid + 512 * i, r = idx >> 5, hh = idx & 31;
            DTP[(size_t)(t0 + r) * 32 + hh] = t1[r * 33 + hh]; ACS[(size_t)(t0 + r) * 32 + hh] = t2[r * 33 + hh]; }
        __syncthreads();
    }
}

constexpr int RS = 272, RX = 144;
constexpr int L_C = 0, L_B = 34816, L_X = 69632, L_XW = 88064, L_H = 106496, L_ACS = 123904, L_DT = 124416;
__device__ __forceinline__ bf16x8 tr_frag(LAS unsigned char* base, int rstride, int k0, int c0, int lane) {
    const int i = lane & 15, g = lane >> 4, q = i >> 2, pp = i & 3;
    LAS unsigned char* a = base + (k0 + 8 * g + q) * rstride + (c0 + 4 * pp) * 2;
    const bf16x4 lo = __builtin_amdgcn_ds_read_tr16_b64_v4i16((LAS bf16x4*)a);
    const bf16x4 hi = __builtin_amdgcn_ds_read_tr16_b64_v4i16((LAS bf16x4*)(a + 4 * rstride));
    return (bf16x8){lo[0], lo[1], lo[2], lo[3], hi[0], hi[1], hi[2], hi[3]};
}
constexpr int L_RED = 124928, L_CF = 125056;
__device__ __forceinline__ void ssd_unit(const Params& p, LAS unsigned char* lds, int b, int h, int sbase) {
    unsigned char* ws = p.ws;
    const bf16_t* XC = (const bf16_t*)(ws + OFF_XBCC); const bf16_t* Z = (const bf16_t*)(ws + OFF_Z);
    const float* DTP = (const float*)(ws + OFF_DTP); const float* ACS = (const float*)(ws + OFF_ACS);
    bf16_t* YG = (bf16_t*)(ws + OFF_YG); float* SSQ = (float*)(ws + OFF_SSQ);
    const int tid = fresh_tid(), lane = tid & 63, w = __builtin_amdgcn_readfirstlane(tid >> 6), fr = lane & 15, fq = lane >> 4, g = h >> 3;
    const float Dh = p.in[I_DSKIP][h];
    LAS float* sAcs = (LAS float*)(lds + L_ACS); LAS float* sDt = (LAS float*)(lds + L_DT); LAS float* red = (LAS float*)(lds + L_RED);
    f32x4 hacc[4];
#pragma unroll
    for (int i = 0; i < 4; ++i) hacc[i] = (f32x4){0.f, 0.f, 0.f, 0.f};
    const int hpt = w & 3, hnb = (w >> 2) * 4;
    const int n4 = tid & 31, pr = tid >> 5;
    u32x4 rc[4], rb[4], rx[2]; float wv[2], my_acs = 0.f, my_dt = 0.f, acs_last_n;
#define SSD_PREFETCH(cc) do { const int _t0 = b * SEQ + (cc) * 128; \
        { const int ch = tid & 15, row = tid >> 4; _Pragma("unroll") for (int i = 0; i < 4; ++i) { const bf16_t* src = XC + (size_t)(_t0 + row + 32 * i) * 3072; rb[i] = *(const u32x4*)(src + 2048 + g * 128 + ch * 8); rc[i] = *(const u32x4*)(src + 2560 + g * 128 + ch * 8); } } \
        acs_last_n = ACS[(size_t)(_t0 + 127) * 32 + h]; \
        { const int ch = tid & 7, row = tid >> 3; _Pragma("unroll") for (int i = 0; i < 2; ++i) { const int r = _t0 + row + 64 * i; rx[i] = *(const u32x4*)(XC + (size_t)r * 3072 + h * 64 + ch * 8); \
              wv[i] = __expf(acs_last_n - ACS[(size_t)r * 32 + h]) * DTP[(size_t)r * 32 + h]; } } \
        if (tid < 128) { my_acs = ACS[(size_t)(_t0 + tid) * 32 + h]; my_dt = DTP[(size_t)(_t0 + tid) * 32 + h]; } } while (0)
    SSD_PREFETCH(0);
    int prev_sr = -1, prev_sh = 0;
    for (int c = 0; c < SEQ / 128; ++c) {
        const int t0 = b * SEQ + c * 128;
        __syncthreads();
        if (tid == 0 && prev_sr >= 0) { float v = 0.f;
#pragma unroll
            for (int i = 0; i < 16; ++i) v += red[i];
            SSQ[(size_t)prev_sr * 32 + prev_sh] = v; }
#pragma unroll
        for (int i = 0; i < 4; ++i) { u32x2 o; o.x = cvt_pk_bf16(hacc[i][0], hacc[i][1]); o.y = cvt_pk_bf16(hacc[i][2], hacc[i][3]);
            *(LAS u32x2*)(lds + L_H + (16 * hpt + fr) * RS + (16 * (hnb + i) + 4 * fq) * 2) = o; }
        { const int ch = tid & 15, row = tid >> 4;
#pragma unroll
          for (int i = 0; i < 4; ++i) { *(LAS u32x4*)(lds + L_B + (row + 32 * i) * RS + ch * 16) = rb[i]; *(LAS u32x4*)(lds + L_C + (row + 32 * i) * RS + ch * 16) = rc[i]; } }
        { const int ch = tid & 7, row = tid >> 3;
#pragma unroll
          for (int i = 0; i < 2; ++i) { *(LAS u32x4*)(lds + L_X + (row + 64 * i) * RX + ch * 16) = rx[i];
              const float s = wv[i]; u32x4 o;
              o.x = cvt_pk_bf16(bflo(rx[i].x) * s, bfhi(rx[i].x) * s); o.y = cvt_pk_bf16(bflo(rx[i].y) * s, bfhi(rx[i].y) * s);
              o.z = cvt_pk_bf16(bflo(rx[i].z) * s, bfhi(rx[i].z) * s); o.w = cvt_pk_bf16(bflo(rx[i].w) * s, bfhi(rx[i].w) * s);
              *(LAS u32x4*)(lds + L_XW + (row + 64 * i) * RX + ch * 16) = o; } }
        if (tid < 128) { sAcs[tid] = my_acs; sDt[tid] = my_dt; }
        const float acs_last = acs_last_n;
        __syncthreads();
        const int qt = w < 4 ? w : 11 - w, qrow = 16 * qt + fr;
        const size_t trow = (size_t)(t0 + qrow);
        u32x2 zv[4];
#pragma unroll
        for (int pt = 0; pt < 4; ++pt) zv[pt] = *(const u32x2*)(Z + trow * 2048 + h * 64 + 16 * pt + 4 * fq);
        const int sit = sbase + 256 * c; const bool has_s = sit < NBS * NH;
        const int sb = sit >> 5, sh = sit & 31, sr = MP + sb, sg = sh >> 3;
        f32x4 h0[4]; u32x2 sbu, scu; float sdt = 0.f, sxv[4], szv[4];
        const size_t sbase_off = (((size_t)sb * NH + sh) * HD) * DS;
        if (has_s) {
            const bf16_t* xr = XC + (size_t)sr * 3072;
#pragma unroll
            for (int i = 0; i < 4; ++i) { const int pp = pr + 16 * i; h0[i] = __builtin_nontemporal_load((const f32x4*)(p.in[I_STS] + sbase_off + (size_t)pp * DS + 4 * n4));
                sxv[i] = bf2f(xr[sh * 64 + pp]); szv[i] = bf2f(Z[(size_t)sr * 2048 + sh * 64 + pp]); }
            sbu = *(const u32x2*)(xr + 2048 + sg * 128 + 4 * n4); scu = *(const u32x2*)(xr + 2560 + sg * 128 + 4 * n4);
            sdt = DTP[(size_t)sr * 32 + sh];
        }
        bf16x8 cf[4];
#pragma unroll
        for (int kk = 0; kk < 4; ++kk) cf[kk] = *(const LAS bf16x8*)(lds + L_C + qrow * RS + (kk * 32 + fq * 8) * 2);
        f32x4 yacc[4];
#pragma unroll
        for (int i = 0; i < 4; ++i) yacc[i] = (f32x4){0.f, 0.f, 0.f, 0.f};
        const float acs_q = sAcs[qrow], acs_q0 = sAcs[16 * qt];
        LAS float* cfac = (LAS float*)(lds + L_CF) + w * 128;
#pragma unroll
        for (int i = 0; i < 2; ++i) { const int sidx = lane + 64 * i; if (sidx < 16 * qt) cfac[sidx] = __expf(acs_q0 - sAcs[sidx]) * sDt[sidx]; }
        const float r_q = __expf(acs_q - acs_q0);
        if (c > 0) {
#pragma unroll
            for (int pp = 0; pp < 2; ++pp) {
                bf16x8 hf[2][4];
#pragma unroll
                for (int a = 0; a < 2; ++a)
#pragma unroll
                    for (int kk = 0; kk < 4; ++kk) hf[a][kk] = *(const LAS bf16x8*)(lds + L_H + (16 * (2 * pp + a) + fr) * RS + (kk * 32 + fq * 8) * 2);
#pragma unroll
                for (int kk = 0; kk < 4; ++kk)
#pragma unroll
                    for (int a = 0; a < 2; ++a) yacc[2 * pp + a] = __builtin_amdgcn_mfma_f32_16x16x32_bf16(hf[a][kk], cf[kk], yacc[2 * pp + a], 0, 0, 0);
            }
            const float eq = __expf(acs_q);
#pragma unroll
            for (int pt = 0; pt < 4; ++pt) yacc[pt] = yacc[pt] * eq;
        }
        for (int sp = 0; 2 * sp <= qt; ++sp) {
            const bool two = 2 * sp + 1 <= qt;
            bf16x8 bfr[2][4];
#pragma unroll
            for (int kk = 0; kk < 4; ++kk) bfr[0][kk] = *(const LAS bf16x8*)(lds + L_B + (16 * (2 * sp) + fr) * RS + (kk * 32 + fq * 8) * 2);
            if (two) {
#pragma unroll
                for (int kk = 0; kk < 4; ++kk) bfr[1][kk] = *(const LAS bf16x8*)(lds + L_B + (16 * (2 * sp + 1) + fr) * RS + (kk * 32 + fq * 8) * 2);
            }
            f32x4 sacc[2];
            sacc[0] = (f32x4){0.f, 0.f, 0.f, 0.f}; sacc[1] = sacc[0];
#pragma unroll
            for (int kk = 0; kk < 4; ++kk) sacc[0] = __builtin_amdgcn_mfma_f32_16x16x32_bf16(bfr[0][kk], cf[kk], sacc[0], 0, 0, 0);
            if (two) {
#pragma unroll
                for (int kk = 0; kk < 4; ++kk) sacc[1] = __builtin_amdgcn_mfma_f32_16x16x32_bf16(bfr[1][kk], cf[kk], sacc[1], 0, 0, 0);
            }
#pragma unroll
            for (int a = 0; a < 2; ++a) { const int st = 2 * sp + a, s0 = 16 * st + 4 * fq;
                float pv[4];
                if (st < qt) { const f32x4 cc = *(const LAS f32x4*)(cfac + s0);
#pragma unroll
                    for (int j = 0; j < 4; ++j) pv[j] = sacc[a][j] * r_q * cc[j];
                } else if (st == qt) { const f32x4 as = *(const LAS f32x4*)(sAcs + s0), ds = *(const LAS f32x4*)(sDt + s0);
#pragma unroll
                    for (int j = 0; j < 4; ++j) pv[j] = (s0 + j <= qrow) ? sacc[a][j] * __expf(acs_q - as[j]) * ds[j] : 0.f;
                } else {
#pragma unroll
                    for (int j = 0; j < 4; ++j) pv[j] = 0.f;
                }
                u32x2 o; o.x = cvt_pk_bf16(pv[0], pv[1]); o.y = cvt_pk_bf16(pv[2], pv[3]);
                *(LAS u32x2*)(lds + L_C + qrow * RS + s0 * 2) = o; }
        }
        if (c + 1 < SEQ / 128) SSD_PREFETCH(c + 1);
        for (int kk = 0; kk <= (qt >> 1); ++kk) {
            bf16x8 xf[4];
            const bf16x8 pf = *(const LAS bf16x8*)(lds + L_C + qrow * RS + (kk * 32 + fq * 8) * 2);
#pragma unroll
            for (int pt = 0; pt < 4; ++pt) xf[pt] = tr_frag(lds + L_X, RX, kk * 32, 16 * pt, lane);
#pragma unroll
            for (int pt = 0; pt < 4; ++pt) yacc[pt] = __builtin_amdgcn_mfma_f32_16x16x32_bf16(xf[pt], pf, yacc[pt], 0, 0, 0);
        }
        { float ss = 0.f;
#pragma unroll
          for (int pt = 0; pt < 4; ++pt) { const int pc = 16 * pt + 4 * fq;
              const u32x2 xv = *(const LAS u32x2*)(lds + L_X + qrow * RX + pc * 2);
              const float x0 = bflo(xv.x), x1 = bfhi(xv.x), x2 = bflo(xv.y), x3 = bfhi(xv.y);
              const float g0 = (yacc[pt][0] + Dh * x0) * siluf_(bflo(zv[pt].x)), g1 = (yacc[pt][1] + Dh * x1) * siluf_(bfhi(zv[pt].x));
              const float g2 = (yacc[pt][2] + Dh * x2) * siluf_(bflo(zv[pt].y)), g3 = (yacc[pt][3] + Dh * x3) * siluf_(bfhi(zv[pt].y));
              ss += (g0 * g0 + g1 * g1) + (g2 * g2 + g3 * g3);
              u32x2 o; o.x = cvt_pk_bf16(g0, g1); o.y = cvt_pk_bf16(g2, g3);
              *(u32x2*)(YG + trow * 2048 + h * 64 + pc) = o; }
          ss += __shfl_xor(ss, 16); ss += __shfl_xor(ss, 32);
          if (fq == 0) SSQ[trow * 32 + h] = ss; }
        { const float dec = __expf(acs_last);
#pragma unroll
          for (int i = 0; i < 4; ++i) hacc[i] = hacc[i] * dec;
#pragma unroll
          for (int kp = 0; kp < 2; ++kp) {
              bf16x8 xwf[2], bf[2][4];
#pragma unroll
              for (int a = 0; a < 2; ++a) { const int kk = 2 * kp + a;
                  xwf[a] = tr_frag(lds + L_XW, RX, kk * 32, 16 * hpt, lane);
#pragma unroll
                  for (int i = 0; i < 4; ++i) bf[a][i] = tr_frag(lds + L_B, RS, kk * 32, 16 * (hnb + i), lane); }
              __builtin_amdgcn_sched_barrier(0);
#pragma unroll
              for (int a = 0; a < 2; ++a)
#pragma unroll
                  for (int i = 0; i < 4; ++i) hacc[i] = __builtin_amdgcn_mfma_f32_16x16x32_bf16(bf[a][i], xwf[a], hacc[i], 0, 0, 0);
          } }
        prev_sr = -1;
        if (has_s) {
            const float dA = __expf(sdt * -expf(p.in[I_ALOG][sh])), sD = p.in[I_DSKIP][sh];
            const f32x4 Bv = cv4(sbu), Cv = cv4(scu);
            float part = 0.f;
#pragma unroll
            for (int i = 0; i < 4; ++i) { const int pp = pr + 16 * i;
                const f32x4 hn = h0[i] * dA + Bv * (sdt * sxv[i]);
                __builtin_nontemporal_store(hn, (f32x4*)(p.out + O_SSS + sbase_off + (size_t)pp * DS + 4 * n4));
                float y = (hn[0] * Cv[0] + hn[1] * Cv[1]) + (hn[2] * Cv[2] + hn[3] * Cv[3]);
#pragma unroll
                for (int o = 1; o < 32; o <<= 1) y += __shfl_xor(y, o);
                const float gt = (y + sD * sxv[i]) * siluf_(szv[i]);
                if (n4 == 0) YG[(size_t)sr * 2048 + sh * 64 + pp] = f2bf(gt);
                part += gt * gt; }
            if (n4 == 0) red[pr] = part;
            prev_sr = sr; prev_sh = sh;
        }
    }
#undef SSD_PREFETCH
    float* so = p.out + O_SSP + (((size_t)b * NH + h) * HD + 16 * hpt + fr) * DS;
#pragma unroll
    for (int i = 0; i < 4; ++i) *(f32x4*)(so + 16 * (hnb + i) + 4 * fq) = hacc[i];
    __syncthreads();
    if (tid == 0 && prev_sr >= 0) { float v = 0.f;
#pragma unroll
        for (int i = 0; i < 16; ++i) v += red[i];
        SSQ[(size_t)prev_sr * 32 + prev_sh] = v; }
    __syncthreads();
}
__device__ __forceinline__ void phase_ssd(const Params& p, LAS unsigned char* lds) {
    for (int u = blockIdx.x; u < NBP * NH; u += gridDim.x) {
        const int xcd = u & 7, j = u >> 3, pair = xcd * 4 + (j >> 3), hr = j & 7;
        ssd_unit(p, lds, pair >> 2, (pair & 3) * 8 + hr, u);
    }
}
__device__ __forceinline__ void phase_gnorm(const Params& p) {
    bf16_t* YG = (bf16_t*)(p.ws + OFF_YG); const float* SSQ = (const float*)(p.ws + OFF_SSQ);
    for (int i = blockIdx.x * 512 + fresh_tid(); i < MTOT * 256; i += gridDim.x * 512) {
        const int row = i >> 8, cu = i & 255, g = cu >> 6;
        const f32x4 s0 = *(const f32x4*)(SSQ + (size_t)row * 32 + 8 * g), s1 = *(const f32x4*)(SSQ + (size_t)row * 32 + 8 * g + 4);
        const float rstd = rsqrtf(((s0[0] + s0[1]) + (s0[2] + s0[3]) + (s1[0] + s1[1]) + (s1[2] + s1[3])) * (1.f / 512.f) + EPS);
        bf16_t* q = YG + (size_t)row * 2048 + cu * 8;
        const F8 v = ld8bf(q);
        *(u32x4*)q = pack8(v.a * rstd, v.b * rstd);
    }
}

__global__ void __launch_bounds__(512, 2) fwd_megakernel(Params p) {
    extern __shared__ __attribute__((aligned(16))) unsigned char shm[];
    LAS unsigned char* lds = (LAS unsigned char*)shm;
    cg::grid_group grid = cg::this_grid();
    unsigned char* ws = p.ws;
    const int G = gridDim.x, cid = blockIdx.x;
    float* mod = (float*)(ws + OFF_MOD);
    pg8::StaticOrder S;
    volatile LAS unsigned* xst = (volatile LAS unsigned*)(lds + 131072);
    if (threadIdx.x == 0) { xst[0] = 0u; xst[1] = 0u; }
    __syncthreads();
    XcdBarrier xb = xcd_barrier_post((unsigned*)(ws + OFF_BAR), xst);

    phase0(p, lds, 0);
    if (p.ws == nullptr) grid.sync();
    GSYNC();
    if (cid < 24) {
        pg8::Gemm g{(const bf16_t*)(ws + OFF_CA), (const bf16_t*)(ws + OFF_WADA), 256, 6144, 1024};
        EpiF32Bias E{mod, 6144, p.in[I_BADA]};
        S.init(g.M, g.N, 24, cid); pg8::gemm_phase<EpiF32Bias, pg8::StaticOrder, true, true>(lds, g, S, E);
    } else phase0(p, lds, 1);
    GSYNC();
    phase_rownorm(p, p.in[I_XP], p.in[I_XS], p.in[I_N1G], 1024, 0, (bf16_t*)(ws + OFF_U));
    if (PROBE_EW) phase_rownorm(p, p.in[I_XP], p.in[I_XS], p.in[I_N1G], 1024, 0, (bf16_t*)(ws + OFF_U));
    GSYNC();
    {
        pg8::Gemm g{(const bf16_t*)(ws + OFF_U), (const bf16_t*)(ws + OFF_WIN), MPAD, DINP, 1024};
        EpiIn E{(bf16_t*)(ws + OFF_BG), (bf16_t*)(ws + OFF_CI), (bf16_t*)(ws + OFF_Z), (bf16_t*)(ws + OFF_XBC), (bf16_t*)(ws + OFF_GA), (bf16_t*)(ws + OFF_GB), (float*)(ws + OFF_DTRAW)};
        S.init(g.M, g.N, G, cid); pg8::gemm_phase<EpiIn, pg8::StaticOrder, true, true>(lds, g, S, E);
        if (PROBE_INPROJ) { __syncthreads(); pg8::gemm_phase<EpiIn, pg8::StaticOrder, true, true>(lds, g, S, E); }
        __syncthreads();
        phase0(p, lds, 2);
    }
    GSYNC();
    phase_conv(p, lds);
    if (PROBE_CONV) { __syncthreads(); phase_conv(p, lds); }
    GSYNC();
    phase_ssd(p, lds);
    if (PROBE_SSD) { __syncthreads(); phase_ssd(p, lds); }
    GSYNC();
    phase_gnorm(p);
    GSYNC();
    {
        pg8::Gemm ga{(const bf16_t*)(ws + OFF_VA), (const bf16_t*)(ws + OFF_WAOUT), MP, 1024, 1024};
        EpiGate<0> Ea{(bf16_t*)(ws + OFF_YA), (const bf16_t*)(ws + OFF_GA), nullptr, 1024};
        S.init(ga.M, ga.N, G, cid); pg8::gemm_phase<EpiGate<0>, pg8::StaticOrder, true, true>(lds, ga, S, Ea);
        __syncthreads();
        pg8::Gemm gb{(const bf16_t*)(ws + OFF_YG), (const bf16_t*)(ws + OFF_WBOUT), MP, 1024, 2048};
        EpiGate<1> Eb{(bf16_t*)(ws + OFF_MERGED), (const bf16_t*)(ws + OFF_GB), (const bf16_t*)(ws + OFF_YA), 1024};
        pg8::gemm_phase<EpiGate<1>, pg8::StaticOrder, true, true>(lds, gb, S, Eb);
        __syncthreads();
        SkGate<0> Sa{(bf16_t*)(ws + OFF_YA), (const bf16_t*)(ws + OFF_GA), nullptr, 1024};
        skinny_gemm<4>(lds, (const bf16_t*)(ws + OFF_VA) + (size_t)MP * 1024, (const bf16_t*)(ws + OFF_WAOUT), 1024, 1024, Sa);
        SkGate<1> Sb{(bf16_t*)(ws + OFF_MERGED), (const bf16_t*)(ws + OFF_GB), (const bf16_t*)(ws + OFF_YA), 1024};
        skinny_gemm<4>(lds, (const bf16_t*)(ws + OFF_YG) + (size_t)MP * 2048, (const bf16_t*)(ws + OFF_WBOUT), 1024, 2048, Sb);
    }
    GSYNC();
    {
        pg8::Gemm g{(const bf16_t*)(ws + OFF_MERGED), (const bf16_t*)(ws + OFF_WO), MP, 1024, 1024};
        EpiRes E{(float*)(ws + OFF_X1), p.in[I_XP], p.in[I_XS], mod + 2048};
        S.init(g.M, g.N, G, cid); pg8::gemm_phase<EpiRes, pg8::StaticOrder, true, true>(lds, g, S, E);
        __syncthreads();
        SkRes Sk{(float*)(ws + OFF_X1), p.in[I_XS], mod + 2048};
        skinny_gemm<4>(lds, (const bf16_t*)(ws + OFF_MERGED) + (size_t)MP * 1024, (const bf16_t*)(ws + OFF_WO), 1024, 1024, Sk);
    }
    GSYNC();
    {
        const float* X1 = (const float*)(ws + OFF_X1);
        phase_rownorm(p, X1, X1 + (size_t)MP * D, p.in[I_N2G], 4096, 3072, (bf16_t*)(ws + OFF_U));
        if (PROBE_EW) phase_rownorm(p, X1, X1 + (size_t)MP * D, p.in[I_N2G], 4096, 3072, (bf16_t*)(ws + OFF_U));
    }
    GSYNC();
    {
        pg8::Gemm g{(const bf16_t*)(ws + OFF_U), (const bf16_t*)(ws + OFF_W1), MP, DFF, 1024};
        EpiGate<2> E{(bf16_t*)(ws + OFF_HMID), nullptr, nullptr, DFF};
        S.init(g.M, g.N, G, cid); pg8::gemm_phase<EpiGate<2>, pg8::StaticOrder, true, true>(lds, g, S, E);
        if (PROBE_MLP1) { __syncthreads(); pg8::gemm_phase<EpiGate<2>, pg8::StaticOrder, true, true>(lds, g, S, E); }
        __syncthreads();
        SkGate<2> Sk{(bf16_t*)(ws + OFF_HMID), nullptr, nullptr, DFF};
        skinny_gemm<1>(lds, (const bf16_t*)(ws + OFF_U) + (size_t)MP * 1024, (const bf16_t*)(ws + OFF_W1), DFF, 1024, Sk);
    }
    GSYNC();
    {
        pg8::Gemm g{(const bf16_t*)(ws + OFF_HMID), (const bf16_t*)(ws + OFF_W2), MP, 1024, DFF};
        EpiRes E{(float*)(ws + OFF_X1), nullptr, nullptr, mod + 5120};
        S.init(g.M, g.N, G, cid); pg8::gemm_phase<EpiRes, pg8::StaticOrder, true, true>(lds, g, S, E);
        __syncthreads();
        SkRes Sk{(float*)(ws + OFF_X1), nullptr, mod + 5120};
        skinny_gemm<4>(lds, (const bf16_t*)(ws + OFF_HMID) + (size_t)MP * DFF, (const bf16_t*)(ws + OFF_W2), 1024, DFF, Sk);
    }
    GSYNC();
    phase_final(p);
    if (PROBE_EW) phase_final(p);
}

extern "C" void kernel_launch(void* const* d_in, const int* in_sizes, int n_in, void* d_out, int out_size, void* d_ws, size_t ws_size, hipStream_t stream) {
    constexpr int LDS_BYTES = 131072 + 16;
    static int grid = 0;
    if (grid == 0) {
        if (n_in != 25 || ws_size < WS_END) { fprintf(stderr, "kernel_launch: unexpected n_in %d / ws %zu (need %zu)\n", n_in, ws_size, (size_t)WS_END); grid = -1; return; }
        int dev = 0, cus = 0, per_cu = 0;
        (void)hipGetDevice(&dev);
        (void)hipDeviceGetAttribute(&cus, hipDeviceAttributeMultiprocessorCount, dev);
        if (hipFuncSetAttribute((const void*)fwd_megakernel, hipFuncAttributeMaxDynamicSharedMemorySize, LDS_BYTES) != hipSuccess) { fprintf(stderr, "kernel_launch: hipFuncSetAttribute failed\n"); grid = -1; return; }
        if (hipOccupancyMaxActiveBlocksPerMultiprocessor(&per_cu, (const void*)fwd_megakernel, 512, LDS_BYTES) != hipSuccess || per_cu < 1) { fprintf(stderr, "kernel_launch: occupancy query says %d blocks per CU\n", per_cu); grid = -1; return; }
        grid = cus;
    }
    if (grid < 0) return;
    Params p{};
    for (int i = 0; i < 25; ++i) p.in[i] = (const float*)d_in[i];
    p.out = (float*)d_out; p.ws = (unsigned char*)d_ws;
    (void)hipMemsetAsync((unsigned char*)d_ws + OFF_BAR, 0, 16384, stream);
    void* args[] = {&p};
    hipError_t e = hipLaunchCooperativeKernel((const void*)fwd_megakernel, dim3(grid), dim3(512), args, LDS_BYTES, stream);
    if (e != hipSuccess) fprintf(stderr, "cooperative launch failed: %s (grid %d)\n", hipGetErrorString(e), grid);
}
```

```cpp
#include <hip/hip_runtime.h>
#include <hip/hip_cooperative_groups.h>
#include <cstdio>
#include <cstdint>
namespace cg = cooperative_groups;
#define PROBE_EW 0
#define PROBE_CONV 0
#define PROBE_SSD 0
#define PROBE_SYNC 0
#define PROBE_INPROJ 0
#define PROBE_MLP1 0
#define GSYNC() do { xcd_barrier(xb); if (PROBE_SYNC) xcd_barrier(xb); } while (0)

#define LAS __attribute__((address_space(3)))
typedef unsigned short bf16_t;
typedef short bf16x8 __attribute__((ext_vector_type(8)));
typedef short bf16x4 __attribute__((ext_vector_type(4)));
typedef float f32x4 __attribute__((ext_vector_type(4)));
typedef float f32x2 __attribute__((ext_vector_type(2)));
typedef unsigned u32x4 __attribute__((ext_vector_type(4)));
typedef unsigned u32x2 __attribute__((ext_vector_type(2)));

constexpr int D = 1024, NBP = 8, SEQ = 2048, MP = NBP * SEQ, NBS = 128, MTOT = MP + NBS, MPAD = 16640;
constexpr int DINP = 10496, DINNER = 2048, DXBC = 3072, NH = 32, HD = 64, DS = 128, DFF = 4096, DIN = 10272;
constexpr float EPS = 1e-6f;
constexpr size_t O_YP = 0, O_YS = 16777216, O_SCP = 16908288, O_SBP = 16924672, O_SSP = 16998400, O_SCS = 19095552, O_SBS = 19357696, O_SSS = 20537344;
constexpr size_t S1 = (size_t)MPAD * 1024 * 2;
constexpr size_t OFF_WADA = 0, OFF_WIN = 12582912, OFF_WAOUT = 34078720, OFF_WBOUT = 36175872, OFF_WO = 40370176, OFF_W1 = 42467328, OFF_W2 = 50855936,
                 OFF_CA = 59244544, OFF_MOD = 59768832, OFF_DTRAW = 66060288, OFF_DTP = 68190208, OFF_ACS = 70320128, OFF_SSQ = 72450048, OFF_U = 74579968,
                 OFF_R1 = OFF_U + S1, OFF_BG = OFF_R1, OFF_CI = OFF_R1 + S1, OFF_Z = OFF_R1 + 2 * S1, OFF_XBC = OFF_R1 + 4 * S1, OFF_GA = OFF_R1 + 7 * S1, OFF_GB = OFF_R1 + 8 * S1,
                 OFF_R2 = OFF_R1 + 9 * S1, OFF_BAR = OFF_R2 + 3 * S1, WS_END = OFF_BAR + 16384;
constexpr size_t OFF_VA = OFF_U, OFF_YA = OFF_BG, OFF_MERGED = OFF_CI, OFF_YG = OFF_XBC, OFF_HMID = OFF_R1, OFF_XBCC = OFF_R2, OFF_X1 = OFF_R2;

struct Params {
    const float* in[25];
    float* out;
    unsigned char* ws;
};
enum { I_XP = 0, I_XS, I_CP, I_CS, I_STA, I_STB, I_STS, I_WADA, I_BADA, I_N1G, I_WIN, I_CAW, I_WAOUT, I_CBW, I_CBB, I_DTB, I_ALOG, I_DSKIP, I_SNG, I_WBOUT, I_WO, I_N2G, I_W1, I_W2, I_NFG };

__device__ __forceinline__ unsigned cvt_pk_bf16(float lo, float hi) { unsigned r; asm volatile("v_cvt_pk_bf16_f32 %0, %1, %2" : "=v"(r) : "v"(lo), "v"(hi)); return r; }
__device__ __forceinline__ bf16_t f2bf(float f) { unsigned u = __float_as_uint(f); u += 0x7FFFu + ((u >> 16) & 1u); return (bf16_t)(u >> 16); }
__device__ __forceinline__ float bf2f(bf16_t b) { return __uint_as_float(((unsigned)b) << 16); }
__device__ __forceinline__ float bflo(unsigned u) { return __uint_as_float(u << 16); }
__device__ __forceinline__ float bfhi(unsigned u) { return __uint_as_float(u & 0xffff0000u); }
__device__ __forceinline__ float sigmoidf_(float x) { return __builtin_amdgcn_rcpf(1.f + __expf(-x)); }
__device__ __forceinline__ float siluf_(float x) { return x * sigmoidf_(x); }
__device__ __forceinline__ f32x4 cv4(const u32x2 u) { return (f32x4){bflo(u.x), bfhi(u.x), bflo(u.y), bfhi(u.y)}; }
struct F8 { f32x4 a, b; };
__device__ __forceinline__ F8 cv8(const u32x4 u) { F8 r; r.a = (f32x4){bflo(u.x), bfhi(u.x), bflo(u.y), bfhi(u.y)}; r.b = (f32x4){bflo(u.z), bfhi(u.z), bflo(u.w), bfhi(u.w)}; return r; }
__device__ __forceinline__ int fresh_tid() { int t = threadIdx.x; asm volatile("" : "+v"(t)); __builtin_assume(t >= 0 && t < 512); return t; }
__device__ __forceinline__ float wave_sum(float v) {
#pragma unroll
    for (int o = 1; o < 64; o <<= 1) v += __shfl_xor(v, o);
    return v;
}


#define XB_TMO      128
#define XB_XCNT(j)  (256  + 64 * (j))
#define XB_XSUB(j)  (1280 + 64 * (j))
#define XB_XGEN(j)  (2304 + 64 * (j))
#define XB_TOP      3328
#define XB_TOPGEN   3392
#define XCD_BAR_WORDS 3456
#define XB_SPIN_CAP (1u << 18)
__device__ __forceinline__ unsigned xb_ld(unsigned* p)              { return __hip_atomic_load(p, __ATOMIC_RELAXED, __HIP_MEMORY_SCOPE_AGENT); }
__device__ __forceinline__ unsigned xb_add(unsigned* p, unsigned v) { return __hip_atomic_fetch_add(p, v, __ATOMIC_RELAXED, __HIP_MEMORY_SCOPE_AGENT); }
__device__ __forceinline__ unsigned xb_xcc_id() { return (unsigned)__builtin_amdgcn_s_getreg((3 << 11) | 20) & 0xFu; }
#define XB_SPIN(cond, bar) do { unsigned _sp = 0; while (cond) { __builtin_amdgcn_s_sleep(1); \
    if ((++_sp & 255u) == 0u) { if (xb_ld(&(bar)[XB_TMO])) break; if (_sp > XB_SPIN_CAP) { atomicAdd(&(bar)[XB_TMO], 1u); break; } } } } while (0)
struct XcdBarrier { unsigned* bar; unsigned x; volatile LAS unsigned* st; };
__device__ __forceinline__ XcdBarrier xcd_barrier_post(unsigned* bar, volatile LAS unsigned* st) {
    XcdBarrier b; b.bar = bar; b.x = xb_xcc_id(); b.st = st;
    if (threadIdx.x == 0) (void)xb_add(&bar[XB_XCNT(b.x)], 1u);
    return b;
}
__device__ __forceinline__ void xcd_barrier_complete(unsigned* bar, unsigned x, unsigned& nloc, unsigned& nx) {
    const unsigned G = gridDim.x * gridDim.y * gridDim.z;
    unsigned sum, cnt, mine, sp = 0u;
    for (;;) {
        sum = 0u; cnt = 0u; mine = 0u;
#pragma unroll
        for (unsigned j = 0; j < 16; ++j) { const unsigned c = xb_ld(&bar[XB_XCNT(j)]); sum += c; cnt += (c > 0u) ? 1u : 0u; mine = (j == x) ? c : mine; }
        if (sum == G) break;
        __builtin_amdgcn_s_sleep(1);
        if ((++sp & 255u) == 0u) { if (xb_ld(&bar[XB_TMO])) break; if (sp > XB_SPIN_CAP) { atomicAdd(&bar[XB_TMO], 1u); break; } }
    }
    nloc = mine > 0u ? mine : 1u; nx = cnt > 0u ? cnt : 1u;
}
__device__ __forceinline__ void xcd_barrier(const XcdBarrier& b) {
    asm volatile("s_waitcnt vmcnt(0)" ::: "memory");
    __syncthreads();
    if (threadIdx.x == 0) {
        unsigned* bar = b.bar;
        __builtin_amdgcn_s_waitcnt(0);
        unsigned nloc = b.st[0], nx = b.st[1];
        if (nloc == 0u) { xcd_barrier_complete(bar, b.x, nloc, nx); b.st[0] = nloc; b.st[1] = nx; }
        const unsigned old = xb_add(&bar[XB_XSUB(b.x)], 1u);
        const unsigned gen = old / nloc;
        if (old + 1u == (gen + 1u) * nloc) {
            __builtin_amdgcn_fence(__ATOMIC_RELEASE, "agent");
            asm volatile("s_waitcnt vmcnt(0)" ::: "memory");
            const unsigned og = xb_add(&bar[XB_TOP], 1u);
            const unsigned tg = og / nx;
            if (og + 1u == (tg + 1u) * nx) xb_add(&bar[XB_TOPGEN], 1u);
            else XB_SPIN(xb_ld(&bar[XB_TOPGEN]) == tg, bar);
            __builtin_amdgcn_fence(__ATOMIC_ACQUIRE, "agent");
            xb_add(&bar[XB_XGEN(b.x)], 1u);
            asm volatile("s_waitcnt vmcnt(0)" ::: "memory");
        } else {
            XB_SPIN(xb_ld(&bar[XB_XGEN(b.x)]) == gen, bar);
            __builtin_amdgcn_fence(__ATOMIC_ACQUIRE, "agent");
            asm volatile("s_waitcnt vmcnt(0)" ::: "memory");
        }
    }
    __syncthreads();
}

namespace pg8 {
#define PG8_LAS __attribute__((address_space(3)))
constexpr int BM = 256, BK = 64, HALF = 128, HTB = HALF * BK * 2, STAGE_BYTES = 8 * HTB, NXCD = 8, WGM = 8;
__host__ __device__ __forceinline__ int lds_byte(int r, int c) { const int st = (r >> 4) * 2 + (c >> 5), rr = r & 15, cc = c & 31, ob = rr * 64 + cc * 2; return st * 1024 + (ob ^ (((ob >> 9) & 1) << 5)); }
__host__ __device__ __forceinline__ void stage_rc(int b, int& R, int& C) { const int st = b / 1024, sb = b % 1024, swz = sb ^ (((sb >> 9) & 1) << 5); R = (st >> 1) * 16 + swz / 64; C = (st & 1) * 32 + (swz % 64) / 2; }
__host__ __device__ __forceinline__ int perm32(int rho) { const int n = rho >> 4, i = rho & 15; return 8 * (i >> 2) + 4 * n + (i & 3); }
struct Unit { int pm, pn; };
struct Gemm { const bf16_t* A; const bf16_t* Bt; int M, N, K; };
struct StaticOrder {
    int nM, nN, nwg, G, c;
    __host__ __device__ void init(int M, int N, int G_, int c_) { nM = M / BM; nN = N / BM; nwg = nM * nN; G = G_; c = c_; }
    __host__ __device__ bool next(int i, Unit& u) const {
        const long L = (long)i * G + c; if (L >= nwg) return false;
        int wgid = (int)L; { const int q = nwg / NXCD, r = nwg % NXCD, xcd = wgid % NXCD, off = wgid / NXCD; wgid = (xcd < r ? xcd * (q + 1) : r * (q + 1) + (xcd - r) * q) + off; }
        const int nig = WGM * nN, gid = wgid / nig, fm = gid * WGM, gsz = (nM - fm) < WGM ? (nM - fm) : WGM;
        u.pm = fm + ((wgid % nig) % gsz); u.pn = (wgid % nig) / gsz; return true;
    }
    __device__ __forceinline__ void a_ready(const Unit&) const {}
    __device__ __forceinline__ void done(const Unit&) const {}
};

template <class Epi, class Sched, bool ALIGN_EPI = false, bool SP2 = false>
__device__ __forceinline__ void gemm_phase(PG8_LAS unsigned char* lds, const Gemm g, const Sched& S, const Epi& E) {
    const int tid = fresh_tid(), wid = __builtin_amdgcn_readfirstlane(tid >> 6), lane = tid & 63, wr = wid >> 2, wc = wid & 3, fr = lane & 15, fq = lane >> 4;
    const int K = g.K, nt = K / BK;
    unsigned voffA[2], voffB[2];
#pragma unroll
    for (int i = 0; i < 2; ++i) { int R, C; stage_rc(tid * 16 + i * 8192, R, C); const int Rb = Epi::PERM ? ((R & ~31) + perm32(R & 31)) : R;
        voffA[i] = (unsigned)(R * K + C) * 2u; voffB[i] = (unsigned)(Rb * K + C) * 2u; }
    const size_t kstep = (size_t)(BK * 2);
    const size_t hstep = (size_t)HALF * K * 2;
    const size_t tstep = 2 * hstep;
    const unsigned ldsw = (unsigned)wid * 1024u;
    const int aoff = lds_byte(wr * 64 + fr, fq * 8), boff = lds_byte(wc * 32 + fr, fq * 8);
#define PG8_SA(b, h) (((b) * 2 + (h)) * HTB)
#define PG8_SB(b, h) ((4 + (b) * 2 + (h)) * HTB)
#define PG8_STAGE(bufoff, gbase, voff) do { _Pragma("unroll") for (int _i = 0; _i < 2; ++_i) \
        __builtin_amdgcn_global_load_lds((const unsigned*)((const char*)(gbase) + (voff)[_i]), (PG8_LAS unsigned*)(lds + (bufoff) + ldsw + _i * 8192), 16, 0, 0); } while (0)
#define PG8_LDA(dst, b, h) do { _Pragma("unroll") for (int m = 0; m < 4; ++m) _Pragma("unroll") for (int k = 0; k < 2; ++k) dst[m][k] = *(const PG8_LAS bf16x8*)(lds + PG8_SA(b, h) + aoff + m * 2048 + k * 1024); } while (0)
#define PG8_LDB(dst, b, h) do { _Pragma("unroll") for (int n = 0; n < 2; ++n) _Pragma("unroll") for (int k = 0; k < 2; ++k) dst[n][k] = *(const PG8_LAS bf16x8*)(lds + PG8_SB(b, h) + boff + n * 2048 + k * 1024); } while (0)
#define PG8_MMA(ai, bj, At, Bt) do { __builtin_amdgcn_s_setprio(1); _Pragma("unroll") for (int m = 0; m < 4; ++m) _Pragma("unroll") for (int n = 0; n < 2; ++n) _Pragma("unroll") for (int k = 0; k < 2; ++k) \
        acc[ai][bj][m][n] = __builtin_amdgcn_mfma_f32_16x16x32_bf16(Bt[n][k], At[m][k], acc[ai][bj][m][n], 0, 0, 0); __builtin_amdgcn_s_setprio(0); } while (0)
#define PG8_WAIT_V(n) asm volatile("s_waitcnt vmcnt(" #n ")" ::: "memory")
#define PG8_WAIT_L(n) asm volatile("s_waitcnt lgkmcnt(" #n ")" ::: "memory")
#define PG8_BAR __builtin_amdgcn_s_barrier()
#define PG8_SCHED __builtin_amdgcn_sched_barrier(0)
    Unit cur, nxt; int ui = 0;
    if (!S.next(0, cur)) return;
    f32x4 acc[2][2][4][2];
#pragma unroll
    for (int a = 0; a < 2; ++a)
#pragma unroll
        for (int b = 0; b < 2; ++b)
#pragma unroll
            for (int m = 0; m < 4; ++m)
#pragma unroll
                for (int n = 0; n < 2; ++n) acc[a][b][m][n] = (f32x4){0.f, 0.f, 0.f, 0.f};
    bf16x8 At[4][2], B0[2][2], B1[2][2];
    const char* cA = (const char*)g.A + (size_t)cur.pm * tstep; const char* cB = (const char*)g.Bt + (size_t)cur.pn * tstep;
    S.a_ready(cur);
    if constexpr (SP2) {
        PG8_STAGE(PG8_SB(0, 0), cB, voffB); PG8_STAGE(PG8_SB(0, 1), cB + hstep, voffB); PG8_STAGE(PG8_SA(0, 0), cA, voffA); PG8_STAGE(PG8_SA(0, 1), cA + hstep, voffA);
        if (wr == 1) PG8_BAR;
        PG8_WAIT_V(2); PG8_BAR;
        PG8_STAGE(PG8_SB(1, 0), cB + kstep, voffB); PG8_STAGE(PG8_SA(1, 0), cA + kstep, voffA); PG8_STAGE(PG8_SB(1, 1), cB + hstep + kstep, voffB);
        PG8_WAIT_V(6); PG8_BAR;
    } else {
        PG8_STAGE(PG8_SB(0, 0), cB, voffB); PG8_STAGE(PG8_SA(0, 0), cA, voffA); PG8_STAGE(PG8_SB(0, 1), cB + hstep, voffB); PG8_STAGE(PG8_SA(0, 1), cA + hstep, voffA);
        if (wr == 1) PG8_BAR;
        PG8_WAIT_V(4); PG8_BAR;
        PG8_STAGE(PG8_SB(1, 0), cB + kstep, voffB); PG8_STAGE(PG8_SA(1, 0), cA + kstep, voffA); PG8_STAGE(PG8_SB(1, 1), cB + hstep + kstep, voffB);
        PG8_WAIT_V(6); PG8_BAR;
    }
    for (;;) {
        const bool has_next = S.next(ui + 1, nxt);
        const char* nA = has_next ? (const char*)g.A + (size_t)nxt.pm * tstep : cA; const char* nB = has_next ? (const char*)g.Bt + (size_t)nxt.pn * tstep : cB;
        for (int t = 0; t < nt; t += 2) {
            const bool last = (t == nt - 2);
            const char* a1 = cA + (size_t)(t + 1) * kstep;
            const char* a2 = last ? nA : cA + (size_t)(t + 2) * kstep; const char* b2 = last ? nB : cB + (size_t)(t + 2) * kstep;
            const char* a3 = a2 + kstep; const char* b3 = b2 + kstep;
            if (last && has_next) S.a_ready(nxt);
            if constexpr (SP2) {
            PG8_LDB(B0, 0, 0); PG8_LDB(B1, 0, 1); PG8_SCHED; PG8_LDA(At, 0, 0); PG8_STAGE(PG8_SA(1, 1), a1 + hstep, voffA);
            PG8_WAIT_V(8); PG8_WAIT_L(0); PG8_BAR; PG8_MMA(0, 0, At, B0); PG8_MMA(0, 1, At, B1); PG8_BAR; PG8_SCHED;
            PG8_LDA(At, 0, 1); PG8_STAGE(PG8_SB(0, 0), b2, voffB); PG8_STAGE(PG8_SB(0, 1), b2 + hstep, voffB); PG8_STAGE(PG8_SA(0, 0), a2, voffA);
            PG8_WAIT_V(8); PG8_WAIT_L(0); PG8_BAR; PG8_MMA(1, 0, At, B0); PG8_MMA(1, 1, At, B1); PG8_BAR; PG8_SCHED;
            PG8_LDB(B0, 1, 0); PG8_LDB(B1, 1, 1); PG8_SCHED; PG8_LDA(At, 1, 0); PG8_STAGE(PG8_SA(0, 1), a2 + hstep, voffA);
            PG8_WAIT_V(8); PG8_WAIT_L(0); PG8_BAR; PG8_MMA(0, 0, At, B0); PG8_MMA(0, 1, At, B1); PG8_BAR; PG8_SCHED;
            PG8_LDA(At, 1, 1); PG8_STAGE(PG8_SB(1, 0), b3, voffB); PG8_STAGE(PG8_SB(1, 1), b3 + hstep, voffB); PG8_STAGE(PG8_SA(1, 0), a3, voffA);
            PG8_WAIT_V(8); PG8_WAIT_L(0); PG8_BAR; PG8_MMA(1, 0, At, B0); PG8_MMA(1, 1, At, B1); PG8_BAR; PG8_SCHED;
            } else {
            PG8_LDB(B0, 0, 0); PG8_SCHED; PG8_LDA(At, 0, 0); PG8_STAGE(PG8_SA(1, 1), a1 + hstep, voffA);
            PG8_WAIT_L(8); PG8_BAR; PG8_WAIT_L(0); PG8_MMA(0, 0, At, B0); PG8_BAR; PG8_SCHED;
            PG8_LDB(B1, 0, 1); PG8_STAGE(PG8_SB(0, 0), b2, voffB);
            PG8_BAR; PG8_WAIT_L(0); PG8_MMA(0, 1, At, B1); PG8_BAR;
            PG8_LDA(At, 0, 1); PG8_STAGE(PG8_SA(0, 0), a2, voffA);
            PG8_BAR; PG8_WAIT_L(0); PG8_MMA(1, 0, At, B0); PG8_BAR; PG8_SCHED;
            PG8_STAGE(PG8_SB(0, 1), b2 + hstep, voffB);
            PG8_WAIT_V(6); PG8_BAR; PG8_MMA(1, 1, At, B1); PG8_BAR;
            PG8_LDB(B0, 1, 0); PG8_SCHED; PG8_LDA(At, 1, 0); PG8_STAGE(PG8_SA(0, 1), a2 + hstep, voffA);
            PG8_WAIT_L(8); PG8_BAR; PG8_WAIT_L(0); PG8_MMA(0, 0, At, B0); PG8_BAR; PG8_SCHED;
            PG8_LDB(B1, 1, 1); PG8_STAGE(PG8_SB(1, 0), b3, voffB);
            PG8_BAR; PG8_WAIT_L(0); PG8_MMA(0, 1, At, B1); PG8_BAR;
            PG8_LDA(At, 1, 1); PG8_STAGE(PG8_SA(1, 0), a3, voffA);
            PG8_BAR; PG8_WAIT_L(0); PG8_MMA(1, 0, At, B0); PG8_BAR; PG8_SCHED;
            PG8_STAGE(PG8_SB(1, 1), b3 + hstep, voffB);
            PG8_WAIT_V(6); PG8_BAR; PG8_MMA(1, 1, At, B1); PG8_BAR;
            }
        }
        if constexpr (ALIGN_EPI) { if (wr == 0) PG8_BAR; }
        E(acc, cur, wr, wc, fr, fq);
        if (!has_next) break;
#pragma unroll
        for (int a = 0; a < 2; ++a)
#pragma unroll
            for (int b = 0; b < 2; ++b)
#pragma unroll
                for (int m = 0; m < 4; ++m)
#pragma unroll
                    for (int n = 0; n < 2; ++n) acc[a][b][m][n] = (f32x4){0.f, 0.f, 0.f, 0.f};
        cur = nxt; cA = nA; cB = nB; ++ui;
        if constexpr (ALIGN_EPI) { if (wr == 1) PG8_BAR; }
    }
    PG8_WAIT_V(0);
    if constexpr (!ALIGN_EPI) { if (wr == 0) PG8_BAR; }
    PG8_BAR;
#undef PG8_SA
#undef PG8_SB
#undef PG8_STAGE
#undef PG8_LDA
#undef PG8_LDB
#undef PG8_MMA
#undef PG8_WAIT_V
#undef PG8_WAIT_L
#undef PG8_BAR
#undef PG8_SCHED
}
}
using pg8::Unit;
typedef f32x4 AccT[2][2][4][2];

struct EpiF32Bias {
    static constexpr bool PERM = false;
    float* C; int ldc; const float* bias;
    __device__ __forceinline__ void operator()(const AccT& acc, const Unit& u, int wr, int wc, int fr, int fq) const {
        const int row0 = u.pm * 256 + wr * 64 + fr, col0 = u.pn * 256 + wc * 32 + 4 * fq;
        f32x4 bv[2][2];
#pragma unroll
        for (int bj = 0; bj < 2; ++bj)
#pragma unroll
            for (int n = 0; n < 2; ++n) bv[bj][n] = *(const f32x4*)(bias + col0 + bj * 128 + n * 16);
#pragma unroll
        for (int ai = 0; ai < 2; ++ai)
#pragma unroll
            for (int m = 0; m < 4; ++m) { float* rowp = C + (size_t)(row0 + ai * 128 + m * 16) * ldc + col0;
#pragma unroll
                for (int bj = 0; bj < 2; ++bj)
#pragma unroll
                    for (int n = 0; n < 2; ++n) *(f32x4*)(rowp + bj * 128 + n * 16) = acc[ai][bj][m][n] + bv[bj][n]; }
    }
};
__device__ __forceinline__ u32x4 pack8(f32x4 v0, f32x4 v1) { u32x4 w; w.x = cvt_pk_bf16(v0[0], v0[1]); w.y = cvt_pk_bf16(v0[2], v0[3]); w.z = cvt_pk_bf16(v1[0], v1[1]); w.w = cvt_pk_bf16(v1[2], v1[3]); return w; }
struct EpiIn {
    static constexpr bool PERM = true;
    bf16_t *BG, *CI, *Z, *XBC, *GA, *GB; float* DT;
    __device__ __forceinline__ void operator()(const AccT& acc, const Unit& u, int wr, int wc, int fr, int fq) const {
        const int pn = u.pn, row0 = u.pm * 256 + wr * 64 + fr, cin = wc * 32 + 8 * fq;
        if (pn >= 4 && pn < 12) {
            const int col = (pn - 4) * 128 + cin;
#pragma unroll
            for (int ai = 0; ai < 2; ++ai)
#pragma unroll
                for (int m = 0; m < 4; ++m) { const size_t row = row0 + ai * 128 + m * 16;
                    *(u32x4*)(CI + row * 1024 + col) = pack8(acc[ai][0][m][0] * acc[ai][1][m][0], acc[ai][0][m][1] * acc[ai][1][m][1]); }
        } else if (pn == 40) {
            if (wc == 0) {
#pragma unroll
                for (int ai = 0; ai < 2; ++ai)
#pragma unroll
                    for (int m = 0; m < 4; ++m) { const size_t row = row0 + ai * 128 + m * 16;
                        *(f32x4*)(DT + row * 32 + 8 * fq) = acc[ai][0][m][0]; *(f32x4*)(DT + row * 32 + 8 * fq + 4) = acc[ai][0][m][1]; }
            }
        } else {
            bf16_t* O; int ldc, colt;
            if (pn < 4) { O = BG; ldc = 1024; colt = pn * 256; }
            else if (pn < 20) { O = Z; ldc = 2048; colt = (pn - 12) * 256; }
            else if (pn < 32) { O = XBC; ldc = 3072; colt = (pn - 20) * 256; }
            else if (pn < 36) { O = GA; ldc = 1024; colt = (pn - 32) * 256; }
            else { O = GB; ldc = 1024; colt = (pn - 36) * 256; }
#pragma unroll
            for (int ai = 0; ai < 2; ++ai)
#pragma unroll
                for (int m = 0; m < 4; ++m) { bf16_t* rowp = O + (size_t)(row0 + ai * 128 + m * 16) * ldc + colt + cin;
#pragma unroll
                    for (int bj = 0; bj < 2; ++bj) *(u32x4*)(rowp + bj * 128) = pack8(acc[ai][bj][m][0], acc[ai][bj][m][1]); }
        }
    }
};
template <int MODE> struct EpiGate {
    static constexpr bool PERM = true;
    bf16_t* O; const bf16_t* G; const bf16_t* Y; int ldc;
    __device__ __forceinline__ void operator()(const AccT& acc, const Unit& u, int wr, int wc, int fr, int fq) const {
        const int row0 = u.pm * 256 + wr * 64 + fr, col0 = u.pn * 256 + wc * 32 + 8 * fq;
#pragma unroll
        for (int ai = 0; ai < 2; ++ai) {
            u32x4 gv[4][2], yv[4][2];
            if (MODE != 2) {
#pragma unroll
                for (int m = 0; m < 4; ++m)
#pragma unroll
                    for (int bj = 0; bj < 2; ++bj) { const size_t off = (size_t)(row0 + ai * 128 + m * 16) * ldc + col0 + bj * 128;
                        gv[m][bj] = *(const u32x4*)(G + off); if (MODE == 1) yv[m][bj] = *(const u32x4*)(Y + off); }
            }
#pragma unroll
            for (int m = 0; m < 4; ++m)
#pragma unroll
                for (int bj = 0; bj < 2; ++bj) { const size_t off = (size_t)(row0 + ai * 128 + m * 16) * ldc + col0 + bj * 128;
                    f32x4 v0 = acc[ai][bj][m][0], v1 = acc[ai][bj][m][1];
                    if (MODE == 2) {
#pragma unroll
                        for (int j = 0; j < 4; ++j) { float a = fmaxf(v0[j], 0.f), b = fmaxf(v1[j], 0.f); v0[j] = a * a; v1[j] = b * b; }
                    } else {
                        const u32x4 g = gv[m][bj];
                        v0[0] *= sigmoidf_(bflo(g.x)); v0[1] *= sigmoidf_(bfhi(g.x)); v0[2] *= sigmoidf_(bflo(g.y)); v0[3] *= sigmoidf_(bfhi(g.y));
                        v1[0] *= sigmoidf_(bflo(g.z)); v1[1] *= sigmoidf_(bfhi(g.z)); v1[2] *= sigmoidf_(bflo(g.w)); v1[3] *= sigmoidf_(bfhi(g.w));
                        if (MODE == 1) { const u32x4 y = yv[m][bj];
                            v0[0] += bflo(y.x); v0[1] += bfhi(y.x); v0[2] += bflo(y.y); v0[3] += bfhi(y.y);
                            v1[0] += bflo(y.z); v1[1] += bfhi(y.z); v1[2] += bflo(y.w); v1[3] += bfhi(y.w); }
                    }
                    *(u32x4*)(O + off) = pack8(v0, v1); }
        }
    }
};
struct EpiRes {
    static constexpr bool PERM = true;
    bf16_t* X1; const float* xp; const float* gate;
    __device__ __forceinline__ void operator()(const AccT& acc, const Unit& u, int wr, int wc, int fr, int fq) const {
        const int row0 = u.pm * 256 + wr * 64 + fr, col0 = u.pn * 256 + wc * 32 + 8 * fq;
        const float* gr = gate + (size_t)(u.pm >> 3) * 6144 + col0;
        f32x4 gv[2][2];
#pragma unroll
        for (int bj = 0; bj < 2; ++bj)
#pragma unroll
            for (int n = 0; n < 2; ++n) gv[bj][n] = *(const f32x4*)(gr + bj * 128 + n * 4);
#pragma unroll
        for (int ai = 0; ai < 2; ++ai) {
            if (xp) {
                f32x4 xv[4][2][2];
#pragma unroll
                for (int m = 0; m < 4; ++m)
#pragma unroll
                    for (int bj = 0; bj < 2; ++bj)
#pragma unroll
                        for (int n = 0; n < 2; ++n) xv[m][bj][n] = *(const f32x4*)(xp + (size_t)(row0 + ai * 128 + m * 16) * D + col0 + bj * 128 + n * 4);
#pragma unroll
                for (int m = 0; m < 4; ++m)
#pragma unroll
                    for (int bj = 0; bj < 2; ++bj)
                        *(u32x4*)(X1 + (size_t)(row0 + ai * 128 + m * 16) * D + col0 + bj * 128) = pack8(xv[m][bj][0] + gv[bj][0] * acc[ai][bj][m][0], xv[m][bj][1] + gv[bj][1] * acc[ai][bj][m][1]);
            } else {
                u32x4 xv[4][2];
#pragma unroll
                for (int m = 0; m < 4; ++m)
#pragma unroll
                    for (int bj = 0; bj < 2; ++bj) xv[m][bj] = *(const u32x4*)(X1 + (size_t)(row0 + ai * 128 + m * 16) * D + col0 + bj * 128);
#pragma unroll
                for (int m = 0; m < 4; ++m)
#pragma unroll
                    for (int bj = 0; bj < 2; ++bj) { const F8 x8 = cv8(xv[m][bj]);
                        *(u32x4*)(X1 + (size_t)(row0 + ai * 128 + m * 16) * D + col0 + bj * 128) = pack8(x8.a + gv[bj][0] * acc[ai][bj][m][0], x8.b + gv[bj][1] * acc[ai][bj][m][1]); }
            }
        }
    }
};

template <int KS, class Epi>
__device__ __forceinline__ void skinny_gemm(LAS unsigned char* lds, const bf16_t* A, const bf16_t* Bt, int N, int K, const Epi& E) {
    constexpr int RT = 8 / KS;
    const int tid = fresh_tid(), lane = tid & 63, w = __builtin_amdgcn_readfirstlane(tid >> 6), fr = lane & 15, fq = lane >> 4;
    const int nitems = (N / 16) * KS, klen = K / KS;
    LAS f32x4* red = (LAS f32x4*)lds;
    for (int it = blockIdx.x; it < nitems; it += gridDim.x) {
        const int ct = it / KS, rg = it % KS, rt = rg * RT + (w % RT), kq = w / RT;
        const bf16_t* ap = A + (size_t)(16 * rt + fr) * K + kq * klen + fq * 8;
        const bf16_t* bp = Bt + (size_t)(16 * ct + fr) * K + kq * klen + fq * 8;
        f32x4 acc0 = (f32x4){0.f, 0.f, 0.f, 0.f}, acc1 = acc0;
        for (int k = 0; k < klen; k += 256) {
            bf16x8 a[8], b[8];
#pragma unroll
            for (int j = 0; j < 8; ++j) { a[j] = *(const bf16x8*)(ap + k + 32 * j); b[j] = *(const bf16x8*)(bp + k + 32 * j); }
#pragma unroll
            for (int j = 0; j < 8; j += 2) { acc0 = __builtin_amdgcn_mfma_f32_16x16x32_bf16(b[j], a[j], acc0, 0, 0, 0); acc1 = __builtin_amdgcn_mfma_f32_16x16x32_bf16(b[j + 1], a[j + 1], acc1, 0, 0, 0); }
        }
        f32x4 acc = acc0 + acc1;
        if (KS > 1) {
            if (kq > 0) red[w * 64 + lane] = acc;
            __syncthreads();
            if (kq == 0) {
#pragma unroll
                for (int q = 1; q < KS; ++q) acc = acc + red[(w + q * RT) * 64 + lane];
                E(16 * rt + fr, 16 * ct + 4 * fq, acc);
            }
            __syncthreads();
        } else E(16 * rt + fr, 16 * ct + 4 * fq, acc);
    }
}
__device__ __forceinline__ u32x2 pack4(const f32x4 v) { u32x2 o; o.x = cvt_pk_bf16(v[0], v[1]); o.y = cvt_pk_bf16(v[2], v[3]); return o; }
template <int MODE> struct SkGate {
    bf16_t* O; const bf16_t* G; const bf16_t* Y; int ldc;
    __device__ __forceinline__ void operator()(int r, int c, f32x4 v) const {
        const size_t off = (size_t)(MP + r) * ldc + c;
        if (MODE == 2) {
#pragma unroll
            for (int j = 0; j < 4; ++j) { const float a = fmaxf(v[j], 0.f); v[j] = a * a; }
        } else {
            const f32x4 g = cv4(*(const u32x2*)(G + off));
#pragma unroll
            for (int j = 0; j < 4; ++j) v[j] *= sigmoidf_(g[j]);
            if (MODE == 1) v = v + cv4(*(const u32x2*)(Y + off));
        }
        *(u32x2*)(O + off) = pack4(v);
    }
};
struct SkRes {
    bf16_t* X1; const float* xs; const float* gate;
    __device__ __forceinline__ void operator()(int r, int c, f32x4 v) const {
        bf16_t* o = X1 + (size_t)(MP + r) * D + c;
        const f32x4 src = xs ? *(const f32x4*)(xs + (size_t)r * D + c) : cv4(*(const u32x2*)o);
        *(u32x2*)o = pack4(src + *(const f32x4*)(gate + (size_t)(NBP + r) * 6144 + c) * v);
    }
};

__device__ __forceinline__ int win_dest(int n) {
    if (n < 1024) return n;
    if (n < 2048) { const int j = n - 1024; return 1024 + (j >> 7) * 256 + (j & 127); }
    if (n < 3072) { const int j = n - 2048; return 1024 + (j >> 7) * 256 + 128 + (j & 127); }
    if (n < 8192) return n;
    if (n < 8224) return 10240 + (n - 8192);
    return n - 32;
}
__device__ __forceinline__ void transpose_tile(const float* W, int K, int N, bf16_t* WT, int kt, int ntile, bool remap, const float* kscale, LAS float* scr) {
    const int tid = threadIdx.x, k0 = kt * 64, n0 = ntile * 64, nl = tid & 63, ks = tid >> 6, n = n0 + nl;
#pragma unroll
    for (int i = 0; i < 8; ++i) { const int k = ks + 8 * i; float v = (n < N) ? W[(size_t)(k0 + k) * N + n] : 0.f; if (kscale) v *= kscale[k0 + k]; scr[nl * 65 + k] = v; }
    __syncthreads();
    const int nr = tid >> 3, kc = (tid & 7) * 8, ns = n0 + nr;
    if (ns < N) {
        const int dr = remap ? win_dest(ns) : ns;
        const LAS float* s = scr + nr * 65 + kc;
        u32x4 o; o.x = cvt_pk_bf16(s[0], s[1]); o.y = cvt_pk_bf16(s[2], s[3]); o.z = cvt_pk_bf16(s[4], s[5]); o.w = cvt_pk_bf16(s[6], s[7]);
        *(u32x4*)(WT + (size_t)dr * K + k0 + kc) = o;
    }
    __syncthreads();
}
__device__ __forceinline__ void phase0(const Params& p, LAS unsigned char* lds, int part) {
    LAS float* scr = (LAS float*)lds;
    unsigned char* ws = p.ws;
    constexpr int T_ADA = 16 * 96, T_IN = 16 * 161, T_AO = 16 * 16, T_BO = 32 * 16, T_O = 16 * 16, T_1 = 16 * 64, T_2 = 64 * 16;
    constexpr int TOT = T_ADA + T_IN + T_AO + T_BO + T_O + T_1 + T_2;
    constexpr int NMOD = 24;
    if (part == 0) {
        for (int it = blockIdx.x; it < T_ADA; it += gridDim.x) transpose_tile(p.in[I_WADA], 1024, 6144, (bf16_t*)(ws + OFF_WADA), it / 96, it % 96, false, nullptr, scr);
        bf16_t* cA = (bf16_t*)(ws + OFF_CA);
        for (int i = blockIdx.x * 512 + threadIdx.x; i < (NBP + NBS) * D; i += gridDim.x * 512) {
            const int row = i >> 10, k = i & 1023;
            const float v = row < NBP ? p.in[I_CP][row * D + k] : p.in[I_CS][(row - NBP) * D + k];
            cA[i] = f2bf(siluf_(v));
        }
        return;
    }
    if (part == 1) {
        for (int r = (int)blockIdx.x - NMOD; r < T_IN; r += (int)gridDim.x - NMOD) transpose_tile(p.in[I_WIN], 1024, DIN, (bf16_t*)(ws + OFF_WIN), r / 161, r % 161, true, nullptr, scr);
        return;
    }
    constexpr int FIRST2 = (65 * 41) % 256;
    const int nw2 = (int)gridDim.x > FIRST2 ? (int)gridDim.x - FIRST2 : (int)gridDim.x, w2 = (int)gridDim.x > FIRST2 ? (int)blockIdx.x - FIRST2 : (int)blockIdx.x;
    if (w2 < 0) return;
    for (int it = w2; it < T_AO + T_BO + T_O + T_1 + T_2; it += nw2) {
        int r = it;
        if (r < T_AO) { transpose_tile(p.in[I_WAOUT], 1024, 1024, (bf16_t*)(ws + OFF_WAOUT), r / 16, r % 16, false, nullptr, scr); continue; } r -= T_AO;
        if (r < T_BO) { transpose_tile(p.in[I_WBOUT], 2048, 1024, (bf16_t*)(ws + OFF_WBOUT), r / 16, r % 16, false, p.in[I_SNG], scr); continue; } r -= T_BO;
        if (r < T_O) { transpose_tile(p.in[I_WO], 1024, 1024, (bf16_t*)(ws + OFF_WO), r / 16, r % 16, false, nullptr, scr); continue; } r -= T_O;
        if (r < T_1) { transpose_tile(p.in[I_W1], 1024, 4096, (bf16_t*)(ws + OFF_W1), r / 64, r % 64, false, nullptr, scr); continue; } r -= T_1;
        transpose_tile(p.in[I_W2], 4096, 1024, (bf16_t*)(ws + OFF_W2), r / 16, r % 16, false, nullptr, scr);
    }
}

template <bool BF> __device__ __forceinline__ void load_row(const void* xrow, int lane, f32x4 (&v)[4]) {
#pragma unroll
    for (int j = 0; j < 4; ++j) v[j] = BF ? cv4(((const u32x2*)xrow)[lane + 64 * j]) : ((const f32x4*)xrow)[lane + 64 * j];
}
template <bool BF> __device__ __forceinline__ void rownorm_mod(const void* xrow, const float* g, const float* sc, const float* sh, bf16_t* orow, int lane) {
    f32x4 v[4]; float s = 0.f;
    load_row<BF>(xrow, lane, v);
#pragma unroll
    for (int j = 0; j < 4; ++j) s += (v[j][0] * v[j][0] + v[j][1] * v[j][1]) + (v[j][2] * v[j][2] + v[j][3] * v[j][3]);
    const float rstd = rsqrtf(wave_sum(s) * (1.f / D) + EPS);
#pragma unroll
    for (int j = 0; j < 4; ++j) { const int i4 = lane + 64 * j;
        const f32x4 gg = ((const f32x4*)g)[i4], scv = ((const f32x4*)sc)[i4], shv = ((const f32x4*)sh)[i4];
        const f32x4 o = v[j] * rstd * gg * (scv + 1.f) + shv;
        u32x2 w; w.x = cvt_pk_bf16(o[0], o[1]); w.y = cvt_pk_bf16(o[2], o[3]);
        ((u32x2*)orow)[i4] = w; }
}
template <bool BF> __device__ __forceinline__ void phase_rownorm(const Params& p, const float* gvec, int sc_off, int sh_off, bf16_t* U) {
    const int tid_ = fresh_tid(), lane = tid_ & 63, gw = blockIdx.x * 8 + (tid_ >> 6), NW = gridDim.x * 8;
    const float* mod = (const float*)(p.ws + OFF_MOD);
    for (int row = gw; row < MTOT; row += NW) {
        const int seq = row < MP ? (row >> 11) : (NBP + row - MP);
        const void* xrow = BF ? (const void*)((const bf16_t*)(p.ws + OFF_X1) + (size_t)row * D) : (const void*)(row < MP ? p.in[I_XP] + (size_t)row * D : p.in[I_XS] + (size_t)(row - MP) * D);
        rownorm_mod<BF>(xrow, gvec, mod + (size_t)seq * 6144 + sc_off, mod + (size_t)seq * 6144 + sh_off, U + (size_t)row * D, lane);
    }
}
__device__ __forceinline__ void phase_final(const Params& p) {
    const int tid_ = fresh_tid(), lane = tid_ & 63, gw = blockIdx.x * 8 + (tid_ >> 6), NW = gridDim.x * 8;
    const bf16_t* X = (const bf16_t*)(p.ws + OFF_X1); const float* g = p.in[I_NFG];
    for (int row = gw; row < MTOT; row += NW) {
        float* orow = row < MP ? p.out + O_YP + (size_t)row * D : p.out + O_YS + (size_t)(row - MP) * D;
        f32x4 v[4]; float s = 0.f;
        load_row<true>(X + (size_t)row * D, lane, v);
#pragma unroll
        for (int j = 0; j < 4; ++j) s += (v[j][0] * v[j][0] + v[j][1] * v[j][1]) + (v[j][2] * v[j][2] + v[j][3] * v[j][3]);
        const float rstd = rsqrtf(wave_sum(s) * (1.f / D) + EPS);
#pragma unroll
        for (int j = 0; j < 4; ++j) ((f32x4*)orow)[lane + 64 * j] = v[j] * rstd * ((const f32x4*)g)[lane + 64 * j];
    }
}

__device__ __forceinline__ F8 ld8bf(const bf16_t* p) { const u32x4 u = *(const u32x4*)p; F8 r; r.a = (f32x4){bflo(u.x), bfhi(u.x), bflo(u.y), bfhi(u.y)}; r.b = (f32x4){bflo(u.z), bfhi(u.z), bflo(u.w), bfhi(u.w)}; return r; }
__device__ __forceinline__ F8 ld8f(const float* p) { F8 r; r.a = *(const f32x4*)p; r.b = *(const f32x4*)(p + 4); return r; }
__device__ __forceinline__ void st8f(float* p, const F8& v) { *(f32x4*)p = v.a; *(f32x4*)(p + 4) = v.b; }
__device__ __forceinline__ F8 zero8() { F8 r; r.a = (f32x4){0.f, 0.f, 0.f, 0.f}; r.b = r.a; return r; }
__device__ __forceinline__ void phase_conv(const Params& p, LAS unsigned char* lds) {
    unsigned char* ws = p.ws;
    const bf16_t* BG = (const bf16_t*)(ws + OFF_BG); const bf16_t* CI = (const bf16_t*)(ws + OFF_CI); const bf16_t* XBC = (const bf16_t*)(ws + OFF_XBC);
    bf16_t* VA = (bf16_t*)(ws + OFF_VA); bf16_t* XC = (bf16_t*)(ws + OFF_XBCC);
    const int tid = threadIdx.x;
    for (int it = blockIdx.x; it < MP / 8 + NBS; it += gridDim.x) {
        if (it < MP / 8) {
            const int r0 = it * 8, tpos0 = r0 & (SEQ - 1), b = r0 >> 11;
            if (tid < 128) {
                const int ch = tid * 8;
                u32x4 raw[10], bgr[8];
#pragma unroll
                for (int i = 0; i < 10; ++i) raw[i] = (tpos0 - 2 + i >= 0) ? *(const u32x4*)(CI + (size_t)(r0 - 2 + i) * 1024 + ch) : (u32x4){0u, 0u, 0u, 0u};
#pragma unroll
                for (int i = 0; i < 8; ++i) bgr[i] = *(const u32x4*)(BG + (size_t)(r0 + i) * 1024 + ch);
                const F8 w0 = ld8f(p.in[I_CAW] + ch), w1 = ld8f(p.in[I_CAW] + 1024 + ch), w2 = ld8f(p.in[I_CAW] + 2048 + ch);
#pragma unroll
                for (int i = 0; i < 8; ++i) { const F8 p2 = cv8(raw[i]), p1 = cv8(raw[i + 1]), c0 = cv8(raw[i + 2]), bg = cv8(bgr[i]);
                    const f32x4 va = bg.a * (w0.a * p2.a + w1.a * p1.a + w2.a * c0.a), vb = bg.b * (w0.b * p2.b + w1.b * p1.b + w2.b * c0.b);
                    *(u32x4*)(VA + (size_t)(r0 + i) * 1024 + ch) = pack8(va, vb);
                    if (tpos0 + i >= SEQ - 2) st8f(p.out + O_SCP + ((size_t)b * 2 + (tpos0 + i - (SEQ - 2))) * 1024 + ch, c0); }
            } else {
                const int ch = (tid - 128) * 8;
                u32x4 raw[11];
#pragma unroll
                for (int i = 0; i < 11; ++i) raw[i] = (tpos0 - 3 + i >= 0) ? *(const u32x4*)(XBC + (size_t)(r0 - 3 + i) * 3072 + ch) : (u32x4){0u, 0u, 0u, 0u};
                const F8 w0 = ld8f(p.in[I_CBW] + ch), w1 = ld8f(p.in[I_CBW] + 3072 + ch), w2 = ld8f(p.in[I_CBW] + 6144 + ch), w3 = ld8f(p.in[I_CBW] + 9216 + ch), bb = ld8f(p.in[I_CBB] + ch);
#pragma unroll
                for (int i = 0; i < 8; ++i) { const F8 p3 = cv8(raw[i]), p2 = cv8(raw[i + 1]), p1 = cv8(raw[i + 2]), c0 = cv8(raw[i + 3]);
                    f32x4 va = w0.a * p3.a + w1.a * p2.a + w2.a * p1.a + w3.a * c0.a + bb.a, vb = w0.b * p3.b + w1.b * p2.b + w2.b * p1.b + w3.b * c0.b + bb.b;
#pragma unroll
                    for (int j = 0; j < 4; ++j) { va[j] = siluf_(va[j]); vb[j] = siluf_(vb[j]); }
                    *(u32x4*)(XC + (size_t)(r0 + i) * 3072 + ch) = pack8(va, vb);
                    if (tpos0 + i >= SEQ - 3) st8f(p.out + O_SBP + ((size_t)b * 3 + (tpos0 + i - (SEQ - 3))) * 3072 + ch, c0); }
            }
        } else {
            const int b = it - MP / 8, row = MP + b;
            if (tid < 128) {
                const int ch = tid * 8;
                const F8 c0 = ld8bf(CI + (size_t)row * 1024 + ch);
                const F8 p2 = ld8f(p.in[I_STA] + ((size_t)b * 2 + 0) * 1024 + ch), p1 = ld8f(p.in[I_STA] + ((size_t)b * 2 + 1) * 1024 + ch);
                const F8 w0 = ld8f(p.in[I_CAW] + ch), w1 = ld8f(p.in[I_CAW] + 1024 + ch), w2 = ld8f(p.in[I_CAW] + 2048 + ch);
                const F8 bg = ld8bf(BG + (size_t)row * 1024 + ch);
                const f32x4 va = bg.a * (w0.a * p2.a + w1.a * p1.a + w2.a * c0.a), vb = bg.b * (w0.b * p2.b + w1.b * p1.b + w2.b * c0.b);
                *(u32x4*)(VA + (size_t)row * 1024 + ch) = pack8(va, vb);
                st8f(p.out + O_SCS + ((size_t)b * 2 + 0) * 1024 + ch, p1); st8f(p.out + O_SCS + ((size_t)b * 2 + 1) * 1024 + ch, c0);
            } else {
                const int ch = (tid - 128) * 8;
                const F8 c0 = ld8bf(XBC + (size_t)row * 3072 + ch);
                const F8 p3 = ld8f(p.in[I_STB] + ((size_t)b * 3 + 0) * 3072 + ch), p2 = ld8f(p.in[I_STB] + ((size_t)b * 3 + 1) * 3072 + ch), p1 = ld8f(p.in[I_STB] + ((size_t)b * 3 + 2) * 3072 + ch);
                const F8 w0 = ld8f(p.in[I_CBW] + ch), w1 = ld8f(p.in[I_CBW] + 3072 + ch), w2 = ld8f(p.in[I_CBW] + 6144 + ch), w3 = ld8f(p.in[I_CBW] + 9216 + ch), bb = ld8f(p.in[I_CBB] + ch);
                f32x4 va = w0.a * p3.a + w1.a * p2.a + w2.a * p1.a + w3.a * c0.a + bb.a, vb = w0.b * p3.b + w1.b * p2.b + w2.b * p1.b + w3.b * c0.b + bb.b;
#pragma unroll
                for (int j = 0; j < 4; ++j) { va[j] = siluf_(va[j]); vb[j] = siluf_(vb[j]); }
                *(u32x4*)(XC + (size_t)row * 3072 + ch) = pack8(va, vb);
                st8f(p.out + O_SBS + ((size_t)b * 3 + 0) * 3072 + ch, p2); st8f(p.out + O_SBS + ((size_t)b * 3 + 1) * 3072 + ch, p1); st8f(p.out + O_SBS + ((size_t)b * 3 + 2) * 3072 + ch, c0);
            }
        }
    }
    const float* DTR = (const float*)(ws + OFF_DTRAW); float* DTP = (float*)(ws + OFF_DTP); float* ACS = (float*)(ws + OFF_ACS);
    LAS float* t1 = (LAS float*)lds; LAS float* t2 = t1 + 128 * 33;
    for (int it = blockIdx.x; it < 129; it += gridDim.x) {
        const int t0 = it * 128;
#pragma unroll
        for (int i = 0; i < 8; ++i) { const int idx = tid + 512 * i, r = idx >> 5, hh = idx & 31;
            const float raw = DTR[(size_t)(t0 + r) * 32 + hh] + p.in[I_DTB][hh];
            t1[r * 33 + hh] = raw > 20.f ? raw : log1pf(expf(raw)); }
        __syncthreads();
        if (tid < 32) { const float a = -expf(p.in[I_ALOG][tid]); float run = 0.f;
            for (int s = 0; s < 128; ++s) { run += t1[s * 33 + tid] * a; t2[s * 33 + tid] = run; } }
        __syncthreads();
#pragma unroll
        for (int i = 0; i < 8; ++i) { const int idx = tid + 512 * i, r = idx >> 5, hh = idx & 31;
            DTP[(size_t)(t0 + r) * 32 + hh] = t1[r * 33 + hh]; ACS[(size_t)(t0 + r) * 32 + hh] = t2[r * 33 + hh]; }
        __syncthreads();
    }
}

constexpr int RS = 272, RX = 144;
constexpr int L_C = 0, L_B = 34816, L_X = 69632, L_XW = 88064, L_H = 106496, L_ACS = 123904, L_DT = 124416;
__device__ __forceinline__ bf16x8 tr_frag(LAS unsigned char* base, int rstride, int k0, int c0, int lane) {
    const int i = lane & 15, g = lane >> 4, q = i >> 2, pp = i & 3;
    LAS unsigned char* a = base + (k0 + 8 * g + q) * rstride + (c0 + 4 * pp) * 2;
    const bf16x4 lo = __builtin_amdgcn_ds_read_tr16_b64_v4i16((LAS bf16x4*)a);
    const bf16x4 hi = __builtin_amdgcn_ds_read_tr16_b64_v4i16((LAS bf16x4*)(a + 4 * rstride));
    return (bf16x8){lo[0], lo[1], lo[2], lo[3], hi[0], hi[1], hi[2], hi[3]};
}
constexpr int L_RED = 124928, L_CF = 125056;
__device__ __forceinline__ void ssd_unit(const Params& p, LAS unsigned char* lds, int b, int h, int sbase) {
    unsigned char* ws = p.ws;
    const bf16_t* XC = (const bf16_t*)(ws + OFF_XBCC); const bf16_t* Z = (const bf16_t*)(ws + OFF_Z);
    const float* DTP = (const float*)(ws + OFF_DTP); const float* ACS = (const float*)(ws + OFF_ACS);
    bf16_t* YG = (bf16_t*)(ws + OFF_YG); float* SSQ = (float*)(ws + OFF_SSQ);
    const int tid = fresh_tid(), lane = tid & 63, w = __builtin_amdgcn_readfirstlane(tid >> 6), fr = lane & 15, fq = lane >> 4, g = h >> 3;
    const float Dh = p.in[I_DSKIP][h];
    LAS float* sAcs = (LAS float*)(lds + L_ACS); LAS float* sDt = (LAS float*)(lds + L_DT); LAS float* red = (LAS float*)(lds + L_RED);
    f32x4 hacc[4];
#pragma unroll
    for (int i = 0; i < 4; ++i) hacc[i] = (f32x4){0.f, 0.f, 0.f, 0.f};
    const int hpt = w & 3, hnb = (w >> 2) * 4;
    const int n4 = tid & 31, pr = tid >> 5;
    u32x4 rc[4], rb[4], rx[2]; float wv[2], my_acs = 0.f, my_dt = 0.f, acs_last_n;
#define SSD_PREFETCH(cc) do { const int _t0 = b * SEQ + (cc) * 128; \
        { const int ch = tid & 15, row = tid >> 4; _Pragma("unroll") for (int i = 0; i < 4; ++i) { const bf16_t* src = XC + (size_t)(_t0 + row + 32 * i) * 3072; rb[i] = *(const u32x4*)(src + 2048 + g * 128 + ch * 8); rc[i] = *(const u32x4*)(src + 2560 + g * 128 + ch * 8); } } \
        acs_last_n = ACS[(size_t)(_t0 + 127) * 32 + h]; \
        { const int ch = tid & 7, row = tid >> 3; _Pragma("unroll") for (int i = 0; i < 2; ++i) { const int r = _t0 + row + 64 * i; rx[i] = *(const u32x4*)(XC + (size_t)r * 3072 + h * 64 + ch * 8); \
              wv[i] = __expf(acs_last_n - ACS[(size_t)r * 32 + h]) * DTP[(size_t)r * 32 + h]; } } \
        if (tid < 128) { my_acs = ACS[(size_t)(_t0 + tid) * 32 + h]; my_dt = DTP[(size_t)(_t0 + tid) * 32 + h]; } } while (0)
    SSD_PREFETCH(0);
    int prev_sr = -1, prev_sh = 0;
    for (int c = 0; c < SEQ / 128; ++c) {
        const int t0 = b * SEQ + c * 128;
        __syncthreads();
        if (tid == 0 && prev_sr >= 0) { float v = 0.f;
#pragma unroll
            for (int i = 0; i < 16; ++i) v += red[i];
            SSQ[(size_t)prev_sr * 32 + prev_sh] = v; }
#pragma unroll
        for (int i = 0; i < 4; ++i) { u32x2 o; o.x = cvt_pk_bf16(hacc[i][0], hacc[i][1]); o.y = cvt_pk_bf16(hacc[i][2], hacc[i][3]);
            *(LAS u32x2*)(lds + L_H + (16 * hpt + fr) * RS + (16 * (hnb + i) + 4 * fq) * 2) = o; }
        { const int ch = tid & 15, row = tid >> 4;
#pragma unroll
          for (int i = 0; i < 4; ++i) { *(LAS u32x4*)(lds + L_B + (row + 32 * i) * RS + ch * 16) = rb[i]; *(LAS u32x4*)(lds + L_C + (row + 32 * i) * RS + ch * 16) = rc[i]; } }
        { const int ch = tid & 7, row = tid >> 3;
#pragma unroll
          for (int i = 0; i < 2; ++i) { *(LAS u32x4*)(lds + L_X + (row + 64 * i) * RX + ch * 16) = rx[i];
              const float s = wv[i]; u32x4 o;
              o.x = cvt_pk_bf16(bflo(rx[i].x) * s, bfhi(rx[i].x) * s); o.y = cvt_pk_bf16(bflo(rx[i].y) * s, bfhi(rx[i].y) * s);
              o.z = cvt_pk_bf16(bflo(rx[i].z) * s, bfhi(rx[i].z) * s); o.w = cvt_pk_bf16(bflo(rx[i].w) * s, bfhi(rx[i].w) * s);
              *(LAS u32x4*)(lds + L_XW + (row + 64 * i) * RX + ch * 16) = o; } }
        if (tid < 128) { sAcs[tid] = my_acs; sDt[tid] = my_dt; }
        const float acs_last = acs_last_n;
        __syncthreads();
        const int qt = w < 4 ? w : 11 - w, qrow = 16 * qt + fr;
        const size_t trow = (size_t)(t0 + qrow);
        u32x2 zv[4];
#pragma unroll
        for (int pt = 0; pt < 4; ++pt) zv[pt] = *(const u32x2*)(Z + trow * 2048 + h * 64 + 16 * pt + 4 * fq);
        const int sit = sbase + 256 * c; const bool has_s = sit < NBS * NH;
        const int sb = sit >> 5, sh = sit & 31, sr = MP + sb, sg = sh >> 3;
        f32x4 h0[4]; u32x2 sbu, scu; float sdt = 0.f, sxv[4], szv[4];
        const size_t sbase_off = (((size_t)sb * NH + sh) * HD) * DS;
        if (has_s) {
            const bf16_t* xr = XC + (size_t)sr * 3072;
#pragma unroll
            for (int i = 0; i < 4; ++i) { const int pp = pr + 16 * i; h0[i] = __builtin_nontemporal_load((const f32x4*)(p.in[I_STS] + sbase_off + (size_t)pp * DS + 4 * n4));
                sxv[i] = bf2f(xr[sh * 64 + pp]); szv[i] = bf2f(Z[(size_t)sr * 2048 + sh * 64 + pp]); }
            sbu = *(const u32x2*)(xr + 2048 + sg * 128 + 4 * n4); scu = *(const u32x2*)(xr + 2560 + sg * 128 + 4 * n4);
            sdt = DTP[(size_t)sr * 32 + sh];
        }
        bf16x8 cf[4];
#pragma unroll
        for (int kk = 0; kk < 4; ++kk) cf[kk] = *(const LAS bf16x8*)(lds + L_C + qrow * RS + (kk * 32 + fq * 8) * 2);
        f32x4 yacc[4];
#pragma unroll
        for (int i = 0; i < 4; ++i) yacc[i] = (f32x4){0.f, 0.f, 0.f, 0.f};
        const float acs_q = sAcs[qrow], acs_q0 = sAcs[16 * qt];
        LAS float* cfac = (LAS float*)(lds + L_CF) + w * 128;
#pragma unroll
        for (int i = 0; i < 2; ++i) { const int sidx = lane + 64 * i; if (sidx < 16 * qt) cfac[sidx] = __expf(acs_q0 - sAcs[sidx]) * sDt[sidx]; }
        const float r_q = __expf(acs_q - acs_q0);
        if (c > 0) {
#pragma unroll
            for (int pp = 0; pp < 2; ++pp) {
                bf16x8 hf[2][4];
#pragma unroll
                for (int a = 0; a < 2; ++a)
#pragma unroll
                    for (int kk = 0; kk < 4; ++kk) hf[a][kk] = *(const LAS bf16x8*)(lds + L_H + (16 * (2 * pp + a) + fr) * RS + (kk * 32 + fq * 8) * 2);
#pragma unroll
                for (int kk = 0; kk < 4; ++kk)
#pragma unroll
                    for (int a = 0; a < 2; ++a) yacc[2 * pp + a] = __builtin_amdgcn_mfma_f32_16x16x32_bf16(hf[a][kk], cf[kk], yacc[2 * pp + a], 0, 0, 0);
            }
            const float eq = __expf(acs_q);
#pragma unroll
            for (int pt = 0; pt < 4; ++pt) yacc[pt] = yacc[pt] * eq;
        }
        for (int sp = 0; 2 * sp <= qt; ++sp) {
            const bool two = 2 * sp + 1 <= qt;
            bf16x8 bfr[2][4];
#pragma unroll
            for (int kk = 0; kk < 4; ++kk) bfr[0][kk] = *(const LAS bf16x8*)(lds + L_B + (16 * (2 * sp) + fr) * RS + (kk * 32 + fq * 8) * 2);
            if (two) {
#pragma unroll
                for (int kk = 0; kk < 4; ++kk) bfr[1][kk] = *(const LAS bf16x8*)(lds + L_B + (16 * (2 * sp + 1) + fr) * RS + (kk * 32 + fq * 8) * 2);
            }
            f32x4 sacc[2];
            sacc[0] = (f32x4){0.f, 0.f, 0.f, 0.f}; sacc[1] = sacc[0];
#pragma unroll
            for (int kk = 0; kk < 4; ++kk) sacc[0] = __builtin_amdgcn_mfma_f32_16x16x32_bf16(bfr[0][kk], cf[kk], sacc[0], 0, 0, 0);
            if (two) {
#pragma unroll
                for (int kk = 0; kk < 4; ++kk) sacc[1] = __builtin_amdgcn_mfma_f32_16x16x32_bf16(bfr[1][kk], cf[kk], sacc[1], 0, 0, 0);
            }
#pragma unroll
            for (int a = 0; a < 2; ++a) { const int st = 2 * sp + a, s0 = 16 * st + 4 * fq;
                float pv[4];
                if (st < qt) { const f32x4 cc = *(const LAS f32x4*)(cfac + s0);
#pragma unroll
                    for (int j = 0; j < 4; ++j) pv[j] = sacc[a][j] * r_q * cc[j];
                } else if (st == qt) { const f32x4 as = *(const LAS f32x4*)(sAcs + s0), ds = *(const LAS f32x4*)(sDt + s0);
#pragma unroll
                    for (int j = 0; j < 4; ++j) pv[j] = (s0 + j <= qrow) ? sacc[a][j] * __expf(acs_q - as[j]) * ds[j] : 0.f;
                } else {
#pragma unroll
                    for (int j = 0; j < 4; ++j) pv[j] = 0.f;
                }
                u32x2 o; o.x = cvt_pk_bf16(pv[0], pv[1]); o.y = cvt_pk_bf16(pv[2], pv[3]);
                *(LAS u32x2*)(lds + L_C + qrow * RS + s0 * 2) = o; }
        }
        if (c + 1 < SEQ / 128) SSD_PREFETCH(c + 1);
        for (int kk = 0; kk <= (qt >> 1); ++kk) {
            bf16x8 xf[4];
            const bf16x8 pf = *(const LAS bf16x8*)(lds + L_C + qrow * RS + (kk * 32 + fq * 8) * 2);
#pragma unroll
            for (int pt = 0; pt < 4; ++pt) xf[pt] = tr_frag(lds + L_X, RX, kk * 32, 16 * pt, lane);
#pragma unroll
            for (int pt = 0; pt < 4; ++pt) yacc[pt] = __builtin_amdgcn_mfma_f32_16x16x32_bf16(xf[pt], pf, yacc[pt], 0, 0, 0);
        }
        { float ss = 0.f;
#pragma unroll
          for (int pt = 0; pt < 4; ++pt) { const int pc = 16 * pt + 4 * fq;
              const u32x2 xv = *(const LAS u32x2*)(lds + L_X + qrow * RX + pc * 2);
              const float x0 = bflo(xv.x), x1 = bfhi(xv.x), x2 = bflo(xv.y), x3 = bfhi(xv.y);
              const float g0 = (yacc[pt][0] + Dh * x0) * siluf_(bflo(zv[pt].x)), g1 = (yacc[pt][1] + Dh * x1) * siluf_(bfhi(zv[pt].x));
              const float g2 = (yacc[pt][2] + Dh * x2) * siluf_(bflo(zv[pt].y)), g3 = (yacc[pt][3] + Dh * x3) * siluf_(bfhi(zv[pt].y));
              ss += (g0 * g0 + g1 * g1) + (g2 * g2 + g3 * g3);
              u32x2 o; o.x = cvt_pk_bf16(g0, g1); o.y = cvt_pk_bf16(g2, g3);
              *(u32x2*)(YG + trow * 2048 + h * 64 + pc) = o; }
          ss += __shfl_xor(ss, 16); ss += __shfl_xor(ss, 32);
          if (fq == 0) SSQ[trow * 32 + h] = ss; }
        { const float dec = __expf(acs_last);
#pragma unroll
          for (int i = 0; i < 4; ++i) hacc[i] = hacc[i] * dec;
#pragma unroll
          for (int kp = 0; kp < 2; ++kp) {
              bf16x8 xwf[2], bf[2][4];
#pragma unroll
              for (int a = 0; a < 2; ++a) { const int kk = 2 * kp + a;
                  xwf[a] = tr_frag(lds + L_XW, RX, kk * 32, 16 * hpt, lane);
#pragma unroll
                  for (int i = 0; i < 4; ++i) bf[a][i] = tr_frag(lds + L_B, RS, kk * 32, 16 * (hnb + i), lane); }
              __builtin_amdgcn_sched_barrier(0);
#pragma unroll
              for (int a = 0; a < 2; ++a)
#pragma unroll
                  for (int i = 0; i < 4; ++i) hacc[i] = __builtin_amdgcn_mfma_f32_16x16x32_bf16(bf[a][i], xwf[a], hacc[i], 0, 0, 0);
          } }
        prev_sr = -1;
        if (has_s) {
            const float dA = __expf(sdt * -expf(p.in[I_ALOG][sh])), sD = p.in[I_DSKIP][sh];
            const f32x4 Bv = cv4(sbu), Cv = cv4(scu);
            float part = 0.f;
#pragma unroll
            for (int i = 0; i < 4; ++i) { const int pp = pr + 16 * i;
                const f32x4 hn = h0[i] * dA + Bv * (sdt * sxv[i]);
                __builtin_nontemporal_store(hn, (f32x4*)(p.out + O_SSS + sbase_off + (size_t)pp * DS + 4 * n4));
                float y = (hn[0] * Cv[0] + hn[1] * Cv[1]) + (hn[2] * Cv[2] + hn[3] * Cv[3]);
#pragma unroll
                for (int o = 1; o < 32; o <<= 1) y += __shfl_xor(y, o);
                const float gt = (y + sD * sxv[i]) * siluf_(szv[i]);
                if (n4 == 0) YG[(size_t)sr * 2048 + sh * 64 + pp] = f2bf(gt);
                part += gt * gt; }
            if (n4 == 0) red[pr] = part;
            prev_sr = sr; prev_sh = sh;
        }
    }
#undef SSD_PREFETCH
    float* so = p.out + O_SSP + (((size_t)b * NH + h) * HD + 16 * hpt + fr) * DS;
#pragma unroll
    for (int i = 0; i < 4; ++i) *(f32x4*)(so + 16 * (hnb + i) + 4 * fq) = hacc[i];
    __syncthreads();
    if (tid == 0 && prev_sr >= 0) { float v = 0.f;
#pragma unroll
        for (int i = 0; i < 16; ++i) v += red[i];
        SSQ[(size_t)prev_sr * 32 + prev_sh] = v; }
    __syncthreads();
}
__device__ __forceinline__ void phase_ssd(const Params& p, LAS unsigned char* lds) {
    for (int u = blockIdx.x; u < NBP * NH; u += gridDim.x) {
        const int xcd = u & 7, j = u >> 3, pair = xcd * 4 + (j >> 3), hr = j & 7;
        ssd_unit(p, lds, pair >> 2, (pair & 3) * 8 + hr, u);
    }
}
__device__ __forceinline__ void phase_gnorm(const Params& p) {
    bf16_t* YG = (bf16_t*)(p.ws + OFF_YG); const float* SSQ = (const float*)(p.ws + OFF_SSQ);
    for (int i = blockIdx.x * 512 + fresh_tid(); i < MTOT * 256; i += gridDim.x * 512) {
        const int row = i >> 8, cu = i & 255, g = cu >> 6;
        const f32x4 s0 = *(const f32x4*)(SSQ + (size_t)row * 32 + 8 * g), s1 = *(const f32x4*)(SSQ + (size_t)row * 32 + 8 * g + 4);
        const float rstd = rsqrtf(((s0[0] + s0[1]) + (s0[2] + s0[3]) + (s1[0] + s1[1]) + (s1[2] + s1[3])) * (1.f / 512.f) + EPS);
        bf16_t* q = YG + (size_t)row * 2048 + cu * 8;
        const F8 v = ld8bf(q);
        *(u32x4*)q = pack8(v.a * rstd, v.b * rstd);
    }
}

__global__ void __launch_bounds__(512, 2) fwd_megakernel(Params p) {
    extern __shared__ __attribute__((aligned(16))) unsigned char shm[];
    LAS unsigned char* lds = (LAS unsigned char*)shm;
    cg::grid_group grid = cg::this_grid();
    unsigned char* ws = p.ws;
    const int G = gridDim.x, cid = blockIdx.x;
    float* mod = (float*)(ws + OFF_MOD);
    pg8::StaticOrder S;
    volatile LAS unsigned* xst = (volatile LAS unsigned*)(lds + 131072);
    if (threadIdx.x == 0) { xst[0] = 0u; xst[1] = 0u; }
    __syncthreads();
    XcdBarrier xb = xcd_barrier_post((unsigned*)(ws + OFF_BAR), xst);

    phase0(p, lds, 0);
    if (p.ws == nullptr) grid.sync();
    GSYNC();
    if (cid < 24) {
        pg8::Gemm g{(const bf16_t*)(ws + OFF_CA), (const bf16_t*)(ws + OFF_WADA), 256, 6144, 1024};
        EpiF32Bias E{mod, 6144, p.in[I_BADA]};
        S.init(g.M, g.N, 24, cid); pg8::gemm_phase<EpiF32Bias, pg8::StaticOrder, true, true>(lds, g, S, E);
    } else phase0(p, lds, 1);
    GSYNC();
    phase_rownorm<false>(p, p.in[I_N1G], 1024, 0, (bf16_t*)(ws + OFF_U));
    if (PROBE_EW) phase_rownorm<false>(p, p.in[I_N1G], 1024, 0, (bf16_t*)(ws + OFF_U));
    GSYNC();
    {
        pg8::Gemm g{(const bf16_t*)(ws + OFF_U), (const bf16_t*)(ws + OFF_WIN), MPAD, DINP, 1024};
        EpiIn E{(bf16_t*)(ws + OFF_BG), (bf16_t*)(ws + OFF_CI), (bf16_t*)(ws + OFF_Z), (bf16_t*)(ws + OFF_XBC), (bf16_t*)(ws + OFF_GA), (bf16_t*)(ws + OFF_GB), (float*)(ws + OFF_DTRAW)};
        S.init(g.M, g.N, G, cid); pg8::gemm_phase<EpiIn, pg8::StaticOrder, true, true>(lds, g, S, E);
        if (PROBE_INPROJ) { __syncthreads(); pg8::gemm_phase<EpiIn, pg8::StaticOrder, true, true>(lds, g, S, E); }
        __syncthreads();
        phase0(p, lds, 2);
    }
    GSYNC();
    phase_conv(p, lds);
    if (PROBE_CONV) { __syncthreads(); phase_conv(p, lds); }
    GSYNC();
    phase_ssd(p, lds);
    if (PROBE_SSD) { __syncthreads(); phase_ssd(p, lds); }
    GSYNC();
    phase_gnorm(p);
    GSYNC();
    {
        pg8::Gemm ga{(const bf16_t*)(ws + OFF_VA), (const bf16_t*)(ws + OFF_WAOUT), MP, 1024, 1024};
        EpiGate<0> Ea{(bf16_t*)(ws + OFF_YA), (const bf16_t*)(ws + OFF_GA), nullptr, 1024};
        S.init(ga.M, ga.N, G, cid); pg8::gemm_phase<EpiGate<0>, pg8::StaticOrder, true, true>(lds, ga, S, Ea);
        __syncthreads();
        pg8::Gemm gb{(const bf16_t*)(ws + OFF_YG), (const bf16_t*)(ws + OFF_WBOUT), MP, 1024, 2048};
        EpiGate<1> Eb{(bf16_t*)(ws + OFF_MERGED), (const bf16_t*)(ws + OFF_GB), (const bf16_t*)(ws + OFF_YA), 1024};
        pg8::gemm_phase<EpiGate<1>, pg8::StaticOrder, true, true>(lds, gb, S, Eb);
        __syncthreads();
        SkGate<0> Sa{(bf16_t*)(ws + OFF_YA), (const bf16_t*)(ws + OFF_GA), nullptr, 1024};
        skinny_gemm<4>(lds, (const bf16_t*)(ws + OFF_VA) + (size_t)MP * 1024, (const bf16_t*)(ws + OFF_WAOUT), 1024, 1024, Sa);
        SkGate<1> Sb{(bf16_t*)(ws + OFF_MERGED), (const bf16_t*)(ws + OFF_GB), (const bf16_t*)(ws + OFF_YA), 1024};
        skinny_gemm<4>(lds, (const bf16_t*)(ws + OFF_YG) + (size_t)MP * 2048, (const bf16_t*)(ws + OFF_WBOUT), 1024, 2048, Sb);
    }
    GSYNC();
    {
        pg8::Gemm g{(const bf16_t*)(ws + OFF_MERGED), (const bf16_t*)(ws + OFF_WO), MP, 1024, 1024};
        EpiRes E{(bf16_t*)(ws + OFF_X1), p.in[I_XP], mod + 2048};
        S.init(g.M, g.N, G, cid); pg8::gemm_phase<EpiRes, pg8::StaticOrder, true, true>(lds, g, S, E);
        __syncthreads();
        SkRes Sk{(bf16_t*)(ws + OFF_X1), p.in[I_XS], mod + 2048};
        skinny_gemm<4>(lds, (const bf16_t*)(ws + OFF_MERGED) + (size_t)MP * 1024, (const bf16_t*)(ws + OFF_WO), 1024, 1024, Sk);
    }
    GSYNC();
    phase_rownorm<true>(p, p.in[I_N2G], 4096, 3072, (bf16_t*)(ws + OFF_U));
    if (PROBE_EW) phase_rownorm<true>(p, p.in[I_N2G], 4096, 3072, (bf16_t*)(ws + OFF_U));
    GSYNC();
    {
        pg8::Gemm g{(const bf16_t*)(ws + OFF_U), (const bf16_t*)(ws + OFF_W1), MP, DFF, 1024};
        EpiGate<2> E{(bf16_t*)(ws + OFF_HMID), nullptr, nullptr, DFF};
        S.init(g.M, g.N, G, cid); pg8::gemm_phase<EpiGate<2>, pg8::StaticOrder, true, true>(lds, g, S, E);
        if (PROBE_MLP1) { __syncthreads(); pg8::gemm_phase<EpiGate<2>, pg8::StaticOrder, true, true>(lds, g, S, E); }
        __syncthreads();
        SkGate<2> Sk{(bf16_t*)(ws + OFF_HMID), nullptr, nullptr, DFF};
        skinny_gemm<1>(lds, (const bf16_t*)(ws + OFF_U) + (size_t)MP * 1024, (const bf16_t*)(ws + OFF_W1), DFF, 1024, Sk);
    }
    GSYNC();
    {
        pg8::Gemm g{(const bf16_t*)(ws + OFF_HMID), (const bf16_t*)(ws + OFF_W2), MP, 1024, DFF};
        EpiRes E{(bf16_t*)(ws + OFF_X1), nullptr, mod + 5120};
        S.init(g.M, g.N, G, cid); pg8::gemm_phase<EpiRes, pg8::StaticOrder, true, true>(lds, g, S, E);
        __syncthreads();
        SkRes Sk{(bf16_t*)(ws + OFF_X1), nullptr, mod + 5120};
        skinny_gemm<4>(lds, (const bf16_t*)(ws + OFF_HMID) + (size_t)MP * DFF, (const bf16_t*)(ws + OFF_W2), 1024, DFF, Sk);
    }
    GSYNC();
    phase_final(p);
    if (PROBE_EW) phase_final(p);
}

extern "C" void kernel_launch(void* const* d_in, const int* in_sizes, int n_in, void* d_out, int out_size, void* d_ws, size_t ws_size, hipStream_t stream) {
    constexpr int LDS_BYTES = 131072 + 16;
    static int grid = 0;
    if (grid == 0) {
        if (n_in != 25 || ws_size < WS_END) { fprintf(stderr, "kernel_launch: unexpected n_in %d / ws %zu (need %zu)\n", n_in, ws_size, (size_t)WS_END); grid = -1; return; }
        int dev = 0, cus = 0, per_cu = 0;
        (void)hipGetDevice(&dev);
        (void)hipDeviceGetAttribute(&cus, hipDeviceAttributeMultiprocessorCount, dev);
        if (hipFuncSetAttribute((const void*)fwd_megakernel, hipFuncAttributeMaxDynamicSharedMemorySize, LDS_BYTES) != hipSuccess) { fprintf(stderr, "kernel_launch: hipFuncSetAttribute failed\n"); grid = -1; return; }
        if (hipOccupancyMaxActiveBlocksPerMultiprocessor(&per_cu, (const void*)fwd_megakernel, 512, LDS_BYTES) != hipSuccess || per_cu < 1) { fprintf(stderr, "kernel_launch: occupancy query says %d blocks per CU\n", per_cu); grid = -1; return; }
        grid = cus;
    }
    if (grid < 0) return;
    Params p{};
    for (int i = 0; i < 25; ++i) p.in[i] = (const float*)d_in[i];
    p.out = (float*)d_out; p.ws = (unsigned char*)d_ws;
    (void)hipMemsetAsync((unsigned char*)d_ws + OFF_BAR, 0, 16384, stream);
    void* args[] = {&p};
    hipError_t e = hipLaunchCooperativeKernel((const void*)fwd_megakernel, dim3(grid), dim3(512), args, LDS_BYTES, stream);
    if (e != hipSuccess) fprintf(stderr, "cooperative launch failed: %s (grid %d)\n", hipGetErrorString(e), grid);
}
```

```cpp
#include <hip/hip_runtime.h>
#include <hip/hip_cooperative_groups.h>
#include <cstdio>
#include <cstdint>
namespace cg = cooperative_groups;
#define PROBE_EW 0
#define PROBE_CONV 0
#define PROBE_SSD 0
#define PROBE_SYNC 0
#define PROBE_PHASE -1
#define PROBE_INPROJ 0
#define PROBE_MLP1 0
#define GSYNC() do { xcd_barrier(xb); if (PROBE_SYNC) xcd_barrier(xb); } while (0)

#define LAS __attribute__((address_space(3)))
typedef unsigned short bf16_t;
typedef short bf16x8 __attribute__((ext_vector_type(8)));
typedef short bf16x4 __attribute__((ext_vector_type(4)));
typedef float f32x4 __attribute__((ext_vector_type(4)));
typedef float f32x2 __attribute__((ext_vector_type(2)));
typedef unsigned u32x4 __attribute__((ext_vector_type(4)));
typedef unsigned u32x2 __attribute__((ext_vector_type(2)));

constexpr int D = 1024, NBP = 8, SEQ = 2048, MP = NBP * SEQ, NBS = 128, MTOT = MP + NBS, MPAD = 16640;
constexpr int DINP = 10496, DINNER = 2048, DXBC = 3072, NH = 32, HD = 64, DS = 128, DFF = 4096, DIN = 10272;
constexpr float EPS = 1e-6f;
constexpr size_t O_YP = 0, O_YS = 16777216, O_SCP = 16908288, O_SBP = 16924672, O_SSP = 16998400, O_SCS = 19095552, O_SBS = 19357696, O_SSS = 20537344;
constexpr size_t S1 = (size_t)MPAD * 1024 * 2;
constexpr size_t OFF_WADA = 0, OFF_WIN = 12582912, OFF_WAOUT = 34078720, OFF_WBOUT = 36175872, OFF_WO = 40370176, OFF_W1 = 42467328, OFF_W2 = 50855936,
                 OFF_CA = 59244544, OFF_MOD = 59768832, OFF_DTRAW = 66060288, OFF_DTP = 68190208, OFF_ACS = 70320128, OFF_SSQ = 72450048, OFF_U = 74579968,
                 OFF_R1 = OFF_U + S1, OFF_BG = OFF_R1, OFF_CI = OFF_R1 + S1, OFF_Z = OFF_R1 + 2 * S1, OFF_XBC = OFF_R1 + 4 * S1, OFF_GA = OFF_R1 + 7 * S1, OFF_GB = OFF_R1 + 8 * S1,
                 OFF_R2 = OFF_R1 + 9 * S1, OFF_BAR = OFF_R2 + 3 * S1, WS_END = OFF_BAR + 16384;
constexpr size_t OFF_VA = OFF_U, OFF_YA = OFF_BG, OFF_MERGED = OFF_CI, OFF_YG = OFF_XBC, OFF_HMID = OFF_R1, OFF_XBCC = OFF_R2, OFF_X1 = OFF_R2;

struct Params {
    const float* in[25];
    float* out;
    unsigned char* ws;
};
enum { I_XP = 0, I_XS, I_CP, I_CS, I_STA, I_STB, I_STS, I_WADA, I_BADA, I_N1G, I_WIN, I_CAW, I_WAOUT, I_CBW, I_CBB, I_DTB, I_ALOG, I_DSKIP, I_SNG, I_WBOUT, I_WO, I_N2G, I_W1, I_W2, I_NFG };

__device__ __forceinline__ unsigned cvt_pk_bf16(float lo, float hi) { unsigned r; asm volatile("v_cvt_pk_bf16_f32 %0, %1, %2" : "=v"(r) : "v"(lo), "v"(hi)); return r; }
__device__ __forceinline__ bf16_t f2bf(float f) { unsigned u = __float_as_uint(f); u += 0x7FFFu + ((u >> 16) & 1u); return (bf16_t)(u >> 16); }
__device__ __forceinline__ float bf2f(bf16_t b) { return __uint_as_float(((unsigned)b) << 16); }
__device__ __forceinline__ float bflo(unsigned u) { return __uint_as_float(u << 16); }
__device__ __forceinline__ float bfhi(unsigned u) { return __uint_as_float(u & 0xffff0000u); }
__device__ __forceinline__ float sigmoidf_(float x) { return __builtin_amdgcn_rcpf(1.f + __expf(-x)); }
__device__ __forceinline__ float siluf_(float x) { return x * sigmoidf_(x); }
__device__ __forceinline__ f32x4 cv4(const u32x2 u) { return (f32x4){bflo(u.x), bfhi(u.x), bflo(u.y), bfhi(u.y)}; }
struct F8 { f32x4 a, b; };
__device__ __forceinline__ F8 cv8(const u32x4 u) { F8 r; r.a = (f32x4){bflo(u.x), bfhi(u.x), bflo(u.y), bfhi(u.y)}; r.b = (f32x4){bflo(u.z), bfhi(u.z), bflo(u.w), bfhi(u.w)}; return r; }
__device__ __forceinline__ int tid_of(int wid) { int l; asm volatile("v_mbcnt_lo_u32_b32 %0, -1, 0\n\tv_mbcnt_hi_u32_b32 %0, -1, %0" : "=v"(l)); __builtin_assume(l >= 0 && l < 64); __builtin_assume(wid >= 0 && wid < 8); return wid * 64 + l; }
__device__ __forceinline__ float wave_sum(float v) {
#pragma unroll
    for (int o = 1; o < 64; o <<= 1) v += __shfl_xor(v, o);
    return v;
}


#define XB_TMO      128
#define XB_XCNT(j)  (256  + 64 * (j))
#define XB_XSUB(j)  (1280 + 64 * (j))
#define XB_XGEN(j)  (2304 + 64 * (j))
#define XB_TOP      3328
#define XB_TOPGEN   3392
#define XCD_BAR_WORDS 3456
#define XB_SPIN_CAP (1u << 18)
__device__ __forceinline__ unsigned xb_ld(unsigned* p)              { return __hip_atomic_load(p, __ATOMIC_RELAXED, __HIP_MEMORY_SCOPE_AGENT); }
__device__ __forceinline__ unsigned xb_add(unsigned* p, unsigned v) { return __hip_atomic_fetch_add(p, v, __ATOMIC_RELAXED, __HIP_MEMORY_SCOPE_AGENT); }
__device__ __forceinline__ unsigned xb_xcc_id() { return (unsigned)__builtin_amdgcn_s_getreg((3 << 11) | 20) & 0xFu; }
#define XB_SPIN(cond, bar) do { unsigned _sp = 0; while (cond) { __builtin_amdgcn_s_sleep(1); \
    if ((++_sp & 255u) == 0u) { if (xb_ld(&(bar)[XB_TMO])) break; if (_sp > XB_SPIN_CAP) { atomicAdd(&(bar)[XB_TMO], 1u); break; } } } } while (0)
struct XcdBarrier { unsigned* bar; unsigned x; volatile LAS unsigned* st; int wid; };
__device__ __forceinline__ XcdBarrier xcd_barrier_post(unsigned* bar, volatile LAS unsigned* st, int wid) {
    XcdBarrier b; b.bar = bar; b.x = xb_xcc_id(); b.st = st; b.wid = wid;
    if (tid_of(wid) == 0) (void)xb_add(&bar[XB_XCNT(b.x)], 1u);
    return b;
}
__device__ __forceinline__ void xcd_barrier_complete(unsigned* bar, unsigned x, unsigned& nloc, unsigned& nx) {
    const unsigned G = gridDim.x * gridDim.y * gridDim.z;
    unsigned sum, cnt, mine, sp = 0u;
    for (;;) {
        sum = 0u; cnt = 0u; mine = 0u;
#pragma unroll
        for (unsigned j = 0; j < 16; ++j) { const unsigned c = xb_ld(&bar[XB_XCNT(j)]); sum += c; cnt += (c > 0u) ? 1u : 0u; mine = (j == x) ? c : mine; }
        if (sum == G) break;
        __builtin_amdgcn_s_sleep(1);
        if ((++sp & 255u) == 0u) { if (xb_ld(&bar[XB_TMO])) break; if (sp > XB_SPIN_CAP) { atomicAdd(&bar[XB_TMO], 1u); break; } }
    }
    nloc = mine > 0u ? mine : 1u; nx = cnt > 0u ? cnt : 1u;
}
__device__ __forceinline__ void xcd_barrier(const XcdBarrier& b) {
    asm volatile("s_waitcnt vmcnt(0)" ::: "memory");
    __syncthreads();
    if (tid_of(b.wid) == 0) {
        unsigned* bar = b.bar;
        __builtin_amdgcn_s_waitcnt(0);
        unsigned nloc = b.st[0], nx = b.st[1];
        if (nloc == 0u) { xcd_barrier_complete(bar, b.x, nloc, nx); b.st[0] = nloc; b.st[1] = nx; }
        const unsigned old = xb_add(&bar[XB_XSUB(b.x)], 1u);
        const unsigned gen = old / nloc;
        if (old + 1u == (gen + 1u) * nloc) {
            __builtin_amdgcn_fence(__ATOMIC_RELEASE, "agent");
            asm volatile("s_waitcnt vmcnt(0)" ::: "memory");
            const unsigned og = xb_add(&bar[XB_TOP], 1u);
            const unsigned tg = og / nx;
            if (og + 1u == (tg + 1u) * nx) xb_add(&bar[XB_TOPGEN], 1u);
            else XB_SPIN(xb_ld(&bar[XB_TOPGEN]) == tg, bar);
            __builtin_amdgcn_fence(__ATOMIC_ACQUIRE, "agent");
            xb_add(&bar[XB_XGEN(b.x)], 1u);
            asm volatile("s_waitcnt vmcnt(0)" ::: "memory");
        } else {
            XB_SPIN(xb_ld(&bar[XB_XGEN(b.x)]) == gen, bar);
            __builtin_amdgcn_fence(__ATOMIC_ACQUIRE, "agent");
            asm volatile("s_waitcnt vmcnt(0)" ::: "memory");
        }
    }
    __syncthreads();
}

constexpr int L_XST = 131072, L_RT = 131072 + 16, LDS_TOTAL = L_RT + 4096;
namespace pg8 {
#define PG8_LAS __attribute__((address_space(3)))
constexpr int BM = 256, BK = 64, HALF = 128, HTB = HALF * BK * 2, STAGE_BYTES = 8 * HTB, NXCD = 8, WGM = 4;
__host__ __device__ __forceinline__ int lds_byte(int r, int c) { const int st = (r >> 4) * 2 + (c >> 5), rr = r & 15, cc = c & 31, ob = rr * 64 + cc * 2; return st * 1024 + (ob ^ (((ob >> 9) & 1) << 5)); }
__host__ __device__ __forceinline__ void stage_rc(int b, int& R, int& C) { const int st = b / 1024, sb = b % 1024, swz = sb ^ (((sb >> 9) & 1) << 5); R = (st >> 1) * 16 + swz / 64; C = (st & 1) * 32 + (swz % 64) / 2; }
__host__ __device__ __forceinline__ int perm32(int rho) { const int n = rho >> 4, i = rho & 15; return 8 * (i >> 2) + 4 * n + (i & 3); }
struct Unit { int pm, pn; };
struct Gemm { const bf16_t* A; const bf16_t* Bt; int M, N, K; };
struct StaticOrder {
    int nM, nN, nwg, G, c;
    __host__ __device__ void init(int M, int N, int G_, int c_) { nM = M / BM; nN = N / BM; nwg = nM * nN; G = G_; c = c_; }
    __host__ __device__ bool next(int i, Unit& u) const {
        const long L = (long)i * G + c; if (L >= nwg) return false;
        int wgid = (int)L; { const int q = nwg / NXCD, r = nwg % NXCD, xcd = wgid % NXCD, off = wgid / NXCD; wgid = (xcd < r ? xcd * (q + 1) : r * (q + 1) + (xcd - r) * q) + off; }
        const int nig = WGM * nN, gid = wgid / nig, fm = gid * WGM, gsz = (nM - fm) < WGM ? (nM - fm) : WGM;
        u.pm = fm + ((wgid % nig) % gsz); u.pn = (wgid % nig) / gsz; return true;
    }
    __device__ __forceinline__ void a_ready(const Unit&) const {}
    __device__ __forceinline__ void done(const Unit&) const {}
};

template <class Epi, class Sched, bool ALIGN_EPI = false, bool SP2 = false>
__device__ __forceinline__ void gemm_phase(PG8_LAS unsigned char* lds, const Gemm g, const Sched& S, const Epi& E, const int wid) {
    const int tid = tid_of(wid), lane = tid & 63, wr = wid >> 2, wc = wid & 3, fr = lane & 15, fq = lane >> 4;
    const int K = g.K, nt = K / BK;
    unsigned voffA[2], voffB[2];
#pragma unroll
    for (int i = 0; i < 2; ++i) { int R, C; stage_rc(tid * 16 + i * 8192, R, C); const int Rb = Epi::PERM ? ((R & ~31) + perm32(R & 31)) : R;
        voffA[i] = (unsigned)(R * K + C) * 2u; voffB[i] = (unsigned)(Rb * K + C) * 2u; }
    const size_t kstep = (size_t)(BK * 2);
    const size_t hstep = (size_t)HALF * K * 2;
    const size_t tstep = 2 * hstep;
    const unsigned ldsw = (unsigned)wid * 1024u;
    const int aoff = lds_byte(wr * 64 + fr, fq * 8), boff = lds_byte(wc * 32 + fr, fq * 8);
#define PG8_SA(b, h) (((b) * 2 + (h)) * HTB)
#define PG8_SB(b, h) ((4 + (b) * 2 + (h)) * HTB)
#define PG8_STAGE(bufoff, gbase, voff) do { _Pragma("unroll") for (int _i = 0; _i < 2; ++_i) \
        __builtin_amdgcn_global_load_lds((const unsigned*)((const char*)(gbase) + (voff)[_i]), (PG8_LAS unsigned*)(lds + (bufoff) + ldsw + _i * 8192), 16, 0, 0); } while (0)
#define PG8_LDA(dst, b, h) do { _Pragma("unroll") for (int m = 0; m < 4; ++m) _Pragma("unroll") for (int k = 0; k < 2; ++k) dst[m][k] = *(const PG8_LAS bf16x8*)(lds + PG8_SA(b, h) + aoff + m * 2048 + k * 1024); } while (0)
#define PG8_LDB(dst, b, h) do { _Pragma("unroll") for (int n = 0; n < 2; ++n) _Pragma("unroll") for (int k = 0; k < 2; ++k) dst[n][k] = *(const PG8_LAS bf16x8*)(lds + PG8_SB(b, h) + boff + n * 2048 + k * 1024); } while (0)
#define PG8_MMA(ai, bj, At, Bt) do { __builtin_amdgcn_s_setprio(1); _Pragma("unroll") for (int m = 0; m < 4; ++m) _Pragma("unroll") for (int n = 0; n < 2; ++n) _Pragma("unroll") for (int k = 0; k < 2; ++k) \
        acc[ai][bj][m][n] = __builtin_amdgcn_mfma_f32_16x16x32_bf16(Bt[n][k], At[m][k], acc[ai][bj][m][n], 0, 0, 0); __builtin_amdgcn_s_setprio(0); } while (0)
#define PG8_WAIT_V(n) asm volatile("s_waitcnt vmcnt(" #n ")" ::: "memory")
#define PG8_WAIT_L(n) asm volatile("s_waitcnt lgkmcnt(" #n ")" ::: "memory")
#define PG8_BAR __builtin_amdgcn_s_barrier()
#define PG8_SCHED __builtin_amdgcn_sched_barrier(0)
    Unit cur, nxt; int ui = 0;
    if (!S.next(0, cur)) return;
    f32x4 acc[2][2][4][2];
#pragma unroll
    for (int a = 0; a < 2; ++a)
#pragma unroll
        for (int b = 0; b < 2; ++b)
#pragma unroll
            for (int m = 0; m < 4; ++m)
#pragma unroll
                for (int n = 0; n < 2; ++n) acc[a][b][m][n] = (f32x4){0.f, 0.f, 0.f, 0.f};
    bf16x8 At[4][2], B0[2][2], B1[2][2];
    const char* cA = (const char*)g.A + (size_t)cur.pm * tstep; const char* cB = (const char*)g.Bt + (size_t)cur.pn * tstep;
    S.a_ready(cur);
    if constexpr (SP2) {
        PG8_STAGE(PG8_SB(0, 0), cB, voffB); PG8_STAGE(PG8_SB(0, 1), cB + hstep, voffB); PG8_STAGE(PG8_SA(0, 0), cA, voffA); PG8_STAGE(PG8_SA(0, 1), cA + hstep, voffA);
        if (wr == 1) PG8_BAR;
        PG8_WAIT_V(2); PG8_BAR;
        PG8_STAGE(PG8_SB(1, 0), cB + kstep, voffB); PG8_STAGE(PG8_SA(1, 0), cA + kstep, voffA); PG8_STAGE(PG8_SB(1, 1), cB + hstep + kstep, voffB);
        PG8_WAIT_V(6); PG8_BAR;
    } else {
        PG8_STAGE(PG8_SB(0, 0), cB, voffB); PG8_STAGE(PG8_SA(0, 0), cA, voffA); PG8_STAGE(PG8_SB(0, 1), cB + hstep, voffB); PG8_STAGE(PG8_SA(0, 1), cA + hstep, voffA);
        if (wr == 1) PG8_BAR;
        PG8_WAIT_V(4); PG8_BAR;
        PG8_STAGE(PG8_SB(1, 0), cB + kstep, voffB); PG8_STAGE(PG8_SA(1, 0), cA + kstep, voffA); PG8_STAGE(PG8_SB(1, 1), cB + hstep + kstep, voffB);
        PG8_WAIT_V(6); PG8_BAR;
    }
    for (;;) {
        const bool has_next = S.next(ui + 1, nxt);
        const char* nA = has_next ? (const char*)g.A + (size_t)nxt.pm * tstep : cA; const char* nB = has_next ? (const char*)g.Bt + (size_t)nxt.pn * tstep : cB;
        for (int t = 0; t < nt; t += 2) {
            const bool last = (t == nt - 2);
            const char* a1 = cA + (size_t)(t + 1) * kstep;
            const char* a2 = last ? nA : cA + (size_t)(t + 2) * kstep; const char* b2 = last ? nB : cB + (size_t)(t + 2) * kstep;
            const char* a3 = a2 + kstep; const char* b3 = b2 + kstep;
            if (last && has_next) S.a_ready(nxt);
            if constexpr (Epi::RESCALE) { if (t != 0 && (t & 7) == 0) { PG8_SCHED; E.rescale(acc, (t >> 3) - 1, wr, fr, lds); PG8_SCHED; } }
            if constexpr (SP2) {
            PG8_LDB(B0, 0, 0); PG8_LDB(B1, 0, 1); PG8_SCHED; PG8_LDA(At, 0, 0); PG8_STAGE(PG8_SA(1, 1), a1 + hstep, voffA);
            PG8_WAIT_V(8); PG8_WAIT_L(0); PG8_BAR; PG8_MMA(0, 0, At, B0); PG8_MMA(0, 1, At, B1); PG8_BAR; PG8_SCHED;
            PG8_LDA(At, 0, 1); PG8_STAGE(PG8_SB(0, 0), b2, voffB); PG8_STAGE(PG8_SB(0, 1), b2 + hstep, voffB); PG8_STAGE(PG8_SA(0, 0), a2, voffA);
            PG8_WAIT_V(8); PG8_WAIT_L(0); PG8_BAR; PG8_MMA(1, 0, At, B0); PG8_MMA(1, 1, At, B1); PG8_BAR; PG8_SCHED;
            PG8_LDB(B0, 1, 0); PG8_LDB(B1, 1, 1); PG8_SCHED; PG8_LDA(At, 1, 0); PG8_STAGE(PG8_SA(0, 1), a2 + hstep, voffA);
            PG8_WAIT_V(8); PG8_WAIT_L(0); PG8_BAR; PG8_MMA(0, 0, At, B0); PG8_MMA(0, 1, At, B1); PG8_BAR; PG8_SCHED;
            PG8_LDA(At, 1, 1); PG8_STAGE(PG8_SB(1, 0), b3, voffB); PG8_STAGE(PG8_SB(1, 1), b3 + hstep, voffB); PG8_STAGE(PG8_SA(1, 0), a3, voffA);
            PG8_WAIT_V(8); PG8_WAIT_L(0); PG8_BAR; PG8_MMA(1, 0, At, B0); PG8_MMA(1, 1, At, B1); PG8_BAR; PG8_SCHED;
            } else {
            PG8_LDB(B0, 0, 0); PG8_SCHED; PG8_LDA(At, 0, 0); PG8_STAGE(PG8_SA(1, 1), a1 + hstep, voffA);
            PG8_WAIT_L(8); PG8_BAR; PG8_WAIT_L(0); PG8_MMA(0, 0, At, B0); PG8_BAR; PG8_SCHED;
            PG8_LDB(B1, 0, 1); PG8_STAGE(PG8_SB(0, 0), b2, voffB);
            PG8_BAR; PG8_WAIT_L(0); PG8_MMA(0, 1, At, B1); PG8_BAR;
            PG8_LDA(At, 0, 1); PG8_STAGE(PG8_SA(0, 0), a2, voffA);
            PG8_BAR; PG8_WAIT_L(0); PG8_MMA(1, 0, At, B0); PG8_BAR; PG8_SCHED;
            PG8_STAGE(PG8_SB(0, 1), b2 + hstep, voffB);
            PG8_WAIT_V(6); PG8_BAR; PG8_MMA(1, 1, At, B1); PG8_BAR;
            PG8_LDB(B0, 1, 0); PG8_SCHED; PG8_LDA(At, 1, 0); PG8_STAGE(PG8_SA(0, 1), a2 + hstep, voffA);
            PG8_WAIT_L(8); PG8_BAR; PG8_WAIT_L(0); PG8_MMA(0, 0, At, B0); PG8_BAR; PG8_SCHED;
            PG8_LDB(B1, 1, 1); PG8_STAGE(PG8_SB(1, 0), b3, voffB);
            PG8_BAR; PG8_WAIT_L(0); PG8_MMA(0, 1, At, B1); PG8_BAR;
            PG8_LDA(At, 1, 1); PG8_STAGE(PG8_SA(1, 0), a3, voffA);
            PG8_BAR; PG8_WAIT_L(0); PG8_MMA(1, 0, At, B0); PG8_BAR; PG8_SCHED;
            PG8_STAGE(PG8_SB(1, 1), b3 + hstep, voffB);
            PG8_WAIT_V(6); PG8_BAR; PG8_MMA(1, 1, At, B1); PG8_BAR;
            }
        }
        if constexpr (ALIGN_EPI) { if (wr == 0) PG8_BAR; }
        if constexpr (Epi::RESCALE) E.rescale(acc, 3, wr, fr, lds);
        E(acc, cur, wr, wc, fr, fq);
        if (!has_next) break;
#pragma unroll
        for (int a = 0; a < 2; ++a)
#pragma unroll
            for (int b = 0; b < 2; ++b)
#pragma unroll
                for (int m = 0; m < 4; ++m)
#pragma unroll
                    for (int n = 0; n < 2; ++n) acc[a][b][m][n] = (f32x4){0.f, 0.f, 0.f, 0.f};
        cur = nxt; cA = nA; cB = nB; ++ui;
        if constexpr (ALIGN_EPI) { if (wr == 1) PG8_BAR; }
    }
    PG8_WAIT_V(0);
    if constexpr (!ALIGN_EPI) { if (wr == 0) PG8_BAR; }
    PG8_BAR;
#undef PG8_SA
#undef PG8_SB
#undef PG8_STAGE
#undef PG8_LDA
#undef PG8_LDB
#undef PG8_MMA
#undef PG8_WAIT_V
#undef PG8_WAIT_L
#undef PG8_BAR
#undef PG8_SCHED
}
}
using pg8::Unit;
typedef f32x4 AccT[2][2][4][2];

struct EpiF32Bias {
    static constexpr bool PERM = false, RESCALE = false;
    float* C; int ldc; const float* bias;
    __device__ __forceinline__ void operator()(const AccT& acc, const Unit& u, int wr, int wc, int fr, int fq) const {
        const int row0 = u.pm * 256 + wr * 64 + fr, col0 = u.pn * 256 + wc * 32 + 4 * fq;
        f32x4 bv[2][2];
#pragma unroll
        for (int bj = 0; bj < 2; ++bj)
#pragma unroll
            for (int n = 0; n < 2; ++n) bv[bj][n] = *(const f32x4*)(bias + col0 + bj * 128 + n * 16);
#pragma unroll
        for (int ai = 0; ai < 2; ++ai)
#pragma unroll
            for (int m = 0; m < 4; ++m) { float* rowp = C + (size_t)(row0 + ai * 128 + m * 16) * ldc + col0;
#pragma unroll
                for (int bj = 0; bj < 2; ++bj)
#pragma unroll
                    for (int n = 0; n < 2; ++n) *(f32x4*)(rowp + bj * 128 + n * 16) = acc[ai][bj][m][n] + bv[bj][n]; }
    }
};
__device__ __forceinline__ u32x4 pack8(f32x4 v0, f32x4 v1) { u32x4 w; w.x = cvt_pk_bf16(v0[0], v0[1]); w.y = cvt_pk_bf16(v0[2], v0[3]); w.z = cvt_pk_bf16(v1[0], v1[1]); w.w = cvt_pk_bf16(v1[2], v1[3]); return w; }
struct EpiIn {
    static constexpr bool PERM = true, RESCALE = false;
    bf16_t *BG, *CI, *Z, *XBC, *GA, *GB; float* DT;
    __device__ __forceinline__ void operator()(const AccT& acc, const Unit& u, int wr, int wc, int fr, int fq) const {
        const int pn = u.pn, row0 = u.pm * 256 + wr * 64 + fr, cin = wc * 32 + 8 * fq;
        if (pn >= 4 && pn < 12) {
            const int col = (pn - 4) * 128 + cin;
#pragma unroll
            for (int ai = 0; ai < 2; ++ai)
#pragma unroll
                for (int m = 0; m < 4; ++m) { const size_t row = row0 + ai * 128 + m * 16;
                    *(u32x4*)(CI + row * 1024 + col) = pack8(acc[ai][0][m][0] * acc[ai][1][m][0], acc[ai][0][m][1] * acc[ai][1][m][1]); }
        } else if (pn == 40) {
            if (wc == 0) {
#pragma unroll
                for (int ai = 0; ai < 2; ++ai)
#pragma unroll
                    for (int m = 0; m < 4; ++m) { const size_t row = row0 + ai * 128 + m * 16;
                        *(f32x4*)(DT + row * 32 + 8 * fq) = acc[ai][0][m][0]; *(f32x4*)(DT + row * 32 + 8 * fq + 4) = acc[ai][0][m][1]; }
            }
        } else {
            bf16_t* O; int ldc, colt;
            if (pn < 4) { O = BG; ldc = 1024; colt = pn * 256; }
            else if (pn < 20) { O = Z; ldc = 2048; colt = (pn - 12) * 256; }
            else if (pn < 32) { O = XBC; ldc = 3072; colt = (pn - 20) * 256; }
            else if (pn < 36) { O = GA; ldc = 1024; colt = (pn - 32) * 256; }
            else { O = GB; ldc = 1024; colt = (pn - 36) * 256; }
#pragma unroll
            for (int ai = 0; ai < 2; ++ai)
#pragma unroll
                for (int m = 0; m < 4; ++m) { bf16_t* rowp = O + (size_t)(row0 + ai * 128 + m * 16) * ldc + colt + cin;
#pragma unroll
                    for (int bj = 0; bj < 2; ++bj) { f32x4 v0 = acc[ai][bj][m][0], v1 = acc[ai][bj][m][1];
                        if (O == Z) {
#pragma unroll
                            for (int j = 0; j < 4; ++j) { v0[j] = siluf_(v0[j]); v1[j] = siluf_(v1[j]); } }
                        *(u32x4*)(rowp + bj * 128) = pack8(v0, v1); } }
        }
    }
};
template <int MODE> struct EpiGate {
    static constexpr bool PERM = true, RESCALE = (MODE == 1);
    bf16_t* O; const bf16_t* G; const bf16_t* Y; int ldc;
    __device__ __forceinline__ void rescale(AccT& acc, int b, int wr, int fr, PG8_LAS unsigned char* lds) const {
        int frl = fr; asm volatile("" : "+v"(frl));
        const PG8_LAS float* rt = (const PG8_LAS float*)(lds + L_RT) + (64 * wr + frl) * 4 + b;
#pragma unroll
        for (int ai = 0; ai < 2; ++ai)
#pragma unroll
            for (int m = 0; m < 4; ++m) { const float f = rt[(128 * ai + 16 * m) * 4];
#pragma unroll
                for (int bj = 0; bj < 2; ++bj)
#pragma unroll
                    for (int n = 0; n < 2; ++n) acc[ai][bj][m][n] = acc[ai][bj][m][n] * f; }
    }
    __device__ __forceinline__ void operator()(const AccT& acc, const Unit& u, int wr, int wc, int fr, int fq) const {
        asm volatile("" : "+v"(fr), "+v"(fq));
        const int row0 = u.pm * 256 + wr * 64 + fr, col0 = u.pn * 256 + wc * 32 + 8 * fq;
#pragma unroll
        for (int ai = 0; ai < 2; ++ai)
#pragma unroll
        for (int mh = 0; mh < 2; ++mh) {
            u32x4 gv[2][2], yv[2][2];
            if (MODE != 2) {
#pragma unroll
                for (int mm = 0; mm < 2; ++mm)
#pragma unroll
                    for (int bj = 0; bj < 2; ++bj) { const size_t off = (size_t)(row0 + ai * 128 + (2 * mh + mm) * 16) * ldc + col0 + bj * 128;
                        gv[mm][bj] = *(const u32x4*)(G + off); if (MODE == 1) yv[mm][bj] = *(const u32x4*)(Y + off); }
            }
#pragma unroll
            for (int mm = 0; mm < 2; ++mm)
#pragma unroll
                for (int bj = 0; bj < 2; ++bj) { const int m = 2 * mh + mm; const size_t off = (size_t)(row0 + ai * 128 + m * 16) * ldc + col0 + bj * 128;
                    f32x4 v0 = acc[ai][bj][m][0], v1 = acc[ai][bj][m][1];
                    if (MODE == 2) {
#pragma unroll
                        for (int j = 0; j < 4; ++j) { float a = fmaxf(v0[j], 0.f), b = fmaxf(v1[j], 0.f); v0[j] = a * a; v1[j] = b * b; }
                    } else {
                        const u32x4 g = gv[mm][bj];
                        v0[0] *= sigmoidf_(bflo(g.x)); v0[1] *= sigmoidf_(bfhi(g.x)); v0[2] *= sigmoidf_(bflo(g.y)); v0[3] *= sigmoidf_(bfhi(g.y));
                        v1[0] *= sigmoidf_(bflo(g.z)); v1[1] *= sigmoidf_(bfhi(g.z)); v1[2] *= sigmoidf_(bflo(g.w)); v1[3] *= sigmoidf_(bfhi(g.w));
                        if (MODE == 1) { const u32x4 y = yv[mm][bj];
                            v0[0] += bflo(y.x); v0[1] += bfhi(y.x); v0[2] += bflo(y.y); v0[3] += bfhi(y.y);
                            v1[0] += bflo(y.z); v1[1] += bfhi(y.z); v1[2] += bflo(y.w); v1[3] += bfhi(y.w); }
                    }
                    *(u32x4*)(O + off) = pack8(v0, v1); }
        }
    }
};
struct EpiRes {
    static constexpr bool PERM = true, RESCALE = false;
    bf16_t* X1; const float* xp; const float* gate;
    __device__ __forceinline__ void operator()(const AccT& acc, const Unit& u, int wr, int wc, int fr, int fq) const {
        const int row0 = u.pm * 256 + wr * 64 + fr, col0 = u.pn * 256 + wc * 32 + 8 * fq;
        const float* gr = gate + (size_t)(u.pm >> 3) * 6144 + col0;
        f32x4 gv[2][2];
#pragma unroll
        for (int bj = 0; bj < 2; ++bj)
#pragma unroll
            for (int n = 0; n < 2; ++n) gv[bj][n] = *(const f32x4*)(gr + bj * 128 + n * 4);
#pragma unroll
        for (int ai = 0; ai < 2; ++ai) {
            if (xp) {
                f32x4 xv[4][2][2];
#pragma unroll
                for (int m = 0; m < 4; ++m)
#pragma unroll
                    for (int bj = 0; bj < 2; ++bj)
#pragma unroll
                        for (int n = 0; n < 2; ++n) xv[m][bj][n] = *(const f32x4*)(xp + (size_t)(row0 + ai * 128 + m * 16) * D + col0 + bj * 128 + n * 4);
#pragma unroll
                for (int m = 0; m < 4; ++m)
#pragma unroll
                    for (int bj = 0; bj < 2; ++bj)
                        *(u32x4*)(X1 + (size_t)(row0 + ai * 128 + m * 16) * D + col0 + bj * 128) = pack8(xv[m][bj][0] + gv[bj][0] * acc[ai][bj][m][0], xv[m][bj][1] + gv[bj][1] * acc[ai][bj][m][1]);
            } else {
                u32x4 xv[4][2];
#pragma unroll
                for (int m = 0; m < 4; ++m)
#pragma unroll
                    for (int bj = 0; bj < 2; ++bj) xv[m][bj] = *(const u32x4*)(X1 + (size_t)(row0 + ai * 128 + m * 16) * D + col0 + bj * 128);
#pragma unroll
                for (int m = 0; m < 4; ++m)
#pragma unroll
                    for (int bj = 0; bj < 2; ++bj) { const F8 x8 = cv8(xv[m][bj]);
                        *(u32x4*)(X1 + (size_t)(row0 + ai * 128 + m * 16) * D + col0 + bj * 128) = pack8(x8.a + gv[bj][0] * acc[ai][bj][m][0], x8.b + gv[bj][1] * acc[ai][bj][m][1]); }
            }
        }
    }
};

template <int KS, class Epi>
__device__ __forceinline__ void skinny_gemm(LAS unsigned char* lds, const bf16_t* A, const bf16_t* Bt, int N, int K, const Epi& E, const int w) {
    constexpr int RT = 8 / KS;
    const int tid = tid_of(w), lane = tid & 63, fr = lane & 15, fq = lane >> 4;
    const int nitems = (N / 16) * KS, klen = K / KS;
    LAS f32x4* red = (LAS f32x4*)lds;
    for (int it = blockIdx.x; it < nitems; it += gridDim.x) {
        const int ct = it / KS, rg = it % KS, rt = rg * RT + (w % RT), kq = w / RT;
        const bf16_t* ap = A + (size_t)(16 * rt + fr) * K + kq * klen + fq * 8;
        const bf16_t* bp = Bt + (size_t)(16 * ct + fr) * K + kq * klen + fq * 8;
        f32x4 acc0 = (f32x4){0.f, 0.f, 0.f, 0.f}, acc1 = acc0;
        for (int k = 0; k < klen; k += 256) {
            bf16x8 a[8], b[8];
#pragma unroll
            for (int j = 0; j < 8; ++j) { a[j] = *(const bf16x8*)(ap + k + 32 * j); b[j] = *(const bf16x8*)(bp + k + 32 * j); }
#pragma unroll
            for (int j = 0; j < 8; j += 2) { acc0 = __builtin_amdgcn_mfma_f32_16x16x32_bf16(b[j], a[j], acc0, 0, 0, 0); acc1 = __builtin_amdgcn_mfma_f32_16x16x32_bf16(b[j + 1], a[j + 1], acc1, 0, 0, 0); }
        }
        f32x4 acc = (acc0 + acc1) * E.kscale(16 * rt + fr, kq);
        if (KS > 1) {
            if (kq > 0) red[w * 64 + lane] = acc;
            __syncthreads();
            if (kq == 0) {
#pragma unroll
                for (int q = 1; q < KS; ++q) acc = acc + red[(w + q * RT) * 64 + lane];
                E(16 * rt + fr, 16 * ct + 4 * fq, acc);
            }
            __syncthreads();
        } else E(16 * rt + fr, 16 * ct + 4 * fq, acc);
    }
}
__device__ __forceinline__ u32x2 pack4(const f32x4 v) { u32x2 o; o.x = cvt_pk_bf16(v[0], v[1]); o.y = cvt_pk_bf16(v[2], v[3]); return o; }
template <int MODE> struct SkGate {
    bf16_t* O; const bf16_t* G; const bf16_t* Y; int ldc;
    const float* SSQ;
    __device__ __forceinline__ float kscale(int r, int kq) const {
        if (MODE != 1) return 1.f;
        const f32x4 s0 = *(const f32x4*)(SSQ + (size_t)(MP + r) * 32 + 8 * kq), s1 = *(const f32x4*)(SSQ + (size_t)(MP + r) * 32 + 8 * kq + 4);
        return rsqrtf(((s0[0] + s0[1]) + (s0[2] + s0[3]) + (s1[0] + s1[1]) + (s1[2] + s1[3])) * (1.f / 512.f) + EPS);
    }
    __device__ __forceinline__ void operator()(int r, int c, f32x4 v) const {
        const size_t off = (size_t)(MP + r) * ldc + c;
        if (MODE == 2) {
#pragma unroll
            for (int j = 0; j < 4; ++j) { const float a = fmaxf(v[j], 0.f); v[j] = a * a; }
        } else {
            const f32x4 g = cv4(*(const u32x2*)(G + off));
#pragma unroll
            for (int j = 0; j < 4; ++j) v[j] *= sigmoidf_(g[j]);
            if (MODE == 1) v = v + cv4(*(const u32x2*)(Y + off));
        }
        *(u32x2*)(O + off) = pack4(v);
    }
};
struct SkRes {
    bf16_t* X1; const float* xs; const float* gate;
    __device__ __forceinline__ float kscale(int, int) const { return 1.f; }
    __device__ __forceinline__ void operator()(int r, int c, f32x4 v) const {
        bf16_t* o = X1 + (size_t)(MP + r) * D + c;
        const f32x4 src = xs ? *(const f32x4*)(xs + (size_t)r * D + c) : cv4(*(const u32x2*)o);
        *(u32x2*)o = pack4(src + *(const f32x4*)(gate + (size_t)(NBP + r) * 6144 + c) * v);
    }
};

__device__ __forceinline__ int win_dest(int n) {
    if (n < 1024) return n;
    if (n < 2048) { const int j = n - 1024; return 1024 + (j >> 7) * 256 + (j & 127); }
    if (n < 3072) { const int j = n - 2048; return 1024 + (j >> 7) * 256 + 128 + (j & 127); }
    if (n < 8192) return n;
    if (n < 8224) return 10240 + (n - 8192);
    return n - 32;
}
__device__ __forceinline__ void transpose_item(const float* W, int K, int N, bf16_t* WT, int item, bool remap, const float* kscale, LAS float* scr, int lane) {
    const int nblk = N / 32, kb = item / nblk, nb = item % nblk, k0 = 64 * kb, n0 = 32 * nb;
#pragma unroll 16
    for (int i = 0; i < 32; ++i) { const int kk = 2 * i + (lane >> 5); float v = W[(size_t)(k0 + kk) * N + n0 + (lane & 31)]; if (kscale) v *= kscale[k0 + kk]; scr[kk * 33 + (lane & 31)] = v; }
    const int c = lane & 7;
#pragma unroll
    for (int j = 0; j < 4; ++j) { const int n = (lane >> 3) + 8 * j; const LAS float* sp = scr + (8 * c) * 33 + n;
        u32x4 o; o.x = cvt_pk_bf16(sp[0 * 33], sp[1 * 33]); o.y = cvt_pk_bf16(sp[2 * 33], sp[3 * 33]); o.z = cvt_pk_bf16(sp[4 * 33], sp[5 * 33]); o.w = cvt_pk_bf16(sp[6 * 33], sp[7 * 33]);
        const int ns = n0 + n, dr = remap ? win_dest(ns) : ns;
        *(u32x4*)(WT + (size_t)dr * K + k0 + 8 * c) = o; }
    asm volatile("s_waitcnt lgkmcnt(0)" ::: "memory");
}
__device__ __forceinline__ void phase0(const Params& p, LAS unsigned char* lds, int part, const int wid) {
    unsigned char* ws = p.ws;
    const int tid = tid_of(wid), lane = tid & 63;
    LAS float* scr = (LAS float*)lds + wid * (64 * 33);
    constexpr int I_ADA = 16 * 192, I_IN = 16 * 321, I_AO = 16 * 32, I_BO = 32 * 32, I_O = 16 * 32, I_1 = 16 * 128, I_2 = 64 * 32;
    constexpr int NMOD = 24;
    if (part == 0) {
        for (int it = blockIdx.x * 8 + wid; it < I_ADA; it += gridDim.x * 8) transpose_item(p.in[I_WADA], 1024, 6144, (bf16_t*)(ws + OFF_WADA), it, false, nullptr, scr, lane);
        bf16_t* cA = (bf16_t*)(ws + OFF_CA);
        for (int i = blockIdx.x * 512 + tid; i < (NBP + NBS) * D; i += gridDim.x * 512) {
            const int row = i >> 10, k = i & 1023;
            const float v = row < NBP ? p.in[I_CP][row * D + k] : p.in[I_CS][(row - NBP) * D + k];
            cA[i] = f2bf(siluf_(v));
        }
        return;
    }
    if (part == 1) {
        for (int it = ((int)blockIdx.x - NMOD) * 8 + wid; it < I_IN; it += ((int)gridDim.x - NMOD) * 8) transpose_item(p.in[I_WIN], 1024, DIN, (bf16_t*)(ws + OFF_WIN), it, true, nullptr, scr, lane);
        return;
    }
    constexpr int FIRST2 = (65 * 41) % 256;
    const int nw2 = (int)gridDim.x > FIRST2 ? (int)gridDim.x - FIRST2 : (int)gridDim.x, w2 = (int)gridDim.x > FIRST2 ? (int)blockIdx.x - FIRST2 : (int)blockIdx.x;
    if (w2 < 0) return;
    for (int it = w2 * 8 + wid; it < I_AO + I_BO + I_O + I_1 + I_2; it += nw2 * 8) {
        int r = it;
        if (r < I_AO) { transpose_item(p.in[I_WAOUT], 1024, 1024, (bf16_t*)(ws + OFF_WAOUT), r, false, nullptr, scr, lane); continue; } r -= I_AO;
        if (r < I_BO) { transpose_item(p.in[I_WBOUT], 2048, 1024, (bf16_t*)(ws + OFF_WBOUT), r, false, p.in[I_SNG], scr, lane); continue; } r -= I_BO;
        if (r < I_O) { transpose_item(p.in[I_WO], 1024, 1024, (bf16_t*)(ws + OFF_WO), r, false, nullptr, scr, lane); continue; } r -= I_O;
        if (r < I_1) { transpose_item(p.in[I_W1], 1024, 4096, (bf16_t*)(ws + OFF_W1), r, false, nullptr, scr, lane); continue; } r -= I_1;
        transpose_item(p.in[I_W2], 4096, 1024, (bf16_t*)(ws + OFF_W2), r, false, nullptr, scr, lane);
    }
}

template <bool BF> __device__ __forceinline__ void load_row(const void* xrow, int lane, f32x4 (&v)[4]) {
#pragma unroll
    for (int j = 0; j < 4; ++j) v[j] = BF ? cv4(((const u32x2*)xrow)[lane + 64 * j]) : ((const f32x4*)xrow)[lane + 64 * j];
}
template <bool BF> __device__ __forceinline__ void rownorm_mod(const void* xrow, const float* g, const float* sc, const float* sh, bf16_t* orow, int lane) {
    f32x4 v[4]; float s = 0.f;
    load_row<BF>(xrow, lane, v);
#pragma unroll
    for (int j = 0; j < 4; ++j) s += (v[j][0] * v[j][0] + v[j][1] * v[j][1]) + (v[j][2] * v[j][2] + v[j][3] * v[j][3]);
    const float rstd = rsqrtf(wave_sum(s) * (1.f / D) + EPS);
#pragma unroll
    for (int j = 0; j < 4; ++j) { const int i4 = lane + 64 * j;
        const f32x4 gg = ((const f32x4*)g)[i4], scv = ((const f32x4*)sc)[i4], shv = ((const f32x4*)sh)[i4];
        const f32x4 o = v[j] * rstd * gg * (scv + 1.f) + shv;
        u32x2 w; w.x = cvt_pk_bf16(o[0], o[1]); w.y = cvt_pk_bf16(o[2], o[3]);
        ((u32x2*)orow)[i4] = w; }
}
__device__ __forceinline__ float row_ss(const f32x4 (&v)[4]) { float s = 0.f;
#pragma unroll
    for (int j = 0; j < 4; ++j) s += (v[j][0] * v[j][0] + v[j][1] * v[j][1]) + (v[j][2] * v[j][2] + v[j][3] * v[j][3]);
    return s; }
template <bool BF> __device__ __forceinline__ void phase_rownorm(const Params& p, const float* gvec, int sc_off, int sh_off, bf16_t* U, const int wid) {
    const int tid_ = tid_of(wid), lane = tid_ & 63, gw = blockIdx.x * 8 + (tid_ >> 6), NW = gridDim.x * 8;
    const float* mod = (const float*)(p.ws + OFF_MOD);
    for (int blk = gw; blk < MP / 8; blk += NW) {
        const int row0 = blk * 8, seq = row0 >> 11;
        f32x4 gm[4], shv[4];
#pragma unroll
        for (int j = 0; j < 4; ++j) { const int i4 = lane + 64 * j;
            gm[j] = ((const f32x4*)gvec)[i4] * (((const f32x4*)(mod + (size_t)seq * 6144 + sc_off))[i4] + 1.f); shv[j] = ((const f32x4*)(mod + (size_t)seq * 6144 + sh_off))[i4]; }
#pragma unroll
        for (int i = 0; i < 8; i += 2) {
            f32x4 va[4], vb[4];
            const void* ra = BF ? (const void*)((const bf16_t*)(p.ws + OFF_X1) + (size_t)(row0 + i) * D) : (const void*)(p.in[I_XP] + (size_t)(row0 + i) * D);
            const void* rb = BF ? (const void*)((const bf16_t*)(p.ws + OFF_X1) + (size_t)(row0 + i + 1) * D) : (const void*)(p.in[I_XP] + (size_t)(row0 + i + 1) * D);
            load_row<BF>(ra, lane, va); load_row<BF>(rb, lane, vb);
            const float rsa = rsqrtf(wave_sum(row_ss(va)) * (1.f / D) + EPS), rsb = rsqrtf(wave_sum(row_ss(vb)) * (1.f / D) + EPS);
#pragma unroll
            for (int j = 0; j < 4; ++j) { const int i4 = lane + 64 * j;
                const f32x4 oa = va[j] * rsa * gm[j] + shv[j], ob = vb[j] * rsb * gm[j] + shv[j];
                u32x2 w; w.x = cvt_pk_bf16(oa[0], oa[1]); w.y = cvt_pk_bf16(oa[2], oa[3]); ((u32x2*)(U + (size_t)(row0 + i) * D))[i4] = w;
                w.x = cvt_pk_bf16(ob[0], ob[1]); w.y = cvt_pk_bf16(ob[2], ob[3]); ((u32x2*)(U + (size_t)(row0 + i + 1) * D))[i4] = w; }
        }
    }
    for (int r = gw; r < NBS; r += NW) {
        const int row = MP + r, seq = NBP + r;
        const void* xrow = BF ? (const void*)((const bf16_t*)(p.ws + OFF_X1) + (size_t)row * D) : (const void*)(p.in[I_XS] + (size_t)r * D);
        rownorm_mod<BF>(xrow, gvec, mod + (size_t)seq * 6144 + sc_off, mod + (size_t)seq * 6144 + sh_off, U + (size_t)row * D, lane);
    }
}
__device__ __forceinline__ void phase_final(const Params& p, const int wid) {
    const int tid_ = tid_of(wid), lane = tid_ & 63, gw = blockIdx.x * 8 + (tid_ >> 6), NW = gridDim.x * 8;
    const bf16_t* X = (const bf16_t*)(p.ws + OFF_X1);
    f32x4 g[4];
#pragma unroll
    for (int j = 0; j < 4; ++j) g[j] = ((const f32x4*)p.in[I_NFG])[lane + 64 * j];
    for (int pr = gw; pr < MTOT / 2; pr += NW) {
        const int ra = 2 * pr, rb = 2 * pr + 1;
        float* oa = ra < MP ? p.out + O_YP + (size_t)ra * D : p.out + O_YS + (size_t)(ra - MP) * D;
        float* ob = rb < MP ? p.out + O_YP + (size_t)rb * D : p.out + O_YS + (size_t)(rb - MP) * D;
        f32x4 va[4], vb[4];
        load_row<true>(X + (size_t)ra * D, lane, va); load_row<true>(X + (size_t)rb * D, lane, vb);
        const float rsa = rsqrtf(wave_sum(row_ss(va)) * (1.f / D) + EPS), rsb = rsqrtf(wave_sum(row_ss(vb)) * (1.f / D) + EPS);
#pragma unroll
        for (int j = 0; j < 4; ++j) { ((f32x4*)oa)[lane + 64 * j] = va[j] * rsa * g[j]; ((f32x4*)ob)[lane + 64 * j] = vb[j] * rsb * g[j]; }
    }
}

__device__ __forceinline__ F8 ld8bf(const bf16_t* p) { const u32x4 u = *(const u32x4*)p; F8 r; r.a = (f32x4){bflo(u.x), bfhi(u.x), bflo(u.y), bfhi(u.y)}; r.b = (f32x4){bflo(u.z), bfhi(u.z), bflo(u.w), bfhi(u.w)}; return r; }
__device__ __forceinline__ F8 ld8f(const float* p) { F8 r; r.a = *(const f32x4*)p; r.b = *(const f32x4*)(p + 4); return r; }
__device__ __forceinline__ void st8f(float* p, const F8& v) { *(f32x4*)p = v.a; *(f32x4*)(p + 4) = v.b; }
__device__ __forceinline__ F8 zero8() { F8 r; r.a = (f32x4){0.f, 0.f, 0.f, 0.f}; r.b = r.a; return r; }
__device__ __forceinline__ void phase_conv(const Params& p, LAS unsigned char* lds, const int wid) {
    unsigned char* ws = p.ws;
    const bf16_t* BG = (const bf16_t*)(ws + OFF_BG); const bf16_t* CI = (const bf16_t*)(ws + OFF_CI); const bf16_t* XBC = (const bf16_t*)(ws + OFF_XBC);
    bf16_t* VA = (bf16_t*)(ws + OFF_VA); bf16_t* XC = (bf16_t*)(ws + OFF_XBCC);
    const int tid = threadIdx.x;
    for (int kstep = 0; kstep < 9; ++kstep) {
        int it;
        if (kstep < 8) it = (int)blockIdx.x * 8 + kstep; else { if ((int)blockIdx.x >= NBS) break; it = MP / 8 + (int)blockIdx.x; }
        if (it < MP / 8) {
            const int r0 = it * 8, tpos0 = r0 & (SEQ - 1), b = r0 >> 11;
            if (tid < 128) {
                const int ch = tid * 8;
                u32x4 raw[10], bgr[8];
#pragma unroll
                for (int i = 0; i < 10; ++i) raw[i] = (tpos0 - 2 + i >= 0) ? *(const u32x4*)(CI + (size_t)(r0 - 2 + i) * 1024 + ch) : (u32x4){0u, 0u, 0u, 0u};
#pragma unroll
                for (int i = 0; i < 8; ++i) bgr[i] = *(const u32x4*)(BG + (size_t)(r0 + i) * 1024 + ch);
                const F8 w0 = ld8f(p.in[I_CAW] + ch), w1 = ld8f(p.in[I_CAW] + 1024 + ch), w2 = ld8f(p.in[I_CAW] + 2048 + ch);
#pragma unroll
                for (int i = 0; i < 8; ++i) { const F8 p2 = cv8(raw[i]), p1 = cv8(raw[i + 1]), c0 = cv8(raw[i + 2]), bg = cv8(bgr[i]);
                    const f32x4 va = bg.a * (w0.a * p2.a + w1.a * p1.a + w2.a * c0.a), vb = bg.b * (w0.b * p2.b + w1.b * p1.b + w2.b * c0.b);
                    *(u32x4*)(VA + (size_t)(r0 + i) * 1024 + ch) = pack8(va, vb);
                    if (tpos0 + i >= SEQ - 2) st8f(p.out + O_SCP + ((size_t)b * 2 + (tpos0 + i - (SEQ - 2))) * 1024 + ch, c0); }
            } else {
                const int ch = (tid - 128) * 8;
                u32x4 raw[11];
#pragma unroll
                for (int i = 0; i < 11; ++i) raw[i] = (tpos0 - 3 + i >= 0) ? *(const u32x4*)(XBC + (size_t)(r0 - 3 + i) * 3072 + ch) : (u32x4){0u, 0u, 0u, 0u};
                const F8 w0 = ld8f(p.in[I_CBW] + ch), w1 = ld8f(p.in[I_CBW] + 3072 + ch), w2 = ld8f(p.in[I_CBW] + 6144 + ch), w3 = ld8f(p.in[I_CBW] + 9216 + ch), bb = ld8f(p.in[I_CBB] + ch);
#pragma unroll
                for (int i = 0; i < 8; ++i) { const F8 p3 = cv8(raw[i]), p2 = cv8(raw[i + 1]), p1 = cv8(raw[i + 2]), c0 = cv8(raw[i + 3]);
                    f32x4 va = w0.a * p3.a + w1.a * p2.a + w2.a * p1.a + w3.a * c0.a + bb.a, vb = w0.b * p3.b + w1.b * p2.b + w2.b * p1.b + w3.b * c0.b + bb.b;
#pragma unroll
                    for (int j = 0; j < 4; ++j) { va[j] = siluf_(va[j]); vb[j] = siluf_(vb[j]); }
                    *(u32x4*)(XC + (size_t)(r0 + i) * 3072 + ch) = pack8(va, vb);
                    if (tpos0 + i >= SEQ - 3) st8f(p.out + O_SBP + ((size_t)b * 3 + (tpos0 + i - (SEQ - 3))) * 3072 + ch, c0); }
            }
        } else {
            const int b = it - MP / 8, row = MP + b;
            if (tid < 128) {
                const int ch = tid * 8;
                const F8 c0 = ld8bf(CI + (size_t)row * 1024 + ch);
                const F8 p2 = ld8f(p.in[I_STA] + ((size_t)b * 2 + 0) * 1024 + ch), p1 = ld8f(p.in[I_STA] + ((size_t)b * 2 + 1) * 1024 + ch);
                const F8 w0 = ld8f(p.in[I_CAW] + ch), w1 = ld8f(p.in[I_CAW] + 1024 + ch), w2 = ld8f(p.in[I_CAW] + 2048 + ch);
                const F8 bg = ld8bf(BG + (size_t)row * 1024 + ch);
                const f32x4 va = bg.a * (w0.a * p2.a + w1.a * p1.a + w2.a * c0.a), vb = bg.b * (w0.b * p2.b + w1.b * p1.b + w2.b * c0.b);
                *(u32x4*)(VA + (size_t)row * 1024 + ch) = pack8(va, vb);
                st8f(p.out + O_SCS + ((size_t)b * 2 + 0) * 1024 + ch, p1); st8f(p.out + O_SCS + ((size_t)b * 2 + 1) * 1024 + ch, c0);
            } else {
                const int ch = (tid - 128) * 8;
                const F8 c0 = ld8bf(XBC + (size_t)row * 3072 + ch);
                const F8 p3 = ld8f(p.in[I_STB] + ((size_t)b * 3 + 0) * 3072 + ch), p2 = ld8f(p.in[I_STB] + ((size_t)b * 3 + 1) * 3072 + ch), p1 = ld8f(p.in[I_STB] + ((size_t)b * 3 + 2) * 3072 + ch);
                const F8 w0 = ld8f(p.in[I_CBW] + ch), w1 = ld8f(p.in[I_CBW] + 3072 + ch), w2 = ld8f(p.in[I_CBW] + 6144 + ch), w3 = ld8f(p.in[I_CBW] + 9216 + ch), bb = ld8f(p.in[I_CBB] + ch);
                f32x4 va = w0.a * p3.a + w1.a * p2.a + w2.a * p1.a + w3.a * c0.a + bb.a, vb = w0.b * p3.b + w1.b * p2.b + w2.b * p1.b + w3.b * c0.b + bb.b;
#pragma unroll
                for (int j = 0; j < 4; ++j) { va[j] = siluf_(va[j]); vb[j] = siluf_(vb[j]); }
                *(u32x4*)(XC + (size_t)row * 3072 + ch) = pack8(va, vb);
                st8f(p.out + O_SBS + ((size_t)b * 3 + 0) * 3072 + ch, p2); st8f(p.out + O_SBS + ((size_t)b * 3 + 1) * 3072 + ch, p1); st8f(p.out + O_SBS + ((size_t)b * 3 + 2) * 3072 + ch, c0);
            }
        }
    }
    const float* DTR = (const float*)(ws + OFF_DTRAW); float* DTP = (float*)(ws + OFF_DTP); float* ACS = (float*)(ws + OFF_ACS);
    LAS float* t1 = (LAS float*)lds; LAS float* t2 = t1 + 128 * 33;
    LAS float* tot = t2 + 128 * 33;
    for (int it = (int)blockIdx.x - (int)(gridDim.x - 129); it >= 0 && it < 129; it += gridDim.x) {
        const int t0 = it * 128;
#pragma unroll
        for (int i = 0; i < 8; ++i) { const int idx = tid + 512 * i, r = idx >> 5, hh = idx & 31;
            const float raw = DTR[(size_t)(t0 + r) * 32 + hh] + p.in[I_DTB][hh];
            t1[r * 33 + hh] = raw > 20.f ? raw : log1pf(expf(raw)); }
        __syncthreads();
        {
            const int hh = tid & 31, seg = tid >> 5; const float a = -expf(p.in[I_ALOG][hh]);
            float loc[8], run = 0.f;
#pragma unroll
            for (int q = 0; q < 8; ++q) { run += t1[(seg * 8 + q) * 33 + hh] * a; loc[q] = run; }
            tot[seg * 32 + hh] = run;
            __syncthreads();
            float off = 0.f;
            for (int s2 = 0; s2 < seg; ++s2) off += tot[s2 * 32 + hh];
#pragma unroll
            for (int q = 0; q < 8; ++q) t2[(seg * 8 + q) * 33 + hh] = loc[q] + off;
        }
        __syncthreads();
#pragma unroll
        for (int i = 0; i < 8; ++i) { const int idx = tid + 512 * i, r = idx >> 5, hh = idx & 31;
            DTP[(size_t)(t0 + r) * 32 + hh] = t1[r * 33 + hh]; ACS[(size_t)(t0 + r) * 32 + hh] = t2[r * 33 + hh]; }
        __syncthreads();
    }
}

constexpr int RS = 288, RX = 144;
constexpr int L_C = 0, L_B = 36864, L_X = 73728, L_XW = 92160, L_H = 110592, L_ACS = 129024, L_DT = 129536;
__device__ __forceinline__ bf16x8 tr_frag(LAS unsigned char* base, int rstride, int k0, int c0, int lane) {
    const int i = lane & 15, g = lane >> 4, q = i >> 2, pp = i & 3;
    LAS unsigned char* a = base + (k0 + 8 * g + q) * rstride + (c0 + 4 * pp) * 2;
    const bf16x4 lo = __builtin_amdgcn_ds_read_tr16_b64_v4i16((LAS bf16x4*)a);
    const bf16x4 hi = __builtin_amdgcn_ds_read_tr16_b64_v4i16((LAS bf16x4*)(a + 4 * rstride));
    return (bf16x8){lo[0], lo[1], lo[2], lo[3], hi[0], hi[1], hi[2], hi[3]};
}
constexpr int L_RED = 130048, L_CF = L_RT;
__device__ __forceinline__ void ssd_unit(const Params& p, LAS unsigned char* lds, int b, int h, int sbase, const int w) {
    unsigned char* ws = p.ws;
    const bf16_t* XC = (const bf16_t*)(ws + OFF_XBCC); const bf16_t* Z = (const bf16_t*)(ws + OFF_Z);
    const float* DTP = (const float*)(ws + OFF_DTP); const float* ACS = (const float*)(ws + OFF_ACS);
    bf16_t* YG = (bf16_t*)(ws + OFF_YG); float* SSQ = (float*)(ws + OFF_SSQ);
    const int tid = tid_of(w), lane = tid & 63, fr = lane & 15, fq = lane >> 4, g = h >> 3;
    const float Dh = p.in[I_DSKIP][h];
    LAS float* sAcs = (LAS float*)(lds + L_ACS); LAS float* sDt = (LAS float*)(lds + L_DT); LAS float* red = (LAS float*)(lds + L_RED);
    f32x4 hacc[4];
#pragma unroll
    for (int i = 0; i < 4; ++i) hacc[i] = (f32x4){0.f, 0.f, 0.f, 0.f};
    const int hpt = w & 3, hnb = (w >> 2) * 4;
    const int n4 = tid & 31, pr = tid >> 5;
    u32x4 rc[4], rb[4], rx[2]; float wv[2], my_acs = 0.f, my_dt = 0.f, acs_last_n;
#define SSD_PREFETCH(cc) do { const int _t0 = b * SEQ + (cc) * 128; \
        { const int ch = tid & 15, row = tid >> 4; _Pragma("unroll") for (int i = 0; i < 4; ++i) { const bf16_t* src = XC + (size_t)(_t0 + row + 32 * i) * 3072; rb[i] = *(const u32x4*)(src + 2048 + g * 128 + ch * 8); rc[i] = *(const u32x4*)(src + 2560 + g * 128 + ch * 8); } } \
        acs_last_n = ACS[(size_t)(_t0 + 127) * 32 + h]; \
        { const int ch = tid & 7, row = tid >> 3; _Pragma("unroll") for (int i = 0; i < 2; ++i) { const int r = _t0 + row + 64 * i; rx[i] = *(const u32x4*)(XC + (size_t)r * 3072 + h * 64 + ch * 8); \
              wv[i] = __expf(acs_last_n - ACS[(size_t)r * 32 + h]) * DTP[(size_t)r * 32 + h]; } } \
        if (tid < 128) { my_acs = ACS[(size_t)(_t0 + tid) * 32 + h]; my_dt = DTP[(size_t)(_t0 + tid) * 32 + h]; } } while (0)
    SSD_PREFETCH(0);
    int prev_sr = -1, prev_sh = 0;
    for (int c = 0; c < SEQ / 128; ++c) {
        const int t0 = b * SEQ + c * 128;
        __syncthreads();
        if (tid == 0 && prev_sr >= 0) { float v = 0.f;
#pragma unroll
            for (int i = 0; i < 16; ++i) v += red[i];
            SSQ[(size_t)prev_sr * 32 + prev_sh] = v; }
#pragma unroll
        for (int i = 0; i < 4; ++i) { u32x2 o; o.x = cvt_pk_bf16(hacc[i][0], hacc[i][1]); o.y = cvt_pk_bf16(hacc[i][2], hacc[i][3]);
            *(LAS u32x2*)(lds + L_H + (16 * hpt + fr) * RS + (16 * (hnb + i) + 4 * fq) * 2) = o; }
        { const int ch = tid & 15, row = tid >> 4;
#pragma unroll
          for (int i = 0; i < 4; ++i) { *(LAS u32x4*)(lds + L_B + (row + 32 * i) * RS + ch * 16) = rb[i]; *(LAS u32x4*)(lds + L_C + (row + 32 * i) * RS + ch * 16) = rc[i]; } }
        { const int ch = tid & 7, row = tid >> 3;
#pragma unroll
          for (int i = 0; i < 2; ++i) { *(LAS u32x4*)(lds + L_X + (row + 64 * i) * RX + ch * 16) = rx[i];
              const float s = wv[i]; u32x4 o;
              o.x = cvt_pk_bf16(bflo(rx[i].x) * s, bfhi(rx[i].x) * s); o.y = cvt_pk_bf16(bflo(rx[i].y) * s, bfhi(rx[i].y) * s);
              o.z = cvt_pk_bf16(bflo(rx[i].z) * s, bfhi(rx[i].z) * s); o.w = cvt_pk_bf16(bflo(rx[i].w) * s, bfhi(rx[i].w) * s);
              *(LAS u32x4*)(lds + L_XW + (row + 64 * i) * RX + ch * 16) = o; } }
        if (tid < 128) { sAcs[tid] = my_acs; sDt[tid] = my_dt; }
        const float acs_last = acs_last_n;
        __syncthreads();
        const int qt = w < 4 ? w : 11 - w, qrow = 16 * qt + fr;
        const size_t trow = (size_t)(t0 + qrow);
        u32x2 zv[4];
#pragma unroll
        for (int pt = 0; pt < 4; ++pt) zv[pt] = *(const u32x2*)(Z + trow * 2048 + h * 64 + 16 * pt + 4 * fq);
        const int sit = sbase + 256 * c; const bool has_s = sit < NBS * NH;
        const int sb = sit >> 5, sh = sit & 31, sr = MP + sb, sg = sh >> 3;
        f32x4 h0[4]; u32x2 sbu, scu; float sdt = 0.f, sxv[4], szv[4];
        const size_t sbase_off = (((size_t)sb * NH + sh) * HD) * DS;
        if (has_s) {
            const bf16_t* xr = XC + (size_t)sr * 3072;
#pragma unroll
            for (int i = 0; i < 4; ++i) { const int pp = pr + 16 * i; h0[i] = __builtin_nontemporal_load((const f32x4*)(p.in[I_STS] + sbase_off + (size_t)pp * DS + 4 * n4));
                sxv[i] = bf2f(xr[sh * 64 + pp]); szv[i] = bf2f(Z[(size_t)sr * 2048 + sh * 64 + pp]); }
            sbu = *(const u32x2*)(xr + 2048 + sg * 128 + 4 * n4); scu = *(const u32x2*)(xr + 2560 + sg * 128 + 4 * n4);
            sdt = DTP[(size_t)sr * 32 + sh];
        }
        bf16x8 cf[4];
#pragma unroll
        for (int kk = 0; kk < 4; ++kk) cf[kk] = *(const LAS bf16x8*)(lds + L_C + qrow * RS + (kk * 32 + fq * 8) * 2);
        f32x4 yacc[4];
#pragma unroll
        for (int i = 0; i < 4; ++i) yacc[i] = (f32x4){0.f, 0.f, 0.f, 0.f};
        const float acs_q = sAcs[qrow], acs_q0 = sAcs[16 * qt];
        LAS float* cfac = (LAS float*)(lds + L_CF) + w * 128;
#pragma unroll
        for (int i = 0; i < 2; ++i) { const int sidx = lane + 64 * i; if (sidx < 16 * qt) cfac[sidx] = __expf(acs_q0 - sAcs[sidx]) * sDt[sidx]; }
        const float r_q = __expf(acs_q - acs_q0);
        if (c > 0) {
#pragma unroll
            for (int pp = 0; pp < 2; ++pp) {
                bf16x8 hf[2][4];
#pragma unroll
                for (int a = 0; a < 2; ++a)
#pragma unroll
                    for (int kk = 0; kk < 4; ++kk) hf[a][kk] = *(const LAS bf16x8*)(lds + L_H + (16 * (2 * pp + a) + fr) * RS + (kk * 32 + fq * 8) * 2);
#pragma unroll
                for (int kk = 0; kk < 4; ++kk)
#pragma unroll
                    for (int a = 0; a < 2; ++a) yacc[2 * pp + a] = __builtin_amdgcn_mfma_f32_16x16x32_bf16(hf[a][kk], cf[kk], yacc[2 * pp + a], 0, 0, 0);
            }
            const float eq = __expf(acs_q);
#pragma unroll
            for (int pt = 0; pt < 4; ++pt) yacc[pt] = yacc[pt] * eq;
        }
        for (int sp = 0; 2 * sp <= qt; ++sp) {
            const bool two = 2 * sp + 1 <= qt;
            bf16x8 bfr[2][4];
#pragma unroll
            for (int kk = 0; kk < 4; ++kk) bfr[0][kk] = *(const LAS bf16x8*)(lds + L_B + (16 * (2 * sp) + fr) * RS + (kk * 32 + fq * 8) * 2);
            if (two) {
#pragma unroll
                for (int kk = 0; kk < 4; ++kk) bfr[1][kk] = *(const LAS bf16x8*)(lds + L_B + (16 * (2 * sp + 1) + fr) * RS + (kk * 32 + fq * 8) * 2);
            }
            f32x4 sacc[2];
            sacc[0] = (f32x4){0.f, 0.f, 0.f, 0.f}; sacc[1] = sacc[0];
#pragma unroll
            for (int kk = 0; kk < 4; ++kk) sacc[0] = __builtin_amdgcn_mfma_f32_16x16x32_bf16(bfr[0][kk], cf[kk], sacc[0], 0, 0, 0);
            if (two) {
#pragma unroll
                for (int kk = 0; kk < 4; ++kk) sacc[1] = __builtin_amdgcn_mfma_f32_16x16x32_bf16(bfr[1][kk], cf[kk], sacc[1], 0, 0, 0);
            }
#pragma unroll
            for (int a = 0; a < 2; ++a) { const int st = 2 * sp + a, s0 = 16 * st + 4 * fq;
                float pv[4];
                if (st < qt) { const f32x4 cc = *(const LAS f32x4*)(cfac + s0);
#pragma unroll
                    for (int j = 0; j < 4; ++j) pv[j] = sacc[a][j] * r_q * cc[j];
                } else if (st == qt) { const f32x4 as = *(const LAS f32x4*)(sAcs + s0), ds = *(const LAS f32x4*)(sDt + s0);
#pragma unroll
                    for (int j = 0; j < 4; ++j) pv[j] = (s0 + j <= qrow) ? sacc[a][j] * __expf(acs_q - as[j]) * ds[j] : 0.f;
                } else {
#pragma unroll
                    for (int j = 0; j < 4; ++j) pv[j] = 0.f;
                }
                u32x2 o; o.x = cvt_pk_bf16(pv[0], pv[1]); o.y = cvt_pk_bf16(pv[2], pv[3]);
                *(LAS u32x2*)(lds + L_C + qrow * RS + s0 * 2) = o; }
        }
        if (c + 1 < SEQ / 128) SSD_PREFETCH(c + 1);
        for (int kk = 0; kk <= (qt >> 1); ++kk) {
            bf16x8 xf[4];
            const bf16x8 pf = *(const LAS bf16x8*)(lds + L_C + qrow * RS + (kk * 32 + fq * 8) * 2);
#pragma unroll
            for (int pt = 0; pt < 4; ++pt) xf[pt] = tr_frag(lds + L_X, RX, kk * 32, 16 * pt, lane);
#pragma unroll
            for (int pt = 0; pt < 4; ++pt) yacc[pt] = __builtin_amdgcn_mfma_f32_16x16x32_bf16(xf[pt], pf, yacc[pt], 0, 0, 0);
        }
        { float ss = 0.f;
#pragma unroll
          for (int pt = 0; pt < 4; ++pt) { const int pc = 16 * pt + 4 * fq;
              const u32x2 xv = *(const LAS u32x2*)(lds + L_X + qrow * RX + pc * 2);
              const float x0 = bflo(xv.x), x1 = bfhi(xv.x), x2 = bflo(xv.y), x3 = bfhi(xv.y);
              const float g0 = (yacc[pt][0] + Dh * x0) * bflo(zv[pt].x), g1 = (yacc[pt][1] + Dh * x1) * bfhi(zv[pt].x);
              const float g2 = (yacc[pt][2] + Dh * x2) * bflo(zv[pt].y), g3 = (yacc[pt][3] + Dh * x3) * bfhi(zv[pt].y);
              ss += (g0 * g0 + g1 * g1) + (g2 * g2 + g3 * g3);
              u32x2 o; o.x = cvt_pk_bf16(g0, g1); o.y = cvt_pk_bf16(g2, g3);
              *(u32x2*)(YG + trow * 2048 + h * 64 + pc) = o; }
          ss += __shfl_xor(ss, 16); ss += __shfl_xor(ss, 32);
          if (fq == 0) SSQ[trow * 32 + h] = ss; }
        { const float dec = __expf(acs_last);
#pragma unroll
          for (int i = 0; i < 4; ++i) hacc[i] = hacc[i] * dec;
#pragma unroll
          for (int kp = 0; kp < 2; ++kp) {
              bf16x8 xwf[2], bf[2][4];
#pragma unroll
              for (int a = 0; a < 2; ++a) { const int kk = 2 * kp + a;
                  xwf[a] = tr_frag(lds + L_XW, RX, kk * 32, 16 * hpt, lane);
#pragma unroll
                  for (int i = 0; i < 4; ++i) bf[a][i] = tr_frag(lds + L_B, RS, kk * 32, 16 * (hnb + i), lane); }
              __builtin_amdgcn_sched_barrier(0);
#pragma unroll
              for (int a = 0; a < 2; ++a)
#pragma unroll
                  for (int i = 0; i < 4; ++i) hacc[i] = __builtin_amdgcn_mfma_f32_16x16x32_bf16(bf[a][i], xwf[a], hacc[i], 0, 0, 0);
          } }
        prev_sr = -1;
        if (has_s) {
            const float dA = __expf(sdt * -expf(p.in[I_ALOG][sh])), sD = p.in[I_DSKIP][sh];
            const f32x4 Bv = cv4(sbu), Cv = cv4(scu);
            float y[4];
#pragma unroll
            for (int i = 0; i < 4; ++i) { const int pp = pr + 16 * i;
                const f32x4 hn = h0[i] * dA + Bv * (sdt * sxv[i]);
                __builtin_nontemporal_store(hn, (f32x4*)(p.out + O_SSS + sbase_off + (size_t)pp * DS + 4 * n4));
                y[i] = (hn[0] * Cv[0] + hn[1] * Cv[1]) + (hn[2] * Cv[2] + hn[3] * Cv[3]); }
            const bool b4 = (n4 & 16) != 0, b3 = (n4 & 8) != 0;
            const float a0 = (b4 ? y[2] : y[0]) + __shfl_xor(b4 ? y[0] : y[2], 16);
            const float a1 = (b4 ? y[3] : y[1]) + __shfl_xor(b4 ? y[1] : y[3], 16);
            float ys = (b3 ? a1 : a0) + __shfl_xor(b3 ? a0 : a1, 8);
            ys += __shfl_xor(ys, 4); ys += __shfl_xor(ys, 2); ys += __shfl_xor(ys, 1);
            const int gi = n4 >> 3;
            const float xsel = b4 ? (b3 ? sxv[3] : sxv[2]) : (b3 ? sxv[1] : sxv[0]), zsel = b4 ? (b3 ? szv[3] : szv[2]) : (b3 ? szv[1] : szv[0]);
            const float gt = (ys + sD * xsel) * zsel;
            const bool lead = (n4 & 7) == 0;
            if (lead) YG[(size_t)sr * 2048 + sh * 64 + pr + 16 * gi] = f2bf(gt);
            float part = lead ? gt * gt : 0.f;
            part += __shfl_xor(part, 8); part += __shfl_xor(part, 16);
            if (n4 == 0) red[pr] = part;
            prev_sr = sr; prev_sh = sh;
        }
    }
#undef SSD_PREFETCH
    float* so = p.out + O_SSP + (((size_t)b * NH + h) * HD + 16 * hpt + fr) * DS;
#pragma unroll
    for (int i = 0; i < 4; ++i) *(f32x4*)(so + 16 * (hnb + i) + 4 * fq) = hacc[i];
    __syncthreads();
    if (tid == 0 && prev_sr >= 0) { float v = 0.f;
#pragma unroll
        for (int i = 0; i < 16; ++i) v += red[i];
        SSQ[(size_t)prev_sr * 32 + prev_sh] = v; }
    __syncthreads();
}
__device__ __forceinline__ void phase_ssd(const Params& p, LAS unsigned char* lds, const int wid) {
    for (int u = blockIdx.x; u < NBP * NH; u += gridDim.x) {
        const int xcd = u & 7, j = u >> 3, pair = xcd * 4 + (j >> 3), hr = j & 7;
        ssd_unit(p, lds, pair >> 2, (pair & 3) * 8 + hr, u, wid);
    }
}
__device__ __forceinline__ void phase_gnorm(const Params& p) {
    bf16_t* YG = (bf16_t*)(p.ws + OFF_YG); const float* SSQ = (const float*)(p.ws + OFF_SSQ);
    for (int i = blockIdx.x * 512 + (int)threadIdx.x; i < MTOT * 256; i += gridDim.x * 512) {
        const int row = i >> 8, cu = i & 255, g = cu >> 6;
        const f32x4 s0 = *(const f32x4*)(SSQ + (size_t)row * 32 + 8 * g), s1 = *(const f32x4*)(SSQ + (size_t)row * 32 + 8 * g + 4);
        const float rstd = rsqrtf(((s0[0] + s0[1]) + (s0[2] + s0[3]) + (s1[0] + s1[1]) + (s1[2] + s1[3])) * (1.f / 512.f) + EPS);
        bf16_t* q = YG + (size_t)row * 2048 + cu * 8;
        const F8 v = ld8bf(q);
        *(u32x4*)q = pack8(v.a * rstd, v.b * rstd);
    }
}

__global__ void __launch_bounds__(512, 2) fwd_megakernel(Params p) {
    extern __shared__ __attribute__((aligned(16))) unsigned char shm[];
    LAS unsigned char* lds = (LAS unsigned char*)shm;
    cg::grid_group grid = cg::this_grid();
    unsigned char* ws = p.ws;
    const int G = gridDim.x, cid = blockIdx.x;
    float* mod = (float*)(ws + OFF_MOD);
    pg8::StaticOrder S;
    volatile LAS unsigned* xst = (volatile LAS unsigned*)(lds + L_XST);
    const int wid0 = __builtin_amdgcn_readfirstlane((int)threadIdx.x >> 6);
    if (tid_of(wid0) == 0) { xst[0] = 0u; xst[1] = 0u; }
    __syncthreads();
    XcdBarrier xb = xcd_barrier_post((unsigned*)(ws + OFF_BAR), xst, wid0);
    unsigned long long ts0 = 0, ts1 = 0;
#define TSTAMP(k) do { if (PROBE_PHASE >= 0) { if ((k) == PROBE_PHASE) ts0 = __builtin_amdgcn_s_memrealtime(); if ((k) == PROBE_PHASE + 1) ts1 = __builtin_amdgcn_s_memrealtime(); } } while (0)
    TSTAMP(0);

    phase0(p, lds, 0, wid0);
    if (p.ws == nullptr) grid.sync();
    GSYNC(); TSTAMP(1);
    if (cid < 24) {
        pg8::Gemm g{(const bf16_t*)(ws + OFF_CA), (const bf16_t*)(ws + OFF_WADA), 256, 6144, 1024};
        EpiF32Bias E{mod, 6144, p.in[I_BADA]};
        S.init(g.M, g.N, 24, cid); pg8::gemm_phase<EpiF32Bias, pg8::StaticOrder, true, true>(lds, g, S, E, wid0);
    } else phase0(p, lds, 1, wid0);
    GSYNC(); TSTAMP(2);
    phase_rownorm<false>(p, p.in[I_N1G], 1024, 0, (bf16_t*)(ws + OFF_U), wid0);
    if (PROBE_EW) phase_rownorm<false>(p, p.in[I_N1G], 1024, 0, (bf16_t*)(ws + OFF_U), wid0);
    GSYNC(); TSTAMP(3);
    {
        pg8::Gemm g{(const bf16_t*)(ws + OFF_U), (const bf16_t*)(ws + OFF_WIN), MPAD, DINP, 1024};
        EpiIn E{(bf16_t*)(ws + OFF_BG), (bf16_t*)(ws + OFF_CI), (bf16_t*)(ws + OFF_Z), (bf16_t*)(ws + OFF_XBC), (bf16_t*)(ws + OFF_GA), (bf16_t*)(ws + OFF_GB), (float*)(ws + OFF_DTRAW)};
        S.init(g.M, g.N, G, cid); pg8::gemm_phase<EpiIn, pg8::StaticOrder, true, true>(lds, g, S, E, wid0);
        if (PROBE_INPROJ) { __syncthreads(); pg8::gemm_phase<EpiIn, pg8::StaticOrder, true, true>(lds, g, S, E, wid0); }
        __syncthreads();
        phase0(p, lds, 2, wid0);
    }
    GSYNC(); TSTAMP(4);
    phase_conv(p, lds, wid0);
    if (PROBE_CONV) { __syncthreads(); phase_conv(p, lds, wid0); }
    GSYNC(); TSTAMP(5);
    {
        pg8::Gemm ga{(const bf16_t*)(ws + OFF_VA), (const bf16_t*)(ws + OFF_WAOUT), MP, 1024, 1024};
        EpiGate<0> Ea{(bf16_t*)(ws + OFF_YA), (const bf16_t*)(ws + OFF_GA), nullptr, 1024};
        S.init(ga.M, ga.N, G, cid); pg8::gemm_phase<EpiGate<0>, pg8::StaticOrder, true, true>(lds, ga, S, Ea, wid0);
        __syncthreads();
        SkGate<0> Sa{(bf16_t*)(ws + OFF_YA), (const bf16_t*)(ws + OFF_GA), nullptr, 1024, nullptr};
        skinny_gemm<4>(lds, (const bf16_t*)(ws + OFF_VA) + (size_t)MP * 1024, (const bf16_t*)(ws + OFF_WAOUT), 1024, 1024, Sa, wid0);
        __syncthreads();
    }
    phase_ssd(p, lds, wid0);
    if (PROBE_SSD) { __syncthreads(); phase_ssd(p, lds, wid0); }
    GSYNC(); TSTAMP(6);
    {
        S.init(MP, 1024, G, cid);
        {
            Unit u0; S.next(0, u0);
            const int t = tid_of(wid0), rl = t >> 1, g0 = (t & 1) * 2;
            const float* sq = (const float*)(ws + OFF_SSQ) + (size_t)(u0.pm * 256 + rl) * 32;
            float r[4];
#pragma unroll
            for (int g = 0; g < 4; ++g) { const f32x4 s0 = *(const f32x4*)(sq + 8 * g), s1 = *(const f32x4*)(sq + 8 * g + 4);
                r[g] = rsqrtf(((s0[0] + s0[1]) + (s0[2] + s0[3]) + (s1[0] + s1[1]) + (s1[2] + s1[3])) * (1.f / 512.f) + EPS); }
            LAS float* rt = (LAS float*)(lds + L_RT);
            if (g0 == 0) { rt[rl * 4 + 0] = r[0] / r[1]; rt[rl * 4 + 1] = r[1] / r[2]; } else { rt[rl * 4 + 2] = r[2] / r[3]; rt[rl * 4 + 3] = r[3]; }
            __syncthreads();
        }
        pg8::Gemm gb{(const bf16_t*)(ws + OFF_YG), (const bf16_t*)(ws + OFF_WBOUT), MP, 1024, 2048};
        EpiGate<1> Eb{(bf16_t*)(ws + OFF_MERGED), (const bf16_t*)(ws + OFF_GB), (const bf16_t*)(ws + OFF_YA), 1024};
        pg8::gemm_phase<EpiGate<1>, pg8::StaticOrder, true, true>(lds, gb, S, Eb, wid0);
        __syncthreads();
        SkGate<1> Sb{(bf16_t*)(ws + OFF_MERGED), (const bf16_t*)(ws + OFF_GB), (const bf16_t*)(ws + OFF_YA), 1024, (const float*)(ws + OFF_SSQ)};
        skinny_gemm<4>(lds, (const bf16_t*)(ws + OFF_YG) + (size_t)MP * 2048, (const bf16_t*)(ws + OFF_WBOUT), 1024, 2048, Sb, wid0);
    }
    GSYNC(); TSTAMP(7);
    {
        pg8::Gemm g{(const bf16_t*)(ws + OFF_MERGED), (const bf16_t*)(ws + OFF_WO), MP, 1024, 1024};
        EpiRes E{(bf16_t*)(ws + OFF_X1), p.in[I_XP], mod + 2048};
        S.init(g.M, g.N, G, cid); pg8::gemm_phase<EpiRes, pg8::StaticOrder, true, true>(lds, g, S, E, wid0);
        __syncthreads();
        SkRes Sk{(bf16_t*)(ws + OFF_X1), p.in[I_XS], mod + 2048};
        skinny_gemm<4>(lds, (const bf16_t*)(ws + OFF_MERGED) + (size_t)MP * 1024, (const bf16_t*)(ws + OFF_WO), 1024, 1024, Sk, wid0);
    }
    GSYNC(); TSTAMP(8);
    phase_rownorm<true>(p, p.in[I_N2G], 4096, 3072, (bf16_t*)(ws + OFF_U), wid0);
    if (PROBE_EW) phase_rownorm<true>(p, p.in[I_N2G], 4096, 3072, (bf16_t*)(ws + OFF_U), wid0);
    GSYNC(); TSTAMP(9);
    {
        pg8::Gemm g{(const bf16_t*)(ws + OFF_U), (const bf16_t*)(ws + OFF_W1), MP, DFF, 1024};
        EpiGate<2> E{(bf16_t*)(ws + OFF_HMID), nullptr, nullptr, DFF};
        S.init(g.M, g.N, G, cid); pg8::gemm_phase<EpiGate<2>, pg8::StaticOrder, true, true>(lds, g, S, E, wid0);
        if (PROBE_MLP1) { __syncthreads(); pg8::gemm_phase<EpiGate<2>, pg8::StaticOrder, true, true>(lds, g, S, E, wid0); }
        __syncthreads();
        SkGate<2> Sk{(bf16_t*)(ws + OFF_HMID), nullptr, nullptr, DFF, nullptr};
        skinny_gemm<1>(lds, (const bf16_t*)(ws + OFF_U) + (size_t)MP * 1024, (const bf16_t*)(ws + OFF_W1), DFF, 1024, Sk, wid0);
    }
    GSYNC(); TSTAMP(10);
    {
        pg8::Gemm g{(const bf16_t*)(ws + OFF_HMID), (const bf16_t*)(ws + OFF_W2), MP, 1024, DFF};
        EpiRes E{(bf16_t*)(ws + OFF_X1), nullptr, mod + 5120};
        S.init(g.M, g.N, G, cid); pg8::gemm_phase<EpiRes, pg8::StaticOrder, true, true>(lds, g, S, E, wid0);
        __syncthreads();
        SkRes Sk{(bf16_t*)(ws + OFF_X1), nullptr, mod + 5120};
        skinny_gemm<4>(lds, (const bf16_t*)(ws + OFF_HMID) + (size_t)MP * DFF, (const bf16_t*)(ws + OFF_W2), 1024, DFF, Sk, wid0);
    }
    GSYNC(); TSTAMP(11);
    phase_final(p, wid0);
    if (PROBE_EW) phase_final(p, wid0);
    TSTAMP(99);
    if (PROBE_PHASE >= 0 && blockIdx.x == 0) { if (ts1 == 0) ts1 = __builtin_amdgcn_s_memrealtime(); const unsigned long long te = __builtin_amdgcn_s_memrealtime(), wait = 4ull * (ts1 - ts0);
        while (__builtin_amdgcn_s_memrealtime() - te < wait) __builtin_amdgcn_s_sleep(8); }
}

extern "C" void kernel_launch(void* const* d_in, const int* in_sizes, int n_in, void* d_out, int out_size, void* d_ws, size_t ws_size, hipStream_t stream) {
    constexpr int LDS_BYTES = LDS_TOTAL;
    static int grid = 0;
    if (grid == 0) {
        if (n_in != 25 || ws_size < WS_END) { fprintf(stderr, "kernel_launch: unexpected n_in %d / ws %zu (need %zu)\n", n_in, ws_size, (size_t)WS_END); grid = -1; return; }
        int dev = 0, cus = 0, per_cu = 0;
        (void)hipGetDevice(&dev);
        (void)hipDeviceGetAttribute(&cus, hipDeviceAttributeMultiprocessorCount, dev);
        if (hipFuncSetAttribute((const void*)fwd_megakernel, hipFuncAttributeMaxDynamicSharedMemorySize, LDS_BYTES) != hipSuccess) { fprintf(stderr, "kernel_launch: hipFuncSetAttribute failed\n"); grid = -1; return; }
        if (hipOccupancyMaxActiveBlocksPerMultiprocessor(&per_cu, (const void*)fwd_megakernel, 512, LDS_BYTES) != hipSuccess || per_cu < 1) { fprintf(stderr, "kernel_launch: occupancy query says %d blocks per CU\n", per_cu); grid = -1; return; }
        if (cus != 256) { fprintf(stderr, "kernel_launch: built for 256 CUs, found %d\n", cus); grid = -1; return; }
        grid = cus;
    }
    if (grid < 0) return;
    Params p{};
    for (int i = 0; i < 25; ++i) p.in[i] = (const float*)d_in[i];
    p.out = (float*)d_out; p.ws = (unsigned char*)d_ws;
    (void)hipMemsetAsync((unsigned char*)d_ws + OFF_BAR, 0, 16384, stream);
    void* args[] = {&p};
    hipError_t e = hipLaunchCooperativeKernel((const void*)fwd_megakernel, dim3(grid), dim3(512), args, LDS_BYTES, stream);
    if (e != hipSuccess) fprintf(stderr, "cooperative launch failed: %s (grid %d)\n", hipGetErrorString(e), grid);
}
```

```cpp
#include <hip/hip_runtime.h>
#include <hip/hip_cooperative_groups.h>
#include <cstdio>
#include <cstdint>
namespace cg = cooperative_groups;
#define PROBE_EW 0
#define PROBE_CONV 0
#define PROBE_SSD 0
#define PROBE_SYNC 0
#define PROBE_PHASE -1
#define PROBE_INPROJ 0
#define PROBE_MLP1 0
#define GSYNC() do { xcd_barrier(xb); if (PROBE_SYNC) xcd_barrier(xb); } while (0)

#define LAS __attribute__((address_space(3)))
typedef unsigned short bf16_t;
typedef short bf16x8 __attribute__((ext_vector_type(8)));
typedef short bf16x4 __attribute__((ext_vector_type(4)));
typedef float f32x4 __attribute__((ext_vector_type(4)));
typedef float f32x2 __attribute__((ext_vector_type(2)));
typedef unsigned u32x4 __attribute__((ext_vector_type(4)));
typedef unsigned u32x2 __attribute__((ext_vector_type(2)));

constexpr int D = 1024, NBP = 8, SEQ = 2048, MP = NBP * SEQ, NBS = 128, MTOT = MP + NBS, MPAD = 16640;
constexpr int DINP = 10496, DINNER = 2048, DXBC = 3072, NH = 32, HD = 64, DS = 128, DFF = 4096, DIN = 10272;
constexpr float EPS = 1e-6f;
constexpr size_t O_YP = 0, O_YS = 16777216, O_SCP = 16908288, O_SBP = 16924672, O_SSP = 16998400, O_SCS = 19095552, O_SBS = 19357696, O_SSS = 20537344;
constexpr size_t S1 = (size_t)MPAD * 1024 * 2;
constexpr size_t OFF_WADA = 0, OFF_WIN = 12582912, OFF_WAOUT = 34078720, OFF_WBOUT = 36175872, OFF_WO = 40370176, OFF_W1 = 42467328, OFF_W2 = 50855936,
                 OFF_CA = 59244544, OFF_MOD = 59768832, OFF_DTRAW = 66060288, OFF_DTP = 68190208, OFF_ACS = 70320128, OFF_SSQ = 72450048, OFF_U = 74579968,
                 OFF_R1 = OFF_U + S1, OFF_BG = OFF_R1, OFF_CI = OFF_R1 + S1, OFF_Z = OFF_R1 + 2 * S1, OFF_XBC = OFF_R1 + 4 * S1, OFF_GA = OFF_R1 + 7 * S1, OFF_GB = OFF_R1 + 8 * S1,
                 OFF_R2 = OFF_R1 + 9 * S1, OFF_BAR = OFF_R2 + 3 * S1, WS_END = OFF_BAR + 16384;
constexpr size_t OFF_VA = OFF_U, OFF_YA = OFF_BG, OFF_MERGED = OFF_CI, OFF_YG = OFF_XBC, OFF_HMID = OFF_R1, OFF_XBCC = OFF_R2, OFF_X1 = OFF_R2;

struct Params {
    const float* in[25];
    float* out;
    unsigned char* ws;
};
enum { I_XP = 0, I_XS, I_CP, I_CS, I_STA, I_STB, I_STS, I_WADA, I_BADA, I_N1G, I_WIN, I_CAW, I_WAOUT, I_CBW, I_CBB, I_DTB, I_ALOG, I_DSKIP, I_SNG, I_WBOUT, I_WO, I_N2G, I_W1, I_W2, I_NFG };

__device__ __forceinline__ unsigned cvt_pk_bf16(float lo, float hi) { unsigned r; asm volatile("v_cvt_pk_bf16_f32 %0, %1, %2" : "=v"(r) : "v"(lo), "v"(hi)); return r; }
__device__ __forceinline__ bf16_t f2bf(float f) { unsigned u = __float_as_uint(f); u += 0x7FFFu + ((u >> 16) & 1u); return (bf16_t)(u >> 16); }
__device__ __forceinline__ float bf2f(bf16_t b) { return __uint_as_float(((unsigned)b) << 16); }
__device__ __forceinline__ float bflo(unsigned u) { return __uint_as_float(u << 16); }
__device__ __forceinline__ float bfhi(unsigned u) { return __uint_as_float(u & 0xffff0000u); }
__device__ __forceinline__ float sigmoidf_(float x) { return __builtin_amdgcn_rcpf(1.f + __expf(-x)); }
__device__ __forceinline__ float siluf_(float x) { return x * sigmoidf_(x); }
__device__ __forceinline__ f32x4 cv4(const u32x2 u) { return (f32x4){bflo(u.x), bfhi(u.x), bflo(u.y), bfhi(u.y)}; }
struct F8 { f32x4 a, b; };
__device__ __forceinline__ F8 cv8(const u32x4 u) { F8 r; r.a = (f32x4){bflo(u.x), bfhi(u.x), bflo(u.y), bfhi(u.y)}; r.b = (f32x4){bflo(u.z), bfhi(u.z), bflo(u.w), bfhi(u.w)}; return r; }
__device__ __forceinline__ int tid_of(int wid) { int l; asm volatile("v_mbcnt_lo_u32_b32 %0, -1, 0\n\tv_mbcnt_hi_u32_b32 %0, -1, %0" : "=v"(l)); __builtin_assume(l >= 0 && l < 64); __builtin_assume(wid >= 0 && wid < 8); return wid * 64 + l; }
__device__ __forceinline__ float wave_sum(float v) {
#pragma unroll
    for (int o = 1; o < 64; o <<= 1) v += __shfl_xor(v, o);
    return v;
}


#define XB_TMO      128
#define XB_XCNT(j)  (256  + 64 * (j))
#define XB_XSUB(j)  (1280 + 64 * (j))
#define XB_XGEN(j)  (2304 + 64 * (j))
#define XB_TOP      3328
#define XB_TOPGEN   3392
#define XCD_BAR_WORDS 3456
#define XB_SPIN_CAP (1u << 18)
__device__ __forceinline__ unsigned xb_ld(unsigned* p)              { return __hip_atomic_load(p, __ATOMIC_RELAXED, __HIP_MEMORY_SCOPE_AGENT); }
__device__ __forceinline__ unsigned xb_add(unsigned* p, unsigned v) { return __hip_atomic_fetch_add(p, v, __ATOMIC_RELAXED, __HIP_MEMORY_SCOPE_AGENT); }
__device__ __forceinline__ unsigned xb_xcc_id() { return (unsigned)__builtin_amdgcn_s_getreg((3 << 11) | 20) & 0xFu; }
#define XB_SPIN(cond, bar) do { unsigned _sp = 0; while (cond) { __builtin_amdgcn_s_sleep(1); \
    if ((++_sp & 255u) == 0u) { if (xb_ld(&(bar)[XB_TMO])) break; if (_sp > XB_SPIN_CAP) { atomicAdd(&(bar)[XB_TMO], 1u); break; } } } } while (0)
struct XcdBarrier { unsigned* bar; unsigned x; volatile LAS unsigned* st; int wid; };
__device__ __forceinline__ XcdBarrier xcd_barrier_post(unsigned* bar, volatile LAS unsigned* st, int wid) {
    XcdBarrier b; b.bar = bar; b.x = xb_xcc_id(); b.st = st; b.wid = wid;
    if (tid_of(wid) == 0) (void)xb_add(&bar[XB_XCNT(b.x)], 1u);
    return b;
}
__device__ __forceinline__ void xcd_barrier_complete(unsigned* bar, unsigned x, unsigned& nloc, unsigned& nx) {
    const unsigned G = gridDim.x * gridDim.y * gridDim.z;
    unsigned sum, cnt, mine, sp = 0u;
    for (;;) {
        sum = 0u; cnt = 0u; mine = 0u;
#pragma unroll
        for (unsigned j = 0; j < 16; ++j) { const unsigned c = xb_ld(&bar[XB_XCNT(j)]); sum += c; cnt += (c > 0u) ? 1u : 0u; mine = (j == x) ? c : mine; }
        if (sum == G) break;
        __builtin_amdgcn_s_sleep(1);
        if ((++sp & 255u) == 0u) { if (xb_ld(&bar[XB_TMO])) break; if (sp > XB_SPIN_CAP) { atomicAdd(&bar[XB_TMO], 1u); break; } }
    }
    nloc = mine > 0u ? mine : 1u; nx = cnt > 0u ? cnt : 1u;
}
__device__ __forceinline__ void xcd_barrier(const XcdBarrier& b) {
    asm volatile("s_waitcnt vmcnt(0)" ::: "memory");
    __syncthreads();
    if (tid_of(b.wid) == 0) {
        unsigned* bar = b.bar;
        __builtin_amdgcn_s_waitcnt(0);
        unsigned nloc = b.st[0], nx = b.st[1];
        if (nloc == 0u) { xcd_barrier_complete(bar, b.x, nloc, nx); b.st[0] = nloc; b.st[1] = nx; }
        const unsigned old = xb_add(&bar[XB_XSUB(b.x)], 1u);
        const unsigned gen = old / nloc;
        if (old + 1u == (gen + 1u) * nloc) {
            __builtin_amdgcn_fence(__ATOMIC_RELEASE, "agent");
            asm volatile("s_waitcnt vmcnt(0)" ::: "memory");
            const unsigned og = xb_add(&bar[XB_TOP], 1u);
            const unsigned tg = og / nx;
            if (og + 1u == (tg + 1u) * nx) xb_add(&bar[XB_TOPGEN], 1u);
            else XB_SPIN(xb_ld(&bar[XB_TOPGEN]) == tg, bar);
            __builtin_amdgcn_fence(__ATOMIC_ACQUIRE, "agent");
            xb_add(&bar[XB_XGEN(b.x)], 1u);
            asm volatile("s_waitcnt vmcnt(0)" ::: "memory");
        } else {
            XB_SPIN(xb_ld(&bar[XB_XGEN(b.x)]) == gen, bar);
            __builtin_amdgcn_fence(__ATOMIC_ACQUIRE, "agent");
            asm volatile("s_waitcnt vmcnt(0)" ::: "memory");
        }
    }
    __syncthreads();
}

constexpr int L_XST = 131072, L_RT = 131072 + 16, LDS_TOTAL = L_RT + 4096;
namespace pg8 {
#define PG8_LAS __attribute__((address_space(3)))
constexpr int BM = 256, BK = 64, HALF = 128, HTB = HALF * BK * 2, STAGE_BYTES = 8 * HTB, NXCD = 8, WGM = 4;
__host__ __device__ __forceinline__ int lds_byte(int r, int c) { const int st = (r >> 4) * 2 + (c >> 5), rr = r & 15, cc = c & 31, ob = rr * 64 + cc * 2; return st * 1024 + (ob ^ (((ob >> 9) & 1) << 5)); }
__host__ __device__ __forceinline__ void stage_rc(int b, int& R, int& C) { const int st = b / 1024, sb = b % 1024, swz = sb ^ (((sb >> 9) & 1) << 5); R = (st >> 1) * 16 + swz / 64; C = (st & 1) * 32 + (swz % 64) / 2; }
__host__ __device__ __forceinline__ int perm32(int rho) { const int n = rho >> 4, i = rho & 15; return 8 * (i >> 2) + 4 * n + (i & 3); }
struct Unit { int pm, pn; };
struct Gemm { const bf16_t* A; const bf16_t* Bt; int M, N, K; };
struct StaticOrder {
    int nM, nN, nwg, G, c;
    __host__ __device__ void init(int M, int N, int G_, int c_) { nM = M / BM; nN = N / BM; nwg = nM * nN; G = G_; c = c_; }
    __host__ __device__ bool next(int i, Unit& u) const {
        const long L = (long)i * G + c; if (L >= nwg) return false;
        int wgid = (int)L; { const int q = nwg / NXCD, r = nwg % NXCD, xcd = wgid % NXCD, off = wgid / NXCD; wgid = (xcd < r ? xcd * (q + 1) : r * (q + 1) + (xcd - r) * q) + off; }
        const int nig = WGM * nN, gid = wgid / nig, fm = gid * WGM, gsz = (nM - fm) < WGM ? (nM - fm) : WGM;
        u.pm = fm + ((wgid % nig) % gsz); u.pn = (wgid % nig) / gsz; return true;
    }
    __device__ __forceinline__ void a_ready(const Unit&) const {}
    __device__ __forceinline__ void done(const Unit&) const {}
};

template <class Epi, class Sched, bool ALIGN_EPI = false, bool SP2 = false>
__device__ __forceinline__ void gemm_phase(PG8_LAS unsigned char* lds, const Gemm g, const Sched& S, const Epi& E, const int wid) {
    const int tid = tid_of(wid), lane = tid & 63, wr = wid >> 2, wc = wid & 3, fr = lane & 15, fq = lane >> 4;
    const int K = g.K, nt = K / BK;
    unsigned voffA[2], voffB[2];
#pragma unroll
    for (int i = 0; i < 2; ++i) { int R, C; stage_rc(tid * 16 + i * 8192, R, C); const int Rb = Epi::PERM ? ((R & ~31) + perm32(R & 31)) : R;
        voffA[i] = (unsigned)(R * K + C) * 2u; voffB[i] = (unsigned)(Rb * K + C) * 2u; }
    const size_t kstep = (size_t)(BK * 2);
    const size_t hstep = (size_t)HALF * K * 2;
    const size_t tstep = 2 * hstep;
    const unsigned ldsw = (unsigned)wid * 1024u;
    const int aoff = lds_byte(wr * 64 + fr, fq * 8), boff = lds_byte(wc * 32 + fr, fq * 8);
#define PG8_SA(b, h) (((b) * 2 + (h)) * HTB)
#define PG8_SB(b, h) ((4 + (b) * 2 + (h)) * HTB)
#define PG8_STAGE(bufoff, gbase, voff) do { _Pragma("unroll") for (int _i = 0; _i < 2; ++_i) \
        __builtin_amdgcn_global_load_lds((const unsigned*)((const char*)(gbase) + (voff)[_i]), (PG8_LAS unsigned*)(lds + (bufoff) + ldsw + _i * 8192), 16, 0, 0); } while (0)
#define PG8_LDA(dst, b, h) do { _Pragma("unroll") for (int m = 0; m < 4; ++m) _Pragma("unroll") for (int k = 0; k < 2; ++k) dst[m][k] = *(const PG8_LAS bf16x8*)(lds + PG8_SA(b, h) + aoff + m * 2048 + k * 1024); } while (0)
#define PG8_LDB(dst, b, h) do { _Pragma("unroll") for (int n = 0; n < 2; ++n) _Pragma("unroll") for (int k = 0; k < 2; ++k) dst[n][k] = *(const PG8_LAS bf16x8*)(lds + PG8_SB(b, h) + boff + n * 2048 + k * 1024); } while (0)
#define PG8_MMA(ai, bj, At, Bt) do { __builtin_amdgcn_s_setprio(1); _Pragma("unroll") for (int m = 0; m < 4; ++m) _Pragma("unroll") for (int n = 0; n < 2; ++n) _Pragma("unroll") for (int k = 0; k < 2; ++k) \
        acc[ai][bj][m][n] = __builtin_amdgcn_mfma_f32_16x16x32_bf16(Bt[n][k], At[m][k], acc[ai][bj][m][n], 0, 0, 0); __builtin_amdgcn_s_setprio(0); } while (0)
#define PG8_WAIT_V(n) asm volatile("s_waitcnt vmcnt(" #n ")" ::: "memory")
#define PG8_WAIT_L(n) asm volatile("s_waitcnt lgkmcnt(" #n ")" ::: "memory")
#define PG8_BAR __builtin_amdgcn_s_barrier()
#define PG8_SCHED __builtin_amdgcn_sched_barrier(0)
    Unit cur, nxt; int ui = 0;
    if (!S.next(0, cur)) return;
    f32x4 acc[2][2][4][2];
#pragma unroll
    for (int a = 0; a < 2; ++a)
#pragma unroll
        for (int b = 0; b < 2; ++b)
#pragma unroll
            for (int m = 0; m < 4; ++m)
#pragma unroll
                for (int n = 0; n < 2; ++n) acc[a][b][m][n] = (f32x4){0.f, 0.f, 0.f, 0.f};
    bf16x8 At[4][2], B0[2][2], B1[2][2];
    const char* cA = (const char*)g.A + (size_t)cur.pm * tstep; const char* cB = (const char*)g.Bt + (size_t)cur.pn * tstep;
    S.a_ready(cur);
    if constexpr (SP2) {
        PG8_STAGE(PG8_SB(0, 0), cB, voffB); PG8_STAGE(PG8_SB(0, 1), cB + hstep, voffB); PG8_STAGE(PG8_SA(0, 0), cA, voffA); PG8_STAGE(PG8_SA(0, 1), cA + hstep, voffA);
        if (wr == 1) PG8_BAR;
        PG8_WAIT_V(2); PG8_BAR;
        PG8_STAGE(PG8_SB(1, 0), cB + kstep, voffB); PG8_STAGE(PG8_SA(1, 0), cA + kstep, voffA); PG8_STAGE(PG8_SB(1, 1), cB + hstep + kstep, voffB);
        PG8_WAIT_V(6); PG8_BAR;
    } else {
        PG8_STAGE(PG8_SB(0, 0), cB, voffB); PG8_STAGE(PG8_SA(0, 0), cA, voffA); PG8_STAGE(PG8_SB(0, 1), cB + hstep, voffB); PG8_STAGE(PG8_SA(0, 1), cA + hstep, voffA);
        if (wr == 1) PG8_BAR;
        PG8_WAIT_V(4); PG8_BAR;
        PG8_STAGE(PG8_SB(1, 0), cB + kstep, voffB); PG8_STAGE(PG8_SA(1, 0), cA + kstep, voffA); PG8_STAGE(PG8_SB(1, 1), cB + hstep + kstep, voffB);
        PG8_WAIT_V(6); PG8_BAR;
    }
    for (;;) {
        const bool has_next = S.next(ui + 1, nxt);
        const char* nA = has_next ? (const char*)g.A + (size_t)nxt.pm * tstep : cA; const char* nB = has_next ? (const char*)g.Bt + (size_t)nxt.pn * tstep : cB;
        for (int t = 0; t < nt; t += 2) {
            const bool last = (t == nt - 2);
            const char* a1 = cA + (size_t)(t + 1) * kstep;
            const char* a2 = last ? nA : cA + (size_t)(t + 2) * kstep; const char* b2 = last ? nB : cB + (size_t)(t + 2) * kstep;
            const char* a3 = a2 + kstep; const char* b3 = b2 + kstep;
            if (last && has_next) S.a_ready(nxt);
            if constexpr (Epi::RESCALE) { if (t != 0 && (t & 7) == 0) { PG8_SCHED; E.rescale(acc, (t >> 3) - 1, wr, fr, lds); PG8_SCHED; } }
            if constexpr (SP2) {
            PG8_LDB(B0, 0, 0); PG8_LDB(B1, 0, 1); PG8_SCHED; PG8_LDA(At, 0, 0); PG8_STAGE(PG8_SA(1, 1), a1 + hstep, voffA);
            PG8_WAIT_V(8); PG8_WAIT_L(0); PG8_BAR; PG8_MMA(0, 0, At, B0); PG8_MMA(0, 1, At, B1); PG8_BAR; PG8_SCHED;
            PG8_LDA(At, 0, 1); PG8_STAGE(PG8_SB(0, 0), b2, voffB); PG8_STAGE(PG8_SB(0, 1), b2 + hstep, voffB); PG8_STAGE(PG8_SA(0, 0), a2, voffA);
            PG8_WAIT_V(8); PG8_WAIT_L(0); PG8_BAR; PG8_MMA(1, 0, At, B0); PG8_MMA(1, 1, At, B1); PG8_BAR; PG8_SCHED;
            PG8_LDB(B0, 1, 0); PG8_LDB(B1, 1, 1); PG8_SCHED; PG8_LDA(At, 1, 0); PG8_STAGE(PG8_SA(0, 1), a2 + hstep, voffA);
            PG8_WAIT_V(8); PG8_WAIT_L(0); PG8_BAR; PG8_MMA(0, 0, At, B0); PG8_MMA(0, 1, At, B1); PG8_BAR; PG8_SCHED;
            PG8_LDA(At, 1, 1); PG8_STAGE(PG8_SB(1, 0), b3, voffB); PG8_STAGE(PG8_SB(1, 1), b3 + hstep, voffB); PG8_STAGE(PG8_SA(1, 0), a3, voffA);
            PG8_WAIT_V(8); PG8_WAIT_L(0); PG8_BAR; PG8_MMA(1, 0, At, B0); PG8_MMA(1, 1, At, B1); PG8_BAR; PG8_SCHED;
            } else {
            PG8_LDB(B0, 0, 0); PG8_SCHED; PG8_LDA(At, 0, 0); PG8_STAGE(PG8_SA(1, 1), a1 + hstep, voffA);
            PG8_WAIT_L(8); PG8_BAR; PG8_WAIT_L(0); PG8_MMA(0, 0, At, B0); PG8_BAR; PG8_SCHED;
            PG8_LDB(B1, 0, 1); PG8_STAGE(PG8_SB(0, 0), b2, voffB);
            PG8_BAR; PG8_WAIT_L(0); PG8_MMA(0, 1, At, B1); PG8_BAR;
            PG8_LDA(At, 0, 1); PG8_STAGE(PG8_SA(0, 0), a2, voffA);
            PG8_BAR; PG8_WAIT_L(0); PG8_MMA(1, 0, At, B0); PG8_BAR; PG8_SCHED;
            PG8_STAGE(PG8_SB(0, 1), b2 + hstep, voffB);
            PG8_WAIT_V(6); PG8_BAR; PG8_MMA(1, 1, At, B1); PG8_BAR;
            PG8_LDB(B0, 1, 0); PG8_SCHED; PG8_LDA(At, 1, 0); PG8_STAGE(PG8_SA(0, 1), a2 + hstep, voffA);
            PG8_WAIT_L(8); PG8_BAR; PG8_WAIT_L(0); PG8_MMA(0, 0, At, B0); PG8_BAR; PG8_SCHED;
            PG8_LDB(B1, 1, 1); PG8_STAGE(PG8_SB(1, 0), b3, voffB);
            PG8_BAR; PG8_WAIT_L(0); PG8_MMA(0, 1, At, B1); PG8_BAR;
            PG8_LDA(At, 1, 1); PG8_STAGE(PG8_SA(1, 0), a3, voffA);
            PG8_BAR; PG8_WAIT_L(0); PG8_MMA(1, 0, At, B0); PG8_BAR; PG8_SCHED;
            PG8_STAGE(PG8_SB(1, 1), b3 + hstep, voffB);
            PG8_WAIT_V(6); PG8_BAR; PG8_MMA(1, 1, At, B1); PG8_BAR;
            }
        }
        if constexpr (ALIGN_EPI) { if (wr == 0) PG8_BAR; }
        if constexpr (Epi::RESCALE) E.rescale(acc, 3, wr, fr, lds);
        E(acc, cur, wr, wc, fr, fq);
        if (!has_next) break;
#pragma unroll
        for (int a = 0; a < 2; ++a)
#pragma unroll
            for (int b = 0; b < 2; ++b)
#pragma unroll
                for (int m = 0; m < 4; ++m)
#pragma unroll
                    for (int n = 0; n < 2; ++n) acc[a][b][m][n] = (f32x4){0.f, 0.f, 0.f, 0.f};
        cur = nxt; cA = nA; cB = nB; ++ui;
        if constexpr (ALIGN_EPI) { if (wr == 1) PG8_BAR; }
    }
    PG8_WAIT_V(0);
    if constexpr (!ALIGN_EPI) { if (wr == 0) PG8_BAR; }
    PG8_BAR;
#undef PG8_SA
#undef PG8_SB
#undef PG8_STAGE
#undef PG8_LDA
#undef PG8_LDB
#undef PG8_MMA
#undef PG8_WAIT_V
#undef PG8_WAIT_L
#undef PG8_BAR
#undef PG8_SCHED
}
}
using pg8::Unit;
typedef f32x4 AccT[2][2][4][2];

struct EpiF32Bias {
    static constexpr bool PERM = false, RESCALE = false;
    float* C; int ldc; const float* bias;
    __device__ __forceinline__ void operator()(const AccT& acc, const Unit& u, int wr, int wc, int fr, int fq) const {
        const int row0 = u.pm * 256 + wr * 64 + fr, col0 = u.pn * 256 + wc * 32 + 4 * fq;
        f32x4 bv[2][2];
#pragma unroll
        for (int bj = 0; bj < 2; ++bj)
#pragma unroll
            for (int n = 0; n < 2; ++n) bv[bj][n] = *(const f32x4*)(bias + col0 + bj * 128 + n * 16);
#pragma unroll
        for (int ai = 0; ai < 2; ++ai)
#pragma unroll
            for (int m = 0; m < 4; ++m) { float* rowp = C + (size_t)(row0 + ai * 128 + m * 16) * ldc + col0;
#pragma unroll
                for (int bj = 0; bj < 2; ++bj)
#pragma unroll
                    for (int n = 0; n < 2; ++n) *(f32x4*)(rowp + bj * 128 + n * 16) = acc[ai][bj][m][n] + bv[bj][n]; }
    }
};
__device__ __forceinline__ u32x4 pack8(f32x4 v0, f32x4 v1) { u32x4 w; w.x = cvt_pk_bf16(v0[0], v0[1]); w.y = cvt_pk_bf16(v0[2], v0[3]); w.z = cvt_pk_bf16(v1[0], v1[1]); w.w = cvt_pk_bf16(v1[2], v1[3]); return w; }
struct EpiIn {
    static constexpr bool PERM = true, RESCALE = false;
    bf16_t *BG, *CI, *Z, *XBC, *GA, *GB; float* DT;
    __device__ __forceinline__ void operator()(const AccT& acc, const Unit& u, int wr, int wc, int fr, int fq) const {
        const int pn = u.pn, row0 = u.pm * 256 + wr * 64 + fr, cin = wc * 32 + 8 * fq;
        if (pn >= 4 && pn < 12) {
            const int col = (pn - 4) * 128 + cin;
#pragma unroll
            for (int ai = 0; ai < 2; ++ai)
#pragma unroll
                for (int m = 0; m < 4; ++m) { const size_t row = row0 + ai * 128 + m * 16;
                    *(u32x4*)(CI + row * 1024 + col) = pack8(acc[ai][0][m][0] * acc[ai][1][m][0], acc[ai][0][m][1] * acc[ai][1][m][1]); }
        } else if (pn == 40) {
            if (wc == 0) {
#pragma unroll
                for (int ai = 0; ai < 2; ++ai)
#pragma unroll
                    for (int m = 0; m < 4; ++m) { const size_t row = row0 + ai * 128 + m * 16;
                        *(f32x4*)(DT + row * 32 + 8 * fq) = acc[ai][0][m][0]; *(f32x4*)(DT + row * 32 + 8 * fq + 4) = acc[ai][0][m][1]; }
            }
        } else {
            bf16_t* O; int ldc, colt;
            if (pn < 4) { O = BG; ldc = 1024; colt = pn * 256; }
            else if (pn < 20) { O = Z; ldc = 2048; colt = (pn - 12) * 256; }
            else if (pn < 32) { O = XBC; ldc = 3072; colt = (pn - 20) * 256; }
            else if (pn < 36) { O = GA; ldc = 1024; colt = (pn - 32) * 256; }
            else { O = GB; ldc = 1024; colt = (pn - 36) * 256; }
#pragma unroll
            for (int ai = 0; ai < 2; ++ai)
#pragma unroll
                for (int m = 0; m < 4; ++m) { bf16_t* rowp = O + (size_t)(row0 + ai * 128 + m * 16) * ldc + colt + cin;
#pragma unroll
                    for (int bj = 0; bj < 2; ++bj) { f32x4 v0 = acc[ai][bj][m][0], v1 = acc[ai][bj][m][1];
                        if (O == Z) {
#pragma unroll
                            for (int j = 0; j < 4; ++j) { v0[j] = siluf_(v0[j]); v1[j] = siluf_(v1[j]); } }
                        *(u32x4*)(rowp + bj * 128) = pack8(v0, v1); } }
        }
    }
};
template <int MODE> struct EpiGate {
    static constexpr bool PERM = true, RESCALE = (MODE == 1);
    bf16_t* O; const bf16_t* G; const bf16_t* Y; int ldc;
    __device__ __forceinline__ void rescale(AccT& acc, int b, int wr, int fr, PG8_LAS unsigned char* lds) const {
        int frl = fr; asm volatile("" : "+v"(frl));
        const PG8_LAS float* rt = (const PG8_LAS float*)(lds + L_RT) + (64 * wr + frl) * 4 + b;
#pragma unroll
        for (int ai = 0; ai < 2; ++ai)
#pragma unroll
            for (int m = 0; m < 4; ++m) { const float f = rt[(128 * ai + 16 * m) * 4];
#pragma unroll
                for (int bj = 0; bj < 2; ++bj)
#pragma unroll
                    for (int n = 0; n < 2; ++n) acc[ai][bj][m][n] = acc[ai][bj][m][n] * f; }
    }
    __device__ __forceinline__ void operator()(const AccT& acc, const Unit& u, int wr, int wc, int fr, int fq) const {
        asm volatile("" : "+v"(fr), "+v"(fq));
        const int row0 = u.pm * 256 + wr * 64 + fr, col0 = u.pn * 256 + wc * 32 + 8 * fq;
#pragma unroll
        for (int ai = 0; ai < 2; ++ai)
#pragma unroll
        for (int mh = 0; mh < 2; ++mh) {
            u32x4 gv[2][2], yv[2][2];
            if (MODE != 2) {
#pragma unroll
                for (int mm = 0; mm < 2; ++mm)
#pragma unroll
                    for (int bj = 0; bj < 2; ++bj) { const size_t off = (size_t)(row0 + ai * 128 + (2 * mh + mm) * 16) * ldc + col0 + bj * 128;
                        gv[mm][bj] = *(const u32x4*)(G + off); if (MODE == 1) yv[mm][bj] = *(const u32x4*)(Y + off); }
            }
#pragma unroll
            for (int mm = 0; mm < 2; ++mm)
#pragma unroll
                for (int bj = 0; bj < 2; ++bj) { const int m = 2 * mh + mm; const size_t off = (size_t)(row0 + ai * 128 + m * 16) * ldc + col0 + bj * 128;
                    f32x4 v0 = acc[ai][bj][m][0], v1 = acc[ai][bj][m][1];
                    if (MODE == 2) {
#pragma unroll
                        for (int j = 0; j < 4; ++j) { float a = fmaxf(v0[j], 0.f), b = fmaxf(v1[j], 0.f); v0[j] = a * a; v1[j] = b * b; }
                    } else {
                        const u32x4 g = gv[mm][bj];
                        v0[0] *= sigmoidf_(bflo(g.x)); v0[1] *= sigmoidf_(bfhi(g.x)); v0[2] *= sigmoidf_(bflo(g.y)); v0[3] *= sigmoidf_(bfhi(g.y));
                        v1[0] *= sigmoidf_(bflo(g.z)); v1[1] *= sigmoidf_(bfhi(g.z)); v1[2] *= sigmoidf_(bflo(g.w)); v1[3] *= sigmoidf_(bfhi(g.w));
                        if (MODE == 1) { const u32x4 y = yv[mm][bj];
                            v0[0] += bflo(y.x); v0[1] += bfhi(y.x); v0[2] += bflo(y.y); v0[3] += bfhi(y.y);
                            v1[0] += bflo(y.z); v1[1] += bfhi(y.z); v1[2] += bflo(y.w); v1[3] += bfhi(y.w); }
                    }
                    *(u32x4*)(O + off) = pack8(v0, v1); }
        }
    }
};
struct EpiRes {
    static constexpr bool PERM = true, RESCALE = false;
    bf16_t* X1; const float* xp; const float* gate;
    __device__ __forceinline__ void operator()(const AccT& acc, const Unit& u, int wr, int wc, int fr, int fq) const {
        const int row0 = u.pm * 256 + wr * 64 + fr, col0 = u.pn * 256 + wc * 32 + 8 * fq;
        const float* gr = gate + (size_t)(u.pm >> 3) * 6144 + col0;
        f32x4 gv[2][2];
#pragma unroll
        for (int bj = 0; bj < 2; ++bj)
#pragma unroll
            for (int n = 0; n < 2; ++n) gv[bj][n] = *(const f32x4*)(gr + bj * 128 + n * 4);
#pragma unroll
        for (int ai = 0; ai < 2; ++ai) {
            if (xp) {
                f32x4 xv[4][2][2];
#pragma unroll
                for (int m = 0; m < 4; ++m)
#pragma unroll
                    for (int bj = 0; bj < 2; ++bj)
#pragma unroll
                        for (int n = 0; n < 2; ++n) xv[m][bj][n] = *(const f32x4*)(xp + (size_t)(row0 + ai * 128 + m * 16) * D + col0 + bj * 128 + n * 4);
#pragma unroll
                for (int m = 0; m < 4; ++m)
#pragma unroll
                    for (int bj = 0; bj < 2; ++bj)
                        *(u32x4*)(X1 + (size_t)(row0 + ai * 128 + m * 16) * D + col0 + bj * 128) = pack8(xv[m][bj][0] + gv[bj][0] * acc[ai][bj][m][0], xv[m][bj][1] + gv[bj][1] * acc[ai][bj][m][1]);
            } else {
                u32x4 xv[4][2];
#pragma unroll
                for (int m = 0; m < 4; ++m)
#pragma unroll
                    for (int bj = 0; bj < 2; ++bj) xv[m][bj] = *(const u32x4*)(X1 + (size_t)(row0 + ai * 128 + m * 16) * D + col0 + bj * 128);
#pragma unroll
                for (int m = 0; m < 4; ++m)
#pragma unroll
                    for (int bj = 0; bj < 2; ++bj) { const F8 x8 = cv8(xv[m][bj]);
                        *(u32x4*)(X1 + (size_t)(row0 + ai * 128 + m * 16) * D + col0 + bj * 128) = pack8(x8.a + gv[bj][0] * acc[ai][bj][m][0], x8.b + gv[bj][1] * acc[ai][bj][m][1]); }
            }
        }
    }
};

template <int KS, class Epi>
__device__ __forceinline__ void skinny_gemm(LAS unsigned char* lds, const bf16_t* A, const bf16_t* Bt, int N, int K, const Epi& E, const int w) {
    constexpr int RT = 8 / KS;
    const int tid = tid_of(w), lane = tid & 63, fr = lane & 15, fq = lane >> 4;
    const int nitems = (N / 16) * KS, klen = K / KS;
    LAS f32x4* red = (LAS f32x4*)lds;
    for (int it = blockIdx.x; it < nitems; it += gridDim.x) {
        const int ct = it / KS, rg = it % KS, rt = rg * RT + (w % RT), kq = w / RT;
        const bf16_t* ap = A + (size_t)(16 * rt + fr) * K + kq * klen + fq * 8;
        const bf16_t* bp = Bt + (size_t)(16 * ct + fr) * K + kq * klen + fq * 8;
        f32x4 acc0 = (f32x4){0.f, 0.f, 0.f, 0.f}, acc1 = acc0;
        for (int k = 0; k < klen; k += 256) {
            bf16x8 a[8], b[8];
#pragma unroll
            for (int j = 0; j < 8; ++j) { a[j] = *(const bf16x8*)(ap + k + 32 * j); b[j] = *(const bf16x8*)(bp + k + 32 * j); }
#pragma unroll
            for (int j = 0; j < 8; j += 2) { acc0 = __builtin_amdgcn_mfma_f32_16x16x32_bf16(b[j], a[j], acc0, 0, 0, 0); acc1 = __builtin_amdgcn_mfma_f32_16x16x32_bf16(b[j + 1], a[j + 1], acc1, 0, 0, 0); }
        }
        f32x4 acc = (acc0 + acc1) * E.kscale(16 * rt + fr, kq);
        if (KS > 1) {
            if (kq > 0) red[w * 64 + lane] = acc;
            __syncthreads();
            if (kq == 0) {
#pragma unroll
                for (int q = 1; q < KS; ++q) acc = acc + red[(w + q * RT) * 64 + lane];
                E(16 * rt + fr, 16 * ct + 4 * fq, acc);
            }
            __syncthreads();
        } else E(16 * rt + fr, 16 * ct + 4 * fq, acc);
    }
}
__device__ __forceinline__ u32x2 pack4(const f32x4 v) { u32x2 o; o.x = cvt_pk_bf16(v[0], v[1]); o.y = cvt_pk_bf16(v[2], v[3]); return o; }
template <int MODE> struct SkGate {
    bf16_t* O; const bf16_t* G; const bf16_t* Y; int ldc;
    const float* SSQ;
    __device__ __forceinline__ float kscale(int r, int kq) const {
        if (MODE != 1) return 1.f;
        const f32x4 s0 = *(const f32x4*)(SSQ + (size_t)(MP + r) * 32 + 8 * kq), s1 = *(const f32x4*)(SSQ + (size_t)(MP + r) * 32 + 8 * kq + 4);
        return rsqrtf(((s0[0] + s0[1]) + (s0[2] + s0[3]) + (s1[0] + s1[1]) + (s1[2] + s1[3])) * (1.f / 512.f) + EPS);
    }
    __device__ __forceinline__ void operator()(int r, int c, f32x4 v) const {
        const size_t off = (size_t)(MP + r) * ldc + c;
        if (MODE == 2) {
#pragma unroll
            for (int j = 0; j < 4; ++j) { const float a = fmaxf(v[j], 0.f); v[j] = a * a; }
        } else {
            const f32x4 g = cv4(*(const u32x2*)(G + off));
#pragma unroll
            for (int j = 0; j < 4; ++j) v[j] *= sigmoidf_(g[j]);
            if (MODE == 1) v = v + cv4(*(const u32x2*)(Y + off));
        }
        *(u32x2*)(O + off) = pack4(v);
    }
};
struct SkRes {
    bf16_t* X1; const float* xs; const float* gate;
    __device__ __forceinline__ float kscale(int, int) const { return 1.f; }
    __device__ __forceinline__ void operator()(int r, int c, f32x4 v) const {
        bf16_t* o = X1 + (size_t)(MP + r) * D + c;
        const f32x4 src = xs ? *(const f32x4*)(xs + (size_t)r * D + c) : cv4(*(const u32x2*)o);
        *(u32x2*)o = pack4(src + *(const f32x4*)(gate + (size_t)(NBP + r) * 6144 + c) * v);
    }
};

__device__ __forceinline__ int win_dest(int n) {
    if (n < 1024) return n;
    if (n < 2048) { const int j = n - 1024; return 1024 + (j >> 7) * 256 + (j & 127); }
    if (n < 3072) { const int j = n - 2048; return 1024 + (j >> 7) * 256 + 128 + (j & 127); }
    if (n < 8192) return n;
    if (n < 8224) return 10240 + (n - 8192);
    return n - 32;
}
__device__ __forceinline__ void transpose_item(const float* W, int K, int N, bf16_t* WT, int item, bool remap, const float* kscale, LAS float* scr, int lane) {
    const int nblk = N / 32, kb = item / nblk, nb = item % nblk, k0 = 64 * kb, n0 = 32 * nb;
#pragma unroll 16
    for (int i = 0; i < 32; ++i) { const int kk = 2 * i + (lane >> 5); float v = W[(size_t)(k0 + kk) * N + n0 + (lane & 31)]; if (kscale) v *= kscale[k0 + kk]; scr[kk * 33 + (lane & 31)] = v; }
    const int c = lane & 7;
#pragma unroll
    for (int j = 0; j < 4; ++j) { const int n = (lane >> 3) + 8 * j; const LAS float* sp = scr + (8 * c) * 33 + n;
        u32x4 o; o.x = cvt_pk_bf16(sp[0 * 33], sp[1 * 33]); o.y = cvt_pk_bf16(sp[2 * 33], sp[3 * 33]); o.z = cvt_pk_bf16(sp[4 * 33], sp[5 * 33]); o.w = cvt_pk_bf16(sp[6 * 33], sp[7 * 33]);
        const int ns = n0 + n, dr = remap ? win_dest(ns) : ns;
        *(u32x4*)(WT + (size_t)dr * K + k0 + 8 * c) = o; }
    asm volatile("s_waitcnt lgkmcnt(0)" ::: "memory");
}
__device__ __forceinline__ void phase0(const Params& p, LAS unsigned char* lds, int part, const int wid) {
    unsigned char* ws = p.ws;
    const int tid = tid_of(wid), lane = tid & 63;
    LAS float* scr = (LAS float*)lds + wid * (64 * 33);
    constexpr int I_ADA = 16 * 192, I_IN = 16 * 321, I_AO = 16 * 32, I_BO = 32 * 32, I_O = 16 * 32, I_1 = 16 * 128, I_2 = 64 * 32;
    constexpr int NMOD = 24;
    if (part == 0) {
        for (int it = blockIdx.x * 8 + wid; it < I_ADA; it += gridDim.x * 8) transpose_item(p.in[I_WADA], 1024, 6144, (bf16_t*)(ws + OFF_WADA), it, false, nullptr, scr, lane);
        bf16_t* cA = (bf16_t*)(ws + OFF_CA);
        for (int i = blockIdx.x * 512 + tid; i < (NBP + NBS) * D; i += gridDim.x * 512) {
            const int row = i >> 10, k = i & 1023;
            const float v = row < NBP ? p.in[I_CP][row * D + k] : p.in[I_CS][(row - NBP) * D + k];
            cA[i] = f2bf(siluf_(v));
        }
        return;
    }
    if (part == 1) {
        for (int it = ((int)blockIdx.x - NMOD) * 8 + wid; it < I_IN; it += ((int)gridDim.x - NMOD) * 8) transpose_item(p.in[I_WIN], 1024, DIN, (bf16_t*)(ws + OFF_WIN), it, true, nullptr, scr, lane);
        return;
    }
    constexpr int FIRST2 = (65 * 41) % 256;
    const int nw2 = (int)gridDim.x > FIRST2 ? (int)gridDim.x - FIRST2 : (int)gridDim.x, w2 = (int)gridDim.x > FIRST2 ? (int)blockIdx.x - FIRST2 : (int)blockIdx.x;
    if (w2 < 0) return;
    for (int it = w2 * 8 + wid; it < I_AO + I_BO + I_O + I_1 + I_2; it += nw2 * 8) {
        int r = it;
        if (r < I_AO) { transpose_item(p.in[I_WAOUT], 1024, 1024, (bf16_t*)(ws + OFF_WAOUT), r, false, nullptr, scr, lane); continue; } r -= I_AO;
        if (r < I_BO) { transpose_item(p.in[I_WBOUT], 2048, 1024, (bf16_t*)(ws + OFF_WBOUT), r, false, p.in[I_SNG], scr, lane); continue; } r -= I_BO;
        if (r < I_O) { transpose_item(p.in[I_WO], 1024, 1024, (bf16_t*)(ws + OFF_WO), r, false, nullptr, scr, lane); continue; } r -= I_O;
        if (r < I_1) { transpose_item(p.in[I_W1], 1024, 4096, (bf16_t*)(ws + OFF_W1), r, false, nullptr, scr, lane); continue; } r -= I_1;
        transpose_item(p.in[I_W2], 4096, 1024, (bf16_t*)(ws + OFF_W2), r, false, nullptr, scr, lane);
    }
}

template <bool BF> __device__ __forceinline__ void load_row(const void* xrow, int lane, f32x4 (&v)[4]) {
#pragma unroll
    for (int j = 0; j < 4; ++j) v[j] = BF ? cv4(((const u32x2*)xrow)[lane + 64 * j]) : __builtin_nontemporal_load(((const f32x4*)xrow) + lane + 64 * j);
}
template <bool BF> __device__ __forceinline__ void rownorm_mod(const void* xrow, const float* g, const float* sc, const float* sh, bf16_t* orow, int lane) {
    f32x4 v[4]; float s = 0.f;
    load_row<BF>(xrow, lane, v);
#pragma unroll
    for (int j = 0; j < 4; ++j) s += (v[j][0] * v[j][0] + v[j][1] * v[j][1]) + (v[j][2] * v[j][2] + v[j][3] * v[j][3]);
    const float rstd = rsqrtf(wave_sum(s) * (1.f / D) + EPS);
#pragma unroll
    for (int j = 0; j < 4; ++j) { const int i4 = lane + 64 * j;
        const f32x4 gg = ((const f32x4*)g)[i4], scv = ((const f32x4*)sc)[i4], shv = ((const f32x4*)sh)[i4];
        const f32x4 o = v[j] * rstd * gg * (scv + 1.f) + shv;
        u32x2 w; w.x = cvt_pk_bf16(o[0], o[1]); w.y = cvt_pk_bf16(o[2], o[3]);
        ((u32x2*)orow)[i4] = w; }
}
__device__ __forceinline__ float row_ss(const f32x4 (&v)[4]) { float s = 0.f;
#pragma unroll
    for (int j = 0; j < 4; ++j) s += (v[j][0] * v[j][0] + v[j][1] * v[j][1]) + (v[j][2] * v[j][2] + v[j][3] * v[j][3]);
    return s; }
template <bool BF> __device__ __forceinline__ void phase_rownorm(const Params& p, const float* gvec, int sc_off, int sh_off, bf16_t* U, const int wid) {
    const int tid_ = tid_of(wid), lane = tid_ & 63, gw = blockIdx.x * 8 + (tid_ >> 6), NW = gridDim.x * 8;
    const float* mod = (const float*)(p.ws + OFF_MOD);
    for (int blk = gw; blk < MP / 8; blk += NW) {
        const int row0 = blk * 8, seq = row0 >> 11;
        f32x4 gm[4], shv[4];
#pragma unroll
        for (int j = 0; j < 4; ++j) { const int i4 = lane + 64 * j;
            gm[j] = ((const f32x4*)gvec)[i4] * (((const f32x4*)(mod + (size_t)seq * 6144 + sc_off))[i4] + 1.f); shv[j] = ((const f32x4*)(mod + (size_t)seq * 6144 + sh_off))[i4]; }
#pragma unroll
        for (int i = 0; i < 8; i += 2) {
            f32x4 va[4], vb[4];
            const void* ra = BF ? (const void*)((const bf16_t*)(p.ws + OFF_X1) + (size_t)(row0 + i) * D) : (const void*)(p.in[I_XP] + (size_t)(row0 + i) * D);
            const void* rb = BF ? (const void*)((const bf16_t*)(p.ws + OFF_X1) + (size_t)(row0 + i + 1) * D) : (const void*)(p.in[I_XP] + (size_t)(row0 + i + 1) * D);
            load_row<BF>(ra, lane, va); load_row<BF>(rb, lane, vb);
            const float rsa = rsqrtf(wave_sum(row_ss(va)) * (1.f / D) + EPS), rsb = rsqrtf(wave_sum(row_ss(vb)) * (1.f / D) + EPS);
#pragma unroll
            for (int j = 0; j < 4; ++j) { const int i4 = lane + 64 * j;
                const f32x4 oa = va[j] * rsa * gm[j] + shv[j], ob = vb[j] * rsb * gm[j] + shv[j];
                u32x2 w; w.x = cvt_pk_bf16(oa[0], oa[1]); w.y = cvt_pk_bf16(oa[2], oa[3]); ((u32x2*)(U + (size_t)(row0 + i) * D))[i4] = w;
                w.x = cvt_pk_bf16(ob[0], ob[1]); w.y = cvt_pk_bf16(ob[2], ob[3]); ((u32x2*)(U + (size_t)(row0 + i + 1) * D))[i4] = w; }
        }
    }
    for (int r = gw; r < NBS; r += NW) {
        const int row = MP + r, seq = NBP + r;
        const void* xrow = BF ? (const void*)((const bf16_t*)(p.ws + OFF_X1) + (size_t)row * D) : (const void*)(p.in[I_XS] + (size_t)r * D);
        rownorm_mod<BF>(xrow, gvec, mod + (size_t)seq * 6144 + sc_off, mod + (size_t)seq * 6144 + sh_off, U + (size_t)row * D, lane);
    }
}
__device__ __forceinline__ void phase_final(const Params& p, const int wid) {
    const int tid_ = tid_of(wid), lane = tid_ & 63, gw = blockIdx.x * 8 + (tid_ >> 6), NW = gridDim.x * 8;
    const bf16_t* X = (const bf16_t*)(p.ws + OFF_X1);
    f32x4 g[4];
#pragma unroll
    for (int j = 0; j < 4; ++j) g[j] = ((const f32x4*)p.in[I_NFG])[lane + 64 * j];
    for (int pr = gw; pr < MTOT / 2; pr += NW) {
        const int ra = 2 * pr, rb = 2 * pr + 1;
        float* oa = ra < MP ? p.out + O_YP + (size_t)ra * D : p.out + O_YS + (size_t)(ra - MP) * D;
        float* ob = rb < MP ? p.out + O_YP + (size_t)rb * D : p.out + O_YS + (size_t)(rb - MP) * D;
        f32x4 va[4], vb[4];
        load_row<true>(X + (size_t)ra * D, lane, va); load_row<true>(X + (size_t)rb * D, lane, vb);
        const float rsa = rsqrtf(wave_sum(row_ss(va)) * (1.f / D) + EPS), rsb = rsqrtf(wave_sum(row_ss(vb)) * (1.f / D) + EPS);
#pragma unroll
        for (int j = 0; j < 4; ++j) { ((f32x4*)oa)[lane + 64 * j] = va[j] * rsa * g[j]; ((f32x4*)ob)[lane + 64 * j] = vb[j] * rsb * g[j]; }
    }
}

__device__ __forceinline__ F8 ld8bf(const bf16_t* p) { const u32x4 u = *(const u32x4*)p; F8 r; r.a = (f32x4){bflo(u.x), bfhi(u.x), bflo(u.y), bfhi(u.y)}; r.b = (f32x4){bflo(u.z), bfhi(u.z), bflo(u.w), bfhi(u.w)}; return r; }
__device__ __forceinline__ F8 ld8f(const float* p) { F8 r; r.a = *(const f32x4*)p; r.b = *(const f32x4*)(p + 4); return r; }
__device__ __forceinline__ void st8f(float* p, const F8& v) { *(f32x4*)p = v.a; *(f32x4*)(p + 4) = v.b; }
__device__ __forceinline__ F8 zero8() { F8 r; r.a = (f32x4){0.f, 0.f, 0.f, 0.f}; r.b = r.a; return r; }
__device__ __forceinline__ void phase_conv(const Params& p, LAS unsigned char* lds, const int wid) {
    unsigned char* ws = p.ws;
    const bf16_t* BG = (const bf16_t*)(ws + OFF_BG); const bf16_t* CI = (const bf16_t*)(ws + OFF_CI); const bf16_t* XBC = (const bf16_t*)(ws + OFF_XBC);
    bf16_t* VA = (bf16_t*)(ws + OFF_VA); bf16_t* XC = (bf16_t*)(ws + OFF_XBCC);
    const int tid = threadIdx.x;
    for (int kstep = 0; kstep < 9; ++kstep) {
        int it;
        if (kstep < 8) it = (int)blockIdx.x * 8 + kstep; else { if ((int)blockIdx.x >= NBS) break; it = MP / 8 + (int)blockIdx.x; }
        if (it < MP / 8) {
            const int r0 = it * 8, tpos0 = r0 & (SEQ - 1), b = r0 >> 11;
            if (tid < 128) {
                const int ch = tid * 8;
                u32x4 raw[10], bgr[8];
#pragma unroll
                for (int i = 0; i < 10; ++i) raw[i] = (tpos0 - 2 + i >= 0) ? *(const u32x4*)(CI + (size_t)(r0 - 2 + i) * 1024 + ch) : (u32x4){0u, 0u, 0u, 0u};
#pragma unroll
                for (int i = 0; i < 8; ++i) bgr[i] = *(const u32x4*)(BG + (size_t)(r0 + i) * 1024 + ch);
                const F8 w0 = ld8f(p.in[I_CAW] + ch), w1 = ld8f(p.in[I_CAW] + 1024 + ch), w2 = ld8f(p.in[I_CAW] + 2048 + ch);
#pragma unroll
                for (int i = 0; i < 8; ++i) { const F8 p2 = cv8(raw[i]), p1 = cv8(raw[i + 1]), c0 = cv8(raw[i + 2]), bg = cv8(bgr[i]);
                    const f32x4 va = bg.a * (w0.a * p2.a + w1.a * p1.a + w2.a * c0.a), vb = bg.b * (w0.b * p2.b + w1.b * p1.b + w2.b * c0.b);
                    *(u32x4*)(VA + (size_t)(r0 + i) * 1024 + ch) = pack8(va, vb);
                    if (tpos0 + i >= SEQ - 2) st8f(p.out + O_SCP + ((size_t)b * 2 + (tpos0 + i - (SEQ - 2))) * 1024 + ch, c0); }
            } else {
                const int ch = (tid - 128) * 8;
                u32x4 raw[11];
#pragma unroll
                for (int i = 0; i < 11; ++i) raw[i] = (tpos0 - 3 + i >= 0) ? *(const u32x4*)(XBC + (size_t)(r0 - 3 + i) * 3072 + ch) : (u32x4){0u, 0u, 0u, 0u};
                const F8 w0 = ld8f(p.in[I_CBW] + ch), w1 = ld8f(p.in[I_CBW] + 3072 + ch), w2 = ld8f(p.in[I_CBW] + 6144 + ch), w3 = ld8f(p.in[I_CBW] + 9216 + ch), bb = ld8f(p.in[I_CBB] + ch);
#pragma unroll
                for (int i = 0; i < 8; ++i) { const F8 p3 = cv8(raw[i]), p2 = cv8(raw[i + 1]), p1 = cv8(raw[i + 2]), c0 = cv8(raw[i + 3]);
                    f32x4 va = w0.a * p3.a + w1.a * p2.a + w2.a * p1.a + w3.a * c0.a + bb.a, vb = w0.b * p3.b + w1.b * p2.b + w2.b * p1.b + w3.b * c0.b + bb.b;
#pragma unroll
                    for (int j = 0; j < 4; ++j) { va[j] = siluf_(va[j]); vb[j] = siluf_(vb[j]); }
                    *(u32x4*)(XC + (size_t)(r0 + i) * 3072 + ch) = pack8(va, vb);
                    if (tpos0 + i >= SEQ - 3) st8f(p.out + O_SBP + ((size_t)b * 3 + (tpos0 + i - (SEQ - 3))) * 3072 + ch, c0); }
            }
        } else {
            const int b = it - MP / 8, row = MP + b;
            if (tid < 128) {
                const int ch = tid * 8;
                const F8 c0 = ld8bf(CI + (size_t)row * 1024 + ch);
                const F8 p2 = ld8f(p.in[I_STA] + ((size_t)b * 2 + 0) * 1024 + ch), p1 = ld8f(p.in[I_STA] + ((size_t)b * 2 + 1) * 1024 + ch);
                const F8 w0 = ld8f(p.in[I_CAW] + ch), w1 = ld8f(p.in[I_CAW] + 1024 + ch), w2 = ld8f(p.in[I_CAW] + 2048 + ch);
                const F8 bg = ld8bf(BG + (size_t)row * 1024 + ch);
                const f32x4 va = bg.a * (w0.a * p2.a + w1.a * p1.a + w2.a * c0.a), vb = bg.b * (w0.b * p2.b + w1.b * p1.b + w2.b * c0.b);
                *(u32x4*)(VA + (size_t)row * 1024 + ch) = pack8(va, vb);
                st8f(p.out + O_SCS + ((size_t)b * 2 + 0) * 1024 + ch, p1); st8f(p.out + O_SCS + ((size_t)b * 2 + 1) * 1024 + ch, c0);
            } else {
                const int ch = (tid - 128) * 8;
                const F8 c0 = ld8bf(XBC + (size_t)row * 3072 + ch);
                const F8 p3 = ld8f(p.in[I_STB] + ((size_t)b * 3 + 0) * 3072 + ch), p2 = ld8f(p.in[I_STB] + ((size_t)b * 3 + 1) * 3072 + ch), p1 = ld8f(p.in[I_STB] + ((size_t)b * 3 + 2) * 3072 + ch);
                const F8 w0 = ld8f(p.in[I_CBW] + ch), w1 = ld8f(p.in[I_CBW] + 3072 + ch), w2 = ld8f(p.in[I_CBW] + 6144 + ch), w3 = ld8f(p.in[I_CBW] + 9216 + ch), bb = ld8f(p.in[I_CBB] + ch);
                f32x4 va = w0.a * p3.a + w1.a * p2.a + w2.a * p1.a + w3.a * c0.a + bb.a, vb = w0.b * p3.b + w1.b * p2.b + w2.b * p1.b + w3.b * c0.b + bb.b;
#pragma unroll
                for (int j = 0; j < 4; ++j) { va[j] = siluf_(va[j]); vb[j] = siluf_(vb[j]); }
                *(u32x4*)(XC + (size_t)row * 3072 + ch) = pack8(va, vb);
                st8f(p.out + O_SBS + ((size_t)b * 3 + 0) * 3072 + ch, p2); st8f(p.out + O_SBS + ((size_t)b * 3 + 1) * 3072 + ch, p1); st8f(p.out + O_SBS + ((size_t)b * 3 + 2) * 3072 + ch, c0);
            }
        }
    }
    const float* DTR = (const float*)(ws + OFF_DTRAW); float* DTP = (float*)(ws + OFF_DTP); float* ACS = (float*)(ws + OFF_ACS);
    LAS float* t1 = (LAS float*)lds; LAS float* t2 = t1 + 128 * 33;
    for (int it = blockIdx.x; it < 129; it += gridDim.x) {
        const int t0 = it * 128;
#pragma unroll
        for (int i = 0; i < 8; ++i) { const int idx = tid + 512 * i, r = idx >> 5, hh = idx & 31;
            const float raw = DTR[(size_t)(t0 + r) * 32 + hh] + p.in[I_DTB][hh];
            t1[r * 33 + hh] = raw > 20.f ? raw : log1pf(expf(raw)); }
        __syncthreads();
        if (tid < 32) { const float a = -expf(p.in[I_ALOG][tid]); float run = 0.f;
            for (int s = 0; s < 128; ++s) { run += t1[s * 33 + tid] * a; t2[s * 33 + tid] = run; } }
        __syncthreads();
#pragma unroll
        for (int i = 0; i < 8; ++i) { const int idx = tid + 512 * i, r = idx >> 5, hh = idx & 31;
            DTP[(size_t)(t0 + r) * 32 + hh] = t1[r * 33 + hh]; ACS[(size_t)(t0 + r) * 32 + hh] = t2[r * 33 + hh]; }
        __syncthreads();
    }
}

constexpr int RS = 288, RX = 144;
constexpr int L_C = 0, L_B = 36864, L_X = 73728, L_XW = 92160, L_H = 110592, L_ACS = 129024, L_DT = 129536;
__device__ __forceinline__ bf16x8 tr_frag(LAS unsigned char* base, int rstride, int k0, int c0, int lane) {
    const int i = lane & 15, g = lane >> 4, q = i >> 2, pp = i & 3;
    LAS unsigned char* a = base + (k0 + 8 * g + q) * rstride + (c0 + 4 * pp) * 2;
    const bf16x4 lo = __builtin_amdgcn_ds_read_tr16_b64_v4i16((LAS bf16x4*)a);
    const bf16x4 hi = __builtin_amdgcn_ds_read_tr16_b64_v4i16((LAS bf16x4*)(a + 4 * rstride));
    return (bf16x8){lo[0], lo[1], lo[2], lo[3], hi[0], hi[1], hi[2], hi[3]};
}
constexpr int L_RED = 130048, L_CF = L_RT;
__device__ __forceinline__ void ssd_unit(const Params& p, LAS unsigned char* lds, int b, int h, int sbase, const int w) {
    unsigned char* ws = p.ws;
    const bf16_t* XC = (const bf16_t*)(ws + OFF_XBCC); const bf16_t* Z = (const bf16_t*)(ws + OFF_Z);
    const float* DTP = (const float*)(ws + OFF_DTP); const float* ACS = (const float*)(ws + OFF_ACS);
    bf16_t* YG = (bf16_t*)(ws + OFF_YG); float* SSQ = (float*)(ws + OFF_SSQ);
    const int tid = tid_of(w), lane = tid & 63, fr = lane & 15, fq = lane >> 4, g = h >> 3;
    const float Dh = p.in[I_DSKIP][h];
    LAS float* sAcs = (LAS float*)(lds + L_ACS); LAS float* sDt = (LAS float*)(lds + L_DT); LAS float* red = (LAS float*)(lds + L_RED);
    f32x4 hacc[4];
#pragma unroll
    for (int i = 0; i < 4; ++i) hacc[i] = (f32x4){0.f, 0.f, 0.f, 0.f};
    const int hpt = w & 3, hnb = (w >> 2) * 4;
    const int n4 = tid & 31, pr = tid >> 5;
    u32x4 rc[4], rb[4], rx[2]; float wv[2], my_acs = 0.f, my_dt = 0.f, acs_last_n;
#define SSD_PREFETCH(cc) do { const int _t0 = b * SEQ + (cc) * 128; \
        { const int ch = tid & 15, row = tid >> 4; _Pragma("unroll") for (int i = 0; i < 4; ++i) { const bf16_t* src = XC + (size_t)(_t0 + row + 32 * i) * 3072; rb[i] = *(const u32x4*)(src + 2048 + g * 128 + ch * 8); rc[i] = *(const u32x4*)(src + 2560 + g * 128 + ch * 8); } } \
        acs_last_n = ACS[(size_t)(_t0 + 127) * 32 + h]; \
        { const int ch = tid & 7, row = tid >> 3; _Pragma("unroll") for (int i = 0; i < 2; ++i) { const int r = _t0 + row + 64 * i; rx[i] = *(const u32x4*)(XC + (size_t)r * 3072 + h * 64 + ch * 8); \
              wv[i] = __expf(acs_last_n - ACS[(size_t)r * 32 + h]) * DTP[(size_t)r * 32 + h]; } } \
        if (tid < 128) { my_acs = ACS[(size_t)(_t0 + tid) * 32 + h]; my_dt = DTP[(size_t)(_t0 + tid) * 32 + h]; } } while (0)
    SSD_PREFETCH(0);
    int prev_sr = -1, prev_sh = 0;
    for (int c = 0; c < SEQ / 128; ++c) {
        const int t0 = b * SEQ + c * 128;
        __syncthreads();
        if (tid == 0 && prev_sr >= 0) { float v = 0.f;
#pragma unroll
            for (int i = 0; i < 16; ++i) v += red[i];
            SSQ[(size_t)prev_sr * 32 + prev_sh] = v; }
#pragma unroll
        for (int i = 0; i < 4; ++i) { u32x2 o; o.x = cvt_pk_bf16(hacc[i][0], hacc[i][1]); o.y = cvt_pk_bf16(hacc[i][2], hacc[i][3]);
            *(LAS u32x2*)(lds + L_H + (16 * hpt + fr) * RS + (16 * (hnb + i) + 4 * fq) * 2) = o; }
        { const int ch = tid & 15, row = tid >> 4;
#pragma unroll
          for (int i = 0; i < 4; ++i) { *(LAS u32x4*)(lds + L_B + (row + 32 * i) * RS + ch * 16) = rb[i]; *(LAS u32x4*)(lds + L_C + (row + 32 * i) * RS + ch * 16) = rc[i]; } }
        { const int ch = tid & 7, row = tid >> 3;
#pragma unroll
          for (int i = 0; i < 2; ++i) { *(LAS u32x4*)(lds + L_X + (row + 64 * i) * RX + ch * 16) = rx[i];
              const float s = wv[i]; u32x4 o;
              o.x = cvt_pk_bf16(bflo(rx[i].x) * s, bfhi(rx[i].x) * s); o.y = cvt_pk_bf16(bflo(rx[i].y) * s, bfhi(rx[i].y) * s);
              o.z = cvt_pk_bf16(bflo(rx[i].z) * s, bfhi(rx[i].z) * s); o.w = cvt_pk_bf16(bflo(rx[i].w) * s, bfhi(rx[i].w) * s);
              *(LAS u32x4*)(lds + L_XW + (row + 64 * i) * RX + ch * 16) = o; } }
        if (tid < 128) { sAcs[tid] = my_acs; sDt[tid] = my_dt; }
        const float acs_last = acs_last_n;
        __syncthreads();
        const int qt = w < 4 ? w : 11 - w, qrow = 16 * qt + fr;
        const size_t trow = (size_t)(t0 + qrow);
        u32x2 zv[4];
#pragma unroll
        for (int pt = 0; pt < 4; ++pt) zv[pt] = *(const u32x2*)(Z + trow * 2048 + h * 64 + 16 * pt + 4 * fq);
        const int sit = sbase + 256 * c; const bool has_s = sit < NBS * NH;
        const int sb = sit >> 5, sh = sit & 31, sr = MP + sb, sg = sh >> 3;
        f32x4 h0[4]; u32x2 sbu, scu; float sdt = 0.f, sxv[4], szv[4];
        const size_t sbase_off = (((size_t)sb * NH + sh) * HD) * DS;
        if (has_s) {
            const bf16_t* xr = XC + (size_t)sr * 3072;
#pragma unroll
            for (int i = 0; i < 4; ++i) { const int pp = pr + 16 * i; h0[i] = __builtin_nontemporal_load((const f32x4*)(p.in[I_STS] + sbase_off + (size_t)pp * DS + 4 * n4));
                sxv[i] = bf2f(xr[sh * 64 + pp]); szv[i] = bf2f(Z[(size_t)sr * 2048 + sh * 64 + pp]); }
            sbu = *(const u32x2*)(xr + 2048 + sg * 128 + 4 * n4); scu = *(const u32x2*)(xr + 2560 + sg * 128 + 4 * n4);
            sdt = DTP[(size_t)sr * 32 + sh];
        }
        bf16x8 cf[4];
#pragma unroll
        for (int kk = 0; kk < 4; ++kk) cf[kk] = *(const LAS bf16x8*)(lds + L_C + qrow * RS + (kk * 32 + fq * 8) * 2);
        f32x4 yacc[4];
#pragma unroll
        for (int i = 0; i < 4; ++i) yacc[i] = (f32x4){0.f, 0.f, 0.f, 0.f};
        const float acs_q = sAcs[qrow], acs_q0 = sAcs[16 * qt];
        LAS float* cfac = (LAS float*)(lds + L_CF) + w * 128;
#pragma unroll
        for (int i = 0; i < 2; ++i) { const int sidx = lane + 64 * i; if (sidx < 16 * qt) cfac[sidx] = __expf(acs_q0 - sAcs[sidx]) * sDt[sidx]; }
        const float r_q = __expf(acs_q - acs_q0);
        if (c > 0) {
#pragma unroll
            for (int pp = 0; pp < 2; ++pp) {
                bf16x8 hf[2][4];
#pragma unroll
                for (int a = 0; a < 2; ++a)
#pragma unroll
                    for (int kk = 0; kk < 4; ++kk) hf[a][kk] = *(const LAS bf16x8*)(lds + L_H + (16 * (2 * pp + a) + fr) * RS + (kk * 32 + fq * 8) * 2);
#pragma unroll
                for (int kk = 0; kk < 4; ++kk)
#pragma unroll
                    for (int a = 0; a < 2; ++a) yacc[2 * pp + a] = __builtin_amdgcn_mfma_f32_16x16x32_bf16(hf[a][kk], cf[kk], yacc[2 * pp + a], 0, 0, 0);
            }
            const float eq = __expf(acs_q);
#pragma unroll
            for (int pt = 0; pt < 4; ++pt) yacc[pt] = yacc[pt] * eq;
        }
        for (int sp = 0; 2 * sp <= qt; ++sp) {
            const bool two = 2 * sp + 1 <= qt;
            bf16x8 bfr[2][4];
#pragma unroll
            for (int kk = 0; kk < 4; ++kk) bfr[0][kk] = *(const LAS bf16x8*)(lds + L_B + (16 * (2 * sp) + fr) * RS + (kk * 32 + fq * 8) * 2);
            if (two) {
#pragma unroll
                for (int kk = 0; kk < 4; ++kk) bfr[1][kk] = *(const LAS bf16x8*)(lds + L_B + (16 * (2 * sp + 1) + fr) * RS + (kk * 32 + fq * 8) * 2);
            }
            f32x4 sacc[2];
            sacc[0] = (f32x4){0.f, 0.f, 0.f, 0.f}; sacc[1] = sacc[0];
#pragma unroll
            for (int kk = 0; kk < 4; ++kk) sacc[0] = __builtin_amdgcn_mfma_f32_16x16x32_bf16(bfr[0][kk], cf[kk], sacc[0], 0, 0, 0);
            if (two) {
#pragma unroll
                for (int kk = 0; kk < 4; ++kk) sacc[1] = __builtin_amdgcn_mfma_f32_16x16x32_bf16(bfr[1][kk], cf[kk], sacc[1], 0, 0, 0);
            }
#pragma unroll
            for (int a = 0; a < 2; ++a) { const int st = 2 * sp + a, s0 = 16 * st + 4 * fq;
                float pv[4];
                if (st < qt) { const f32x4 cc = *(const LAS f32x4*)(cfac + s0);
#pragma unroll
                    for (int j = 0; j < 4; ++j) pv[j] = sacc[a][j] * r_q * cc[j];
                } else if (st == qt) { const f32x4 as = *(const LAS f32x4*)(sAcs + s0), ds = *(const LAS f32x4*)(sDt + s0);
#pragma unroll
                    for (int j = 0; j < 4; ++j) pv[j] = (s0 + j <= qrow) ? sacc[a][j] * __expf(acs_q - as[j]) * ds[j] : 0.f;
                } else {
#pragma unroll
                    for (int j = 0; j < 4; ++j) pv[j] = 0.f;
                }
                u32x2 o; o.x = cvt_pk_bf16(pv[0], pv[1]); o.y = cvt_pk_bf16(pv[2], pv[3]);
                *(LAS u32x2*)(lds + L_C + qrow * RS + s0 * 2) = o; }
        }
        if (c + 1 < SEQ / 128) SSD_PREFETCH(c + 1);
        for (int kk = 0; kk <= (qt >> 1); ++kk) {
            bf16x8 xf[4];
            const bf16x8 pf = *(const LAS bf16x8*)(lds + L_C + qrow * RS + (kk * 32 + fq * 8) * 2);
#pragma unroll
            for (int pt = 0; pt < 4; ++pt) xf[pt] = tr_frag(lds + L_X, RX, kk * 32, 16 * pt, lane);
#pragma unroll
            for (int pt = 0; pt < 4; ++pt) yacc[pt] = __builtin_amdgcn_mfma_f32_16x16x32_bf16(xf[pt], pf, yacc[pt], 0, 0, 0);
        }
        { float ss = 0.f;
#pragma unroll
          for (int pt = 0; pt < 4; ++pt) { const int pc = 16 * pt + 4 * fq;
              const u32x2 xv = *(const LAS u32x2*)(lds + L_X + qrow * RX + pc * 2);
              const float x0 = bflo(xv.x), x1 = bfhi(xv.x), x2 = bflo(xv.y), x3 = bfhi(xv.y);
              const float g0 = (yacc[pt][0] + Dh * x0) * bflo(zv[pt].x), g1 = (yacc[pt][1] + Dh * x1) * bfhi(zv[pt].x);
              const float g2 = (yacc[pt][2] + Dh * x2) * bflo(zv[pt].y), g3 = (yacc[pt][3] + Dh * x3) * bfhi(zv[pt].y);
              ss += (g0 * g0 + g1 * g1) + (g2 * g2 + g3 * g3);
              u32x2 o; o.x = cvt_pk_bf16(g0, g1); o.y = cvt_pk_bf16(g2, g3);
              *(u32x2*)(YG + trow * 2048 + h * 64 + pc) = o; }
          ss += __shfl_xor(ss, 16); ss += __shfl_xor(ss, 32);
          if (fq == 0) SSQ[trow * 32 + h] = ss; }
        { const float dec = __expf(acs_last);
#pragma unroll
          for (int i = 0; i < 4; ++i) hacc[i] = hacc[i] * dec;
#pragma unroll
          for (int kp = 0; kp < 2; ++kp) {
              bf16x8 xwf[2], bf[2][4];
#pragma unroll
              for (int a = 0; a < 2; ++a) { const int kk = 2 * kp + a;
                  xwf[a] = tr_frag(lds + L_XW, RX, kk * 32, 16 * hpt, lane);
#pragma unroll
                  for (int i = 0; i < 4; ++i) bf[a][i] = tr_frag(lds + L_B, RS, kk * 32, 16 * (hnb + i), lane); }
              __builtin_amdgcn_sched_barrier(0);
#pragma unroll
              for (int a = 0; a < 2; ++a)
#pragma unroll
                  for (int i = 0; i < 4; ++i) hacc[i] = __builtin_amdgcn_mfma_f32_16x16x32_bf16(bf[a][i], xwf[a], hacc[i], 0, 0, 0);
          } }
        prev_sr = -1;
        if (has_s) {
            const float dA = __expf(sdt * -expf(p.in[I_ALOG][sh])), sD = p.in[I_DSKIP][sh];
            const f32x4 Bv = cv4(sbu), Cv = cv4(scu);
            float y[4];
#pragma unroll
            for (int i = 0; i < 4; ++i) { const int pp = pr + 16 * i;
                const f32x4 hn = h0[i] * dA + Bv * (sdt * sxv[i]);
                __builtin_nontemporal_store(hn, (f32x4*)(p.out + O_SSS + sbase_off + (size_t)pp * DS + 4 * n4));
                y[i] = (hn[0] * Cv[0] + hn[1] * Cv[1]) + (hn[2] * Cv[2] + hn[3] * Cv[3]); }
            const bool b4 = (n4 & 16) != 0, b3 = (n4 & 8) != 0;
            const float a0 = (b4 ? y[2] : y[0]) + __shfl_xor(b4 ? y[0] : y[2], 16);
            const float a1 = (b4 ? y[3] : y[1]) + __shfl_xor(b4 ? y[1] : y[3], 16);
            float ys = (b3 ? a1 : a0) + __shfl_xor(b3 ? a0 : a1, 8);
            ys += __shfl_xor(ys, 4); ys += __shfl_xor(ys, 2); ys += __shfl_xor(ys, 1);
            const int gi = n4 >> 3;
            const float xsel = b4 ? (b3 ? sxv[3] : sxv[2]) : (b3 ? sxv[1] : sxv[0]), zsel = b4 ? (b3 ? szv[3] : szv[2]) : (b3 ? szv[1] : szv[0]);
            const float gt = (ys + sD * xsel) * zsel;
            const bool lead = (n4 & 7) == 0;
            if (lead) YG[(size_t)sr * 2048 + sh * 64 + pr + 16 * gi] = f2bf(gt);
            float part = lead ? gt * gt : 0.f;
            part += __shfl_xor(part, 8); part += __shfl_xor(part, 16);
            if (n4 == 0) red[pr] = part;
            prev_sr = sr; prev_sh = sh;
        }
    }
#undef SSD_PREFETCH
    float* so = p.out + O_SSP + (((size_t)b * NH + h) * HD + 16 * hpt + fr) * DS;
#pragma unroll
    for (int i = 0; i < 4; ++i) *(f32x4*)(so + 16 * (hnb + i) + 4 * fq) = hacc[i];
    __syncthreads();
    if (tid == 0 && prev_sr >= 0) { float v = 0.f;
#pragma unroll
        for (int i = 0; i < 16; ++i) v += red[i];
        SSQ[(size_t)prev_sr * 32 + prev_sh] = v; }
    __syncthreads();
}
__device__ __forceinline__ void phase_ssd(const Params& p, LAS unsigned char* lds, const int wid) {
    for (int u = blockIdx.x; u < NBP * NH; u += gridDim.x) {
        const int xcd = u & 7, j = u >> 3, pair = xcd * 4 + (j >> 3), hr = j & 7;
        ssd_unit(p, lds, pair >> 2, (pair & 3) * 8 + hr, u, wid);
    }
}
__device__ __forceinline__ void phase_gnorm(const Params& p) {
    bf16_t* YG = (bf16_t*)(p.ws + OFF_YG); const float* SSQ = (const float*)(p.ws + OFF_SSQ);
    for (int i = blockIdx.x * 512 + (int)threadIdx.x; i < MTOT * 256; i += gridDim.x * 512) {
        const int row = i >> 8, cu = i & 255, g = cu >> 6;
        const f32x4 s0 = *(const f32x4*)(SSQ + (size_t)row * 32 + 8 * g), s1 = *(const f32x4*)(SSQ + (size_t)row * 32 + 8 * g + 4);
        const float rstd = rsqrtf(((s0[0] + s0[1]) + (s0[2] + s0[3]) + (s1[0] + s1[1]) + (s1[2] + s1[3])) * (1.f / 512.f) + EPS);
        bf16_t* q = YG + (size_t)row * 2048 + cu * 8;
        const F8 v = ld8bf(q);
        *(u32x4*)q = pack8(v.a * rstd, v.b * rstd);
    }
}

__global__ void __launch_bounds__(512, 2) fwd_megakernel(Params p) {
    extern __shared__ __attribute__((aligned(16))) unsigned char shm[];
    LAS unsigned char* lds = (LAS unsigned char*)shm;
    cg::grid_group grid = cg::this_grid();
    unsigned char* ws = p.ws;
    const int G = gridDim.x, cid = blockIdx.x;
    float* mod = (float*)(ws + OFF_MOD);
    pg8::StaticOrder S;
    volatile LAS unsigned* xst = (volatile LAS unsigned*)(lds + L_XST);
    const int wid0 = __builtin_amdgcn_readfirstlane((int)threadIdx.x >> 6);
    if (tid_of(wid0) == 0) { xst[0] = 0u; xst[1] = 0u; }
    __syncthreads();
    XcdBarrier xb = xcd_barrier_post((unsigned*)(ws + OFF_BAR), xst, wid0);
    unsigned long long ts0 = 0, ts1 = 0;
#define TSTAMP(k) do { if (PROBE_PHASE >= 0) { if ((k) == PROBE_PHASE) ts0 = __builtin_amdgcn_s_memrealtime(); if ((k) == PROBE_PHASE + 1) ts1 = __builtin_amdgcn_s_memrealtime(); } } while (0)
    TSTAMP(0);

    phase0(p, lds, 0, wid0);
    if (p.ws == nullptr) grid.sync();
    GSYNC(); TSTAMP(1);
    if (cid < 24) {
        pg8::Gemm g{(const bf16_t*)(ws + OFF_CA), (const bf16_t*)(ws + OFF_WADA), 256, 6144, 1024};
        EpiF32Bias E{mod, 6144, p.in[I_BADA]};
        S.init(g.M, g.N, 24, cid); pg8::gemm_phase<EpiF32Bias, pg8::StaticOrder, true, true>(lds, g, S, E, wid0);
    } else phase0(p, lds, 1, wid0);
    GSYNC(); TSTAMP(2);
    phase_rownorm<false>(p, p.in[I_N1G], 1024, 0, (bf16_t*)(ws + OFF_U), wid0);
    if (PROBE_EW) phase_rownorm<false>(p, p.in[I_N1G], 1024, 0, (bf16_t*)(ws + OFF_U), wid0);
    GSYNC(); TSTAMP(3);
    {
        pg8::Gemm g{(const bf16_t*)(ws + OFF_U), (const bf16_t*)(ws + OFF_WIN), MPAD, DINP, 1024};
        EpiIn E{(bf16_t*)(ws + OFF_BG), (bf16_t*)(ws + OFF_CI), (bf16_t*)(ws + OFF_Z), (bf16_t*)(ws + OFF_XBC), (bf16_t*)(ws + OFF_GA), (bf16_t*)(ws + OFF_GB), (float*)(ws + OFF_DTRAW)};
        S.init(g.M, g.N, G, cid); pg8::gemm_phase<EpiIn, pg8::StaticOrder, true, true>(lds, g, S, E, wid0);
        if (PROBE_INPROJ) { __syncthreads(); pg8::gemm_phase<EpiIn, pg8::StaticOrder, true, true>(lds, g, S, E, wid0); }
        __syncthreads();
        phase0(p, lds, 2, wid0);
    }
    GSYNC(); TSTAMP(4);
    phase_conv(p, lds, wid0);
    if (PROBE_CONV) { __syncthreads(); phase_conv(p, lds, wid0); }
    GSYNC(); TSTAMP(5);
    {
        pg8::Gemm ga{(const bf16_t*)(ws + OFF_VA), (const bf16_t*)(ws + OFF_WAOUT), MP, 1024, 1024};
        EpiGate<0> Ea{(bf16_t*)(ws + OFF_YA), (const bf16_t*)(ws + OFF_GA), nullptr, 1024};
        S.init(ga.M, ga.N, G, cid); pg8::gemm_phase<EpiGate<0>, pg8::StaticOrder, true, true>(lds, ga, S, Ea, wid0);
        __syncthreads();
        SkGate<0> Sa{(bf16_t*)(ws + OFF_YA), (const bf16_t*)(ws + OFF_GA), nullptr, 1024, nullptr};
        skinny_gemm<4>(lds, (const bf16_t*)(ws + OFF_VA) + (size_t)MP * 1024, (const bf16_t*)(ws + OFF_WAOUT), 1024, 1024, Sa, wid0);
        __syncthreads();
    }
    phase_ssd(p, lds, wid0);
    if (PROBE_SSD) { __syncthreads(); phase_ssd(p, lds, wid0); }
    GSYNC(); TSTAMP(6);
    {
        S.init(MP, 1024, G, cid);
        {
            Unit u0; S.next(0, u0);
            const int t = tid_of(wid0), rl = t >> 1, g0 = (t & 1) * 2;
            const float* sq = (const float*)(ws + OFF_SSQ) + (size_t)(u0.pm * 256 + rl) * 32;
            float r[4];
#pragma unroll
            for (int g = 0; g < 4; ++g) { const f32x4 s0 = *(const f32x4*)(sq + 8 * g), s1 = *(const f32x4*)(sq + 8 * g + 4);
                r[g] = rsqrtf(((s0[0] + s0[1]) + (s0[2] + s0[3]) + (s1[0] + s1[1]) + (s1[2] + s1[3])) * (1.f / 512.f) + EPS); }
            LAS float* rt = (LAS float*)(lds + L_RT);
            if (g0 == 0) { rt[rl * 4 + 0] = r[0] / r[1]; rt[rl * 4 + 1] = r[1] / r[2]; } else { rt[rl * 4 + 2] = r[2] / r[3]; rt[rl * 4 + 3] = r[3]; }
            __syncthreads();
        }
        pg8::Gemm gb{(const bf16_t*)(ws + OFF_YG), (const bf16_t*)(ws + OFF_WBOUT), MP, 1024, 2048};
        EpiGate<1> Eb{(bf16_t*)(ws + OFF_MERGED), (const bf16_t*)(ws + OFF_GB), (const bf16_t*)(ws + OFF_YA), 1024};
        pg8::gemm_phase<EpiGate<1>, pg8::StaticOrder, true, true>(lds, gb, S, Eb, wid0);
        __syncthreads();
        SkGate<1> Sb{(bf16_t*)(ws + OFF_MERGED), (const bf16_t*)(ws + OFF_GB), (const bf16_t*)(ws + OFF_YA), 1024, (const float*)(ws + OFF_SSQ)};
        skinny_gemm<4>(lds, (const bf16_t*)(ws + OFF_YG) + (size_t)MP * 2048, (const bf16_t*)(ws + OFF_WBOUT), 1024, 2048, Sb, wid0);
    }
    GSYNC(); TSTAMP(7);
    {
        pg8::Gemm g{(const bf16_t*)(ws + OFF_MERGED), (const bf16_t*)(ws + OFF_WO), MP, 1024, 1024};
        EpiRes E{(bf16_t*)(ws + OFF_X1), p.in[I_XP], mod + 2048};
        S.init(g.M, g.N, G, cid); pg8::gemm_phase<EpiRes, pg8::StaticOrder, true, true>(lds, g, S, E, wid0);
        __syncthreads();
        SkRes Sk{(bf16_t*)(ws + OFF_X1), p.in[I_XS], mod + 2048};
        skinny_gemm<4>(lds, (const bf16_t*)(ws + OFF_MERGED) + (size_t)MP * 1024, (const bf16_t*)(ws + OFF_WO), 1024, 1024, Sk, wid0);
    }
    GSYNC(); TSTAMP(8);
    phase_rownorm<true>(p, p.in[I_N2G], 4096, 3072, (bf16_t*)(ws + OFF_U), wid0);
    if (PROBE_EW) phase_rownorm<true>(p, p.in[I_N2G], 4096, 3072, (bf16_t*)(ws + OFF_U), wid0);
    GSYNC(); TSTAMP(9);
    {
        pg8::Gemm g{(const bf16_t*)(ws + OFF_U), (const bf16_t*)(ws + OFF_W1), MP, DFF, 1024};
        EpiGate<2> E{(bf16_t*)(ws + OFF_HMID), nullptr, nullptr, DFF};
        S.init(g.M, g.N, G, cid); pg8::gemm_phase<EpiGate<2>, pg8::StaticOrder, true, true>(lds, g, S, E, wid0);
        if (PROBE_MLP1) { __syncthreads(); pg8::gemm_phase<EpiGate<2>, pg8::StaticOrder, true, true>(lds, g, S, E, wid0); }
        __syncthreads();
        SkGate<2> Sk{(bf16_t*)(ws + OFF_HMID), nullptr, nullptr, DFF, nullptr};
        skinny_gemm<1>(lds, (const bf16_t*)(ws + OFF_U) + (size_t)MP * 1024, (const bf16_t*)(ws + OFF_W1), DFF, 1024, Sk, wid0);
    }
    GSYNC(); TSTAMP(10);
    {
        pg8::Gemm g{(const bf16_t*)(ws + OFF_HMID), (const bf16_t*)(ws + OFF_W2), MP, 1024, DFF};
        EpiRes E{(bf16_t*)(ws + OFF_X1), nullptr, mod + 5120};
        S.init(g.M, g.N, G, cid); pg8::gemm_phase<EpiRes, pg8::StaticOrder, true, true>(lds, g, S, E, wid0);
        __syncthreads();
        SkRes Sk{(bf16_t*)(ws + OFF_X1), nullptr, mod + 5120};
        skinny_gemm<4>(lds, (const bf16_t*)(ws + OFF_HMID) + (size_t)MP * DFF, (const bf16_t*)(ws + OFF_W2), 1024, DFF, Sk, wid0);
    }
    GSYNC(); TSTAMP(11);
    phase_final(p, wid0);
    if (PROBE_EW) phase_final(p, wid0);
    TSTAMP(99);
    if (PROBE_PHASE >= 0 && blockIdx.x == 0) { if (ts1 == 0) ts1 = __builtin_amdgcn_s_memrealtime(); const unsigned long long te = __builtin_amdgcn_s_memrealtime(), wait = 4ull * (ts1 - ts0);
        while (__builtin_amdgcn_s_memrealtime() - te < wait) __builtin_amdgcn_s_sleep(8); }
}

extern "C" void kernel_launch(void* const* d_in, const int* in_sizes, int n_in, void* d_out, int out_size, void* d_ws, size_t ws_size, hipStream_t stream) {
    constexpr int LDS_BYTES = LDS_TOTAL;
    static int grid = 0;
    if (grid == 0) {
        if (n_in != 25 || ws_size < WS_END) { fprintf(stderr, "kernel_launch: unexpected n_in %d / ws %zu (need %zu)\n", n_in, ws_size, (size_t)WS_END); grid = -1; return; }
        int dev = 0, cus = 0, per_cu = 0;
        (void)hipGetDevice(&dev);
        (void)hipDeviceGetAttribute(&cus, hipDeviceAttributeMultiprocessorCount, dev);
        if (hipFuncSetAttribute((const void*)fwd_megakernel, hipFuncAttributeMaxDynamicSharedMemorySize, LDS_BYTES) != hipSuccess) { fprintf(stderr, "kernel_launch: hipFuncSetAttribute failed\n"); grid = -1; return; }
        if (hipOccupancyMaxActiveBlocksPerMultiprocessor(&per_cu, (const void*)fwd_megakernel, 512, LDS_BYTES) != hipSuccess || per_cu < 1) { fprintf(stderr, "kernel_launch: occupancy query says %d blocks per CU\n", per_cu); grid = -1; return; }
        if (cus != 256) { fprintf(stderr, "kernel_launch: built for 256 CUs, found %d\n", cus); grid = -1; return; }
        grid = cus;
    }
    if (grid < 0) return;
    Params p{};
    for (int i = 0; i < 25; ++i) p.in[i] = (const float*)d_in[i];
    p.out = (float*)d_out; p.ws = (unsigned char*)d_ws;
    (void)hipMemsetAsync((unsigned char*)d_ws + OFF_BAR, 0, 16384, stream);
    void* args[] = {&p};
    hipError_t e = hipLaunchCooperativeKernel((const void*)fwd_megakernel, dim3(grid), dim3(512), args, LDS_BYTES, stream);
    if (e != hipSuccess) fprintf(stderr, "cooperative launch failed: %s (grid %d)\n", hipGetErrorString(e), grid);
}
```

```cpp
#include <hip/hip_runtime.h>
#include <hip/hip_cooperative_groups.h>
#include <cstdio>
#include <cstdint>
namespace cg = cooperative_groups;
#define PROBE_EW 0
#define PROBE_CONV 0
#define PROBE_SSD 0
#define PROBE_SYNC 0
#define PROBE_PHASE -1
#define PROBE_INPROJ 0
#define PROBE_MLP1 0
#define GSYNC() do { xcd_barrier(xb); if (PROBE_SYNC) xcd_barrier(xb); } while (0)

#define LAS __attribute__((address_space(3)))
typedef unsigned short bf16_t;
typedef short bf16x8 __attribute__((ext_vector_type(8)));
typedef short bf16x4 __attribute__((ext_vector_type(4)));
typedef float f32x4 __attribute__((ext_vector_type(4)));
typedef float f32x2 __attribute__((ext_vector_type(2)));
typedef unsigned u32x4 __attribute__((ext_vector_type(4)));
typedef unsigned u32x2 __attribute__((ext_vector_type(2)));

constexpr int D = 1024, NBP = 8, SEQ = 2048, MP = NBP * SEQ, NBS = 128, MTOT = MP + NBS, MPAD = 16640;
constexpr int DINP = 10496, DINNER = 2048, DXBC = 3072, NH = 32, HD = 64, DS = 128, DFF = 4096, DIN = 10272;
constexpr float EPS = 1e-6f;
constexpr size_t O_YP = 0, O_YS = 16777216, O_SCP = 16908288, O_SBP = 16924672, O_SSP = 16998400, O_SCS = 19095552, O_SBS = 19357696, O_SSS = 20537344;
constexpr size_t S1 = (size_t)MPAD * 1024 * 2;
constexpr size_t OFF_WADA = 0, OFF_WIN = 12582912, OFF_WAOUT = 34078720, OFF_WBOUT = 36175872, OFF_WO = 40370176, OFF_W1 = 42467328, OFF_W2 = 50855936,
                 OFF_CA = 59244544, OFF_MOD = 59768832, OFF_DTRAW = 66060288, OFF_DTP = 68190208, OFF_ACS = 70320128, OFF_SSQ = 72450048, OFF_U = 74579968,
                 OFF_R1 = OFF_U + S1, OFF_BG = OFF_R1, OFF_CI = OFF_R1 + S1, OFF_Z = OFF_R1 + 2 * S1, OFF_XBC = OFF_R1 + 4 * S1, OFF_GA = OFF_R1 + 7 * S1, OFF_GB = OFF_R1 + 8 * S1,
                 OFF_R2 = OFF_R1 + 9 * S1, OFF_BAR = OFF_R2 + 3 * S1, WS_END = OFF_BAR + 16384;
constexpr size_t OFF_VA = OFF_U, OFF_YA = OFF_BG, OFF_MERGED = OFF_CI, OFF_YG = OFF_XBC, OFF_HMID = OFF_R1, OFF_XBCC = OFF_R2, OFF_X1 = OFF_R2;

struct Params {
    const float* in[25];
    float* out;
    unsigned char* ws;
};
enum { I_XP = 0, I_XS, I_CP, I_CS, I_STA, I_STB, I_STS, I_WADA, I_BADA, I_N1G, I_WIN, I_CAW, I_WAOUT, I_CBW, I_CBB, I_DTB, I_ALOG, I_DSKIP, I_SNG, I_WBOUT, I_WO, I_N2G, I_W1, I_W2, I_NFG };

__device__ __forceinline__ unsigned cvt_pk_bf16(float lo, float hi) { unsigned r; asm volatile("v_cvt_pk_bf16_f32 %0, %1, %2" : "=v"(r) : "v"(lo), "v"(hi)); return r; }
__device__ __forceinline__ bf16_t f2bf(float f) { unsigned u = __float_as_uint(f); u += 0x7FFFu + ((u >> 16) & 1u); return (bf16_t)(u >> 16); }
__device__ __forceinline__ float bf2f(bf16_t b) { return __uint_as_float(((unsigned)b) << 16); }
__device__ __forceinline__ float bflo(unsigned u) { return __uint_as_float(u << 16); }
__device__ __forceinline__ float bfhi(unsigned u) { return __uint_as_float(u & 0xffff0000u); }
__device__ __forceinline__ float sigmoidf_(float x) { return __builtin_amdgcn_rcpf(1.f + __expf(-x)); }
__device__ __forceinline__ float siluf_(float x) { return x * sigmoidf_(x); }
__device__ __forceinline__ f32x4 cv4(const u32x2 u) { return (f32x4){bflo(u.x), bfhi(u.x), bflo(u.y), bfhi(u.y)}; }
struct F8 { f32x4 a, b; };
__device__ __forceinline__ F8 cv8(const u32x4 u) { F8 r; r.a = (f32x4){bflo(u.x), bfhi(u.x), bflo(u.y), bfhi(u.y)}; r.b = (f32x4){bflo(u.z), bfhi(u.z), bflo(u.w), bfhi(u.w)}; return r; }
__device__ __forceinline__ int tid_of(int wid) { int l; asm volatile("v_mbcnt_lo_u32_b32 %0, -1, 0\n\tv_mbcnt_hi_u32_b32 %0, -1, %0" : "=v"(l)); __builtin_assume(l >= 0 && l < 64); __builtin_assume(wid >= 0 && wid < 8); return wid * 64 + l; }
__device__ __forceinline__ float wave_sum(float v) {
#pragma unroll
    for (int o = 1; o < 64; o <<= 1) v += __shfl_xor(v, o);
    return v;
}


#define XB_TMO      128
#define XB_XCNT(j)  (256  + 64 * (j))
#define XB_XSUB(j)  (1280 + 64 * (j))
#define XB_XGEN(j)  (2304 + 64 * (j))
#define XB_TOP      3328
#define XB_TOPGEN   3392
#define XCD_BAR_WORDS 3456
#define XB_SPIN_CAP (1u << 18)
__device__ __forceinline__ unsigned xb_ld(unsigned* p)              { return __hip_atomic_load(p, __ATOMIC_RELAXED, __HIP_MEMORY_SCOPE_AGENT); }
__device__ __forceinline__ unsigned xb_add(unsigned* p, unsigned v) { return __hip_atomic_fetch_add(p, v, __ATOMIC_RELAXED, __HIP_MEMORY_SCOPE_AGENT); }
__device__ __forceinline__ unsigned xb_xcc_id() { return (unsigned)__builtin_amdgcn_s_getreg((3 << 11) | 20) & 0xFu; }
#define XB_SPIN(cond, bar) do { unsigned _sp = 0; while (cond) { __builtin_amdgcn_s_sleep(1); \
    if ((++_sp & 255u) == 0u) { if (xb_ld(&(bar)[XB_TMO])) break; if (_sp > XB_SPIN_CAP) { atomicAdd(&(bar)[XB_TMO], 1u); break; } } } } while (0)
struct XcdBarrier { unsigned* bar; unsigned x; volatile LAS unsigned* st; int wid; };
__device__ __forceinline__ XcdBarrier xcd_barrier_post(unsigned* bar, volatile LAS unsigned* st, int wid) {
    XcdBarrier b; b.bar = bar; b.x = xb_xcc_id(); b.st = st; b.wid = wid;
    if (tid_of(wid) == 0) (void)xb_add(&bar[XB_XCNT(b.x)], 1u);
    return b;
}
__device__ __forceinline__ void xcd_barrier_complete(unsigned* bar, unsigned x, unsigned& nloc, unsigned& nx) {
    const unsigned G = gridDim.x * gridDim.y * gridDim.z;
    unsigned sum, cnt, mine, sp = 0u;
    for (;;) {
        sum = 0u; cnt = 0u; mine = 0u;
#pragma unroll
        for (unsigned j = 0; j < 16; ++j) { const unsigned c = xb_ld(&bar[XB_XCNT(j)]); sum += c; cnt += (c > 0u) ? 1u : 0u; mine = (j == x) ? c : mine; }
        if (sum == G) break;
        __builtin_amdgcn_s_sleep(1);
        if ((++sp & 255u) == 0u) { if (xb_ld(&bar[XB_TMO])) break; if (sp > XB_SPIN_CAP) { atomicAdd(&bar[XB_TMO], 1u); break; } }
    }
    nloc = mine > 0u ? mine : 1u; nx = cnt > 0u ? cnt : 1u;
}
__device__ __forceinline__ void xcd_barrier(const XcdBarrier& b) {
    asm volatile("s_waitcnt vmcnt(0)" ::: "memory");
    __syncthreads();
    if (tid_of(b.wid) == 0) {
        unsigned* bar = b.bar;
        __builtin_amdgcn_s_waitcnt(0);
        unsigned nloc = b.st[0], nx = b.st[1];
        if (nloc == 0u) { xcd_barrier_complete(bar, b.x, nloc, nx); b.st[0] = nloc; b.st[1] = nx; }
        const unsigned old = xb_add(&bar[XB_XSUB(b.x)], 1u);
        const unsigned gen = old / nloc;
        if (old + 1u == (gen + 1u) * nloc) {
            __builtin_amdgcn_fence(__ATOMIC_RELEASE, "agent");
            asm volatile("s_waitcnt vmcnt(0)" ::: "memory");
            const unsigned og = xb_add(&bar[XB_TOP], 1u);
            const unsigned tg = og / nx;
            if (og + 1u == (tg + 1u) * nx) xb_add(&bar[XB_TOPGEN], 1u);
            else XB_SPIN(xb_ld(&bar[XB_TOPGEN]) == tg, bar);
            __builtin_amdgcn_fence(__ATOMIC_ACQUIRE, "agent");
            xb_add(&bar[XB_XGEN(b.x)], 1u);
            asm volatile("s_waitcnt vmcnt(0)" ::: "memory");
        } else {
            XB_SPIN(xb_ld(&bar[XB_XGEN(b.x)]) == gen, bar);
            __builtin_amdgcn_fence(__ATOMIC_ACQUIRE, "agent");
            asm volatile("s_waitcnt vmcnt(0)" ::: "memory");
        }
    }
    __syncthreads();
}

constexpr int L_XST = 131072, L_RT = 131072 + 16, LDS_TOTAL = L_RT + 4096;
namespace pg8 {
#define PG8_LAS __attribute__((address_space(3)))
constexpr int BM = 256, BK = 64, HALF = 128, HTB = HALF * BK * 2, STAGE_BYTES = 8 * HTB, NXCD = 8, WGM = 4;
__host__ __device__ __forceinline__ int lds_byte(int r, int c) { const int st = (r >> 4) * 2 + (c >> 5), rr = r & 15, cc = c & 31, ob = rr * 64 + cc * 2; return st * 1024 + (ob ^ (((ob >> 9) & 1) << 5)); }
__host__ __device__ __forceinline__ void stage_rc(int b, int& R, int& C) { const int st = b / 1024, sb = b % 1024, swz = sb ^ (((sb >> 9) & 1) << 5); R = (st >> 1) * 16 + swz / 64; C = (st & 1) * 32 + (swz % 64) / 2; }
__host__ __device__ __forceinline__ int perm32(int rho) { const int n = rho >> 4, i = rho & 15; return 8 * (i >> 2) + 4 * n + (i & 3); }
struct Unit { int pm, pn; };
struct Gemm { const bf16_t* A; const bf16_t* Bt; int M, N, K; };
struct StaticOrder {
    int nM, nN, nwg, G, c;
    __host__ __device__ void init(int M, int N, int G_, int c_) { nM = M / BM; nN = N / BM; nwg = nM * nN; G = G_; c = c_; }
    __host__ __device__ bool next(int i, Unit& u) const {
        const long L = (long)i * G + c; if (L >= nwg) return false;
        int wgid = (int)L; { const int q = nwg / NXCD, r = nwg % NXCD, xcd = wgid % NXCD, off = wgid / NXCD; wgid = (xcd < r ? xcd * (q + 1) : r * (q + 1) + (xcd - r) * q) + off; }
        const int nig = WGM * nN, gid = wgid / nig, fm = gid * WGM, gsz = (nM - fm) < WGM ? (nM - fm) : WGM;
        u.pm = fm + ((wgid % nig) % gsz); u.pn = (wgid % nig) / gsz; return true;
    }
    __device__ __forceinline__ void a_ready(const Unit&) const {}
    __device__ __forceinline__ void done(const Unit&) const {}
};

template <class Epi, class Sched, bool ALIGN_EPI = false, bool SP2 = false>
__device__ __forceinline__ void gemm_phase(PG8_LAS unsigned char* lds, const Gemm g, const Sched& S, const Epi& E, const int wid) {
    const int tid = tid_of(wid), lane = tid & 63, wr = wid >> 2, wc = wid & 3, fr = lane & 15, fq = lane >> 4;
    const int K = g.K, nt = K / BK;
    unsigned voffA[2], voffB[2];
#pragma unroll
    for (int i = 0; i < 2; ++i) { int R, C; stage_rc(tid * 16 + i * 8192, R, C); const int Rb = Epi::PERM ? ((R & ~31) + perm32(R & 31)) : R;
        voffA[i] = (unsigned)(R * K + C) * 2u; voffB[i] = (unsigned)(Rb * K + C) * 2u; }
    const size_t kstep = (size_t)(BK * 2);
    const size_t hstep = (size_t)HALF * K * 2;
    const size_t tstep = 2 * hstep;
    const unsigned ldsw = (unsigned)wid * 1024u;
    const int aoff = lds_byte(wr * 64 + fr, fq * 8), boff = lds_byte(wc * 32 + fr, fq * 8);
#define PG8_SA(b, h) (((b) * 2 + (h)) * HTB)
#define PG8_SB(b, h) ((4 + (b) * 2 + (h)) * HTB)
#define PG8_STAGE(bufoff, gbase, voff) do { _Pragma("unroll") for (int _i = 0; _i < 2; ++_i) \
        __builtin_amdgcn_global_load_lds((const unsigned*)((const char*)(gbase) + (voff)[_i]), (PG8_LAS unsigned*)(lds + (bufoff) + ldsw + _i * 8192), 16, 0, 0); } while (0)
#define PG8_LDA(dst, b, h) do { _Pragma("unroll") for (int m = 0; m < 4; ++m) _Pragma("unroll") for (int k = 0; k < 2; ++k) dst[m][k] = *(const PG8_LAS bf16x8*)(lds + PG8_SA(b, h) + aoff + m * 2048 + k * 1024); } while (0)
#define PG8_LDB(dst, b, h) do { _Pragma("unroll") for (int n = 0; n < 2; ++n) _Pragma("unroll") for (int k = 0; k < 2; ++k) dst[n][k] = *(const PG8_LAS bf16x8*)(lds + PG8_SB(b, h) + boff + n * 2048 + k * 1024); } while (0)
#define PG8_MMA(ai, bj, At, Bt) do { __builtin_amdgcn_s_setprio(1); _Pragma("unroll") for (int m = 0; m < 4; ++m) _Pragma("unroll") for (int n = 0; n < 2; ++n) _Pragma("unroll") for (int k = 0; k < 2; ++k) \
        acc[ai][bj][m][n] = __builtin_amdgcn_mfma_f32_16x16x32_bf16(Bt[n][k], At[m][k], acc[ai][bj][m][n], 0, 0, 0); __builtin_amdgcn_s_setprio(0); } while (0)
#define PG8_WAIT_V(n) asm volatile("s_waitcnt vmcnt(" #n ")" ::: "memory")
#define PG8_WAIT_L(n) asm volatile("s_waitcnt lgkmcnt(" #n ")" ::: "memory")
#define PG8_BAR __builtin_amdgcn_s_barrier()
#define PG8_SCHED __builtin_amdgcn_sched_barrier(0)
    Unit cur, nxt; int ui = 0;
    if (!S.next(0, cur)) return;
    f32x4 acc[2][2][4][2];
#pragma unroll
    for (int a = 0; a < 2; ++a)
#pragma unroll
        for (int b = 0; b < 2; ++b)
#pragma unroll
            for (int m = 0; m < 4; ++m)
#pragma unroll
                for (int n = 0; n < 2; ++n) acc[a][b][m][n] = (f32x4){0.f, 0.f, 0.f, 0.f};
    bf16x8 At[4][2], B0[2][2], B1[2][2];
    const char* cA = (const char*)g.A + (size_t)cur.pm * tstep; const char* cB = (const char*)g.Bt + (size_t)cur.pn * tstep;
    S.a_ready(cur);
    if constexpr (SP2) {
        PG8_STAGE(PG8_SB(0, 0), cB, voffB); PG8_STAGE(PG8_SB(0, 1), cB + hstep, voffB); PG8_STAGE(PG8_SA(0, 0), cA, voffA); PG8_STAGE(PG8_SA(0, 1), cA + hstep, voffA);
        if (wr == 1) PG8_BAR;
        PG8_WAIT_V(2); PG8_BAR;
        PG8_STAGE(PG8_SB(1, 0), cB + kstep, voffB); PG8_STAGE(PG8_SA(1, 0), cA + kstep, voffA); PG8_STAGE(PG8_SB(1, 1), cB + hstep + kstep, voffB);
        PG8_WAIT_V(6); PG8_BAR;
    } else {
        PG8_STAGE(PG8_SB(0, 0), cB, voffB); PG8_STAGE(PG8_SA(0, 0), cA, voffA); PG8_STAGE(PG8_SB(0, 1), cB + hstep, voffB); PG8_STAGE(PG8_SA(0, 1), cA + hstep, voffA);
        if (wr == 1) PG8_BAR;
        PG8_WAIT_V(4); PG8_BAR;
        PG8_STAGE(PG8_SB(1, 0), cB + kstep, voffB); PG8_STAGE(PG8_SA(1, 0), cA + kstep, voffA); PG8_STAGE(PG8_SB(1, 1), cB + hstep + kstep, voffB);
        PG8_WAIT_V(6); PG8_BAR;
    }
    for (;;) {
        const bool has_next = S.next(ui + 1, nxt);
        const char* nA = has_next ? (const char*)g.A + (size_t)nxt.pm * tstep : cA; const char* nB = has_next ? (const char*)g.Bt + (size_t)nxt.pn * tstep : cB;
        for (int t = 0; t < nt; t += 2) {
            const bool last = (t == nt - 2);
            const char* a1 = cA + (size_t)(t + 1) * kstep;
            const char* a2 = last ? nA : cA + (size_t)(t + 2) * kstep; const char* b2 = last ? nB : cB + (size_t)(t + 2) * kstep;
            const char* a3 = a2 + kstep; const char* b3 = b2 + kstep;
            if (last && has_next) S.a_ready(nxt);
            if constexpr (Epi::RESCALE) { if (t != 0 && (t & 7) == 0) { PG8_SCHED; E.rescale(acc, (t >> 3) - 1, wr, fr, lds); PG8_SCHED; } }
            if constexpr (SP2) {
            PG8_LDB(B0, 0, 0); PG8_LDB(B1, 0, 1); PG8_SCHED; PG8_LDA(At, 0, 0); PG8_STAGE(PG8_SA(1, 1), a1 + hstep, voffA);
            PG8_WAIT_V(8); PG8_WAIT_L(0); PG8_BAR; PG8_MMA(0, 0, At, B0); PG8_MMA(0, 1, At, B1); PG8_BAR; PG8_SCHED;
            PG8_LDA(At, 0, 1); PG8_STAGE(PG8_SB(0, 0), b2, voffB); PG8_STAGE(PG8_SB(0, 1), b2 + hstep, voffB); PG8_STAGE(PG8_SA(0, 0), a2, voffA);
            PG8_WAIT_V(8); PG8_WAIT_L(0); PG8_BAR; PG8_MMA(1, 0, At, B0); PG8_MMA(1, 1, At, B1); PG8_BAR; PG8_SCHED;
            PG8_LDB(B0, 1, 0); PG8_LDB(B1, 1, 1); PG8_SCHED; PG8_LDA(At, 1, 0); PG8_STAGE(PG8_SA(0, 1), a2 + hstep, voffA);
            PG8_WAIT_V(8); PG8_WAIT_L(0); PG8_BAR; PG8_MMA(0, 0, At, B0); PG8_MMA(0, 1, At, B1); PG8_BAR; PG8_SCHED;
            PG8_LDA(At, 1, 1); PG8_STAGE(PG8_SB(1, 0), b3, voffB); PG8_STAGE(PG8_SB(1, 1), b3 + hstep, voffB); PG8_STAGE(PG8_SA(1, 0), a3, voffA);
            PG8_WAIT_V(8); PG8_WAIT_L(0); PG8_BAR; PG8_MMA(1, 0, At, B0); PG8_MMA(1, 1, At, B1); PG8_BAR; PG8_SCHED;
            } else {
            PG8_LDB(B0, 0, 0); PG8_SCHED; PG8_LDA(At, 0, 0); PG8_STAGE(PG8_SA(1, 1), a1 + hstep, voffA);
            PG8_WAIT_L(8); PG8_BAR; PG8_WAIT_L(0); PG8_MMA(0, 0, At, B0); PG8_BAR; PG8_SCHED;
            PG8_LDB(B1, 0, 1); PG8_STAGE(PG8_SB(0, 0), b2, voffB);
            PG8_BAR; PG8_WAIT_L(0); PG8_MMA(0, 1, At, B1); PG8_BAR;
            PG8_LDA(At, 0, 1); PG8_STAGE(PG8_SA(0, 0), a2, voffA);
            PG8_BAR; PG8_WAIT_L(0); PG8_MMA(1, 0, At, B0); PG8_BAR; PG8_SCHED;
            PG8_STAGE(PG8_SB(0, 1), b2 + hstep, voffB);
            PG8_WAIT_V(6); PG8_BAR; PG8_MMA(1, 1, At, B1); PG8_BAR;
            PG8_LDB(B0, 1, 0); PG8_SCHED; PG8_LDA(At, 1, 0); PG8_STAGE(PG8_SA(0, 1), a2 + hstep, voffA);
            PG8_WAIT_L(8); PG8_BAR; PG8_WAIT_L(0); PG8_MMA(0, 0, At, B0); PG8_BAR; PG8_SCHED;
            PG8_LDB(B1, 1, 1); PG8_STAGE(PG8_SB(1, 0), b3, voffB);
            PG8_BAR; PG8_WAIT_L(0); PG8_MMA(0, 1, At, B1); PG8_BAR;
            PG8_LDA(At, 1, 1); PG8_STAGE(PG8_SA(1, 0), a3, voffA);
            PG8_BAR; PG8_WAIT_L(0); PG8_MMA(1, 0, At, B0); PG8_BAR; PG8_SCHED;
            PG8_STAGE(PG8_SB(1, 1), b3 + hstep, voffB);
            PG8_WAIT_V(6); PG8_BAR; PG8_MMA(1, 1, At, B1); PG8_BAR;
            }
        }
        if constexpr (ALIGN_EPI) { if (wr == 0) PG8_BAR; }
        if constexpr (Epi::RESCALE) E.rescale(acc, 3, wr, fr, lds);
        E(acc, cur, wr, wc, fr, fq);
        if (!has_next) break;
#pragma unroll
        for (int a = 0; a < 2; ++a)
#pragma unroll
            for (int b = 0; b < 2; ++b)
#pragma unroll
                for (int m = 0; m < 4; ++m)
#pragma unroll
                    for (int n = 0; n < 2; ++n) acc[a][b][m][n] = (f32x4){0.f, 0.f, 0.f, 0.f};
        cur = nxt; cA = nA; cB = nB; ++ui;
        if constexpr (ALIGN_EPI) { if (wr == 1) PG8_BAR; }
    }
    PG8_WAIT_V(0);
    if constexpr (!ALIGN_EPI) { if (wr == 0) PG8_BAR; }
    PG8_BAR;
#undef PG8_SA
#undef PG8_SB
#undef PG8_STAGE
#undef PG8_LDA
#undef PG8_LDB
#undef PG8_MMA
#undef PG8_WAIT_V
#undef PG8_WAIT_L
#undef PG8_BAR
#undef PG8_SCHED
}
}
using pg8::Unit;
typedef f32x4 AccT[2][2][4][2];

struct EpiF32Bias {
    static constexpr bool PERM = false, RESCALE = false;
    float* C; int ldc; const float* bias;
    __device__ __forceinline__ void operator()(const AccT& acc, const Unit& u, int wr, int wc, int fr, int fq) const {
        const int row0 = u.pm * 256 + wr * 64 + fr, col0 = u.pn * 256 + wc * 32 + 4 * fq;
        f32x4 bv[2][2];
#pragma unroll
        for (int bj = 0; bj < 2; ++bj)
#pragma unroll
            for (int n = 0; n < 2; ++n) bv[bj][n] = *(const f32x4*)(bias + col0 + bj * 128 + n * 16);
#pragma unroll
        for (int ai = 0; ai < 2; ++ai)
#pragma unroll
            for (int m = 0; m < 4; ++m) { float* rowp = C + (size_t)(row0 + ai * 128 + m * 16) * ldc + col0;
#pragma unroll
                for (int bj = 0; bj < 2; ++bj)
#pragma unroll
                    for (int n = 0; n < 2; ++n) *(f32x4*)(rowp + bj * 128 + n * 16) = acc[ai][bj][m][n] + bv[bj][n]; }
    }
};
__device__ __forceinline__ u32x4 pack8(f32x4 v0, f32x4 v1) { u32x4 w; w.x = cvt_pk_bf16(v0[0], v0[1]); w.y = cvt_pk_bf16(v0[2], v0[3]); w.z = cvt_pk_bf16(v1[0], v1[1]); w.w = cvt_pk_bf16(v1[2], v1[3]); return w; }
struct EpiIn {
    static constexpr bool PERM = true, RESCALE = false;
    bf16_t *BG, *CI, *Z, *XBC, *GA, *GB; float* DT;
    __device__ __forceinline__ void operator()(const AccT& acc, const Unit& u, int wr, int wc, int fr, int fq) const {
        const int pn = u.pn, row0 = u.pm * 256 + wr * 64 + fr, cin = wc * 32 + 8 * fq;
        if (pn >= 4 && pn < 12) {
            const int col = (pn - 4) * 128 + cin;
#pragma unroll
            for (int ai = 0; ai < 2; ++ai)
#pragma unroll
                for (int m = 0; m < 4; ++m) { const size_t row = row0 + ai * 128 + m * 16;
                    *(u32x4*)(CI + row * 1024 + col) = pack8(acc[ai][0][m][0] * acc[ai][1][m][0], acc[ai][0][m][1] * acc[ai][1][m][1]); }
        } else if (pn == 40) {
            if (wc == 0) {
#pragma unroll
                for (int ai = 0; ai < 2; ++ai)
#pragma unroll
                    for (int m = 0; m < 4; ++m) { const size_t row = row0 + ai * 128 + m * 16;
                        *(f32x4*)(DT + row * 32 + 8 * fq) = acc[ai][0][m][0]; *(f32x4*)(DT + row * 32 + 8 * fq + 4) = acc[ai][0][m][1]; }
            }
        } else {
            bf16_t* O; int ldc, colt;
            if (pn < 4) { O = BG; ldc = 1024; colt = pn * 256; }
            else if (pn < 20) { O = Z; ldc = 2048; colt = (pn - 12) * 256; }
            else if (pn < 32) { O = XBC; ldc = 3072; colt = (pn - 20) * 256; }
            else if (pn < 36) { O = GA; ldc = 1024; colt = (pn - 32) * 256; }
            else { O = GB; ldc = 1024; colt = (pn - 36) * 256; }
#pragma unroll
            for (int ai = 0; ai < 2; ++ai)
#pragma unroll
                for (int m = 0; m < 4; ++m) { bf16_t* rowp = O + (size_t)(row0 + ai * 128 + m * 16) * ldc + colt + cin;
#pragma unroll
                    for (int bj = 0; bj < 2; ++bj) { f32x4 v0 = acc[ai][bj][m][0], v1 = acc[ai][bj][m][1];
                        if (O == Z) {
#pragma unroll
                            for (int j = 0; j < 4; ++j) { v0[j] = siluf_(v0[j]); v1[j] = siluf_(v1[j]); } }
                        *(u32x4*)(rowp + bj * 128) = pack8(v0, v1); } }
        }
    }
};
template <int MODE> struct EpiGate {
    static constexpr bool PERM = true, RESCALE = (MODE == 1);
    bf16_t* O; const bf16_t* G; const bf16_t* Y; int ldc;
    __device__ __forceinline__ void rescale(AccT& acc, int b, int wr, int fr, PG8_LAS unsigned char* lds) const {
        int frl = fr; asm volatile("" : "+v"(frl));
        const PG8_LAS float* rt = (const PG8_LAS float*)(lds + L_RT) + (64 * wr + frl) * 4 + b;
#pragma unroll
        for (int ai = 0; ai < 2; ++ai)
#pragma unroll
            for (int m = 0; m < 4; ++m) { const float f = rt[(128 * ai + 16 * m) * 4];
#pragma unroll
                for (int bj = 0; bj < 2; ++bj)
#pragma unroll
                    for (int n = 0; n < 2; ++n) acc[ai][bj][m][n] = acc[ai][bj][m][n] * f; }
    }
    __device__ __forceinline__ void operator()(const AccT& acc, const Unit& u, int wr, int wc, int fr, int fq) const {
        asm volatile("" : "+v"(fr), "+v"(fq));
        const int row0 = u.pm * 256 + wr * 64 + fr, col0 = u.pn * 256 + wc * 32 + 8 * fq;
#pragma unroll
        for (int ai = 0; ai < 2; ++ai)
#pragma unroll
        for (int mh = 0; mh < 2; ++mh) {
            u32x4 gv[2][2], yv[2][2];
            if (MODE != 2) {
#pragma unroll
                for (int mm = 0; mm < 2; ++mm)
#pragma unroll
                    for (int bj = 0; bj < 2; ++bj) { const size_t off = (size_t)(row0 + ai * 128 + (2 * mh + mm) * 16) * ldc + col0 + bj * 128;
                        gv[mm][bj] = *(const u32x4*)(G + off); if (MODE == 1) yv[mm][bj] = *(const u32x4*)(Y + off); }
            }
#pragma unroll
            for (int mm = 0; mm < 2; ++mm)
#pragma unroll
                for (int bj = 0; bj < 2; ++bj) { const int m = 2 * mh + mm; const size_t off = (size_t)(row0 + ai * 128 + m * 16) * ldc + col0 + bj * 128;
                    f32x4 v0 = acc[ai][bj][m][0], v1 = acc[ai][bj][m][1];
                    if (MODE == 2) {
#pragma unroll
                        for (int j = 0; j < 4; ++j) { float a = fmaxf(v0[j], 0.f), b = fmaxf(v1[j], 0.f); v0[j] = a * a; v1[j] = b * b; }
                    } else {
                        const u32x4 g = gv[mm][bj];
                        v0[0] *= sigmoidf_(bflo(g.x)); v0[1] *= sigmoidf_(bfhi(g.x)); v0[2] *= sigmoidf_(bflo(g.y)); v0[3] *= sigmoidf_(bfhi(g.y));
                        v1[0] *= sigmoidf_(bflo(g.z)); v1[1] *= sigmoidf_(bfhi(g.z)); v1[2] *= sigmoidf_(bflo(g.w)); v1[3] *= sigmoidf_(bfhi(g.w));
                        if (MODE == 1) { const u32x4 y = yv[mm][bj];
                            v0[0] += bflo(y.x); v0[1] += bfhi(y.x); v0[2] += bflo(y.y); v0[3] += bfhi(y.y);
                            v1[0] += bflo(y.z); v1[1] += bfhi(y.z); v1[2] += bflo(y.w); v1[3] += bfhi(y.w); }
                    }
                    *(u32x4*)(O + off) = pack8(v0, v1); }
        }
    }
};
struct EpiRes {
    static constexpr bool PERM = true, RESCALE = false;
    bf16_t* X1; const float* xp; const float* gate;
    __device__ __forceinline__ void operator()(const AccT& acc, const Unit& u, int wr, int wc, int fr, int fq) const {
        const int row0 = u.pm * 256 + wr * 64 + fr, col0 = u.pn * 256 + wc * 32 + 8 * fq;
        const float* gr = gate + (size_t)(u.pm >> 3) * 6144 + col0;
        f32x4 gv[2][2];
#pragma unroll
        for (int bj = 0; bj < 2; ++bj)
#pragma unroll
            for (int n = 0; n < 2; ++n) gv[bj][n] = *(const f32x4*)(gr + bj * 128 + n * 4);
#pragma unroll
        for (int ai = 0; ai < 2; ++ai) {
            if (xp) {
                f32x4 xv[4][2][2];
#pragma unroll
                for (int m = 0; m < 4; ++m)
#pragma unroll
                    for (int bj = 0; bj < 2; ++bj)
#pragma unroll
                        for (int n = 0; n < 2; ++n) xv[m][bj][n] = *(const f32x4*)(xp + (size_t)(row0 + ai * 128 + m * 16) * D + col0 + bj * 128 + n * 4);
#pragma unroll
                for (int m = 0; m < 4; ++m)
#pragma unroll
                    for (int bj = 0; bj < 2; ++bj)
                        *(u32x4*)(X1 + (size_t)(row0 + ai * 128 + m * 16) * D + col0 + bj * 128) = pack8(xv[m][bj][0] + gv[bj][0] * acc[ai][bj][m][0], xv[m][bj][1] + gv[bj][1] * acc[ai][bj][m][1]);
            } else {
                u32x4 xv[4][2];
#pragma unroll
                for (int m = 0; m < 4; ++m)
#pragma unroll
                    for (int bj = 0; bj < 2; ++bj) xv[m][bj] = *(const u32x4*)(X1 + (size_t)(row0 + ai * 128 + m * 16) * D + col0 + bj * 128);
#pragma unroll
                for (int m = 0; m < 4; ++m)
#pragma unroll
                    for (int bj = 0; bj < 2; ++bj) { const F8 x8 = cv8(xv[m][bj]);
                        *(u32x4*)(X1 + (size_t)(row0 + ai * 128 + m * 16) * D + col0 + bj * 128) = pack8(x8.a + gv[bj][0] * acc[ai][bj][m][0], x8.b + gv[bj][1] * acc[ai][bj][m][1]); }
            }
        }
    }
};

template <int KS, class Epi>
__device__ __forceinline__ void skinny_gemm(LAS unsigned char* lds, const bf16_t* A, const bf16_t* Bt, int N, int K, const Epi& E, const int w) {
    constexpr int RT = 8 / KS;
    const int tid = tid_of(w), lane = tid & 63, fr = lane & 15, fq = lane >> 4;
    const int nitems = (N / 16) * KS, klen = K / KS;
    LAS f32x4* red = (LAS f32x4*)lds;
    for (int it = blockIdx.x; it < nitems; it += gridDim.x) {
        const int ct = it / KS, rg = it % KS, rt = rg * RT + (w % RT), kq = w / RT;
        const bf16_t* ap = A + (size_t)(16 * rt + fr) * K + kq * klen + fq * 8;
        const bf16_t* bp = Bt + (size_t)(16 * ct + fr) * K + kq * klen + fq * 8;
        f32x4 acc0 = (f32x4){0.f, 0.f, 0.f, 0.f}, acc1 = acc0;
        for (int k = 0; k < klen; k += 256) {
            bf16x8 a[8], b[8];
#pragma unroll
            for (int j = 0; j < 8; ++j) { a[j] = *(const bf16x8*)(ap + k + 32 * j); b[j] = *(const bf16x8*)(bp + k + 32 * j); }
#pragma unroll
            for (int j = 0; j < 8; j += 2) { acc0 = __builtin_amdgcn_mfma_f32_16x16x32_bf16(b[j], a[j], acc0, 0, 0, 0); acc1 = __builtin_amdgcn_mfma_f32_16x16x32_bf16(b[j + 1], a[j + 1], acc1, 0, 0, 0); }
        }
        f32x4 acc = (acc0 + acc1) * E.kscale(16 * rt + fr, kq);
        if (KS > 1) {
            if (kq > 0) red[w * 64 + lane] = acc;
            __syncthreads();
            if (kq == 0) {
#pragma unroll
                for (int q = 1; q < KS; ++q) acc = acc + red[(w + q * RT) * 64 + lane];
                E(16 * rt + fr, 16 * ct + 4 * fq, acc);
            }
            __syncthreads();
        } else E(16 * rt + fr, 16 * ct + 4 * fq, acc);
    }
}
__device__ __forceinline__ u32x2 pack4(const f32x4 v) { u32x2 o; o.x = cvt_pk_bf16(v[0], v[1]); o.y = cvt_pk_bf16(v[2], v[3]); return o; }
template <int MODE> struct SkGate {
    bf16_t* O; const bf16_t* G; const bf16_t* Y; int ldc;
    const float* SSQ;
    __device__ __forceinline__ float kscale(int r, int kq) const {
        if (MODE != 1) return 1.f;
        const f32x4 s0 = *(const f32x4*)(SSQ + (size_t)(MP + r) * 32 + 8 * kq), s1 = *(const f32x4*)(SSQ + (size_t)(MP + r) * 32 + 8 * kq + 4);
        return rsqrtf(((s0[0] + s0[1]) + (s0[2] + s0[3]) + (s1[0] + s1[1]) + (s1[2] + s1[3])) * (1.f / 512.f) + EPS);
    }
    __device__ __forceinline__ void operator()(int r, int c, f32x4 v) const {
        const size_t off = (size_t)(MP + r) * ldc + c;
        if (MODE == 2) {
#pragma unroll
            for (int j = 0; j < 4; ++j) { const float a = fmaxf(v[j], 0.f); v[j] = a * a; }
        } else {
            const f32x4 g = cv4(*(const u32x2*)(G + off));
#pragma unroll
            for (int j = 0; j < 4; ++j) v[j] *= sigmoidf_(g[j]);
            if (MODE == 1) v = v + cv4(*(const u32x2*)(Y + off));
        }
        *(u32x2*)(O + off) = pack4(v);
    }
};
struct SkRes {
    bf16_t* X1; const float* xs; const float* gate;
    __device__ __forceinline__ float kscale(int, int) const { return 1.f; }
    __device__ __forceinline__ void operator()(int r, int c, f32x4 v) const {
        bf16_t* o = X1 + (size_t)(MP + r) * D + c;
        const f32x4 src = xs ? *(const f32x4*)(xs + (size_t)r * D + c) : cv4(*(const u32x2*)o);
        *(u32x2*)o = pack4(src + *(const f32x4*)(gate + (size_t)(NBP + r) * 6144 + c) * v);
    }
};

__device__ __forceinline__ int win_dest(int n) {
    if (n < 1024) return n;
    if (n < 2048) { const int j = n - 1024; return 1024 + (j >> 7) * 256 + (j & 127); }
    if (n < 3072) { const int j = n - 2048; return 1024 + (j >> 7) * 256 + 128 + (j & 127); }
    if (n < 8192) return n;
    if (n < 8224) return 10240 + (n - 8192);
    return n - 32;
}
__device__ __forceinline__ void transpose_item(const float* W, int K, int N, bf16_t* WT, int item, bool remap, const float* kscale, LAS float* scr, int lane) {
    const int nblk = N / 32, kb = item / nblk, nb = item % nblk, k0 = 64 * kb, n0 = 32 * nb;
#pragma unroll 16
    for (int i = 0; i < 32; ++i) { const int kk = 2 * i + (lane >> 5); float v = __builtin_nontemporal_load(W + (size_t)(k0 + kk) * N + n0 + (lane & 31));     if (kscale) v *= kscale[k0 + kk]; scr[kk * 33 + (lane & 31)] = v; }
    const int c = lane & 7;
#pragma unroll
    for (int j = 0; j < 4; ++j) { const int n = (lane >> 3) + 8 * j; const LAS float* sp = scr + (8 * c) * 33 + n;
        u32x4 o; o.x = cvt_pk_bf16(sp[0 * 33], sp[1 * 33]); o.y = cvt_pk_bf16(sp[2 * 33], sp[3 * 33]); o.z = cvt_pk_bf16(sp[4 * 33], sp[5 * 33]); o.w = cvt_pk_bf16(sp[6 * 33], sp[7 * 33]);
        const int ns = n0 + n, dr = remap ? win_dest(ns) : ns;
        *(u32x4*)(WT + (size_t)dr * K + k0 + 8 * c) = o; }
    asm volatile("s_waitcnt lgkmcnt(0)" ::: "memory");
}
__device__ __forceinline__ void phase0(const Params& p, LAS unsigned char* lds, int part, const int wid) {
    unsigned char* ws = p.ws;
    const int tid = tid_of(wid), lane = tid & 63;
    LAS float* scr = (LAS float*)lds + wid * (64 * 33);
    constexpr int I_ADA = 16 * 192, I_IN = 16 * 321, I_AO = 16 * 32, I_BO = 32 * 32, I_O = 16 * 32, I_1 = 16 * 128, I_2 = 64 * 32;
    constexpr int NMOD = 24;
    if (part == 0) {
        for (int it = blockIdx.x * 8 + wid; it < I_ADA; it += gridDim.x * 8) transpose_item(p.in[I_WADA], 1024, 6144, (bf16_t*)(ws + OFF_WADA), it, false, nullptr, scr, lane);
        bf16_t* cA = (bf16_t*)(ws + OFF_CA);
        for (int i = blockIdx.x * 512 + tid; i < (NBP + NBS) * D; i += gridDim.x * 512) {
            const int row = i >> 10, k = i & 1023;
            const float v = row < NBP ? p.in[I_CP][row * D + k] : p.in[I_CS][(row - NBP) * D + k];
            cA[i] = f2bf(siluf_(v));
        }
        return;
    }
    if (part == 1) {
        for (int it = ((int)blockIdx.x - NMOD) * 8 + wid; it < I_IN; it += ((int)gridDim.x - NMOD) * 8) transpose_item(p.in[I_WIN], 1024, DIN, (bf16_t*)(ws + OFF_WIN), it, true, nullptr, scr, lane);
        return;
    }
    constexpr int FIRST2 = (65 * 41) % 256;
    const int nw2 = (int)gridDim.x > FIRST2 ? (int)gridDim.x - FIRST2 : (int)gridDim.x, w2 = (int)gridDim.x > FIRST2 ? (int)blockIdx.x - FIRST2 : (int)blockIdx.x;
    if (w2 < 0) return;
    for (int it = w2 * 8 + wid; it < I_AO + I_BO + I_O + I_1 + I_2; it += nw2 * 8) {
        int r = it;
        if (r < I_AO) { transpose_item(p.in[I_WAOUT], 1024, 1024, (bf16_t*)(ws + OFF_WAOUT), r, false, nullptr, scr, lane); continue; } r -= I_AO;
        if (r < I_BO) { transpose_item(p.in[I_WBOUT], 2048, 1024, (bf16_t*)(ws + OFF_WBOUT), r, false, p.in[I_SNG], scr, lane); continue; } r -= I_BO;
        if (r < I_O) { transpose_item(p.in[I_WO], 1024, 1024, (bf16_t*)(ws + OFF_WO), r, false, nullptr, scr, lane); continue; } r -= I_O;
        if (r < I_1) { transpose_item(p.in[I_W1], 1024, 4096, (bf16_t*)(ws + OFF_W1), r, false, nullptr, scr, lane); continue; } r -= I_1;
        transpose_item(p.in[I_W2], 4096, 1024, (bf16_t*)(ws + OFF_W2), r, false, nullptr, scr, lane);
    }
}

template <bool BF> __device__ __forceinline__ void load_row(const void* xrow, int lane, f32x4 (&v)[4]) {
#pragma unroll
    for (int j = 0; j < 4; ++j) v[j] = BF ? cv4(((const u32x2*)xrow)[lane + 64 * j]) : __builtin_nontemporal_load(((const f32x4*)xrow) + lane + 64 * j);
}
template <bool BF> __device__ __forceinline__ void rownorm_mod(const void* xrow, const float* g, const float* sc, const float* sh, bf16_t* orow, int lane) {
    f32x4 v[4]; float s = 0.f;
    load_row<BF>(xrow, lane, v);
#pragma unroll
    for (int j = 0; j < 4; ++j) s += (v[j][0] * v[j][0] + v[j][1] * v[j][1]) + (v[j][2] * v[j][2] + v[j][3] * v[j][3]);
    const float rstd = rsqrtf(wave_sum(s) * (1.f / D) + EPS);
#pragma unroll
    for (int j = 0; j < 4; ++j) { const int i4 = lane + 64 * j;
        const f32x4 gg = ((const f32x4*)g)[i4], scv = ((const f32x4*)sc)[i4], shv = ((const f32x4*)sh)[i4];
        const f32x4 o = v[j] * rstd * gg * (scv + 1.f) + shv;
        u32x2 w; w.x = cvt_pk_bf16(o[0], o[1]); w.y = cvt_pk_bf16(o[2], o[3]);
        ((u32x2*)orow)[i4] = w; }
}
__device__ __forceinline__ float row_ss(const f32x4 (&v)[4]) { float s = 0.f;
#pragma unroll
    for (int j = 0; j < 4; ++j) s += (v[j][0] * v[j][0] + v[j][1] * v[j][1]) + (v[j][2] * v[j][2] + v[j][3] * v[j][3]);
    return s; }
template <bool BF> __device__ __forceinline__ void phase_rownorm(const Params& p, const float* gvec, int sc_off, int sh_off, bf16_t* U, const int wid) {
    const int tid_ = tid_of(wid), lane = tid_ & 63, gw = blockIdx.x * 8 + (tid_ >> 6), NW = gridDim.x * 8;
    const float* mod = (const float*)(p.ws + OFF_MOD);
    for (int blk = gw; blk < MP / 8; blk += NW) {
        const int row0 = blk * 8, seq = row0 >> 11;
        f32x4 gm[4], shv[4];
#pragma unroll
        for (int j = 0; j < 4; ++j) { const int i4 = lane + 64 * j;
            gm[j] = ((const f32x4*)gvec)[i4] * (((const f32x4*)(mod + (size_t)seq * 6144 + sc_off))[i4] + 1.f); shv[j] = ((const f32x4*)(mod + (size_t)seq * 6144 + sh_off))[i4]; }
#pragma unroll
        for (int i = 0; i < 8; i += 2) {
            f32x4 va[4], vb[4];
            const void* ra = BF ? (const void*)((const bf16_t*)(p.ws + OFF_X1) + (size_t)(row0 + i) * D) : (const void*)(p.in[I_XP] + (size_t)(row0 + i) * D);
            const void* rb = BF ? (const void*)((const bf16_t*)(p.ws + OFF_X1) + (size_t)(row0 + i + 1) * D) : (const void*)(p.in[I_XP] + (size_t)(row0 + i + 1) * D);
            load_row<BF>(ra, lane, va); load_row<BF>(rb, lane, vb);
            const float rsa = rsqrtf(wave_sum(row_ss(va)) * (1.f / D) + EPS), rsb = rsqrtf(wave_sum(row_ss(vb)) * (1.f / D) + EPS);
#pragma unroll
            for (int j = 0; j < 4; ++j) { const int i4 = lane + 64 * j;
                const f32x4 oa = va[j] * rsa * gm[j] + shv[j], ob = vb[j] * rsb * gm[j] + shv[j];
                u32x2 w; w.x = cvt_pk_bf16(oa[0], oa[1]); w.y = cvt_pk_bf16(oa[2], oa[3]); ((u32x2*)(U + (size_t)(row0 + i) * D))[i4] = w;
                w.x = cvt_pk_bf16(ob[0], ob[1]); w.y = cvt_pk_bf16(ob[2], ob[3]); ((u32x2*)(U + (size_t)(row0 + i + 1) * D))[i4] = w; }
        }
    }
    for (int r = gw; r < NBS; r += NW) {
        const int row = MP + r, seq = NBP + r;
        const void* xrow = BF ? (const void*)((const bf16_t*)(p.ws + OFF_X1) + (size_t)row * D) : (const void*)(p.in[I_XS] + (size_t)r * D);
        rownorm_mod<BF>(xrow, gvec, mod + (size_t)seq * 6144 + sc_off, mod + (size_t)seq * 6144 + sh_off, U + (size_t)row * D, lane);
    }
}
__device__ __forceinline__ void phase_final(const Params& p, const int wid) {
    const int tid_ = tid_of(wid), lane = tid_ & 63, gw = blockIdx.x * 8 + (tid_ >> 6), NW = gridDim.x * 8;
    const bf16_t* X = (const bf16_t*)(p.ws + OFF_X1);
    f32x4 g[4];
#pragma unroll
    for (int j = 0; j < 4; ++j) g[j] = ((const f32x4*)p.in[I_NFG])[lane + 64 * j];
    for (int pr = gw; pr < MTOT / 2; pr += NW) {
        const int ra = 2 * pr, rb = 2 * pr + 1;
        float* oa = ra < MP ? p.out + O_YP + (size_t)ra * D : p.out + O_YS + (size_t)(ra - MP) * D;
        float* ob = rb < MP ? p.out + O_YP + (size_t)rb * D : p.out + O_YS + (size_t)(rb - MP) * D;
        f32x4 va[4], vb[4];
        load_row<true>(X + (size_t)ra * D, lane, va); load_row<true>(X + (size_t)rb * D, lane, vb);
        const float rsa = rsqrtf(wave_sum(row_ss(va)) * (1.f / D) + EPS), rsb = rsqrtf(wave_sum(row_ss(vb)) * (1.f / D) + EPS);
#pragma unroll
        for (int j = 0; j < 4; ++j) { ((f32x4*)oa)[lane + 64 * j] = va[j] * rsa * g[j]; ((f32x4*)ob)[lane + 64 * j] = vb[j] * rsb * g[j]; }
    }
}

__device__ __forceinline__ F8 ld8bf(const bf16_t* p) { const u32x4 u = *(const u32x4*)p; F8 r; r.a = (f32x4){bflo(u.x), bfhi(u.x), bflo(u.y), bfhi(u.y)}; r.b = (f32x4){bflo(u.z), bfhi(u.z), bflo(u.w), bfhi(u.w)}; return r; }
__device__ __forceinline__ F8 ld8f(const float* p) { F8 r; r.a = *(const f32x4*)p; r.b = *(const f32x4*)(p + 4); return r; }
__device__ __forceinline__ void st8f(float* p, const F8& v) { *(f32x4*)p = v.a; *(f32x4*)(p + 4) = v.b; }
__device__ __forceinline__ F8 zero8() { F8 r; r.a = (f32x4){0.f, 0.f, 0.f, 0.f}; r.b = r.a; return r; }
__device__ __forceinline__ void phase_conv(const Params& p, LAS unsigned char* lds, const int wid) {
    unsigned char* ws = p.ws;
    const bf16_t* BG = (const bf16_t*)(ws + OFF_BG); const bf16_t* CI = (const bf16_t*)(ws + OFF_CI); const bf16_t* XBC = (const bf16_t*)(ws + OFF_XBC);
    bf16_t* VA = (bf16_t*)(ws + OFF_VA); bf16_t* XC = (bf16_t*)(ws + OFF_XBCC);
    const int tid = threadIdx.x;
    for (int kstep = 0; kstep < 9; ++kstep) {
        int it;
        if (kstep < 8) it = (int)blockIdx.x * 8 + kstep; else { if ((int)blockIdx.x >= NBS) break; it = MP / 8 + (int)blockIdx.x; }
        if (it < MP / 8) {
            const int r0 = it * 8, tpos0 = r0 & (SEQ - 1), b = r0 >> 11;
            if (tid < 128) {
                const int ch = tid * 8;
                u32x4 raw[10], bgr[8];
#pragma unroll
                for (int i = 0; i < 10; ++i) raw[i] = (tpos0 - 2 + i >= 0) ? *(const u32x4*)(CI + (size_t)(r0 - 2 + i) * 1024 + ch) : (u32x4){0u, 0u, 0u, 0u};
#pragma unroll
                for (int i = 0; i < 8; ++i) bgr[i] = *(const u32x4*)(BG + (size_t)(r0 + i) * 1024 + ch);
                const F8 w0 = ld8f(p.in[I_CAW] + ch), w1 = ld8f(p.in[I_CAW] + 1024 + ch), w2 = ld8f(p.in[I_CAW] + 2048 + ch);
#pragma unroll
                for (int i = 0; i < 8; ++i) { const F8 p2 = cv8(raw[i]), p1 = cv8(raw[i + 1]), c0 = cv8(raw[i + 2]), bg = cv8(bgr[i]);
                    const f32x4 va = bg.a * (w0.a * p2.a + w1.a * p1.a + w2.a * c0.a), vb = bg.b * (w0.b * p2.b + w1.b * p1.b + w2.b * c0.b);
                    *(u32x4*)(VA + (size_t)(r0 + i) * 1024 + ch) = pack8(va, vb);
                    if (tpos0 + i >= SEQ - 2) st8f(p.out + O_SCP + ((size_t)b * 2 + (tpos0 + i - (SEQ - 2))) * 1024 + ch, c0); }
            } else {
                const int ch = (tid - 128) * 8;
                u32x4 raw[11];
#pragma unroll
                for (int i = 0; i < 11; ++i) raw[i] = (tpos0 - 3 + i >= 0) ? *(const u32x4*)(XBC + (size_t)(r0 - 3 + i) * 3072 + ch) : (u32x4){0u, 0u, 0u, 0u};
                const F8 w0 = ld8f(p.in[I_CBW] + ch), w1 = ld8f(p.in[I_CBW] + 3072 + ch), w2 = ld8f(p.in[I_CBW] + 6144 + ch), w3 = ld8f(p.in[I_CBW] + 9216 + ch), bb = ld8f(p.in[I_CBB] + ch);
#pragma unroll
                for (int i = 0; i < 8; ++i) { const F8 p3 = cv8(raw[i]), p2 = cv8(raw[i + 1]), p1 = cv8(raw[i + 2]), c0 = cv8(raw[i + 3]);
                    f32x4 va = w0.a * p3.a + w1.a * p2.a + w2.a * p1.a + w3.a * c0.a + bb.a, vb = w0.b * p3.b + w1.b * p2.b + w2.b * p1.b + w3.b * c0.b + bb.b;
#pragma unroll
                    for (int j = 0; j < 4; ++j) { va[j] = siluf_(va[j]); vb[j] = siluf_(vb[j]); }
                    *(u32x4*)(XC + (size_t)(r0 + i) * 3072 + ch) = pack8(va, vb);
                    if (tpos0 + i >= SEQ - 3) st8f(p.out + O_SBP + ((size_t)b * 3 + (tpos0 + i - (SEQ - 3))) * 3072 + ch, c0); }
            }
        } else {
            const int b = it - MP / 8, row = MP + b;
            if (tid < 128) {
                const int ch = tid * 8;
                const F8 c0 = ld8bf(CI + (size_t)row * 1024 + ch);
                const F8 p2 = ld8f(p.in[I_STA] + ((size_t)b * 2 + 0) * 1024 + ch), p1 = ld8f(p.in[I_STA] + ((size_t)b * 2 + 1) * 1024 + ch);
                const F8 w0 = ld8f(p.in[I_CAW] + ch), w1 = ld8f(p.in[I_CAW] + 1024 + ch), w2 = ld8f(p.in[I_CAW] + 2048 + ch);
                const F8 bg = ld8bf(BG + (size_t)row * 1024 + ch);
                const f32x4 va = bg.a * (w0.a * p2.a + w1.a * p1.a + w2.a * c0.a), vb = bg.b * (w0.b * p2.b + w1.b * p1.b + w2.b * c0.b);
                *(u32x4*)(VA + (size_t)row * 1024 + ch) = pack8(va, vb);
                st8f(p.out + O_SCS + ((size_t)b * 2 + 0) * 1024 + ch, p1); st8f(p.out + O_SCS + ((size_t)b * 2 + 1) * 1024 + ch, c0);
            } else {
                const int ch = (tid - 128) * 8;
                const F8 c0 = ld8bf(XBC + (size_t)row * 3072 + ch);
                const F8 p3 = ld8f(p.in[I_STB] + ((size_t)b * 3 + 0) * 3072 + ch), p2 = ld8f(p.in[I_STB] + ((size_t)b * 3 + 1) * 3072 + ch), p1 = ld8f(p.in[I_STB] + ((size_t)b * 3 + 2) * 3072 + ch);
                const F8 w0 = ld8f(p.in[I_CBW] + ch), w1 = ld8f(p.in[I_CBW] + 3072 + ch), w2 = ld8f(p.in[I_CBW] + 6144 + ch), w3 = ld8f(p.in[I_CBW] + 9216 + ch), bb = ld8f(p.in[I_CBB] + ch);
                f32x4 va = w0.a * p3.a + w1.a * p2.a + w2.a * p1.a + w3.a * c0.a + bb.a, vb = w0.b * p3.b + w1.b * p2.b + w2.b * p1.b + w3.b * c0.b + bb.b;
#pragma unroll
                for (int j = 0; j < 4; ++j) { va[j] = siluf_(va[j]); vb[j] = siluf_(vb[j]); }
                *(u32x4*)(XC + (size_t)row * 3072 + ch) = pack8(va, vb);
                st8f(p.out + O_SBS + ((size_t)b * 3 + 0) * 3072 + ch, p2); st8f(p.out + O_SBS + ((size_t)b * 3 + 1) * 3072 + ch, p1); st8f(p.out + O_SBS + ((size_t)b * 3 + 2) * 3072 + ch, c0);
            }
        }
    }
    const float* DTR = (const float*)(ws + OFF_DTRAW); float* DTP = (float*)(ws + OFF_DTP); float* ACS = (float*)(ws + OFF_ACS);
    LAS float* t1 = (LAS float*)lds; LAS float* t2 = t1 + 128 * 33;
    for (int it = blockIdx.x; it < 129; it += gridDim.x) {
        const int t0 = it * 128;
#pragma unroll
        for (int i = 0; i < 8; ++i) { const int idx = tid + 512 * i, r = idx >> 5, hh = idx & 31;
            const float raw = DTR[(size_t)(t0 + r) * 32 + hh] + p.in[I_DTB][hh];
            t1[r * 33 + hh] = raw > 20.f ? raw : log1pf(expf(raw)); }
        __syncthreads();
        if (tid < 32) { const float a = -expf(p.in[I_ALOG][tid]); float run = 0.f;
            for (int s = 0; s < 128; ++s) { run += t1[s * 33 + tid] * a; t2[s * 33 + tid] = run; } }
        __syncthreads();
#pragma unroll
        for (int i = 0; i < 8; ++i) { const int idx = tid + 512 * i, r = idx >> 5, hh = idx & 31;
            DTP[(size_t)(t0 + r) * 32 + hh] = t1[r * 33 + hh]; ACS[(size_t)(t0 + r) * 32 + hh] = t2[r * 33 + hh]; }
        __syncthreads();
    }
}

constexpr int RS = 288, RX = 144;
constexpr int L_C = 0, L_B = 36864, L_X = 73728, L_XW = 92160, L_H = 110592, L_ACS = 129024, L_DT = 129536;
__device__ __forceinline__ bf16x8 tr_frag(LAS unsigned char* base, int rstride, int k0, int c0, int lane) {
    const int i = lane & 15, g = lane >> 4, q = i >> 2, pp = i & 3;
    LAS unsigned char* a = base + (k0 + 8 * g + q) * rstride + (c0 + 4 * pp) * 2;
    const bf16x4 lo = __builtin_amdgcn_ds_read_tr16_b64_v4i16((LAS bf16x4*)a);
    const bf16x4 hi = __builtin_amdgcn_ds_read_tr16_b64_v4i16((LAS bf16x4*)(a + 4 * rstride));
    return (bf16x8){lo[0], lo[1], lo[2], lo[3], hi[0], hi[1], hi[2], hi[3]};
}
constexpr int L_RED = 130048, L_CF = L_RT;
__device__ __forceinline__ void ssd_unit(const Params& p, LAS unsigned char* lds, int b, int h, int sbase, const int w) {
    unsigned char* ws = p.ws;
    const bf16_t* XC = (const bf16_t*)(ws + OFF_XBCC); const bf16_t* Z = (const bf16_t*)(ws + OFF_Z);
    const float* DTP = (const float*)(ws + OFF_DTP); const float* ACS = (const float*)(ws + OFF_ACS);
    bf16_t* YG = (bf16_t*)(ws + OFF_YG); float* SSQ = (float*)(ws + OFF_SSQ);
    const int tid = tid_of(w), lane = tid & 63, fr = lane & 15, fq = lane >> 4, g = h >> 3;
    const float Dh = p.in[I_DSKIP][h];
    LAS float* sAcs = (LAS float*)(lds + L_ACS); LAS float* sDt = (LAS float*)(lds + L_DT); LAS float* red = (LAS float*)(lds + L_RED);
    f32x4 hacc[4];
#pragma unroll
    for (int i = 0; i < 4; ++i) hacc[i] = (f32x4){0.f, 0.f, 0.f, 0.f};
    const int hpt = w & 3, hnb = (w >> 2) * 4;
    const int n4 = tid & 31, pr = tid >> 5;
    u32x4 rc[4], rb[4], rx[2]; float wv[2], my_acs = 0.f, my_dt = 0.f, acs_last_n;
#define SSD_PREFETCH(cc) do { const int _t0 = b * SEQ + (cc) * 128; \
        { const int ch = tid & 15, row = tid >> 4; _Pragma("unroll") for (int i = 0; i < 4; ++i) { const bf16_t* src = XC + (size_t)(_t0 + row + 32 * i) * 3072; rb[i] = *(const u32x4*)(src + 2048 + g * 128 + ch * 8); rc[i] = *(const u32x4*)(src + 2560 + g * 128 + ch * 8); } } \
        acs_last_n = ACS[(size_t)(_t0 + 127) * 32 + h]; \
        { const int ch = tid & 7, row = tid >> 3; _Pragma("unroll") for (int i = 0; i < 2; ++i) { const int r = _t0 + row + 64 * i; rx[i] = *(const u32x4*)(XC + (size_t)r * 3072 + h * 64 + ch * 8); \
              wv[i] = __expf(acs_last_n - ACS[(size_t)r * 32 + h]) * DTP[(size_t)r * 32 + h]; } } \
        if (tid < 128) { my_acs = ACS[(size_t)(_t0 + tid) * 32 + h]; my_dt = DTP[(size_t)(_t0 + tid) * 32 + h]; } } while (0)
    SSD_PREFETCH(0);
    int prev_sr = -1, prev_sh = 0;
    for (int c = 0; c < SEQ / 128; ++c) {
        const int t0 = b * SEQ + c * 128;
        __syncthreads();
        if (tid == 0 && prev_sr >= 0) { float v = 0.f;
#pragma unroll
            for (int i = 0; i < 16; ++i) v += red[i];
            SSQ[(size_t)prev_sr * 32 + prev_sh] = v; }
#pragma unroll
        for (int i = 0; i < 4; ++i) { u32x2 o; o.x = cvt_pk_bf16(hacc[i][0], hacc[i][1]); o.y = cvt_pk_bf16(hacc[i][2], hacc[i][3]);
            *(LAS u32x2*)(lds + L_H + (16 * hpt + fr) * RS + (16 * (hnb + i) + 4 * fq) * 2) = o; }
        { const int ch = tid & 15, row = tid >> 4;
#pragma unroll
          for (int i = 0; i < 4; ++i) { *(LAS u32x4*)(lds + L_B + (row + 32 * i) * RS + ch * 16) = rb[i]; *(LAS u32x4*)(lds + L_C + (row + 32 * i) * RS + ch * 16) = rc[i]; } }
        { const int ch = tid & 7, row = tid >> 3;
#pragma unroll
          for (int i = 0; i < 2; ++i) { *(LAS u32x4*)(lds + L_X + (row + 64 * i) * RX + ch * 16) = rx[i];
              const float s = wv[i]; u32x4 o;
              o.x = cvt_pk_bf16(bflo(rx[i].x) * s, bfhi(rx[i].x) * s); o.y = cvt_pk_bf16(bflo(rx[i].y) * s, bfhi(rx[i].y) * s);
              o.z = cvt_pk_bf16(bflo(rx[i].z) * s, bfhi(rx[i].z) * s); o.w = cvt_pk_bf16(bflo(rx[i].w) * s, bfhi(rx[i].w) * s);
              *(LAS u32x4*)(lds + L_XW + (row + 64 * i) * RX + ch * 16) = o; } }
        if (tid < 128) { sAcs[tid] = my_acs; sDt[tid] = my_dt; }
        const float acs_last = acs_last_n;
        __syncthreads();
        const int qt = w < 4 ? w : 11 - w, qrow = 16 * qt + fr;
        const size_t trow = (size_t)(t0 + qrow);
        u32x2 zv[4];
#pragma unroll
        for (int pt = 0; pt < 4; ++pt) zv[pt] = *(const u32x2*)(Z + trow * 2048 + h * 64 + 16 * pt + 4 * fq);
        const int sit = sbase + 256 * c; const bool has_s = sit < NBS * NH;
        const int sb = sit >> 5, sh = sit & 31, sr = MP + sb, sg = sh >> 3;
        f32x4 h0[4]; u32x2 sbu, scu; float sdt = 0.f, sxv[4], szv[4];
        const size_t sbase_off = (((size_t)sb * NH + sh) * HD) * DS;
        if (has_s) {
            const bf16_t* xr = XC + (size_t)sr * 3072;
#pragma unroll
            for (int i = 0; i < 4; ++i) { const int pp = pr + 16 * i; h0[i] = __builtin_nontemporal_load((const f32x4*)(p.in[I_STS] + sbase_off + (size_t)pp * DS + 4 * n4));
                sxv[i] = bf2f(xr[sh * 64 + pp]); szv[i] = bf2f(Z[(size_t)sr * 2048 + sh * 64 + pp]); }
            sbu = *(const u32x2*)(xr + 2048 + sg * 128 + 4 * n4); scu = *(const u32x2*)(xr + 2560 + sg * 128 + 4 * n4);
            sdt = DTP[(size_t)sr * 32 + sh];
        }
        bf16x8 cf[4];
#pragma unroll
        for (int kk = 0; kk < 4; ++kk) cf[kk] = *(const LAS bf16x8*)(lds + L_C + qrow * RS + (kk * 32 + fq * 8) * 2);
        f32x4 yacc[4];
#pragma unroll
        for (int i = 0; i < 4; ++i) yacc[i] = (f32x4){0.f, 0.f, 0.f, 0.f};
        const float acs_q = sAcs[qrow], acs_q0 = sAcs[16 * qt];
        LAS float* cfac = (LAS float*)(lds + L_CF) + w * 128;
#pragma unroll
        for (int i = 0; i < 2; ++i) { const int sidx = lane + 64 * i; if (sidx < 16 * qt) cfac[sidx] = __expf(acs_q0 - sAcs[sidx]) * sDt[sidx]; }
        const float r_q = __expf(acs_q - acs_q0);
        if (c > 0) {
#pragma unroll
            for (int pp = 0; pp < 2; ++pp) {
                bf16x8 hf[2][4];
#pragma unroll
                for (int a = 0; a < 2; ++a)
#pragma unroll
                    for (int kk = 0; kk < 4; ++kk) hf[a][kk] = *(const LAS bf16x8*)(lds + L_H + (16 * (2 * pp + a) + fr) * RS + (kk * 32 + fq * 8) * 2);
#pragma unroll
                for (int kk = 0; kk < 4; ++kk)
#pragma unroll
                    for (int a = 0; a < 2; ++a) yacc[2 * pp + a] = __builtin_amdgcn_mfma_f32_16x16x32_bf16(hf[a][kk], cf[kk], yacc[2 * pp + a], 0, 0, 0);
            }
            const float eq = __expf(acs_q);
#pragma unroll
            for (int pt = 0; pt < 4; ++pt) yacc[pt] = yacc[pt] * eq;
        }
        for (int sp = 0; 2 * sp <= qt; ++sp) {
            const bool two = 2 * sp + 1 <= qt;
            bf16x8 bfr[2][4];
#pragma unroll
            for (int kk = 0; kk < 4; ++kk) bfr[0][kk] = *(const LAS bf16x8*)(lds + L_B + (16 * (2 * sp) + fr) * RS + (kk * 32 + fq * 8) * 2);
            if (two) {
#pragma unroll
                for (int kk = 0; kk < 4; ++kk) bfr[1][kk] = *(const LAS bf16x8*)(lds + L_B + (16 * (2 * sp + 1) + fr) * RS + (kk * 32 + fq * 8) * 2);
            }
            f32x4 sacc[2];
            sacc[0] = (f32x4){0.f, 0.f, 0.f, 0.f}; sacc[1] = sacc[0];
#pragma unroll
            for (int kk = 0; kk < 4; ++kk) sacc[0] = __builtin_amdgcn_mfma_f32_16x16x32_bf16(bfr[0][kk], cf[kk], sacc[0], 0, 0, 0);
            if (two) {
#pragma unroll
                for (int kk = 0; kk < 4; ++kk) sacc[1] = __builtin_amdgcn_mfma_f32_16x16x32_bf16(bfr[1][kk], cf[kk], sacc[1], 0, 0, 0);
            }
#pragma unroll
            for (int a = 0; a < 2; ++a) { const int st = 2 * sp + a, s0 = 16 * st + 4 * fq;
                float pv[4];
                if (st < qt) { const f32x4 cc = *(const LAS f32x4*)(cfac + s0);
#pragma unroll
                    for (int j = 0; j < 4; ++j) pv[j] = sacc[a][j] * r_q * cc[j];
                } else if (st == qt) { const f32x4 as = *(const LAS f32x4*)(sAcs + s0), ds = *(const LAS f32x4*)(sDt + s0);
#pragma unroll
                    for (int j = 0; j < 4; ++j) pv[j] = (s0 + j <= qrow) ? sacc[a][j] * __expf(acs_q - as[j]) * ds[j] : 0.f;
                } else {
#pragma unroll
                    for (int j = 0; j < 4; ++j) pv[j] = 0.f;
                }
                u32x2 o; o.x = cvt_pk_bf16(pv[0], pv[1]); o.y = cvt_pk_bf16(pv[2], pv[3]);
                *(LAS u32x2*)(lds + L_C + qrow * RS + s0 * 2) = o; }
        }
        if (c + 1 < SEQ / 128) SSD_PREFETCH(c + 1);
        for (int kk = 0; kk <= (qt >> 1); ++kk) {
            bf16x8 xf[4];
            const bf16x8 pf = *(const LAS bf16x8*)(lds + L_C + qrow * RS + (kk * 32 + fq * 8) * 2);
#pragma unroll
            for (int pt = 0; pt < 4; ++pt) xf[pt] = tr_frag(lds + L_X, RX, kk * 32, 16 * pt, lane);
#pragma unroll
            for (int pt = 0; pt < 4; ++pt) yacc[pt] = __builtin_amdgcn_mfma_f32_16x16x32_bf16(xf[pt], pf, yacc[pt], 0, 0, 0);
        }
        { float ss = 0.f;
#pragma unroll
          for (int pt = 0; pt < 4; ++pt) { const int pc = 16 * pt + 4 * fq;
              const u32x2 xv = *(const LAS u32x2*)(lds + L_X + qrow * RX + pc * 2);
              const float x0 = bflo(xv.x), x1 = bfhi(xv.x), x2 = bflo(xv.y), x3 = bfhi(xv.y);
              const float g0 = (yacc[pt][0] + Dh * x0) * bflo(zv[pt].x), g1 = (yacc[pt][1] + Dh * x1) * bfhi(zv[pt].x);
              const float g2 = (yacc[pt][2] + Dh * x2) * bflo(zv[pt].y), g3 = (yacc[pt][3] + Dh * x3) * bfhi(zv[pt].y);
              ss += (g0 * g0 + g1 * g1) + (g2 * g2 + g3 * g3);
              u32x2 o; o.x = cvt_pk_bf16(g0, g1); o.y = cvt_pk_bf16(g2, g3);
              *(u32x2*)(YG + trow * 2048 + h * 64 + pc) = o; }
          ss += __shfl_xor(ss, 16); ss += __shfl_xor(ss, 32);
          if (fq == 0) SSQ[trow * 32 + h] = ss; }
        { const float dec = __expf(acs_last);
#pragma unroll
          for (int i = 0; i < 4; ++i) hacc[i] = hacc[i] * dec;
#pragma unroll
          for (int kp = 0; kp < 2; ++kp) {
              bf16x8 xwf[2], bf[2][4];
#pragma unroll
              for (int a = 0; a < 2; ++a) { const int kk = 2 * kp + a;
                  xwf[a] = tr_frag(lds + L_XW, RX, kk * 32, 16 * hpt, lane);
#pragma unroll
                  for (int i = 0; i < 4; ++i) bf[a][i] = tr_frag(lds + L_B, RS, kk * 32, 16 * (hnb + i), lane); }
              __builtin_amdgcn_sched_barrier(0);
#pragma unroll
              for (int a = 0; a < 2; ++a)
#pragma unroll
                  for (int i = 0; i < 4; ++i) hacc[i] = __builtin_amdgcn_mfma_f32_16x16x32_bf16(bf[a][i], xwf[a], hacc[i], 0, 0, 0);
          } }
        prev_sr = -1;
        if (has_s) {
            const float dA = __expf(sdt * -expf(p.in[I_ALOG][sh])), sD = p.in[I_DSKIP][sh];
            const f32x4 Bv = cv4(sbu), Cv = cv4(scu);
            float y[4];
#pragma unroll
            for (int i = 0; i < 4; ++i) { const int pp = pr + 16 * i;
                const f32x4 hn = h0[i] * dA + Bv * (sdt * sxv[i]);
                __builtin_nontemporal_store(hn, (f32x4*)(p.out + O_SSS + sbase_off + (size_t)pp * DS + 4 * n4));
                y[i] = (hn[0] * Cv[0] + hn[1] * Cv[1]) + (hn[2] * Cv[2] + hn[3] * Cv[3]); }
            const bool b4 = (n4 & 16) != 0, b3 = (n4 & 8) != 0;
            const float a0 = (b4 ? y[2] : y[0]) + __shfl_xor(b4 ? y[0] : y[2], 16);
            const float a1 = (b4 ? y[3] : y[1]) + __shfl_xor(b4 ? y[1] : y[3], 16);
            float ys = (b3 ? a1 : a0) + __shfl_xor(b3 ? a0 : a1, 8);
            ys += __shfl_xor(ys, 4); ys += __shfl_xor(ys, 2); ys += __shfl_xor(ys, 1);
            const int gi = n4 >> 3;
            const float xsel = b4 ? (b3 ? sxv[3] : sxv[2]) : (b3 ? sxv[1] : sxv[0]), zsel = b4 ? (b3 ? szv[3] : szv[2]) : (b3 ? szv[1] : szv[0]);
            const float gt = (ys + sD * xsel) * zsel;
            const bool lead = (n4 & 7) == 0;
            if (lead) YG[(size_t)sr * 2048 + sh * 64 + pr + 16 * gi] = f2bf(gt);
            float part = lead ? gt * gt : 0.f;
            part += __shfl_xor(part, 8); part += __shfl_xor(part, 16);
            if (n4 == 0) red[pr] = part;
            prev_sr = sr; prev_sh = sh;
        }
    }
#undef SSD_PREFETCH
    float* so = p.out + O_SSP + (((size_t)b * NH + h) * HD + 16 * hpt + fr) * DS;
#pragma unroll
    for (int i = 0; i < 4; ++i) *(f32x4*)(so + 16 * (hnb + i) + 4 * fq) = hacc[i];
    __syncthreads();
    if (tid == 0 && prev_sr >= 0) { float v = 0.f;
#pragma unroll
        for (int i = 0; i < 16; ++i) v += red[i];
        SSQ[(size_t)prev_sr * 32 + prev_sh] = v; }
    __syncthreads();
}
__device__ __forceinline__ void phase_ssd(const Params& p, LAS unsigned char* lds, const int wid) {
    for (int u = blockIdx.x; u < NBP * NH; u += gridDim.x) {
        const int xcd = u & 7, j = u >> 3, pair = xcd * 4 + (j >> 3), hr = j & 7;
        ssd_unit(p, lds, pair >> 2, (pair & 3) * 8 + hr, u, wid);
    }
}
__device__ __forceinline__ void phase_gnorm(const Params& p) {
    bf16_t* YG = (bf16_t*)(p.ws + OFF_YG); const float* SSQ = (const float*)(p.ws + OFF_SSQ);
    for (int i = blockIdx.x * 512 + (int)threadIdx.x; i < MTOT * 256; i += gridDim.x * 512) {
        const int row = i >> 8, cu = i & 255, g = cu >> 6;
        const f32x4 s0 = *(const f32x4*)(SSQ + (size_t)row * 32 + 8 * g), s1 = *(const f32x4*)(SSQ + (size_t)row * 32 + 8 * g + 4);
        const float rstd = rsqrtf(((s0[0] + s0[1]) + (s0[2] + s0[3]) + (s1[0] + s1[1]) + (s1[2] + s1[3])) * (1.f / 512.f) + EPS);
        bf16_t* q = YG + (size_t)row * 2048 + cu * 8;
        const F8 v = ld8bf(q);
        *(u32x4*)q = pack8(v.a * rstd, v.b * rstd);
    }
}

__global__ void __launch_bounds__(512, 2) fwd_megakernel(Params p) {
    extern __shared__ __attribute__((aligned(16))) unsigned char shm[];
    LAS unsigned char* lds = (LAS unsigned char*)shm;
    cg::grid_group grid = cg::this_grid();
    unsigned char* ws = p.ws;
    const int G = gridDim.x, cid = blockIdx.x;
    float* mod = (float*)(ws + OFF_MOD);
    pg8::StaticOrder S;
    volatile LAS unsigned* xst = (volatile LAS unsigned*)(lds + L_XST);
    const int wid0 = __builtin_amdgcn_readfirstlane((int)threadIdx.x >> 6);
    if (tid_of(wid0) == 0) { xst[0] = 0u; xst[1] = 0u; }
    __syncthreads();
    XcdBarrier xb = xcd_barrier_post((unsigned*)(ws + OFF_BAR), xst, wid0);
    unsigned long long ts0 = 0, ts1 = 0;
#define TSTAMP(k) do { if (PROBE_PHASE >= 0) { if ((k) == PROBE_PHASE) ts0 = __builtin_amdgcn_s_memrealtime(); if ((k) == PROBE_PHASE + 1) ts1 = __builtin_amdgcn_s_memrealtime(); } } while (0)
    TSTAMP(0);

    phase0(p, lds, 0, wid0);
    if (p.ws == nullptr) grid.sync();
    GSYNC(); TSTAMP(1);
    if (cid < 24) {
        pg8::Gemm g{(const bf16_t*)(ws + OFF_CA), (const bf16_t*)(ws + OFF_WADA), 256, 6144, 1024};
        EpiF32Bias E{mod, 6144, p.in[I_BADA]};
        S.init(g.M, g.N, 24, cid); pg8::gemm_phase<EpiF32Bias, pg8::StaticOrder, true, true>(lds, g, S, E, wid0);
    } else phase0(p, lds, 1, wid0);
    GSYNC(); TSTAMP(2);
    phase_rownorm<false>(p, p.in[I_N1G], 1024, 0, (bf16_t*)(ws + OFF_U), wid0);
    if (PROBE_EW) phase_rownorm<false>(p, p.in[I_N1G], 1024, 0, (bf16_t*)(ws + OFF_U), wid0);
    GSYNC(); TSTAMP(3);
    {
        pg8::Gemm g{(const bf16_t*)(ws + OFF_U), (const bf16_t*)(ws + OFF_WIN), MPAD, DINP, 1024};
        EpiIn E{(bf16_t*)(ws + OFF_BG), (bf16_t*)(ws + OFF_CI), (bf16_t*)(ws + OFF_Z), (bf16_t*)(ws + OFF_XBC), (bf16_t*)(ws + OFF_GA), (bf16_t*)(ws + OFF_GB), (float*)(ws + OFF_DTRAW)};
        S.init(g.M, g.N, G, cid); pg8::gemm_phase<EpiIn, pg8::StaticOrder, true, true>(lds, g, S, E, wid0);
        if (PROBE_INPROJ) { __syncthreads(); pg8::gemm_phase<EpiIn, pg8::StaticOrder, true, true>(lds, g, S, E, wid0); }
        __syncthreads();
        phase0(p, lds, 2, wid0);
    }
    GSYNC(); TSTAMP(4);
    phase_conv(p, lds, wid0);
    if (PROBE_CONV) { __syncthreads(); phase_conv(p, lds, wid0); }
    GSYNC(); TSTAMP(5);
    {
        pg8::Gemm ga{(const bf16_t*)(ws + OFF_VA), (const bf16_t*)(ws + OFF_WAOUT), MP, 1024, 1024};
        EpiGate<0> Ea{(bf16_t*)(ws + OFF_YA), (const bf16_t*)(ws + OFF_GA), nullptr, 1024};
        S.init(ga.M, ga.N, G, cid); pg8::gemm_phase<EpiGate<0>, pg8::StaticOrder, true, true>(lds, ga, S, Ea, wid0);
        __syncthreads();
        SkGate<0> Sa{(bf16_t*)(ws + OFF_YA), (const bf16_t*)(ws + OFF_GA), nullptr, 1024, nullptr};
        skinny_gemm<4>(lds, (const bf16_t*)(ws + OFF_VA) + (size_t)MP * 1024, (const bf16_t*)(ws + OFF_WAOUT), 1024, 1024, Sa, wid0);
        __syncthreads();
    }
    phase_ssd(p, lds, wid0);
    if (PROBE_SSD) { __syncthreads(); phase_ssd(p, lds, wid0); }
    GSYNC(); TSTAMP(6);
    {
        S.init(MP, 1024, G, cid);
        {
            Unit u0; S.next(0, u0);
            const int t = tid_of(wid0), rl = t >> 1, g0 = (t & 1) * 2;
            const float* sq = (const float*)(ws + OFF_SSQ) + (size_t)(u0.pm * 256 + rl) * 32;
            float r[4];
#pragma unroll
            for (int g = 0; g < 4; ++g) { const f32x4 s0 = *(const f32x4*)(sq + 8 * g), s1 = *(const f32x4*)(sq + 8 * g + 4);
                r[g] = rsqrtf(((s0[0] + s0[1]) + (s0[2] + s0[3]) + (s1[0] + s1[1]) + (s1[2] + s1[3])) * (1.f / 512.f) + EPS); }
            LAS float* rt = (LAS float*)(lds + L_RT);
            if (g0 == 0) { rt[rl * 4 + 0] = r[0] / r[1]; rt[rl * 4 + 1] = r[1] / r[2]; } else { rt[rl * 4 + 2] = r[2] / r[3]; rt[rl * 4 + 3] = r[3]; }
            __syncthreads();
        }
        pg8::Gemm gb{(const bf16_t*)(ws + OFF_YG), (const bf16_t*)(ws + OFF_WBOUT), MP, 1024, 2048};
        EpiGate<1> Eb{(bf16_t*)(ws + OFF_MERGED), (const bf16_t*)(ws + OFF_GB), (const bf16_t*)(ws + OFF_YA), 1024};
        pg8::gemm_phase<EpiGate<1>, pg8::StaticOrder, true, true>(lds, gb, S, Eb, wid0);
        __syncthreads();
        SkGate<1> Sb{(bf16_t*)(ws + OFF_MERGED), (const bf16_t*)(ws + OFF_GB), (const bf16_t*)(ws + OFF_YA), 1024, (const float*)(ws + OFF_SSQ)};
        skinny_gemm<4>(lds, (const bf16_t*)(ws + OFF_YG) + (size_t)MP * 2048, (const bf16_t*)(ws + OFF_WBOUT), 1024, 2048, Sb, wid0);
    }
    GSYNC(); TSTAMP(7);
    {
        pg8::Gemm g{(const bf16_t*)(ws + OFF_MERGED), (const bf16_t*)(ws + OFF_WO), MP, 1024, 1024};
        EpiRes E{(bf16_t*)(ws + OFF_X1), p.in[I_XP], mod + 2048};
        S.init(g.M, g.N, G, cid); pg8::gemm_phase<EpiRes, pg8::StaticOrder, true, true>(lds, g, S, E, wid0);
        __syncthreads();
        SkRes Sk{(bf16_t*)(ws + OFF_X1), p.in[I_XS], mod + 2048};
        skinny_gemm<4>(lds, (const bf16_t*)(ws + OFF_MERGED) + (size_t)MP * 1024, (const bf16_t*)(ws + OFF_WO), 1024, 1024, Sk, wid0);
    }
    GSYNC(); TSTAMP(8);
    phase_rownorm<true>(p, p.in[I_N2G], 4096, 3072, (bf16_t*)(ws + OFF_U), wid0);
    if (PROBE_EW) phase_rownorm<true>(p, p.in[I_N2G], 4096, 3072, (bf16_t*)(ws + OFF_U), wid0);
    GSYNC(); TSTAMP(9);
    {
        pg8::Gemm g{(const bf16_t*)(ws + OFF_U), (const bf16_t*)(ws + OFF_W1), MP, DFF, 1024};
        EpiGate<2> E{(bf16_t*)(ws + OFF_HMID), nullptr, nullptr, DFF};
        S.init(g.M, g.N, G, cid); pg8::gemm_phase<EpiGate<2>, pg8::StaticOrder, true, true>(lds, g, S, E, wid0);
        if (PROBE_MLP1) { __syncthreads(); pg8::gemm_phase<EpiGate<2>, pg8::StaticOrder, true, true>(lds, g, S, E, wid0); }
        __syncthreads();
        SkGate<2> Sk{(bf16_t*)(ws + OFF_HMID), nullptr, nullptr, DFF, nullptr};
        skinny_gemm<1>(lds, (const bf16_t*)(ws + OFF_U) + (size_t)MP * 1024, (const bf16_t*)(ws + OFF_W1), DFF, 1024, Sk, wid0);
    }
    GSYNC(); TSTAMP(10);
    {
        pg8::Gemm g{(const bf16_t*)(ws + OFF_HMID), (const bf16_t*)(ws + OFF_W2), MP, 1024, DFF};
        EpiRes E{(bf16_t*)(ws + OFF_X1), nullptr, mod + 5120};
        S.init(g.M, g.N, G, cid); pg8::gemm_phase<EpiRes, pg8::StaticOrder, true, true>(lds, g, S, E, wid0);
        __syncthreads();
        SkRes Sk{(bf16_t*)(ws + OFF_X1), nullptr, mod + 5120};
        skinny_gemm<4>(lds, (const bf16_t*)(ws + OFF_HMID) + (size_t)MP * DFF, (const bf16_t*)(ws + OFF_W2), 1024, DFF, Sk, wid0);
    }
    GSYNC(); TSTAMP(11);
    phase_final(p, wid0);
    if (PROBE_EW) phase_final(p, wid0);
    TSTAMP(99);
    if (PROBE_PHASE >= 0 && blockIdx.x == 0) { if (ts1 == 0) ts1 = __builtin_amdgcn_s_memrealtime(); const unsigned long long te = __builtin_amdgcn_s_memrealtime(), wait = 4ull * (ts1 - ts0);
        while (__builtin_amdgcn_s_memrealtime() - te < wait) __builtin_amdgcn_s_sleep(8); }
}

extern "C" void kernel_launch(void* const* d_in, const int* in_sizes, int n_in, void* d_out, int out_size, void* d_ws, size_t ws_size, hipStream_t stream) {
    constexpr int LDS_BYTES = LDS_TOTAL;
    static int grid = 0;
    if (grid == 0) {
        if (n_in != 25 || ws_size < WS_END) { fprintf(stderr, "kernel_launch: unexpected n_in %d / ws %zu (need %zu)\n", n_in, ws_size, (size_t)WS_END); grid = -1; return; }
        int dev = 0, cus = 0, per_cu = 0;
        (void)hipGetDevice(&dev);
        (void)hipDeviceGetAttribute(&cus, hipDeviceAttributeMultiprocessorCount, dev);
        if (hipFuncSetAttribute((const void*)fwd_megakernel, hipFuncAttributeMaxDynamicSharedMemorySize, LDS_BYTES) != hipSuccess) { fprintf(stderr, "kernel_launch: hipFuncSetAttribute failed\n"); grid = -1; return; }
        if (hipOccupancyMaxActiveBlocksPerMultiprocessor(&per_cu, (const void*)fwd_megakernel, 512, LDS_BYTES) != hipSuccess || per_cu < 1) { fprintf(stderr, "kernel_launch: occupancy query says %d blocks per CU\n", per_cu); grid = -1; return; }
        if (cus != 256) { fprintf(stderr, "kernel_launch: built for 256 CUs, found %d\n", cus); grid = -1; return; }
        grid = cus;
    }
    if (grid < 0) return;
    Params p{};
    for (int i = 0; i < 25; ++i) p.in[i] = (const float*)d_in[i];
    p.out = (float*)d_out; p.ws = (unsigned char*)d_ws;
    (void)hipMemsetAsync((unsigned char*)d_ws + OFF_BAR, 0, 16384, stream);
    void* args[] = {&p};
    hipError_t e = hipLaunchCooperativeKernel((const void*)fwd_megakernel, dim3(grid), dim3(512), args, LDS_BYTES, stream);
    if (e != hipSuccess) fprintf(stderr, "cooperative launch failed: %s (grid %d)\n", hipGetErrorString(e), grid);
}
```
